# Optimizing an MI355X kernel written in HIP

```python
import jax, jax.numpy as jnp
from jax import lax
import numpy as np

D_MODEL = 2048
BATCH = 1
SEQ = 8192
DEPTH = 1

PLE_DIM = 256
HGRN_HEADS = 8
HGRN_HEAD_DIM = 128
HGRN_WIDTH = HGRN_HEADS * HGRN_HEAD_DIM
HGRN_CHUNK = 64
MOBA_HEADS = 8
MOBA_HEAD_DIM = 128
MOBA_WIDTH = MOBA_HEADS * MOBA_HEAD_DIM
MOBA_BLOCK = 256
MOBA_TOPK = 3
MOBA_QBLOCK = 64
ROPE_THETA = 10000.0
N_GROUPS = 4
EXPERTS_PER_GROUP = 8
N_EXPERTS = N_GROUPS * EXPERTS_PER_GROUP
TOPK_IN_GROUP = 2
D_EXPERT = 512
MOE_ROW_BLOCK = 128
IN_COLS = 4 * HGRN_WIDTH + 3 * MOBA_WIDTH + 2 * D_MODEL
EPS = 1e-6
NEG_INF = -1e30

kernel_name = "hybrid_hgrn2_moba_hmoe_block"


def rmsnorm(x, g):
    x32 = x.astype(jnp.float32)
    y = x32 * lax.rsqrt(jnp.mean(x32 * x32, axis=-1, keepdims=True) + EPS) * g.astype(jnp.float32)
    return y.astype(x.dtype)


def rope(x, positions):
    half = x.shape[-1] // 2
    inv_freq = ROPE_THETA ** (-jnp.arange(half, dtype=jnp.float32) / half)
    ang = positions.astype(jnp.float32)[:, None] * inv_freq[None, :]
    cos = jnp.cos(ang)[None, :, None, :]
    sin = jnp.sin(ang)[None, :, None, :]
    x32 = x.astype(jnp.float32)
    x1, x2 = x32[..., :half], x32[..., half:]
    out = jnp.concatenate([x1 * cos - x2 * sin, x2 * cos + x1 * sin], axis=-1)
    return out.astype(x.dtype)


def hgrn2_mixer(q_raw, f_raw, i_raw, og_raw, lb, norm_g):
    B, T, _ = q_raw.shape
    H, dk, C = HGRN_HEADS, HGRN_HEAD_DIM, HGRN_CHUNK
    nc = T // C
    f32 = jnp.float32
    q = jax.nn.silu(q_raw.astype(f32))
    lb32 = lb.astype(f32)
    log_f = jnp.logaddexp(jnp.log(lb32), jnp.log1p(-lb32) + jax.nn.log_sigmoid(f_raw.astype(f32)))
    k = -jnp.expm1(log_f)
    v = i_raw.astype(f32)

    def to_chunks(a):
        return a.reshape(B, nc, C, H, dk).transpose(1, 0, 3, 2, 4)

    causal = jnp.tril(jnp.ones((C, C), dtype=bool))[:, :, None]

    def step(S, inp):
        qc, kc, vc, gc = inp
        b = jnp.cumsum(gc, axis=2)
        diff = b[:, :, :, None, :] - b[:, :, None, :, :]
        decay = jnp.where(causal, jnp.exp(jnp.where(causal, diff, 0.0)), 0.0)
        scores = jnp.einsum('bhtk,bhsk,bhtsk->bhts', qc, kc, decay)
        o = (jnp.einsum('bhts,bhsv->bhtv', scores, vc)
             + jnp.einsum('bhtk,bhkv->bhtv', qc * jnp.exp(b), S))
        b_last = b[:, :, -1:, :]
        S = (jnp.exp(b_last)[:, :, 0, :, None] * S
             + jnp.einsum('bhsk,bhsv->bhkv', kc * jnp.exp(b_last - b), vc))
        return S, o

    S0 = jnp.zeros((B, H, dk, dk), f32)
    _, o = lax.scan(step, S0, (to_chunks(q), to_chunks(k), to_chunks(v), to_chunks(log_f)))
    o = o.transpose(1, 0, 3, 2, 4).reshape(B, T, H, dk)
    o = o * lax.rsqrt(jnp.mean(o * o, axis=-1, keepdims=True) + EPS) * norm_g.astype(f32)
    o = o.reshape(B, T, H * dk) * jax.nn.silu(og_raw.astype(f32))
    return o.astype(q_raw.dtype)


def moba_mixer(q, k, v):
    B, T, H, hd = q.shape
    BS, QB = MOBA_BLOCK, MOBA_QBLOCK
    f32 = jnp.float32
    nb = -(-T // BS)
    t_pad = nb * BS
    nq = T // QB
    k_sel_n = min(MOBA_TOPK, nb)
    pad = ((0, 0), (0, t_pad - T), (0, 0), (0, 0))
    kbh = jnp.pad(k, pad).reshape(B, nb, BS, H, hd).transpose(0, 3, 1, 2, 4)
    vbh = jnp.pad(v, pad).reshape(B, nb, BS, H, hd).transpose(0, 3, 1, 2, 4)
    k_mean = jnp.mean(kbh.astype(f32), axis=3)
    scale = hd ** -0.5
    bi = jnp.arange(B)[:, None, None, None]
    hi = jnp.arange(H)[None, None, :, None]
    q_chunks = q.reshape(B, nq, QB, H, hd).transpose(1, 0, 2, 3, 4)

    def attend(args):
        qc, ci = args
        q_pos = ci * QB + jnp.arange(QB)
        cur = (ci * QB) // BS
        gate = jnp.einsum('bqhd,bhnd->bqhn', qc.astype(f32), k_mean)
        gate = jnp.where(jnp.arange(nb) < cur, gate, NEG_INF)
        _, sel = lax.top_k(gate, k_sel_n)
        valid = sel < cur
        kg = kbh[bi, hi, sel]
        vg = vbh[bi, hi, sel]
        s_sel = jnp.einsum('bqhd,bqhjsd->bqhjs', qc, kg).astype(f32) * scale
        s_sel = jnp.where(valid[..., None], s_sel, NEG_INF).reshape(B, QB, H, k_sel_n * BS)
        k_own = lax.dynamic_index_in_dim(kbh, cur, axis=2, keepdims=False)
        v_own = lax.dynamic_index_in_dim(vbh, cur, axis=2, keepdims=False)
        s_own = jnp.einsum('bqhd,bhsd->bqhs', qc, k_own).astype(f32) * scale
        key_pos = cur * BS + jnp.arange(BS)
        s_own = jnp.where((key_pos[None, :] <= q_pos[:, None])[None, :, None, :], s_own, NEG_INF)
        probs = jax.nn.softmax(jnp.concatenate([s_sel, s_own], axis=-1), axis=-1).astype(v.dtype)
        p_sel = probs[..., :k_sel_n * BS].reshape(B, QB, H, k_sel_n, BS)
        p_own = probs[..., k_sel_n * BS:]
        return (jnp.einsum('bqhjs,bqhjsd->bqhd', p_sel, vg)
                + jnp.einsum('bqhs,bhsd->bqhd', p_own, v_own))

    o = lax.map(attend, (q_chunks, jnp.arange(nq)))
    return o.transpose(1, 0, 2, 3, 4).reshape(B, T, H * hd)


def hier_moe(h, w_router_group, w_router_expert, w_gate, w_up, w_down):
    B, T, D = h.shape
    N = B * T
    f32 = jnp.float32
    hf = h.reshape(N, D)
    g_logits = (hf @ w_router_group).astype(f32)
    g_probs = jax.nn.softmax(g_logits, axis=-1)
    g_sel = jnp.argmax(g_logits, axis=-1)
    p_group = jnp.take_along_axis(g_probs, g_sel[:, None], axis=-1)
    e_logits = (hf @ w_router_expert).astype(f32).reshape(N, N_GROUPS, EXPERTS_PER_GROUP)
    e_logits = jnp.take_along_axis(e_logits, g_sel[:, None, None], axis=1)[:, 0]
    top_p, top_i = lax.top_k(jax.nn.softmax(e_logits, axis=-1), TOPK_IN_GROUP)
    weights = p_group * top_p / jnp.sum(top_p, axis=-1, keepdims=True)
    eid = g_sel[:, None] * EXPERTS_PER_GROUP + top_i

    R = MOE_ROW_BLOCK
    M = N * TOPK_IN_GROUP
    flat_e = eid.reshape(M).astype(jnp.int32)
    flat_tok = jnp.repeat(jnp.arange(N, dtype=jnp.int32), TOPK_IN_GROUP)
    flat_w = weights.reshape(M)
    order = jnp.argsort(flat_e)
    es, ts, ws = flat_e[order], flat_tok[order], flat_w[order]
    counts = jnp.bincount(flat_e, length=N_EXPERTS).astype(jnp.int32)
    padded = (counts + R - 1) // R * R
    start = jnp.cumsum(counts) - counts
    pad_end = jnp.cumsum(padded)
    pad_start = pad_end - padded
    dest = pad_start[es] + jnp.arange(M, dtype=jnp.int32) - start[es]
    n_blocks = -(-M // R) + N_EXPERTS
    m_pad = n_blocks * R
    tok_pad = jnp.zeros((m_pad,), jnp.int32).at[dest].set(ts)
    w_pad = jnp.zeros((m_pad,), f32).at[dest].set(ws)
    block_expert = jnp.minimum(
        jnp.searchsorted(pad_end, jnp.arange(n_blocks, dtype=jnp.int32) * R, side='right'),
        N_EXPERTS - 1)
    xb = hf[tok_pad].reshape(n_blocks, R, D)

    def expert_block(args):
        xr, e = args
        return (jax.nn.silu(xr @ w_gate[e]) * (xr @ w_up[e])) @ w_down[e]

    yb = lax.map(expert_block, (xb, block_expert)).reshape(m_pad, D)
    y = jnp.zeros((N, D), f32).at[tok_pad].add(yb.astype(f32) * w_pad[:, None])
    return y.reshape(B, T, D).astype(h.dtype)


def setup_inputs(seed: int = 0) -> dict:
    key = jax.random.key(seed)
    ks = jax.random.split(key, 20)
    f32 = jnp.float32
    nrm = lambda k, shape, s: jax.random.normal(k, shape, f32) * s
    gain = lambda k, shape: 1.0 + 0.02 * jax.random.normal(k, shape, f32)
    return {
        "x": nrm(ks[0], (BATCH, SEQ, D_MODEL), 1.0),
        "p": nrm(ks[1], (DEPTH, BATCH, SEQ, PLE_DIM), 1.0),
        "norm_mix_g": gain(ks[2], (DEPTH, D_MODEL)),
        "w_in": nrm(ks[3], (DEPTH, D_MODEL, IN_COLS), D_MODEL ** -0.5),
        "hgrn_lb_raw": nrm(ks[4], (DEPTH + 1, HGRN_WIDTH), 0.5),
        "hgrn_norm_g": gain(ks[5], (DEPTH, HGRN_HEAD_DIM)),
        "w_up_hgrn": nrm(ks[6], (DEPTH, HGRN_WIDTH, D_MODEL), HGRN_WIDTH ** -0.5),
        "w_up_moba": nrm(ks[7], (DEPTH, MOBA_WIDTH, D_MODEL), MOBA_WIDTH ** -0.5),
        "w_out": nrm(ks[8], (DEPTH, D_MODEL, D_MODEL), D_MODEL ** -0.5),
        "norm_ffn_g": gain(ks[9], (DEPTH, D_MODEL)),
        "w_router_group": nrm(ks[10], (DEPTH, D_MODEL, N_GROUPS), D_MODEL ** -0.5),
        "w_router_expert": nrm(ks[11], (DEPTH, D_MODEL, N_EXPERTS), D_MODEL ** -0.5),
        "w_exp_gate": nrm(ks[12], (DEPTH, N_EXPERTS, D_MODEL, D_EXPERT), D_MODEL ** -0.5),
        "w_exp_up": nrm(ks[13], (DEPTH, N_EXPERTS, D_MODEL, D_EXPERT), D_MODEL ** -0.5),
        "w_exp_down": nrm(ks[14], (DEPTH, N_EXPERTS, D_EXPERT, D_MODEL), D_EXPERT ** -0.5),
        "norm_ple_g": gain(ks[15], (DEPTH, D_MODEL)),
        "w_ple_gate": nrm(ks[16], (DEPTH, D_MODEL, D_MODEL), D_MODEL ** -0.5),
        "w_ple_proj": nrm(ks[17], (DEPTH, PLE_DIM, D_MODEL), PLE_DIM ** -0.5),
        "norm_final_g": gain(ks[18], (D_MODEL,)),
    }


def reference(x, p, norm_mix_g, w_in, hgrn_lb_raw, hgrn_norm_g, w_up_hgrn, w_up_moba, w_out,
              norm_ffn_g, w_router_group, w_router_expert, w_exp_gate, w_exp_up, w_exp_down,
              norm_ple_g, w_ple_gate, w_ple_proj, norm_final_g):
    B, T, D = x.shape
    positions = jnp.arange(T)
    lower_bounds = jnp.cumsum(jax.nn.softmax(hgrn_lb_raw.astype(jnp.float32), axis=0), axis=0)
    sizes = [HGRN_WIDTH] * 4 + [MOBA_WIDTH] * 3 + [D_MODEL] * 2
    offsets = []
    acc = 0
    for s in sizes[:-1]:
        acc += s
        offsets.append(acc)
    for i in range(DEPTH):
        h = rmsnorm(x, norm_mix_g[i])
        proj = h @ w_in[i]
        hq, hf_, hi_, hog, mq, mk, mv, gate_a, gate_b = jnp.split(proj, offsets, axis=-1)
        o_hgrn = hgrn2_mixer(hq, hf_, hi_, hog, lower_bounds[i], hgrn_norm_g[i])
        mq = rope(mq.reshape(B, T, MOBA_HEADS, MOBA_HEAD_DIM), positions)
        mk = rope(mk.reshape(B, T, MOBA_HEADS, MOBA_HEAD_DIM), positions)
        mv = mv.reshape(B, T, MOBA_HEADS, MOBA_HEAD_DIM)
        o_moba = moba_mixer(mq, mk, mv)
        merged = (jax.nn.sigmoid(gate_a) * (o_hgrn @ w_up_hgrn[i])
                  + jax.nn.sigmoid(gate_b) * (o_moba @ w_up_moba[i]))
        x = x + merged @ w_out[i]
        x = x + hier_moe(rmsnorm(x, norm_ffn_g[i]), w_router_group[i], w_router_expert[i],
                         w_exp_gate[i], w_exp_up[i], w_exp_down[i])
        hp = rmsnorm(x, norm_ple_g[i])
        x = x + jax.nn.sigmoid(hp @ w_ple_gate[i]) * (p[i] @ w_ple_proj[i])
    return rmsnorm(x, norm_final_g)
```

```cpp
#include <hip/hip_runtime.h>
#include <cstdio>
#include <cstdint>
#include <cmath>

#define GAS __attribute__((address_space(1)))
#define LAS __attribute__((address_space(3)))
typedef unsigned short bf16;
typedef unsigned v4u __attribute__((ext_vector_type(4)));
typedef unsigned v2u __attribute__((ext_vector_type(2)));
typedef float f32x4 __attribute__((ext_vector_type(4)));
typedef float f32x2 __attribute__((ext_vector_type(2)));
typedef short bf16x8 __attribute__((ext_vector_type(8)));

constexpr int T = 8192, D = 2048, HW = 1024, NH = 8, HD = 128, INC = 11264, NE = 32, DE = 512, PLE = 256, NB = 32, BS = 256;
constexpr float EPS = 1e-6f;
constexpr int NWAVES = 8, NTHR = 512;
constexpr int N_PHASES = 14;
#ifndef FP1
#define FP1 1
#endif
#ifndef FP5
#define FP5 1
#endif
#ifndef FP6
#define FP6 1
#endif
#ifndef FP9
#define FP9 1
#endif
#ifndef FP10
#define FP10 1
#endif
#ifndef FP12
#define FP12 1
#endif
#ifndef FHG
#define FHG 1
#endif
#ifndef FMB
#define FMB 1
#endif
#ifndef MK_N_LAUNCHES
#define MK_N_LAUNCHES 1
#endif

constexpr size_t MiB = 1u << 20;
constexpr size_t WS_CTL = 0, CTL_ZERO_BYTES = 64 * 1024;
constexpr size_t WS_TRIG = 2 * MiB;
constexpr size_t WS_KMEAN = 6 * MiB;
constexpr size_t WS_LB = 6 * MiB + 384 * 1024;
constexpr size_t WS_WRT = 6 * MiB + 512 * 1024;
constexpr size_t WS_ROUTE = 7 * MiB;
constexpr size_t WS_ROWSLOT = 8 * MiB;
constexpr size_t WS_PB = 10 * MiB;
constexpr size_t WS_WIN_T = 16 * MiB, WS_WUP_T = 60 * MiB, WS_WOUT_T = 68 * MiB, WS_WPG_T = 76 * MiB, WS_WPP_T = 84 * MiB;
constexpr size_t WS_PP = 86 * MiB;
constexpr size_t WS_GA = 118 * MiB, WS_GB = 150 * MiB;
constexpr size_t WS_QH = 182 * MiB;
constexpr size_t WS_GH = 198 * MiB;
constexpr size_t WS_VH = 230 * MiB, WS_OG = 246 * MiB, WS_MQ = 262 * MiB, WS_MK = 278 * MiB, WS_MV = 294 * MiB;
constexpr size_t WS_H1 = 310 * MiB;
constexpr size_t WS_TMPF = 342 * MiB;
constexpr size_t WS_DEC = 14 * MiB;
constexpr size_t WS_ST = 310 * MiB;
constexpr size_t WS_DS = 342 * MiB;
constexpr size_t WS_PO = 406 * MiB;
constexpr size_t WS_PLSE = 544 * MiB;
constexpr size_t WS_MLIST = 504 * MiB;
constexpr size_t WS_CNTP = 9 * MiB;
constexpr size_t WS_AUP = 472 * MiB;
constexpr size_t WS_MERGED = 504 * MiB;
constexpr size_t WS_HFFN = 310 * MiB;
constexpr size_t WS_XG = 342 * MiB;
constexpr size_t WS_HMOE = 438 * MiB;
constexpr size_t WS_Y = 462 * MiB;
constexpr size_t WS_HP = 342 * MiB;
constexpr size_t WS_WEGU = 118 * MiB;
constexpr size_t WS_WED = 246 * MiB;
constexpr size_t WS_END = 576 * MiB;
constexpr int CW_TMO = 0, CW_CODE = 1;
constexpr int CW_ECNT = 64;
constexpr int CW_MCNT = 128;
constexpr int CW_BAR = 4096;

constexpr int RING_BYTES = 131072;
constexpr int LDSCTL_OFF = RING_BYTES, MISC_OFF = LDSCTL_OFF + 320;
constexpr int LDS_BYTES = 147456;

typedef GAS unsigned gu32;
#define RLX_AGENT __ATOMIC_RELAXED, __HIP_MEMORY_SCOPE_AGENT
#define LDS_WAIT() asm volatile("s_waitcnt lgkmcnt(0)" ::: "memory")
#define VM_WAIT() asm volatile("s_waitcnt vmcnt(0)" ::: "memory")
typedef __bf16 hwbf2 __attribute__((ext_vector_type(2)));
__device__ __forceinline__ unsigned pk2(float lo, float hi) { hwbf2 v; v.x = (__bf16)lo; v.y = (__bf16)hi; return __builtin_bit_cast(unsigned, v); }
__device__ __forceinline__ unsigned f2bf(float f) { return pk2(f, 0.f) & 0xffffu; }
__device__ __forceinline__ float bf2f(unsigned b) { return __builtin_bit_cast(float, b << 16); }
__device__ __forceinline__ float bflo(unsigned w) { return __builtin_bit_cast(float, w << 16); }
__device__ __forceinline__ float bfhi(unsigned w) { return __builtin_bit_cast(float, w & 0xffff0000u); }
__device__ __forceinline__ float sigmoidf_(float x) { return 1.0f / (1.0f + __expf(-x)); }
__device__ __forceinline__ float siluf_(float x) { return x / (1.0f + __expf(-x)); }

#define XB_TMO      128
#define XB_XCNT(j)  (256  + 64 * (j))
#define XB_XSUB(j)  (1280 + 64 * (j))
#define XB_XGEN(j)  (2304 + 64 * (j))
#define XB_TOP      3328
#define XB_TOPGEN   3392
#define XCD_BAR_WORDS 3456
#define XB_SPIN_CAP (1u << 25)
__device__ __forceinline__ unsigned xb_ld(unsigned* p)              { return __hip_atomic_load(p, __ATOMIC_RELAXED, __HIP_MEMORY_SCOPE_AGENT); }
__device__ __forceinline__ unsigned xb_add(unsigned* p, unsigned v) { return __hip_atomic_fetch_add(p, v, __ATOMIC_RELAXED, __HIP_MEMORY_SCOPE_AGENT); }
__device__ __forceinline__ unsigned xb_xcc_id() { return (unsigned)__builtin_amdgcn_s_getreg((3 << 11) | 20) & 0xFu; }
#define XB_SPIN(cond, bar) do { unsigned _sp = 0; while (cond) { __builtin_amdgcn_s_sleep(1); \
    if ((++_sp & 255u) == 0u) { if (xb_ld(&(bar)[XB_TMO])) break; if (_sp > XB_SPIN_CAP) { atomicAdd(&(bar)[XB_TMO], 1u); break; } } } } while (0)
struct XcdBarrier { unsigned* bar; unsigned x; volatile LAS unsigned* st; };
__device__ __forceinline__ XcdBarrier xcd_barrier_post(unsigned* bar, volatile LAS unsigned* st) {
    XcdBarrier b; b.bar = bar; b.x = xb_xcc_id(); b.st = st;
    if (threadIdx.x == 0) (void)xb_add(&bar[XB_XCNT(b.x)], 1u);
    return b;
}
__device__ __forceinline__ void xcd_barrier_complete(unsigned* bar, unsigned x, unsigned& nloc, unsigned& nx) {
    const unsigned G = gridDim.x * gridDim.y * gridDim.z;
    unsigned sum, cnt, mine, sp = 0u;
    for (;;) {
        sum = 0u; cnt = 0u; mine = 0u;
#pragma unroll
        for (unsigned j = 0; j < 16; ++j) { const unsigned c = xb_ld(&bar[XB_XCNT(j)]); sum += c; cnt += (c > 0u) ? 1u : 0u; mine = (j == x) ? c : mine; }
        if (sum == G) break;
        __builtin_amdgcn_s_sleep(1);
        if ((++sp & 255u) == 0u) { if (xb_ld(&bar[XB_TMO])) break; if (sp > XB_SPIN_CAP) { atomicAdd(&bar[XB_TMO], 1u); break; } }
    }
    nloc = mine > 0u ? mine : 1u; nx = cnt > 0u ? cnt : 1u;
}
__device__ __forceinline__ void xcd_barrier(const XcdBarrier& b) {
    asm volatile("s_waitcnt vmcnt(0)" ::: "memory");
    __syncthreads();
    if (threadIdx.x == 0) {
        unsigned* bar = b.bar;
        __builtin_amdgcn_s_waitcnt(0);
        unsigned nloc = b.st[0], nx = b.st[1];
        if (nloc == 0u) { xcd_barrier_complete(bar, b.x, nloc, nx); b.st[0] = nloc; b.st[1] = nx; }
        const unsigned old = xb_add(&bar[XB_XSUB(b.x)], 1u);
        const unsigned gen = old / nloc;
        if (old + 1u == (gen + 1u) * nloc) {
            __builtin_amdgcn_fence(__ATOMIC_RELEASE, "agent");
            asm volatile("s_waitcnt vmcnt(0)" ::: "memory");
            const unsigned og = xb_add(&bar[XB_TOP], 1u);
            const unsigned tg = og / nx;
            if (og + 1u == (tg + 1u) * nx) xb_add(&bar[XB_TOPGEN], 1u);
            else XB_SPIN(xb_ld(&bar[XB_TOPGEN]) == tg, bar);
            __builtin_amdgcn_fence(__ATOMIC_ACQUIRE, "agent");
            xb_add(&bar[XB_XGEN(b.x)], 1u);
            asm volatile("s_waitcnt vmcnt(0)" ::: "memory");
        } else {
            XB_SPIN(xb_ld(&bar[XB_XGEN(b.x)]) == gen, bar);
            __builtin_amdgcn_fence(__ATOMIC_ACQUIRE, "agent");
            asm volatile("s_waitcnt vmcnt(0)" ::: "memory");
        }
    }
    __syncthreads();
}

struct Args { const float* in[19]; float* out; unsigned char* ws; double rfreq[64]; int ph_lo, ph_hi, li, pad; };
enum { I_X = 0, I_P, I_NMIX, I_WIN, I_LBRAW, I_HNG, I_WUH, I_WUM, I_WOUT, I_NFFN, I_WRG, I_WRE, I_WEG, I_WEU, I_WED, I_NPLE, I_WPG, I_WPP, I_NFIN };

struct Frame {
    LAS unsigned char* lds;
    volatile LAS unsigned* MISC;
    gu32* ctl;
    int tid, lane, wave, vcu, G;
    unsigned char* ws;
};

__device__ __forceinline__ int opaque_tid() { int t = threadIdx.x; asm volatile("" : "+v"(t)); return t; }
__device__ __forceinline__ float wave_sum(float v) {
#pragma unroll
    for (int o = 1; o < 64; o <<= 1) v += __shfl_xor(v, o);
    return v;
}
__device__ __forceinline__ float wave_max(float v) {
#pragma unroll
    for (int o = 1; o < 64; o <<= 1) v = fmaxf(v, __shfl_xor(v, o));
    return v;
}

__device__ __forceinline__ void rms_row_to_bf16(int lane, const float* xrow, const float* g, bf16* orow) {
    const f32x4* xr = (const f32x4*)xrow + lane; const f32x4* gr = (const f32x4*)g + lane;
    f32x4 v[8]; float s = 0.f;
#pragma unroll
    for (int j = 0; j < 8; ++j) { v[j] = xr[64 * j]; s += (v[j].x * v[j].x + v[j].y * v[j].y) + (v[j].z * v[j].z + v[j].w * v[j].w); }
    f32x4 g8[8];
#pragma unroll
    for (int j = 0; j < 8; ++j) g8[j] = gr[64 * j];
    const float r = 1.0f / sqrtf(wave_sum(s) * (1.f / D) + EPS);
    unsigned long long* o8 = (unsigned long long*)orow + lane;
#pragma unroll
    for (int j = 0; j < 8; ++j) { const f32x4 gg = g8[j];
        o8[64 * j] = (unsigned long long)pk2(v[j].x * r * gg.x, v[j].y * r * gg.y) | ((unsigned long long)pk2(v[j].z * r * gg.z, v[j].w * r * gg.w) << 32); }
}

__device__ __forceinline__ void sgemm_acc(float (&acc)[8][4], LAS float* As, LAS float* Bs, const bf16* A, int lda, int m0, const float* W, int ldb, int n0, int K, int tid) {
    const int tx = tid & 31, ty = tid >> 5;
    const int ar = tid >> 2, akq = tid & 3;
    for (int k0 = 0; k0 < K; k0 += 16) {
        const v2u av = *(const v2u*)(A + (size_t)(m0 + ar) * lda + k0 + akq * 4);
        const f32x4 bv = *(const f32x4*)(W + (size_t)(k0 + ty) * ldb + n0 + tx * 4);
        __syncthreads();
        As[(akq * 4 + 0) * 132 + ar] = bflo(av.x); As[(akq * 4 + 1) * 132 + ar] = bfhi(av.x);
        As[(akq * 4 + 2) * 132 + ar] = bflo(av.y); As[(akq * 4 + 3) * 132 + ar] = bfhi(av.y);
        *(LAS f32x4*)(Bs + ty * 128 + tx * 4) = bv;
        __syncthreads();
#pragma unroll 4
        for (int kk = 0; kk < 16; ++kk) {
            const f32x4 a0 = *(const LAS f32x4*)(As + kk * 132 + ty * 8), a1 = *(const LAS f32x4*)(As + kk * 132 + ty * 8 + 4);
            const f32x4 b = *(const LAS f32x4*)(Bs + kk * 128 + tx * 4);
            const float a[8] = {a0.x, a0.y, a0.z, a0.w, a1.x, a1.y, a1.z, a1.w};
#pragma unroll
            for (int i = 0; i < 8; ++i) { acc[i][0] += a[i] * b.x; acc[i][1] += a[i] * b.y; acc[i][2] += a[i] * b.z; acc[i][3] += a[i] * b.w; }
        }
    }
    __syncthreads();
}
__device__ __forceinline__ void zero_acc(float (&acc)[8][4]) {
#pragma unroll
    for (int i = 0; i < 8; ++i) { acc[i][0] = 0.f; acc[i][1] = 0.f; acc[i][2] = 0.f; acc[i][3] = 0.f; }
}
__device__ __forceinline__ void st_bf16x4(bf16* p, float a, float b, float c, float d) { v2u w; w.x = pk2(a, b); w.y = pk2(c, d); *(v2u*)p = w; }

__device__ __forceinline__ void inproj_epi(unsigned char* ws, int m, int n, const float (&v)[4]) {
    if (n < 1024) { st_bf16x4((bf16*)(ws + WS_QH) + (size_t)m * HW + n, siluf_(v[0]), siluf_(v[1]), siluf_(v[2]), siluf_(v[3])); }
    else if (n < 2048) { const int c = n - 1024; const f32x4 lb = *(const f32x4*)((const float*)(ws + WS_LB) + c);
        f32x4 o; o.x = __logf(lb.x + (1.f - lb.x) * sigmoidf_(v[0])); o.y = __logf(lb.y + (1.f - lb.y) * sigmoidf_(v[1]));
        o.z = __logf(lb.z + (1.f - lb.z) * sigmoidf_(v[2])); o.w = __logf(lb.w + (1.f - lb.w) * sigmoidf_(v[3]));
        *(f32x4*)((float*)(ws + WS_GH) + (size_t)m * HW + c) = o; }
    else if (n < 3072) { st_bf16x4((bf16*)(ws + WS_VH) + (size_t)m * HW + (n - 2048), v[0], v[1], v[2], v[3]); }
    else if (n < 4096) { st_bf16x4((bf16*)(ws + WS_OG) + (size_t)m * HW + (n - 3072), siluf_(v[0]), siluf_(v[1]), siluf_(v[2]), siluf_(v[3])); }
    else if (n < 6144) { f32x4 o = {v[0], v[1], v[2], v[3]}; *(f32x4*)((float*)(ws + WS_TMPF) + (size_t)m * D + (n - 4096)) = o; }
    else if (n < 7168) { st_bf16x4((bf16*)(ws + WS_MV) + (size_t)m * HW + (n - 6144), v[0], v[1], v[2], v[3]); }
    else if (n < 9216) { st_bf16x4((bf16*)(ws + WS_GA) + (size_t)m * D + (n - 7168), sigmoidf_(v[0]), sigmoidf_(v[1]), sigmoidf_(v[2]), sigmoidf_(v[3])); }
    else { st_bf16x4((bf16*)(ws + WS_GB) + (size_t)m * D + (n - 9216), sigmoidf_(v[0]), sigmoidf_(v[1]), sigmoidf_(v[2]), sigmoidf_(v[3])); }
}


__device__ __forceinline__ void transpose_item(const float* W, int ldw, int k0, int sn0, bf16* WT, int ldt, int drow0, int dcol0, LAS float* scr, int lane) {
#pragma unroll 8
    for (int i = 0; i < 32; ++i) { const int kk = 2 * i + (lane >> 5); scr[kk * 33 + (lane & 31)] = W[(size_t)(k0 + kk) * ldw + sn0 + (lane & 31)]; }
    LDS_WAIT(); asm volatile("" ::: "memory");
    const int c = lane & 7;
#pragma unroll
    for (int j = 0; j < 4; ++j) { const int n = (lane >> 3) + 8 * j; const LAS float* sp = scr + (8 * c) * 33 + n;
        v4u o; o.x = pk2(sp[0 * 33], sp[1 * 33]); o.y = pk2(sp[2 * 33], sp[3 * 33]); o.z = pk2(sp[4 * 33], sp[5 * 33]); o.w = pk2(sp[6 * 33], sp[7 * 33]);
        *(v4u*)(WT + (size_t)(drow0 + n) * ldt + dcol0 + 8 * c) = o; }
    LDS_WAIT(); asm volatile("" ::: "memory");
}
struct TrItem { const float* src; bf16* dst; int ldw, ldt; };
__device__ __forceinline__ void tr_load(f32x4 (&v)[8], const float* src, int ldw, int lane) {
    const int kr = lane >> 3, c4 = 4 * (lane & 7);
#pragma unroll
    for (int i = 0; i < 8; ++i) v[i] = *(const f32x4*)(src + (size_t)(8 * i + kr) * ldw + c4);
}
__device__ __forceinline__ void tr_store(const f32x4 (&v)[8], bf16* dst, int ldt, LAS float* scr, int lane) {
    const int kr = lane >> 3, c4 = 4 * (lane & 7);
#pragma unroll
    for (int i = 0; i < 8; ++i) { LAS float* d = scr + (8 * i + kr) * 33 + c4; d[0] = v[i].x; d[1] = v[i].y; d[2] = v[i].z; d[3] = v[i].w; }
    LDS_WAIT(); asm volatile("" ::: "memory");
    const int c = lane & 7;
#pragma unroll
    for (int j = 0; j < 4; ++j) { const int n = (lane >> 3) + 8 * j; const LAS float* sp = scr + (8 * c) * 33 + n;
        v4u o; o.x = pk2(sp[0 * 33], sp[1 * 33]); o.y = pk2(sp[2 * 33], sp[3 * 33]); o.z = pk2(sp[4 * 33], sp[5 * 33]); o.w = pk2(sp[6 * 33], sp[7 * 33]);
        *(v4u*)(dst + (size_t)n * ldt + 8 * c) = o; }
    LDS_WAIT(); asm volatile("" ::: "memory");
}
#define TR_PIPE(first, N, step, ITEM) do { f32x4 va_[8], vb_[8]; TrItem ia_, ib_; int it_ = (first); \
    if (it_ < (N)) { ia_ = ITEM(it_); tr_load(va_, ia_.src, ia_.ldw, lane); } \
    while (it_ < (N)) { const int i2_ = it_ + (step); \
        if (i2_ < (N)) { ib_ = ITEM(i2_); tr_load(vb_, ib_.src, ib_.ldw, lane); } \
        tr_store(va_, ia_.dst, ia_.ldt, scr, lane); \
        if (i2_ >= (N)) break; \
        const int i3_ = i2_ + (step); \
        if (i3_ < (N)) { ia_ = ITEM(i3_); tr_load(va_, ia_.src, ia_.ldw, lane); } \
        tr_store(vb_, ib_.dst, ib_.ldt, scr, lane); \
        it_ = i3_; } } while (0)

__device__ __forceinline__ int phys2log_inproj(int n0) {
    const int tile = n0 >> 8; if (tile < 16 || tile >= 24) return n0;
    const int p = n0 & 255, bj = p >> 7, q = p & 127, head = 2 * ((tile - 16) & 3) + (q >> 6), d = (q & 63) + 64 * bj, which = (tile - 16) >> 2;
    return 4096 + which * 1024 + head * 128 + d;
}


typedef short v4i16_t __attribute__((ext_vector_type(4)));
__device__ __forceinline__ f32x4 mfma16(bf16x8 a, bf16x8 b, f32x4 c) { return __builtin_amdgcn_mfma_f32_16x16x32_bf16(a, b, c, 0, 0, 0); }
constexpr int HG_RED = 0, HG_BR = 2048, HG_RS = 2560, HG_KT = 4096, HG_VT = HG_KT + 128 * 144, HG_Q1 = HG_VT + 128 * 144, HG_K1 = HG_Q1 + 64 * 272, HG_Q2 = HG_K1 + 64 * 272, HG_P = HG_Q2 + 64 * 272;
static_assert(HG_P + 64 * 144 <= 131072, "hgrn lds");

__device__ __forceinline__ void hgrn_cumsum(const float* G, int col, int qt, LAS float* red, float (&gv)[16], float (&b)[16], float& btot) {
    float run = 0.f;
#pragma unroll
    for (int i = 0; i < 16; ++i) { gv[i] = G[(size_t)(16 * qt + i) * HW + col]; }
#pragma unroll
    for (int i = 0; i < 16; ++i) { run += gv[i]; b[i] = run; }
    red[qt * 128 + col] = run;
    __syncthreads();
    const float r0 = red[col], r1 = red[128 + col], r2 = red[256 + col], r3 = red[384 + col];
    const float pre = (qt > 0 ? r0 : 0.f) + (qt > 1 ? r1 : 0.f) + (qt > 2 ? r2 : 0.f);
    btot = ((r0 + r1) + r2) + r3;
#pragma unroll
    for (int i = 0; i < 16; ++i) b[i] += pre;
}
__device__ __forceinline__ void st_lds_bf16x16(LAS unsigned char* p, const float (&v)[16]) {
    v4u a, b; a.x = pk2(v[0], v[1]); a.y = pk2(v[2], v[3]); a.z = pk2(v[4], v[5]); a.w = pk2(v[6], v[7]); b.x = pk2(v[8], v[9]); b.y = pk2(v[10], v[11]); b.z = pk2(v[12], v[13]); b.w = pk2(v[14], v[15]);
    *(LAS v4u*)p = a; *(LAS v4u*)(p + 16) = b;
}
__device__ __forceinline__ void hgrn_pass_a(unsigned char* ws, LAS unsigned char* lds, int item, int tid) {
    const int c = item >> 3, h = item & 7, col = tid & 127, qt = tid >> 7, lane = tid & 63, w = tid >> 6, t0 = c * 64;
    float gv[16], b[16], btot;
    hgrn_cumsum((const float*)(ws + WS_GH) + (size_t)t0 * HW + h * HD, col, qt, (LAS float*)(lds + HG_RED), gv, b, btot);
    float kt[16], vv[16];
    const bf16* VH = (const bf16*)(ws + WS_VH) + (size_t)(t0 + 16 * qt) * HW + h * HD + col;
#pragma unroll
    for (int i = 0; i < 16; ++i) { kt[i] = (1.f - __expf(gv[i])) * __expf(btot - b[i]); vv[i] = bf2f(VH[(size_t)i * HW]); }
    st_lds_bf16x16(lds + HG_KT + col * 144 + qt * 32, kt); st_lds_bf16x16(lds + HG_VT + col * 144 + qt * 32, vv);
    if (qt == 0) ((float*)(ws + WS_DEC))[(size_t)item * HD + col] = __expf(btot);
    __syncthreads();
    const int fr = lane & 15, fq = lane >> 4;
    const bf16x8 a0 = *(const LAS bf16x8*)(lds + HG_KT + (16 * w + fr) * 144 + fq * 16), a1 = *(const LAS bf16x8*)(lds + HG_KT + (16 * w + fr) * 144 + fq * 16 + 64);
    float* dst = (float*)(ws + WS_DS) + (size_t)item * HD * HD + 16 * w + 4 * fq;
#pragma unroll
    for (int nt = 0; nt < 8; ++nt) {
        const bf16x8 b0 = *(const LAS bf16x8*)(lds + HG_VT + (16 * nt + fr) * 144 + fq * 16), b1 = *(const LAS bf16x8*)(lds + HG_VT + (16 * nt + fr) * 144 + fq * 16 + 64);
        f32x4 acc = {0.f, 0.f, 0.f, 0.f}; acc = mfma16(a0, b0, acc); acc = mfma16(a1, b1, acc);
        *(f32x4*)(dst + (size_t)(16 * nt + fr) * HD) = acc;
    }
    __syncthreads();
}
__device__ __forceinline__ void hgrn_pass_c(unsigned char* ws, LAS unsigned char* lds, const float* ng, int item, int tid) {
    const int c = item >> 3, h = item & 7, col = tid & 127, qt = tid >> 7, lane = tid & 63, w = tid >> 6, t0 = c * 64, fr = lane & 15, fq = lane >> 4;
    const int fr_ = lane & 15, fq_ = lane >> 4, mt_ = w & 3, vh_ = w >> 2;
    bf16 qraw[16], vraw[16];
    { const bf16* QHp = (const bf16*)(ws + WS_QH) + (size_t)(t0 + 16 * qt) * HW + h * HD + col; const bf16* VHp = (const bf16*)(ws + WS_VH) + (size_t)(t0 + 16 * qt) * HW + h * HD + col;
#pragma unroll
      for (int i = 0; i < 16; ++i) { qraw[i] = QHp[(size_t)i * HW]; vraw[i] = VHp[(size_t)i * HW]; } }
    bf16x8 stf[4][4];
    { const bf16* STp = (const bf16*)(ws + WS_ST) + (size_t)item * HD * HD;
#pragma unroll
      for (int nt = 0; nt < 4; ++nt)
#pragma unroll
          for (int ks = 0; ks < 4; ++ks) stf[nt][ks] = *(const bf16x8*)(STp + (size_t)(16 * (4 * vh_ + nt) + fr_) * HD + fq_ * 8 + ks * 32); }
    bf16 ograw[4][4]; float ngv[4];
#pragma unroll
    for (int nt = 0; nt < 4; ++nt) ngv[nt] = ng[16 * (4 * vh_ + nt) + fr_];
#pragma unroll
    for (int r = 0; r < 4; ++r)
#pragma unroll
        for (int nt = 0; nt < 4; ++nt) ograw[r][nt] = ((const bf16*)(ws + WS_OG))[(size_t)(t0 + 16 * mt_ + 4 * fq_ + r) * HW + h * HD + 16 * (4 * vh_ + nt) + fr_];
    float gv[16], b[16], btot;
    hgrn_cumsum((const float*)(ws + WS_GH) + (size_t)t0 * HW + h * HD, col, qt, (LAS float*)(lds + HG_RED), gv, b, btot);
    LAS float* BR = (LAS float*)(lds + HG_BR);
    if (qt == 1) BR[col] = b[15];
    float vv[16];
#pragma unroll
    for (int i = 0; i < 16; ++i) vv[i] = bf2f(vraw[i]);
    st_lds_bf16x16(lds + HG_VT + col * 144 + qt * 32, vv);
    __syncthreads();
    const float bref = BR[col];
    {
#pragma unroll
      for (int i = 0; i < 16; ++i) { const float q = bf2f(qraw[i]); const int s = 16 * qt + i;
          *(LAS bf16*)(lds + HG_Q1 + s * 272 + col * 2) = (bf16)f2bf(q * __expf(b[i] - bref));
          *(LAS bf16*)(lds + HG_Q2 + s * 272 + col * 2) = (bf16)f2bf(q * __expf(b[i]));
          *(LAS bf16*)(lds + HG_K1 + s * 272 + col * 2) = (bf16)f2bf((1.f - __expf(gv[i])) * __expf(bref - b[i])); } }
    __syncthreads();
    {
        const int mt = w >> 1;
#pragma unroll
        for (int u = 0; u < 2; ++u) { const int nt = 2 * (w & 1) + u; f32x4 acc = {0.f, 0.f, 0.f, 0.f};
            if (nt <= mt) {
#pragma unroll
                for (int ks = 0; ks < 4; ++ks) { const bf16x8 a = *(const LAS bf16x8*)(lds + HG_Q1 + (16 * mt + fr) * 272 + fq * 16 + ks * 64), bb = *(const LAS bf16x8*)(lds + HG_K1 + (16 * nt + fr) * 272 + fq * 16 + ks * 64);
                    acc = mfma16(a, bb, acc); } }
            const int sidx = 16 * nt + fr;
#pragma unroll
            for (int r = 0; r < 4; ++r) { const int tr = 16 * mt + 4 * fq + r; const float pv = (nt <= mt && sidx <= tr) ? acc[r] : 0.f;
                *(LAS bf16*)(lds + HG_P + tr * 144 + sidx * 2) = (bf16)f2bf(pv); } }
    }
    __syncthreads();
    const int mt = w & 3, vh = w >> 2;
    f32x4 o[4];
#pragma unroll
    for (int nt = 0; nt < 4; ++nt) { const int vt = 4 * vh + nt; f32x4 acc = {0.f, 0.f, 0.f, 0.f};
#pragma unroll
        for (int ks = 0; ks < 2; ++ks) { const bf16x8 a = *(const LAS bf16x8*)(lds + HG_P + (16 * mt + fr) * 144 + fq * 16 + ks * 64), bb = *(const LAS bf16x8*)(lds + HG_VT + (16 * vt + fr) * 144 + fq * 16 + ks * 64);
            acc = mfma16(a, bb, acc); }
#pragma unroll
        for (int ks = 0; ks < 4; ++ks) { const bf16x8 a = *(const LAS bf16x8*)(lds + HG_Q2 + (16 * mt + fr) * 272 + fq * 16 + ks * 64); const bf16x8 bb = stf[nt][ks];
            acc = mfma16(a, bb, acc); }
        o[nt] = acc; }
    LAS float* RS = (LAS float*)(lds + HG_RS);
#pragma unroll
    for (int r = 0; r < 4; ++r) { float ss = 0.f;
#pragma unroll
        for (int nt = 0; nt < 4; ++nt) ss += o[nt][r] * o[nt][r];
        ss += __shfl_xor(ss, 1); ss += __shfl_xor(ss, 2); ss += __shfl_xor(ss, 4); ss += __shfl_xor(ss, 8);
        if (fr == 0) RS[vh * 64 + 16 * mt + 4 * fq + r] = ss; }
    __syncthreads();
    bf16* AUP = (bf16*)(ws + WS_AUP);
#pragma unroll
    for (int r = 0; r < 4; ++r) { const int tl = 16 * mt + 4 * fq + r; const float rn = 1.0f / sqrtf((RS[tl] + RS[64 + tl]) * (1.f / HD) + EPS);
#pragma unroll
        for (int nt = 0; nt < 4; ++nt) { const int v = 16 * (4 * vh + nt) + fr;
            AUP[(size_t)(t0 + tl) * D + h * HD + v] = (bf16)f2bf(o[nt][r] * rn * ngv[nt] * bf2f(ograw[r][nt])); } }
    __syncthreads();
}
__device__ __forceinline__ void moba_gate_item(unsigned char* ws, LAS unsigned char* lds, int item, int tid) {
    const int h = item >> 5, cur = item & 31, lane = tid & 63;
    if (cur == 0) return;
    LAS float* km = (LAS float*)lds;
    LAS unsigned* lcnt = (LAS unsigned*)(lds + 16384);
    if (tid < NB) lcnt[tid] = 0u;
    { const float* KM = (const float*)(ws + WS_KMEAN);
      for (int i = tid; i < NB * HD; i += NTHR) { const int j = i >> 7, d = i & 127; km[i] = (KM[(size_t)j * HW + h * HD + d] + KM[(size_t)(NB + j) * HW + h * HD + d]) * (1.f / BS); } }
    __syncthreads();
    if (tid < 256) {
        const int t = cur * BS + tid;
        const v4u* qp = (const v4u*)((const bf16*)(ws + WS_MQ) + (size_t)t * HW + h * HD);
        float g[32];
#pragma unroll
        for (int j = 0; j < 32; ++j) g[j] = 0.f;
        for (int dc = 0; dc < 16; ++dc) { const v4u qw = qp[dc]; const float q0 = bflo(qw.x), q1 = bfhi(qw.x), q2 = bflo(qw.y), q3 = bfhi(qw.y), q4 = bflo(qw.z), q5 = bfhi(qw.z), q6 = bflo(qw.w), q7 = bfhi(qw.w);
#pragma unroll
            for (int j = 0; j < 32; ++j) if (j < cur) { const f32x4 k0 = *(const LAS f32x4*)(km + j * 128 + dc * 8), k1 = *(const LAS f32x4*)(km + j * 128 + dc * 8 + 4);
                g[j] += (q0 * k0.x + q1 * k0.y + q2 * k0.z + q3 * k0.w) + (q4 * k1.x + q5 * k1.y + q6 * k1.z + q7 * k1.w); } }
#pragma unroll
        for (int j = 0; j < 32; ++j) if (j >= cur) g[j] = -3.0e38f;
        unsigned* LIST = (unsigned*)(ws + WS_MLIST);
#pragma unroll
        for (int r = 0; r < 3; ++r) {
            float best = g[0]; int bi = 0;
#pragma unroll
            for (int j = 1; j < 32; ++j) if (g[j] > best) { best = g[j]; bi = j; }
#pragma unroll
            for (int j = 0; j < 32; ++j) if (j == bi) g[j] = -3.0e38f;
            if (r < cur) {
                const int pos = (int)__hip_atomic_fetch_add(lcnt + bi, 1u, __ATOMIC_RELAXED, __HIP_MEMORY_SCOPE_WORKGROUP);
                LIST[(size_t)((h * NB + bi) * NB + cur) * 256 + pos] = ((unsigned)t << 2) | (unsigned)(r + 1);
            }
        }
    }
    __syncthreads();
    if (tid < NB) ((int*)(ws + WS_CNTP))[(h * NB + cur) * NB + tid] = (int)lcnt[tid];
    __syncthreads();
}
__device__ __forceinline__ void moba_unit(unsigned char* ws, LAS unsigned char* lds, int h, int j, int cur, bool causal, int g, int n, const LAS int* lst, int tid) {
    const int lane = tid & 63, w = tid >> 6, fr = lane & 15, fq = lane >> 4;
    const bf16* MK = (const bf16*)(ws + WS_MK) + (size_t)(j * BS) * HW + h * HD; const bf16* MV = (const bf16*)(ws + WS_MV) + (size_t)(j * BS) * HW + h * HD;
#pragma unroll
    for (int i = 0; i < 8; ++i) { const int p = i * NTHR + tid, row = p >> 4, ch = p & 15;
        const v4u kv = *(const v4u*)(MK + (size_t)row * HW + ch * 8), vv = *(const v4u*)(MV + (size_t)row * HW + ch * 8);
        *(LAS v4u*)(lds + row * 256 + ((ch ^ (row & 15)) << 4)) = kv; *(LAS v4u*)(lds + 65536 + row * 256 + ((ch ^ ((row & 7) << 1)) << 4)) = vv; }
    int t, slot; bool valid = true;
    if (causal) { t = cur * BS + g * 128 + w * 16 + fr; slot = 0; }
    else { int rr = g * 128 + w * 16 + fr; valid = rr < n; if (!valid) rr = n - 1; rr = rr < 0 ? 0 : (rr > 255 ? 255 : rr); const int e = lst[rr]; t = cur * BS + ((e >> 2) & 255); slot = e & 3; if (slot == 0) valid = false; }
    bf16x8 qa[4];
    { const bf16* qp = (const bf16*)(ws + WS_MQ) + (size_t)t * HW + h * HD + fq * 8;
#pragma unroll
      for (int ks = 0; ks < 4; ++ks) qa[ks] = *(const bf16x8*)(qp + ks * 32); }
    __syncthreads();
    const bool wact = causal || (__builtin_amdgcn_readfirstlane(g * 128 + (tid >> 6) * 16) < n);
    if (wact) {
    const int qidx = g * 128 + w * 16 + fr;
    const int ntmax = causal ? (g * 128 + w * 16 + 15) >> 4 : 15;
    f32x4 acc[16];
#pragma unroll
    for (int nt = 0; nt < 16; ++nt) { acc[nt] = (f32x4){0.f, 0.f, 0.f, 0.f};
        if (nt <= ntmax) { const int row = 16 * nt + fr;
#pragma unroll
            for (int ks = 0; ks < 4; ++ks) { const bf16x8 kf = *(const LAS bf16x8*)(lds + row * 256 + (((4 * ks + fq) ^ fr) << 4)); acc[nt] = mfma16(kf, qa[ks], acc[nt]); }
            if (causal) {
#pragma unroll
                for (int r = 0; r < 4; ++r) if (16 * nt + 4 * fq + r > qidx) acc[nt][r] = -3.0e38f; }
        } else { acc[nt] = (f32x4){-3.0e38f, -3.0e38f, -3.0e38f, -3.0e38f}; } }
    float m = -3.0e38f;
#pragma unroll
    for (int nt = 0; nt < 16; ++nt) m = fmaxf(fmaxf(fmaxf(m, acc[nt][0]), fmaxf(acc[nt][1], acc[nt][2])), acc[nt][3]);
    m = fmaxf(m, __shfl_xor(m, 16)); m = fmaxf(m, __shfl_xor(m, 32));
    const float cexp = 0.08838834764831845f * 1.4426950408889634f; float l = 0.f;
    bf16x8 pa[8];
#pragma unroll
    for (int k2 = 0; k2 < 8; ++k2) { float p[8];
#pragma unroll
        for (int r = 0; r < 4; ++r) { p[r] = __builtin_amdgcn_exp2f((acc[2 * k2][r] - m) * cexp); p[4 + r] = __builtin_amdgcn_exp2f((acc[2 * k2 + 1][r] - m) * cexp); }
        l += ((p[0] + p[1]) + (p[2] + p[3])) + ((p[4] + p[5]) + (p[6] + p[7]));
        v4u pw; pw.x = pk2(p[0], p[1]); pw.y = pk2(p[2], p[3]); pw.z = pk2(p[4], p[5]); pw.w = pk2(p[6], p[7]); pa[k2] = __builtin_bit_cast(bf16x8, pw); }
    l += __shfl_xor(l, 16); l += __shfl_xor(l, 32);
    f32x4 o[8];
    const int gl = fr >> 2, pp = fr & 3;
#pragma unroll
    for (int dt = 0; dt < 8; ++dt) o[dt] = (f32x4){0.f, 0.f, 0.f, 0.f};
#pragma unroll
    for (int k2 = 0; k2 < 8; ++k2) { const int r0 = 32 * k2 + 4 * fq + gl, r1 = r0 + 16;
#pragma unroll
        for (int dt = 0; dt < 8; ++dt) { const int ch = 2 * dt + (pp >> 1);
            const v4i16_t lo = __builtin_amdgcn_ds_read_tr16_b64_v4i16((LAS v4i16_t*)(lds + 65536 + r0 * 256 + ((ch ^ ((r0 & 7) << 1)) << 4) + 8 * (pp & 1)));
            const v4i16_t hi = __builtin_amdgcn_ds_read_tr16_b64_v4i16((LAS v4i16_t*)(lds + 65536 + r1 * 256 + ((ch ^ ((r1 & 7) << 1)) << 4) + 8 * (pp & 1)));
            bf16x8 vf; vf[0] = lo[0]; vf[1] = lo[1]; vf[2] = lo[2]; vf[3] = lo[3]; vf[4] = hi[0]; vf[5] = hi[1]; vf[6] = hi[2]; vf[7] = hi[3];
            o[dt] = mfma16(vf, pa[k2], o[dt]); } }
    const float il = 1.0f / l;
    int t2, slot2; bool valid2 = true;
    if (causal) { t2 = cur * BS + g * 128 + w * 16 + fr; slot2 = 0; }
    else { int rr = g * 128 + w * 16 + fr; valid2 = rr < n; if (!valid2) rr = n - 1; rr = rr < 0 ? 0 : (rr > 255 ? 255 : rr); const int e = lst[rr]; t2 = cur * BS + ((e >> 2) & 255); slot2 = e & 3; if (slot2 == 0) valid2 = false; }
    if (valid2) { bf16* po = (bf16*)(ws + WS_PO) + ((size_t)(t2 * NH + h) * 4 + slot2) * HD + 4 * fq;
#pragma unroll
        for (int dt = 0; dt < 8; ++dt) { v2u wv; wv.x = pk2(o[dt][0] * il, o[dt][1] * il); wv.y = pk2(o[dt][2] * il, o[dt][3] * il); *(v2u*)(po + 16 * dt) = wv; }
        if (fq == 0) ((float*)(ws + WS_PLSE))[((size_t)(t2 * NH + h) * 4 + slot2) * 32] = m * 0.08838834764831845f + __logf(l); }
    }
    __syncthreads();
}

__device__ __forceinline__ void moba_unit2(unsigned char* ws, LAS unsigned char* lds, int h, int j, bool causal, int g, int n, const unsigned short* glist, int tid) {
    const int lane = tid & 63, w = tid >> 6, fr = lane & 15, fq = lane >> 4;
    int t, slot; bool valid = true;
    if (causal) { t = j * BS + g * 128 + w * 16 + fr; slot = 0; }
    else { int rr = g * 128 + w * 16 + fr; valid = rr < n; if (!valid) rr = n - 1; rr = rr < 0 ? 0 : rr; const int e = (int)glist[rr]; t = (e >> 2) & (T - 1); slot = e & 3; if (slot == 0) valid = false; }
    bf16x8 qa[4];
    { const bf16* qp = (const bf16*)(ws + WS_MQ) + (size_t)t * HW + h * HD + fq * 8;
#pragma unroll
      for (int ks = 0; ks < 4; ++ks) qa[ks] = *(const bf16x8*)(qp + ks * 32); }
    __syncthreads();
    const bool wact = causal || (__builtin_amdgcn_readfirstlane(g * 128 + (tid >> 6) * 16) < n);
    if (wact) {
    const int qidx = g * 128 + w * 16 + fr;
    const int ntmax = causal ? (g * 128 + w * 16 + 15) >> 4 : 15;
    f32x4 acc[16];
#pragma unroll
    for (int nt = 0; nt < 16; ++nt) { acc[nt] = (f32x4){0.f, 0.f, 0.f, 0.f};
        if (nt <= ntmax) { const int row = 16 * nt + fr;
#pragma unroll
            for (int ks = 0; ks < 4; ++ks) { const bf16x8 kf = *(const LAS bf16x8*)(lds + row * 256 + (((4 * ks + fq) ^ fr) << 4)); acc[nt] = mfma16(kf, qa[ks], acc[nt]); }
            if (causal) {
#pragma unroll
                for (int r = 0; r < 4; ++r) if (16 * nt + 4 * fq + r > qidx) acc[nt][r] = -3.0e38f; }
        } else { acc[nt] = (f32x4){-3.0e38f, -3.0e38f, -3.0e38f, -3.0e38f}; } }
    float m = -3.0e38f;
#pragma unroll
    for (int nt = 0; nt < 16; ++nt) m = fmaxf(fmaxf(fmaxf(m, acc[nt][0]), fmaxf(acc[nt][1], acc[nt][2])), acc[nt][3]);
    m = fmaxf(m, __shfl_xor(m, 16)); m = fmaxf(m, __shfl_xor(m, 32));
    const float cexp = 0.08838834764831845f * 1.4426950408889634f; float l = 0.f;
    bf16x8 pa[8];
#pragma unroll
    for (int k2 = 0; k2 < 8; ++k2) { float p[8];
#pragma unroll
        for (int r = 0; r < 4; ++r) { p[r] = __builtin_amdgcn_exp2f((acc[2 * k2][r] - m) * cexp); p[4 + r] = __builtin_amdgcn_exp2f((acc[2 * k2 + 1][r] - m) * cexp); }
        l += ((p[0] + p[1]) + (p[2] + p[3])) + ((p[4] + p[5]) + (p[6] + p[7]));
        v4u pw; pw.x = pk2(p[0], p[1]); pw.y = pk2(p[2], p[3]); pw.z = pk2(p[4], p[5]); pw.w = pk2(p[6], p[7]); pa[k2] = __builtin_bit_cast(bf16x8, pw); }
    l += __shfl_xor(l, 16); l += __shfl_xor(l, 32);
    f32x4 o[8];
    const int gl = fr >> 2, pp = fr & 3;
#pragma unroll
    for (int dt = 0; dt < 8; ++dt) o[dt] = (f32x4){0.f, 0.f, 0.f, 0.f};
#pragma unroll
    for (int k2 = 0; k2 < 8; ++k2) { const int r0 = 32 * k2 + 4 * fq + gl, r1 = r0 + 16;
#pragma unroll
        for (int dt = 0; dt < 8; ++dt) { const int ch = 2 * dt + (pp >> 1);
            const v4i16_t lo = __builtin_amdgcn_ds_read_tr16_b64_v4i16((LAS v4i16_t*)(lds + 65536 + r0 * 256 + ((ch ^ ((r0 & 7) << 1)) << 4) + 8 * (pp & 1)));
            const v4i16_t hi = __builtin_amdgcn_ds_read_tr16_b64_v4i16((LAS v4i16_t*)(lds + 65536 + r1 * 256 + ((ch ^ ((r1 & 7) << 1)) << 4) + 8 * (pp & 1)));
            bf16x8 vf; vf[0] = lo[0]; vf[1] = lo[1]; vf[2] = lo[2]; vf[3] = lo[3]; vf[4] = hi[0]; vf[5] = hi[1]; vf[6] = hi[2]; vf[7] = hi[3];
            o[dt] = mfma16(vf, pa[k2], o[dt]); } }
    const float il = 1.0f / l;
    int t2, slot2; bool valid2 = true;
    if (causal) { t2 = j * BS + g * 128 + w * 16 + fr; slot2 = 0; }
    else { int rr = g * 128 + w * 16 + fr; valid2 = rr < n; if (!valid2) rr = n - 1; rr = rr < 0 ? 0 : rr; const int e = (int)glist[rr]; t2 = (e >> 2) & (T - 1); slot2 = e & 3; if (slot2 == 0) valid2 = false; }
    if (valid2) { bf16* po = (bf16*)(ws + WS_PO) + ((size_t)(t2 * NH + h) * 4 + slot2) * HD + 4 * fq;
#pragma unroll
        for (int dt = 0; dt < 8; ++dt) { v2u wv; wv.x = pk2(o[dt][0] * il, o[dt][1] * il); wv.y = pk2(o[dt][2] * il, o[dt][3] * il); *(v2u*)(po + 16 * dt) = wv; }
        if (fq == 0) ((float*)(ws + WS_PLSE))[((size_t)(t2 * NH + h) * 4 + slot2) * 32] = m * 0.08838834764831845f + __logf(l); }
    }
    __syncthreads();
}


constexpr size_t WS_GL = 16 * MiB;
constexpr int MB_RCH = 512;
__device__ __forceinline__ void moba_kv_item(unsigned char* ws, LAS unsigned char* lds, int h, int j, bool causal, const unsigned short* glist, int n, int tid) {
    const int lane = tid & 63, w = tid >> 6, fr = lane & 15, fq = lane >> 4;
    { const bf16* MK = (const bf16*)(ws + WS_MK) + (size_t)(j * BS) * HW + h * HD; const bf16* MV = (const bf16*)(ws + WS_MV) + (size_t)(j * BS) * HW + h * HD;
#pragma unroll
    for (int i = 0; i < 8; ++i) { const int p = i * NTHR + tid, row = p >> 4, ch = p & 15;
        const v4u kv = *(const v4u*)(MK + (size_t)row * HW + ch * 8), vv = *(const v4u*)(MV + (size_t)row * HW + ch * 8);
        *(LAS v4u*)(lds + row * 256 + ((ch ^ (row & 15)) << 4)) = kv; *(LAS v4u*)(lds + 65536 + row * 256 + ((ch ^ ((row & 7) << 1)) << 4)) = vv; } }
    const int ng = (n + 127) >> 7;
#define MKV_FETCH(G) do { int rr_ = (G) * 128 + w * 16 + fr; int ee_; \
        if (causal) ee_ = ((j * BS + rr_) << 2) | 0x8000; \
        else { const bool v_ = rr_ < n; if (!v_) rr_ = n - 1; rr_ = rr_ < 0 ? 0 : rr_; ee_ = (int)glist[rr_]; ee_ = (v_ && (ee_ & 3)) ? (ee_ | 0x8000) : (ee_ & 0x7fff); } \
        e_n = ee_; const bf16* qp_ = (const bf16*)(ws + WS_MQ) + (size_t)((ee_ >> 2) & (T - 1)) * HW + h * HD + fq * 8; \
        _Pragma("unroll") for (int ks_ = 0; ks_ < 4; ++ks_) qn[ks_] = *(const bf16x8*)(qp_ + ks_ * 32); } while (0)
    int e_n; bf16x8 qn[4];
    MKV_FETCH(0);
    __syncthreads();
    for (int g = 0; g < ng; ++g) {
        const int e = e_n; bf16x8 qa[4];
#pragma unroll
        for (int ks = 0; ks < 4; ++ks) qa[ks] = qn[ks];
        if (g + 1 < ng) MKV_FETCH(g + 1);
        const bool wact = causal || (__builtin_amdgcn_readfirstlane(g * 128 + w * 16) < n);
        if (wact) {
    const int qidx = g * 128 + w * 16 + fr;
    const int ntmax = causal ? (g * 128 + w * 16 + 15) >> 4 : 15;
    f32x4 acc[16];
#pragma unroll
    for (int nt = 0; nt < 16; ++nt) { acc[nt] = (f32x4){0.f, 0.f, 0.f, 0.f};
        if (nt <= ntmax) { const int row = 16 * nt + fr;
#pragma unroll
            for (int ks = 0; ks < 4; ++ks) { const bf16x8 kf = *(const LAS bf16x8*)(lds + row * 256 + (((4 * ks + fq) ^ fr) << 4)); acc[nt] = mfma16(kf, qa[ks], acc[nt]); }
            if (causal) {
#pragma unroll
                for (int r = 0; r < 4; ++r) if (16 * nt + 4 * fq + r > qidx) acc[nt][r] = -3.0e38f; }
        } else { acc[nt] = (f32x4){-3.0e38f, -3.0e38f, -3.0e38f, -3.0e38f}; } }
    float m = -3.0e38f;
#pragma unroll
    for (int nt = 0; nt < 16; ++nt) m = fmaxf(fmaxf(fmaxf(m, acc[nt][0]), fmaxf(acc[nt][1], acc[nt][2])), acc[nt][3]);
    m = fmaxf(m, __shfl_xor(m, 16)); m = fmaxf(m, __shfl_xor(m, 32));
    const float cexp = 0.08838834764831845f * 1.4426950408889634f; float l = 0.f;
    bf16x8 pa[8];
#pragma unroll
    for (int k2 = 0; k2 < 8; ++k2) { float p[8];
#pragma unroll
        for (int r = 0; r < 4; ++r) { p[r] = __builtin_amdgcn_exp2f((acc[2 * k2][r] - m) * cexp); p[4 + r] = __builtin_amdgcn_exp2f((acc[2 * k2 + 1][r] - m) * cexp); }
        l += ((p[0] + p[1]) + (p[2] + p[3])) + ((p[4] + p[5]) + (p[6] + p[7]));
        v4u pw; pw.x = pk2(p[0], p[1]); pw.y = pk2(p[2], p[3]); pw.z = pk2(p[4], p[5]); pw.w = pk2(p[6], p[7]); pa[k2] = __builtin_bit_cast(bf16x8, pw); }
    l += __shfl_xor(l, 16); l += __shfl_xor(l, 32);
    f32x4 o[8];
    const int gl = fr >> 2, pp = fr & 3;
#pragma unroll
    for (int dt = 0; dt < 8; ++dt) o[dt] = (f32x4){0.f, 0.f, 0.f, 0.f};
#pragma unroll
    for (int k2 = 0; k2 < 8; ++k2) { const int r0 = 32 * k2 + 4 * fq + gl, r1 = r0 + 16;
#pragma unroll
        for (int dt = 0; dt < 8; ++dt) { const int ch = 2 * dt + (pp >> 1);
            const v4i16_t lo = __builtin_amdgcn_ds_read_tr16_b64_v4i16((LAS v4i16_t*)(lds + 65536 + r0 * 256 + ((ch ^ ((r0 & 7) << 1)) << 4) + 8 * (pp & 1)));
            const v4i16_t hi = __builtin_amdgcn_ds_read_tr16_b64_v4i16((LAS v4i16_t*)(lds + 65536 + r1 * 256 + ((ch ^ ((r1 & 7) << 1)) << 4) + 8 * (pp & 1)));
            bf16x8 vf; vf[0] = lo[0]; vf[1] = lo[1]; vf[2] = lo[2]; vf[3] = lo[3]; vf[4] = hi[0]; vf[5] = hi[1]; vf[6] = hi[2]; vf[7] = hi[3];
            o[dt] = mfma16(vf, pa[k2], o[dt]); } }
    const float il = 1.0f / l;
    if (e & 0x8000) { const int t2 = (e >> 2) & (T - 1), slot2 = e & 3; bf16* po = (bf16*)(ws + WS_PO) + ((size_t)(t2 * NH + h) * 4 + slot2) * HD + 4 * fq;
#pragma unroll
        for (int dt = 0; dt < 8; ++dt) { v2u wv; wv.x = pk2(o[dt][0] * il, o[dt][1] * il); wv.y = pk2(o[dt][2] * il, o[dt][3] * il); *(v2u*)(po + 16 * dt) = wv; }
        if (fq == 0) ((float*)(ws + WS_PLSE))[((size_t)(t2 * NH + h) * 4 + slot2) * 32] = m * 0.08838834764831845f + __logf(l); }
        }
    }
#undef MKV_FETCH
    __syncthreads();
}
__device__ __forceinline__ void moba_gate_lists(unsigned char* ws, gu32* ctl, LAS unsigned char* lds, int h, int cur, int tid) {
    LAS float* km = (LAS float*)lds;
    LAS float* gs = (LAS float*)(lds + 17408);
    LAS unsigned short* lists = (LAS unsigned short*)(lds + 65536);
    LAS int* cnt = (LAS int*)(lds + 61440); LAS int* gbase = cnt + 32;
    unsigned sel = 0xFFFFFFu;
    if (tid < 32) cnt[tid] = 0;
    { const float* KM = (const float*)(ws + WS_KMEAN);
      for (int i = tid; i < NB * HD; i += NTHR) { const int j = i >> 7, d = i & 127; km[j * 132 + d] = (KM[(size_t)j * HW + h * HD + d] + KM[(size_t)(NB + j) * HW + h * HD + d]) * (1.f / BS); } }
    __syncthreads();
    {
        const int lane = tid & 63, w = tid >> 6, fr = lane & 15, fq = lane >> 4;
        f32x4 acc[2][2];
#pragma unroll
        for (int rt = 0; rt < 2; ++rt)
#pragma unroll
            for (int ct = 0; ct < 2; ++ct) acc[rt][ct] = (f32x4){0.f, 0.f, 0.f, 0.f};
        const bf16* qb = (const bf16*)(ws + WS_MQ) + (size_t)(cur * BS + 32 * w + fr) * HW + h * HD + 8 * fq;
#pragma unroll
        for (int J = 0; J < 4; ++J) {
            const v4u q0 = *(const v4u*)(qb + 32 * J), q1 = *(const v4u*)(qb + (size_t)16 * HW + 32 * J);
            const f32x4 k00 = *(const LAS f32x4*)(km + fr * 132 + 32 * J + 8 * fq), k01 = *(const LAS f32x4*)(km + fr * 132 + 32 * J + 8 * fq + 4);
            const f32x4 k10 = *(const LAS f32x4*)(km + (16 + fr) * 132 + 32 * J + 8 * fq), k11 = *(const LAS f32x4*)(km + (16 + fr) * 132 + 32 * J + 8 * fq + 4);
            const float a0[8] = {bflo(q0.x), bfhi(q0.x), bflo(q0.y), bfhi(q0.y), bflo(q0.z), bfhi(q0.z), bflo(q0.w), bfhi(q0.w)};
            const float a1[8] = {bflo(q1.x), bfhi(q1.x), bflo(q1.y), bfhi(q1.y), bflo(q1.z), bfhi(q1.z), bflo(q1.w), bfhi(q1.w)};
            const float b0[8] = {k00.x, k00.y, k00.z, k00.w, k01.x, k01.y, k01.z, k01.w};
            const float b1[8] = {k10.x, k10.y, k10.z, k10.w, k11.x, k11.y, k11.z, k11.w};
#pragma unroll
            for (int s8 = 0; s8 < 8; ++s8) {
                acc[0][0] = __builtin_amdgcn_mfma_f32_16x16x4f32(a0[s8], b0[s8], acc[0][0], 0, 0, 0); acc[0][1] = __builtin_amdgcn_mfma_f32_16x16x4f32(a0[s8], b1[s8], acc[0][1], 0, 0, 0);
                acc[1][0] = __builtin_amdgcn_mfma_f32_16x16x4f32(a1[s8], b0[s8], acc[1][0], 0, 0, 0); acc[1][1] = __builtin_amdgcn_mfma_f32_16x16x4f32(a1[s8], b1[s8], acc[1][1], 0, 0, 0); } }
#pragma unroll
        for (int rt = 0; rt < 2; ++rt)
#pragma unroll
            for (int ct = 0; ct < 2; ++ct)
#pragma unroll
                for (int i = 0; i < 4; ++i) gs[(32 * w + 16 * rt + 4 * fq + i) * 33 + 16 * ct + fr] = acc[rt][ct][i];
    }
    __syncthreads();
    if (tid < 256) {
        const int t = cur * BS + tid;
        float g[32];
#pragma unroll
        for (int j = 0; j < 32; ++j) g[j] = (j < cur) ? gs[tid * 33 + j] : -3.0e38f;
#pragma unroll
        for (int r = 0; r < 3; ++r) {
            float best = g[0]; int bi = 0;
#pragma unroll
            for (int j = 1; j < 32; ++j) if (g[j] > best) { best = g[j]; bi = j; }
#pragma unroll
            for (int j = 0; j < 32; ++j) if (j == bi) g[j] = -3.0e38f;
            if (r < cur) sel = (sel & ~(0xFFu << (8 * r))) | ((unsigned)bi << (8 * r));
        }
#pragma unroll
        for (int r = 0; r < 3; ++r) { const int b = (int)((sel >> (8 * r)) & 255u);
            if (b < 32) { const int pos = (int)__hip_atomic_fetch_add((LAS unsigned*)(cnt + b), 1u, __ATOMIC_RELAXED, __HIP_MEMORY_SCOPE_WORKGROUP); lists[b * 256 + (pos & 255)] = (unsigned short)((t << 2) | (r + 1)); } }
    }
    __syncthreads();
    if (tid < 32) gbase[tid] = (tid < cur && cnt[tid] > 0) ? (int)__hip_atomic_fetch_add((unsigned*)(ctl + CW_MCNT) + h * NB + tid, (unsigned)cnt[tid], RLX_AGENT) : 0;
    __syncthreads();
    { unsigned short* GL = (unsigned short*)(ws + WS_GL);
      for (int i = tid; i < NB * 256; i += NTHR) { const int j = i >> 8, q = i & 255; if (j < cur && q < cnt[j]) GL[(size_t)(h * NB + j) * 8192 + ((gbase[j] + q) & 8191)] = lists[i]; } }
    __syncthreads();
}
#ifndef MBRT
#define MBRT 31
#endif
#ifndef MB_STAGE
#define MB_STAGE 3
#endif
__device__ __forceinline__ void moba_block_item(unsigned char* ws, LAS unsigned char* lds, int h, int cur, int jlo, int jhi, int flags, int tid) {
    unsigned sel = 0xFFFFFFu;
    if (jhi > jlo) {
        LAS float* km = (LAS float*)lds;
        { const float* KM = (const float*)(ws + WS_KMEAN);
          for (int i = tid; i < NB * HD; i += NTHR) { const int j = i >> 7, d = i & 127; km[i] = (KM[(size_t)j * HW + h * HD + d] + KM[(size_t)(NB + j) * HW + h * HD + d]) * (1.f / BS); } }
        __syncthreads();
        if (tid < 256) {
            const int t = cur * BS + tid;
            const v4u* qp = (const v4u*)((const bf16*)(ws + WS_MQ) + (size_t)t * HW + h * HD);
            float g[32];
#pragma unroll
            for (int j = 0; j < 32; ++j) g[j] = 0.f;
            for (int dc = 0; dc < 16; ++dc) { const v4u qw = qp[dc]; const float q0 = bflo(qw.x), q1 = bfhi(qw.x), q2 = bflo(qw.y), q3 = bfhi(qw.y), q4 = bflo(qw.z), q5 = bfhi(qw.z), q6 = bflo(qw.w), q7 = bfhi(qw.w);
#pragma unroll
                for (int j = 0; j < 32; ++j) if (j < cur) { const f32x4 k0 = *(const LAS f32x4*)(km + j * 128 + dc * 8), k1 = *(const LAS f32x4*)(km + j * 128 + dc * 8 + 4);
                    g[j] += (q0 * k0.x + q1 * k0.y + q2 * k0.z + q3 * k0.w) + (q4 * k1.x + q5 * k1.y + q6 * k1.z + q7 * k1.w); } }
#pragma unroll
            for (int j = 0; j < 32; ++j) if (j >= cur) g[j] = -3.0e38f;
#pragma unroll
            for (int r = 0; r < 3; ++r) {
                float best = g[0]; int bi = 0;
#pragma unroll
                for (int j = 1; j < 32; ++j) if (g[j] > best) { best = g[j]; bi = j; }
#pragma unroll
                for (int j = 0; j < 32; ++j) if (j == bi) g[j] = -3.0e38f;
                if (r < cur) sel = (sel & ~(0xFFu << (8 * r))) | ((unsigned)bi << (8 * r));
            }
        }
        __syncthreads();
    }
    LAS int* lc = (LAS int*)(lds + LDSCTL_OFF + 1024); LAS int* lst = lc + 4;
    for (int jj = (flags & 1) ? -2 : jlo; jj < jhi; jj = (jj == -1) ? jlo : jj + 1) {
        const bool causal = jj < 0; const int j = causal ? cur : jj; int n = 256;
        if (!causal) {
            if (tid == 0) *lc = 0;
            __syncthreads();
            if (tid < 256) { const int slot = ((int)(sel & 255u) == j) ? 1 : ((int)((sel >> 8) & 255u) == j) ? 2 : ((int)((sel >> 16) & 255u) == j) ? 3 : 0;
                if (slot) { const int pos = (int)__hip_atomic_fetch_add((LAS unsigned*)lc, 1u, __ATOMIC_RELAXED, __HIP_MEMORY_SCOPE_WORKGROUP); lst[pos] = (tid << 2) | slot; } }
            __syncthreads();
            n = *lc;
        }
        const int g0 = causal ? jj + 2 : 0, g1 = causal ? g0 + 1 : (n + 127) >> 7;
        for (int g = g0; g < g1; ++g) moba_unit(ws, lds, h, j, cur, causal, g, n, lst, tid);
        __syncthreads();
    }
    asm volatile("s_waitcnt vmcnt(0)" ::: "memory"); __syncthreads();
    if (flags & 2) { const bf16* PO = (const bf16*)(ws + WS_PO); const float* PL = (const float*)(ws + WS_PLSE); bf16* AUP = (bf16*)(ws + WS_AUP); const int nv = cur < 3 ? cur : 3;
      for (int idx = tid; idx < BS * 16; idx += NTHR) { const int t = cur * BS + (idx >> 4), dq = idx & 15, th = t * NH + h;
          const float* plp = PL + (size_t)th * 128; float ls[4]; ls[0] = plp[0]; ls[1] = nv > 0 ? plp[32] : 0.f; ls[2] = nv > 1 ? plp[64] : 0.f; ls[3] = nv > 2 ? plp[96] : 0.f;
          float M = ls[0]; if (nv > 0) M = fmaxf(M, ls[1]); if (nv > 1) M = fmaxf(M, ls[2]); if (nv > 2) M = fmaxf(M, ls[3]);
          float wv[4]; wv[0] = __expf(ls[0] - M); wv[1] = nv > 0 ? __expf(ls[1] - M) : 0.f; wv[2] = nv > 1 ? __expf(ls[2] - M) : 0.f; wv[3] = nv > 2 ? __expf(ls[3] - M) : 0.f;
          const float inv = 1.0f / ((wv[0] + wv[1]) + (wv[2] + wv[3]));
          float acc[8] = {0.f, 0.f, 0.f, 0.f, 0.f, 0.f, 0.f, 0.f};
#pragma unroll
          for (int i = 0; i < 4; ++i) if (i <= nv) { const v4u pw = *(const v4u*)(PO + ((size_t)th * 4 + i) * HD + dq * 8); const float wi = wv[i] * inv;
              acc[0] += wi * bflo(pw.x); acc[1] += wi * bfhi(pw.x); acc[2] += wi * bflo(pw.y); acc[3] += wi * bfhi(pw.y); acc[4] += wi * bflo(pw.z); acc[5] += wi * bfhi(pw.z); acc[6] += wi * bflo(pw.w); acc[7] += wi * bfhi(pw.w); }
          v4u ov; ov.x = pk2(acc[0], acc[1]); ov.y = pk2(acc[2], acc[3]); ov.z = pk2(acc[4], acc[5]); ov.w = pk2(acc[6], acc[7]);
          *(v4u*)(AUP + (size_t)t * D + HW + h * HD + dq * 8) = ov; } }
    __syncthreads();
}

namespace pg8 {
#define PG8_LAS __attribute__((address_space(3)))
typedef unsigned short bf16_t;
typedef unsigned u32x4 __attribute__((ext_vector_type(4)));
constexpr int BM = 256, BK = 64, HALF = 128, HTB = HALF * BK * 2, STAGE_BYTES = 8 * HTB, NXCD = 8, WGM = 8;
__host__ __device__ __forceinline__ int lds_byte(int r, int c) { const int st = (r >> 4) * 2 + (c >> 5), rr = r & 15, cc = c & 31, ob = rr * 64 + cc * 2; return st * 1024 + (ob ^ (((ob >> 9) & 1) << 5)); }
__host__ __device__ __forceinline__ void stage_rc(int b, int& R, int& C) { const int st = b / 1024, sb = b % 1024, swz = sb ^ (((sb >> 9) & 1) << 5); R = (st >> 1) * 16 + swz / 64; C = (st & 1) * 32 + (swz % 64) / 2; }
__host__ __device__ __forceinline__ int perm32(int rho) { const int n = rho >> 4, i = rho & 15; return 8 * (i >> 2) + 4 * n + (i & 3); }
struct Unit { int pm, pn; };
struct Gemm { const bf16_t* A; const bf16_t* Bt; int lda, ldb, K; };
struct StaticOrder {
    int nM, nN, nwg, G, c;
    __host__ __device__ void init(int M, int N, int G_, int c_) { nM = M / BM; nN = N / BM; nwg = nM * nN; G = G_; c = c_; }
    __host__ __device__ bool next(int i, Unit& u) const {
        const long L = (long)i * G + c; if (L >= nwg) return false;
        int wgid = (int)L; { const int q = nwg / NXCD, r = nwg % NXCD, xcd = wgid % NXCD, off = wgid / NXCD; wgid = (xcd < r ? xcd * (q + 1) : r * (q + 1) + (xcd - r) * q) + off; }
        const int nig = WGM * nN, gid = wgid / nig, fm = gid * WGM, gsz = (nM - fm) < WGM ? (nM - fm) : WGM;
        u.pm = fm + ((wgid % nig) % gsz); u.pn = (wgid % nig) / gsz; return true;
    }
    __device__ __forceinline__ void a_ready(const Unit&) const {}
    __device__ __forceinline__ void done(const Unit&) const {}
};
struct MoeOrder {
    const PG8_LAS int* pstart; int npn, G, c;
    __device__ bool next(int i, Unit& u) const {
        const int L = i * G + c, ntile = pstart[32] >> 8; if (L >= ntile * npn) return false;
        const int tile = L / npn, pnl = L % npn; int e = 0;
        for (int q = 1; q < 32; ++q) if (pstart[q] <= tile * 256) e = q;
        u.pm = tile; u.pn = e * npn + pnl; return true;
    }
    __device__ __forceinline__ void a_ready(const Unit&) const {}
    __device__ __forceinline__ void done(const Unit&) const {}
};
__device__ __forceinline__ unsigned cvt_pk_bf16(float lo, float hi) { unsigned r; asm volatile("v_cvt_pk_bf16_f32 %0, %1, %2" : "=v"(r) : "v"(lo), "v"(hi)); return r; }
__device__ __forceinline__ u32x4 pack8(const f32x4& a, const f32x4& b) { u32x4 w; w.x = cvt_pk_bf16(a[0], a[1]); w.y = cvt_pk_bf16(a[2], a[3]); w.z = cvt_pk_bf16(b[0], b[1]); w.w = cvt_pk_bf16(b[2], b[3]); return w; }
__device__ __forceinline__ float bl(unsigned w) { return __builtin_bit_cast(float, w << 16); }
__device__ __forceinline__ float bh(unsigned w) { return __builtin_bit_cast(float, w & 0xffff0000u); }
__device__ __forceinline__ f32x4 sig4(const f32x4& v) { f32x4 o; for (int i = 0; i < 4; ++i) o[i] = __builtin_amdgcn_rcpf(1.0f + __expf(-v[i])); return o; }
__device__ __forceinline__ f32x4 silu4(const f32x4& v) { f32x4 o; for (int i = 0; i < 4; ++i) o[i] = v[i] * __builtin_amdgcn_rcpf(1.0f + __expf(-v[i])); return o; }

struct EpiInProj {
    static constexpr bool PERM = true, AFTER_DRAIN = false, HAS_MID = false;
    unsigned char* ws;
    __device__ __forceinline__ void mid(f32x4 (&)[2][2][4][2], const Unit&, int, int, int, int) const {}
    __device__ __forceinline__ void operator()(const f32x4 (&acc)[2][2][4][2], const Unit& u, int wr, int wc, int fr, int fq) const {
        const int pn = u.pn, row0 = u.pm * BM + wr * 64 + fr, cl = wc * 32 + 8 * fq;
        if (pn >= 16 && pn < 24) {
            const int which = (pn - 16) >> 2, head = 2 * ((pn - 16) & 3) + (wc >> 1), d = (wc & 1) * 32 + 8 * fq;
            bf16_t* dst = (bf16_t*)(ws + (which ? WS_MK : WS_MQ)) + head * HD + d;
            const f32x2* trig = (const f32x2*)(ws + WS_TRIG) + d;
            float cs[16];
#pragma unroll
            for (int i = 0; i < 16; ++i) cs[i] = 0.f;
#pragma unroll
            for (int ai = 0; ai < 2; ++ai)
#pragma unroll
                for (int mp = 0; mp < 2; ++mp) {
                    f32x4 tg[2][4];
#pragma unroll
                    for (int mm = 0; mm < 2; ++mm) { const f32x4* tp = (const f32x4*)(trig + (size_t)(row0 + ai * HALF + (2 * mp + mm) * 16) * 64);
#pragma unroll
                        for (int q = 0; q < 4; ++q) tg[mm][q] = tp[q]; }
#pragma unroll
                    for (int mm = 0; mm < 2; ++mm) { const int m = 2 * mp + mm, row = row0 + ai * HALF + m * 16;
                    u32x4 wl, wh;
                    { const f32x4 t0 = tg[mm][0], t1 = tg[mm][1]; const f32x4 x1a = acc[ai][0][m][0], x2a = acc[ai][1][m][0]; f32x4 la, ha;
                      la[0] = x1a[0] * t0[0] - x2a[0] * t0[1]; ha[0] = x2a[0] * t0[0] + x1a[0] * t0[1];
                      la[1] = x1a[1] * t0[2] - x2a[1] * t0[3]; ha[1] = x2a[1] * t0[2] + x1a[1] * t0[3];
                      la[2] = x1a[2] * t1[0] - x2a[2] * t1[1]; ha[2] = x2a[2] * t1[0] + x1a[2] * t1[1];
                      la[3] = x1a[3] * t1[2] - x2a[3] * t1[3]; ha[3] = x2a[3] * t1[2] + x1a[3] * t1[3];
                      wl.x = cvt_pk_bf16(la[0], la[1]); wl.y = cvt_pk_bf16(la[2], la[3]); wh.x = cvt_pk_bf16(ha[0], ha[1]); wh.y = cvt_pk_bf16(ha[2], ha[3]);
                      if (which) {
#pragma unroll
                          for (int i = 0; i < 4; ++i) { cs[i] += la[i]; cs[8 + i] += ha[i]; } } }
                    { const f32x4 t2 = tg[mm][2], t3 = tg[mm][3]; const f32x4 x1b = acc[ai][0][m][1], x2b = acc[ai][1][m][1]; f32x4 lb_, hb;
                      lb_[0] = x1b[0] * t2[0] - x2b[0] * t2[1]; hb[0] = x2b[0] * t2[0] + x1b[0] * t2[1];
                      lb_[1] = x1b[1] * t2[2] - x2b[1] * t2[3]; hb[1] = x2b[1] * t2[2] + x1b[1] * t2[3];
                      lb_[2] = x1b[2] * t3[0] - x2b[2] * t3[1]; hb[2] = x2b[2] * t3[0] + x1b[2] * t3[1];
                      lb_[3] = x1b[3] * t3[2] - x2b[3] * t3[3]; hb[3] = x2b[3] * t3[2] + x1b[3] * t3[3];
                      wl.z = cvt_pk_bf16(lb_[0], lb_[1]); wl.w = cvt_pk_bf16(lb_[2], lb_[3]); wh.z = cvt_pk_bf16(hb[0], hb[1]); wh.w = cvt_pk_bf16(hb[2], hb[3]);
                      if (which) {
#pragma unroll
                          for (int i = 0; i < 4; ++i) { cs[4 + i] += lb_[i]; cs[12 + i] += hb[i]; } } }
                    *(u32x4*)(dst + (size_t)row * HW) = wl; *(u32x4*)(dst + (size_t)row * HW + 64) = wh; }
                    asm volatile("" ::: "memory"); }
            if (which) {
                float* ks = (float*)(ws + WS_KMEAN) + (size_t)(wr * NB + u.pm) * HW + head * HD + d;
#pragma unroll
                for (int i = 0; i < 16; ++i) { float v = cs[i]; v += __shfl_xor(v, 1); v += __shfl_xor(v, 2); v += __shfl_xor(v, 4); v += __shfl_xor(v, 8);
                    if (fr == 0) ks[(i & 7) + 64 * (i >> 3)] = v; }
            }
            return;
        }
        int kind, ld; size_t base; int colb;
        if (pn < 4) { kind = 1; base = WS_QH; ld = HW; colb = pn * 256; }
        else if (pn < 8) { kind = 3; base = WS_GH; ld = HW; colb = (pn - 4) * 256; }
        else if (pn < 12) { kind = 0; base = WS_VH; ld = HW; colb = (pn - 8) * 256; }
        else if (pn < 16) { kind = 1; base = WS_OG; ld = HW; colb = (pn - 12) * 256; }
        else if (pn < 28) { kind = 0; base = WS_MV; ld = HW; colb = (pn - 24) * 256; }
        else if (pn < 36) { kind = 2; base = WS_GA; ld = D; colb = (pn - 28) * 256; }
        else { kind = 2; base = WS_GB; ld = D; colb = (pn - 36) * 256; }
        if (kind == 3) {
            const float* lbp = (const float*)(ws + WS_LB) + colb + cl; float* dst = (float*)(ws + base) + colb + cl;
#pragma unroll
            for (int bj = 0; bj < 2; ++bj) { const f32x4 l0 = *(const f32x4*)(lbp + bj * HALF), l1 = *(const f32x4*)(lbp + bj * HALF + 4);
#pragma unroll
                for (int ai = 0; ai < 2; ++ai)
#pragma unroll
                    for (int m = 0; m < 4; ++m) { const int row = row0 + ai * HALF + m * 16; const f32x4 s0 = sig4(acc[ai][bj][m][0]), s1 = sig4(acc[ai][bj][m][1]); f32x4 o0, o1;
#pragma unroll
                        for (int i = 0; i < 4; ++i) { o0[i] = __logf(l0[i] + (1.f - l0[i]) * s0[i]); o1[i] = __logf(l1[i] + (1.f - l1[i]) * s1[i]); }
                        float* p = dst + (size_t)row * ld + bj * HALF; *(f32x4*)p = o0; *(f32x4*)(p + 4) = o1; } }
            return;
        }
        bf16_t* dst = (bf16_t*)(ws + base) + colb + cl;
#pragma unroll
        for (int ai = 0; ai < 2; ++ai)
#pragma unroll
            for (int m = 0; m < 4; ++m) { const int row = row0 + ai * HALF + m * 16;
#pragma unroll
                for (int bj = 0; bj < 2; ++bj) { f32x4 v0 = acc[ai][bj][m][0], v1 = acc[ai][bj][m][1];
                    if (kind == 1) { v0 = silu4(v0); v1 = silu4(v1); } else if (kind == 2) { v0 = sig4(v0); v1 = sig4(v1); }
                    *(u32x4*)(dst + (size_t)row * ld + bj * HALF) = pack8(v0, v1); } }
    }
};
struct EpiBf16Plain {
    static constexpr bool PERM = true, AFTER_DRAIN = false, HAS_MID = false;
    bf16_t* O; int ld;
    __device__ __forceinline__ void mid(f32x4 (&)[2][2][4][2], const Unit&, int, int, int, int) const {}
    __device__ __forceinline__ void operator()(const f32x4 (&acc)[2][2][4][2], const Unit& u, int wr, int wc, int fr, int fq) const {
        const int row0 = u.pm * BM + wr * 64 + fr, col0 = u.pn * BM + wc * 32 + 8 * fq;
#pragma unroll
        for (int ai = 0; ai < 2; ++ai)
#pragma unroll
            for (int m = 0; m < 4; ++m)
#pragma unroll
                for (int bj = 0; bj < 2; ++bj) *(u32x4*)(O + (size_t)(row0 + ai * HALF + m * 16) * ld + col0 + bj * HALF) = pack8(acc[ai][bj][m][0], acc[ai][bj][m][1]);
    }
};
template <int PASS> struct EpiUp {
    static constexpr bool PERM = true, AFTER_DRAIN = false, HAS_MID = false;
    const bf16_t* GT; bf16_t* O;
    __device__ __forceinline__ void mid(f32x4 (&)[2][2][4][2], const Unit&, int, int, int, int) const {}
    __device__ __forceinline__ void operator()(const f32x4 (&acc)[2][2][4][2], const Unit& u, int wr, int wc, int fr, int fq) const {
        const int row0 = u.pm * BM + wr * 64 + fr, col0 = u.pn * BM + wc * 32 + 8 * fq;
#pragma unroll
        for (int ai = 0; ai < 2; ++ai)
#pragma unroll
            for (int m = 0; m < 4; ++m) {
#pragma unroll
                for (int bj = 0; bj < 2; ++bj) { const size_t off = (size_t)(row0 + ai * HALF + m * 16) * D + col0 + bj * HALF; const u32x4 b = *(const u32x4*)(GT + off);
                    f32x4 v0 = acc[ai][bj][m][0], v1 = acc[ai][bj][m][1];
                    v0[0] *= bl(b.x); v0[1] *= bh(b.x); v0[2] *= bl(b.y); v0[3] *= bh(b.y); v1[0] *= bl(b.z); v1[1] *= bh(b.z); v1[2] *= bl(b.w); v1[3] *= bh(b.w);
                    if (PASS == 1) { const u32x4 p = *(const u32x4*)(O + off);
                        v0[0] += bl(p.x); v0[1] += bh(p.x); v0[2] += bl(p.y); v0[3] += bh(p.y); v1[0] += bl(p.z); v1[1] += bh(p.z); v1[2] += bl(p.w); v1[3] += bh(p.w); }
                    *(u32x4*)(O + off) = pack8(v0, v1); }
                asm volatile("" ::: "memory"); }
    }
};
struct EpiUp2 {
    static constexpr bool PERM = true, AFTER_DRAIN = false, HAS_MID = true;
    const bf16_t* GA; const bf16_t* GB; bf16_t* O;
    __device__ __forceinline__ void mid(f32x4 (&acc)[2][2][4][2], const Unit& u, int wr, int wc, int fr_, int fq_) const {
        int fr = fr_, fq = fq_; asm volatile("" : "+v"(fr), "+v"(fq));
        const int row0 = u.pm * BM + wr * 64 + fr, col0 = u.pn * BM + wc * 32 + 8 * fq;
#pragma unroll
        for (int ai = 0; ai < 2; ++ai) {
#pragma unroll
            for (int m = 0; m < 4; ++m) {
#pragma unroll
                for (int bj = 0; bj < 2; ++bj) { const size_t off = (size_t)(row0 + ai * HALF + m * 16) * D + col0 + bj * HALF; const u32x4 a = *(const u32x4*)(GA + off), b = *(const u32x4*)(GB + off);
                    const float lo = 8.673617379884035e-19f;
                    acc[ai][bj][m][0][0] *= bl(a.x) * __builtin_amdgcn_rcpf(fmaxf(bl(b.x), lo)); acc[ai][bj][m][0][1] *= bh(a.x) * __builtin_amdgcn_rcpf(fmaxf(bh(b.x), lo));
                    acc[ai][bj][m][0][2] *= bl(a.y) * __builtin_amdgcn_rcpf(fmaxf(bl(b.y), lo)); acc[ai][bj][m][0][3] *= bh(a.y) * __builtin_amdgcn_rcpf(fmaxf(bh(b.y), lo));
                    acc[ai][bj][m][1][0] *= bl(a.z) * __builtin_amdgcn_rcpf(fmaxf(bl(b.z), lo)); acc[ai][bj][m][1][1] *= bh(a.z) * __builtin_amdgcn_rcpf(fmaxf(bh(b.z), lo));
                    acc[ai][bj][m][1][2] *= bl(a.w) * __builtin_amdgcn_rcpf(fmaxf(bl(b.w), lo)); acc[ai][bj][m][1][3] *= bh(a.w) * __builtin_amdgcn_rcpf(fmaxf(bh(b.w), lo)); }
                asm volatile("" ::: "memory"); } }
    }
    __device__ __forceinline__ void operator()(const f32x4 (&acc)[2][2][4][2], const Unit& u, int wr, int wc, int fr, int fq) const {
        const int row0 = u.pm * BM + wr * 64 + fr, col0 = u.pn * BM + wc * 32 + 8 * fq;
        const float lo = 8.673617379884035e-19f;
#pragma unroll
        for (int ai = 0; ai < 2; ++ai) {
            u32x4 gb[4][2];
#pragma unroll
            for (int m = 0; m < 4; ++m)
#pragma unroll
                for (int bj = 0; bj < 2; ++bj) gb[m][bj] = *(const u32x4*)(GB + (size_t)(row0 + ai * HALF + m * 16) * D + col0 + bj * HALF);
#pragma unroll
            for (int m = 0; m < 4; ++m)
#pragma unroll
                for (int bj = 0; bj < 2; ++bj) { const size_t off = (size_t)(row0 + ai * HALF + m * 16) * D + col0 + bj * HALF; const u32x4 b = gb[m][bj];
                    f32x4 v0 = acc[ai][bj][m][0], v1 = acc[ai][bj][m][1];
                    v0[0] *= fmaxf(bl(b.x), lo); v0[1] *= fmaxf(bh(b.x), lo); v0[2] *= fmaxf(bl(b.y), lo); v0[3] *= fmaxf(bh(b.y), lo); v1[0] *= fmaxf(bl(b.z), lo); v1[1] *= fmaxf(bh(b.z), lo); v1[2] *= fmaxf(bl(b.w), lo); v1[3] *= fmaxf(bh(b.w), lo);
                    *(u32x4*)(O + off) = pack8(v0, v1); }
            asm volatile("" ::: "memory"); }
    }
};
template <int MODE  > struct EpiResid {
    static constexpr bool PERM = false, AFTER_DRAIN = false, HAS_MID = false;
    static constexpr int RG = (MODE == 0) ? 4 : 2;
    const float* base; float* out; const bf16_t* PP;
    __device__ __forceinline__ void mid(f32x4 (&)[2][2][4][2], const Unit&, int, int, int, int) const {}
    __device__ __forceinline__ void operator()(const f32x4 (&acc)[2][2][4][2], const Unit& u, int wr, int wc, int fr, int fq) const {
        const int row0 = u.pm * BM + wr * 64 + fr, col0 = u.pn * BM + wc * 32 + 4 * fq;
#pragma unroll
        for (int ai = 0; ai < 2; ++ai)
#pragma unroll
            for (int mp = 0; mp < 4 / RG; ++mp) {
                f32x4 bs[RG][2][2]; v2u pw[RG][2][2];
#pragma unroll
                for (int mm = 0; mm < RG; ++mm)
#pragma unroll
                    for (int bj = 0; bj < 2; ++bj)
#pragma unroll
                        for (int n = 0; n < 2; ++n) { const size_t off = (size_t)(row0 + ai * HALF + (RG * mp + mm) * 16) * D + col0 + bj * HALF + n * 16; bs[mm][bj][n] = *(const f32x4*)(base + off);
                            if (MODE == 1) pw[mm][bj][n] = *(const v2u*)(PP + off); }
#pragma unroll
                for (int mm = 0; mm < RG; ++mm)
#pragma unroll
                    for (int bj = 0; bj < 2; ++bj)
#pragma unroll
                        for (int n = 0; n < 2; ++n) { const size_t off = (size_t)(row0 + ai * HALF + (RG * mp + mm) * 16) * D + col0 + bj * HALF + n * 16; f32x4 v = acc[ai][bj][RG * mp + mm][n];
                            if (MODE == 1) { const unsigned p0 = pw[mm][bj][n].x, p1 = pw[mm][bj][n].y; v = sig4(v); v[0] *= bl(p0); v[1] *= bh(p0); v[2] *= bl(p1); v[3] *= bh(p1); }
                            *(f32x4*)(out + off) = bs[mm][bj][n] + v; }
                asm volatile("" ::: "memory"); }
    }
};
struct EpiMoe1 {
    static constexpr bool PERM = true, AFTER_DRAIN = false, HAS_MID = false;
    bf16_t* H;
    __device__ __forceinline__ void mid(f32x4 (&)[2][2][4][2], const Unit&, int, int, int, int) const {}
    __device__ __forceinline__ void operator()(const f32x4 (&acc)[2][2][4][2], const Unit& u, int wr, int wc, int fr, int fq) const {
        const int row0 = u.pm * BM + wr * 64 + fr, col0 = (u.pn & 3) * 128 + wc * 32 + 8 * fq;
#pragma unroll
        for (int ai = 0; ai < 2; ++ai)
#pragma unroll
            for (int m = 0; m < 4; ++m) { const f32x4 g0 = silu4(acc[ai][0][m][0]), g1 = silu4(acc[ai][0][m][1]);
                *(u32x4*)(H + (size_t)(row0 + ai * HALF + m * 16) * DE + col0) = pack8(g0 * acc[ai][1][m][0], g1 * acc[ai][1][m][1]); }
    }
};
struct EpiMoe2 {
    static constexpr bool PERM = true, AFTER_DRAIN = false, HAS_MID = false;
    bf16_t* Y; const int* rowslot; const PG8_LAS int* pstart;
    __device__ __forceinline__ void mid(f32x4 (&)[2][2][4][2], const Unit&, int, int, int, int) const {}
    __device__ __forceinline__ void operator()(const f32x4 (&acc)[2][2][4][2], const Unit& u, int wr, int wc, int fr, int fq) const {
        const int row0 = u.pm * BM + wr * 64 + fr, col0 = (u.pn & 7) * 256 + wc * 32 + 8 * fq;
        const int e = u.pn >> 3, ps = pstart[e], pc = pstart[40 + e];
        int slot[2][4];
#pragma unroll
        for (int ai = 0; ai < 2; ++ai)
#pragma unroll
            for (int m = 0; m < 4; ++m) { const int prow = row0 + ai * HALF + m * 16; slot[ai][m] = (prow - ps < pc) ? __hip_atomic_load((int*)rowslot + prow, RLX_AGENT) : -1; }
#pragma unroll
        for (int ai = 0; ai < 2; ++ai)
#pragma unroll
            for (int m = 0; m < 4; ++m) if (slot[ai][m] >= 0) {
#pragma unroll
                for (int bj = 0; bj < 2; ++bj) *(u32x4*)(Y + (size_t)slot[ai][m] * D + col0 + bj * HALF) = pack8(acc[ai][bj][m][0], acc[ai][bj][m][1]); }
    }
};

template <class Epi, class Sched, bool ALIGN_EPI = false, bool SP2 = false>
__device__ __forceinline__ void gemm_phase(PG8_LAS unsigned char* lds, const Gemm g, const Sched& S, const Epi& E) {
    const int tid = threadIdx.x, wid = __builtin_amdgcn_readfirstlane(tid >> 6), lane = tid & 63, wr = wid >> 2, wc = wid & 3, fr = lane & 15, fq = lane >> 4;
    const int K = g.K, nt = K / BK;
    unsigned voffA[2], voffB[2];
#pragma unroll
    for (int i = 0; i < 2; ++i) { int R, C; stage_rc(tid * 16 + i * 8192, R, C); const int Rb = Epi::PERM ? ((R & ~31) + perm32(R & 31)) : R;
        voffA[i] = (unsigned)(R * g.lda + C) * 2u; voffB[i] = (unsigned)(Rb * g.ldb + C) * 2u; }
    const size_t kstep = (size_t)(BK * 2);
    const size_t hstepA = (size_t)HALF * g.lda * 2, hstepB = (size_t)HALF * g.ldb * 2;
    const size_t tstepA = 2 * hstepA, tstepB = 2 * hstepB;
    const unsigned ldsw = (unsigned)wid * 1024u;
    const int aoff = lds_byte(wr * 64 + fr, fq * 8), boff = lds_byte(wc * 32 + fr, fq * 8);
#define PG8_SA(b, h) (((b) * 2 + (h)) * HTB)
#define PG8_SB(b, h) ((4 + (b) * 2 + (h)) * HTB)
#define PG8_STAGE(bufoff, gbase, voff) do { _Pragma("unroll") for (int _i = 0; _i < 2; ++_i) \
        __builtin_amdgcn_global_load_lds((const unsigned*)((const char*)(gbase) + (voff)[_i]), (PG8_LAS unsigned*)(lds + (bufoff) + ldsw + _i * 8192), 16, 0, 0); } while (0)
#define PG8_LDA(dst, b, h) do { _Pragma("unroll") for (int m = 0; m < 4; ++m) _Pragma("unroll") for (int k = 0; k < 2; ++k) dst[m][k] = *(const PG8_LAS bf16x8*)(lds + PG8_SA(b, h) + aoff + m * 2048 + k * 1024); } while (0)
#define PG8_LDB(dst, b, h) do { _Pragma("unroll") for (int n = 0; n < 2; ++n) _Pragma("unroll") for (int k = 0; k < 2; ++k) dst[n][k] = *(const PG8_LAS bf16x8*)(lds + PG8_SB(b, h) + boff + n * 2048 + k * 1024); } while (0)
#define PG8_MMA(ai, bj, At, Bt) do { __builtin_amdgcn_s_setprio(1); _Pragma("unroll") for (int m = 0; m < 4; ++m) _Pragma("unroll") for (int n = 0; n < 2; ++n) _Pragma("unroll") for (int k = 0; k < 2; ++k) \
        acc[ai][bj][m][n] = __builtin_amdgcn_mfma_f32_16x16x32_bf16(Bt[n][k], At[m][k], acc[ai][bj][m][n], 0, 0, 0); __builtin_amdgcn_s_setprio(0); } while (0)
#define PG8_WAIT_V(n) asm volatile("s_waitcnt vmcnt(" #n ")" ::: "memory")
#define PG8_WAIT_L(n) asm volatile("s_waitcnt lgkmcnt(" #n ")" ::: "memory")
#define PG8_BAR __builtin_amdgcn_s_barrier()
#define PG8_SCHED __builtin_amdgcn_sched_barrier(0)
    Unit cur, nxt; int ui = 0;
    if (!S.next(0, cur)) return;
    f32x4 acc[2][2][4][2];
#pragma unroll
    for (int a = 0; a < 2; ++a)
#pragma unroll
        for (int b = 0; b < 2; ++b)
#pragma unroll
            for (int m = 0; m < 4; ++m)
#pragma unroll
                for (int n = 0; n < 2; ++n) acc[a][b][m][n] = (f32x4){0.f, 0.f, 0.f, 0.f};
    bf16x8 At[4][2], B0[2][2], B1[2][2];
    const char* cA = (const char*)g.A + (size_t)cur.pm * tstepA; const char* cB = (const char*)g.Bt + (size_t)cur.pn * tstepB;
    S.a_ready(cur);
    if constexpr (SP2) {
        PG8_STAGE(PG8_SB(0, 0), cB, voffB); PG8_STAGE(PG8_SB(0, 1), cB + hstepB, voffB); PG8_STAGE(PG8_SA(0, 0), cA, voffA); PG8_STAGE(PG8_SA(0, 1), cA + hstepA, voffA);
        if (wr == 1) PG8_BAR;
        PG8_WAIT_V(2); PG8_BAR;
        PG8_STAGE(PG8_SB(1, 0), cB + kstep, voffB); PG8_STAGE(PG8_SA(1, 0), cA + kstep, voffA); PG8_STAGE(PG8_SB(1, 1), cB + hstepB + kstep, voffB);
        PG8_WAIT_V(6); PG8_BAR;
    } else {
        PG8_STAGE(PG8_SB(0, 0), cB, voffB); PG8_STAGE(PG8_SA(0, 0), cA, voffA); PG8_STAGE(PG8_SB(0, 1), cB + hstepB, voffB); PG8_STAGE(PG8_SA(0, 1), cA + hstepA, voffA);
        if (wr == 1) PG8_BAR;
        PG8_WAIT_V(4); PG8_BAR;
        PG8_STAGE(PG8_SB(1, 0), cB + kstep, voffB); PG8_STAGE(PG8_SA(1, 0), cA + kstep, voffA); PG8_STAGE(PG8_SB(1, 1), cB + hstepB + kstep, voffB);
        PG8_WAIT_V(6); PG8_BAR;
    }
    for (;;) {
        const bool has_next = S.next(ui + 1, nxt);
        const char* nA = has_next ? (const char*)g.A + (size_t)nxt.pm * tstepA : cA; const char* nB = has_next ? (const char*)g.Bt + (size_t)nxt.pn * tstepB : cB;
        for (int t = 0; t < nt; t += 2) {
            const bool last = (t == nt - 2);
            if constexpr (Epi::HAS_MID) { if (t == (nt >> 1)) E.mid(acc, cur, wr, wc, fr, fq); }
            const char* a1 = cA + (size_t)(t + 1) * kstep;
            const char* a2 = last ? nA : cA + (size_t)(t + 2) * kstep; const char* b2 = last ? nB : cB + (size_t)(t + 2) * kstep;
            const char* a3 = a2 + kstep; const char* b3 = b2 + kstep;
            if (last && has_next) S.a_ready(nxt);
            if constexpr (SP2) {
            PG8_LDB(B0, 0, 0); PG8_LDB(B1, 0, 1); PG8_SCHED; PG8_LDA(At, 0, 0); PG8_STAGE(PG8_SA(1, 1), a1 + hstepA, voffA);
            PG8_WAIT_V(8); PG8_WAIT_L(0); PG8_BAR; PG8_MMA(0, 0, At, B0); PG8_MMA(0, 1, At, B1); PG8_BAR; PG8_SCHED;
            PG8_LDA(At, 0, 1); PG8_STAGE(PG8_SB(0, 0), b2, voffB); PG8_STAGE(PG8_SB(0, 1), b2 + hstepB, voffB); PG8_STAGE(PG8_SA(0, 0), a2, voffA);
            PG8_WAIT_V(8); PG8_WAIT_L(0); PG8_BAR; PG8_MMA(1, 0, At, B0); PG8_MMA(1, 1, At, B1); PG8_BAR; PG8_SCHED;
            PG8_LDB(B0, 1, 0); PG8_LDB(B1, 1, 1); PG8_SCHED; PG8_LDA(At, 1, 0); PG8_STAGE(PG8_SA(0, 1), a2 + hstepA, voffA);
            PG8_WAIT_V(8); PG8_WAIT_L(0); PG8_BAR; PG8_MMA(0, 0, At, B0); PG8_MMA(0, 1, At, B1); PG8_BAR; PG8_SCHED;
            PG8_LDA(At, 1, 1); PG8_STAGE(PG8_SB(1, 0), b3, voffB); PG8_STAGE(PG8_SB(1, 1), b3 + hstepB, voffB); PG8_STAGE(PG8_SA(1, 0), a3, voffA);
            PG8_WAIT_V(8); PG8_WAIT_L(0); PG8_BAR; PG8_MMA(1, 0, At, B0); PG8_MMA(1, 1, At, B1); PG8_BAR; PG8_SCHED;
            } else {
            PG8_LDB(B0, 0, 0); PG8_SCHED; PG8_LDA(At, 0, 0); PG8_STAGE(PG8_SA(1, 1), a1 + hstepA, voffA);
            PG8_WAIT_L(8); PG8_BAR; PG8_WAIT_L(0); PG8_MMA(0, 0, At, B0); PG8_BAR; PG8_SCHED;
            PG8_LDB(B1, 0, 1); PG8_STAGE(PG8_SB(0, 0), b2, voffB);
            PG8_BAR; PG8_WAIT_L(0); PG8_MMA(0, 1, At, B1); PG8_BAR;
            PG8_LDA(At, 0, 1); PG8_STAGE(PG8_SA(0, 0), a2, voffA);
            PG8_BAR; PG8_WAIT_L(0); PG8_MMA(1, 0, At, B0); PG8_BAR; PG8_SCHED;
            PG8_STAGE(PG8_SB(0, 1), b2 + hstepB, voffB);
            PG8_WAIT_V(6); PG8_BAR; PG8_MMA(1, 1, At, B1); PG8_BAR;
            PG8_LDB(B0, 1, 0); PG8_SCHED; PG8_LDA(At, 1, 0); PG8_STAGE(PG8_SA(0, 1), a2 + hstepA, voffA);
            PG8_WAIT_L(8); PG8_BAR; PG8_WAIT_L(0); PG8_MMA(0, 0, At, B0); PG8_BAR; PG8_SCHED;
            PG8_LDB(B1, 1, 1); PG8_STAGE(PG8_SB(1, 0), b3, voffB);
            PG8_BAR; PG8_WAIT_L(0); PG8_MMA(0, 1, At, B1); PG8_BAR;
            PG8_LDA(At, 1, 1); PG8_STAGE(PG8_SA(1, 0), a3, voffA);
            PG8_BAR; PG8_WAIT_L(0); PG8_MMA(1, 0, At, B0); PG8_BAR; PG8_SCHED;
            PG8_STAGE(PG8_SB(1, 1), b3 + hstepB, voffB);
            PG8_WAIT_V(6); PG8_BAR; PG8_MMA(1, 1, At, B1); PG8_BAR;
            }
        }
        if constexpr (ALIGN_EPI) { if (wr == 0) PG8_BAR; }
        if constexpr (!Epi::AFTER_DRAIN) { E(acc, cur, wr, wc, fr, fq); S.done(cur); }
        if (!has_next) break;
#pragma unroll
        for (int a = 0; a < 2; ++a)
#pragma unroll
            for (int b = 0; b < 2; ++b)
#pragma unroll
                for (int m = 0; m < 4; ++m)
#pragma unroll
                    for (int n = 0; n < 2; ++n) acc[a][b][m][n] = (f32x4){0.f, 0.f, 0.f, 0.f};
        cur = nxt; cA = nA; cB = nB; ++ui;
        if constexpr (ALIGN_EPI) { if (wr == 1) PG8_BAR; }
    }
    PG8_WAIT_V(0);
    if constexpr (!ALIGN_EPI) { if (wr == 0) PG8_BAR; }
    PG8_BAR;
    if constexpr (Epi::AFTER_DRAIN) { E.fused(acc, cur, wr, wc, fr, fq, lds, wid, lane); S.done(cur); }
#undef PG8_SA
#undef PG8_SB
#undef PG8_STAGE
#undef PG8_LDA
#undef PG8_LDB
#undef PG8_MMA
#undef PG8_WAIT_V
#undef PG8_WAIT_L
#undef PG8_BAR
#undef PG8_SCHED
}

}
#define PG8_SP2 true
#define PG8_ALIGN true

__global__ void __launch_bounds__(NTHR, 2) fwd(Args args) {
    extern __shared__ __attribute__((aligned(16))) unsigned char lds[];
    Frame F;
    F.lds = (LAS unsigned char*)lds;
    F.MISC = (volatile LAS unsigned*)(F.lds + MISC_OFF);
    F.tid = 0; F.lane = 0; F.wave = __builtin_amdgcn_readfirstlane(threadIdx.x >> 6);
    F.G = gridDim.x; { const int bx = blockIdx.x; F.vcu = (F.G % 8 == 0) ? (bx % 8) * (F.G / 8) + bx / 8 : bx; }
    unsigned char* ws = args.ws; F.ws = ws;
    F.ctl = (gu32*)(ws + WS_CTL);
    for (int u = threadIdx.x; u < (LDS_BYTES - LDSCTL_OFF) / 4; u += NTHR) ((LAS unsigned*)(F.lds + LDSCTL_OFF))[u] = 0u;
    __syncthreads();
    XcdBarrier bar = xcd_barrier_post((unsigned*)(F.ctl + CW_BAR) + args.li * XCD_BAR_WORDS, F.MISC + 8);
    const int lo = args.ph_lo, hi = args.ph_hi;
#define IN(k) (lo <= (k) && (k) < hi)
#define SEAM(k) do { if (IN(k) && IN((k) + 1)) xcd_barrier(bar); } while (0)
    const int wave = F.wave;
    const int gw = F.vcu * NWAVES + wave, NGW = F.G * NWAVES;
    const int NGT = F.G * NTHR;
#define TVARS const int tid = opaque_tid(); const int lane = tid & 63; const int gt = blockIdx.x * NTHR + tid; (void)lane; (void)gt;
    LAS float* As = (LAS float*)F.lds; LAS float* Bs = As + 16 * 132;
    const float* x = args.in[I_X];
    float* out = args.out;

    if (IN(0)) {
        TVARS
        for (int m = gw; m < T; m += NGW) rms_row_to_bf16(lane, x + (size_t)m * D, args.in[I_NMIX], (bf16*)(ws + WS_H1) + (size_t)m * D);
        { const f32x4* p4 = (const f32x4*)args.in[I_P]; v2u* o = (v2u*)(ws + WS_PB);
          for (int i = gt; i < T * PLE / 4; i += NGT) { const f32x4 v = p4[i]; v2u w; w.x = pk2(v.x, v.y); w.y = pk2(v.z, v.w); o[i] = w; } }
        { f32x2* tr = (f32x2*)(ws + WS_TRIG);
          for (int i = gt; i < T * 64; i += NGT) { const int pos = i >> 6, j = i & 63; double r = (double)pos * args.rfreq[j]; r -= floor(r); if (r > 0.5) r -= 1.0;
              const float rf = (float)r; f32x2 cs; cs.x = __builtin_amdgcn_cosf(rf); cs.y = __builtin_amdgcn_sinf(rf); tr[i] = cs; } }
        { float* lb = (float*)(ws + WS_LB); const float* raw = args.in[I_LBRAW];
          for (int c = gt; c < HW; c += NGT) lb[c] = 1.0f / (1.0f + expf(raw[HW + c] - raw[c])); }
        { float* wrt = (float*)(ws + WS_WRT); const float* wg = args.in[I_WRG]; const float* we = args.in[I_WRE];
          for (int i = gt; i < 36 * D; i += NGT) { const int c = i / D, k = i % D; wrt[i] = args.in[I_NFFN][k] * ((c < 4) ? wg[k * 4 + c] : we[k * NE + (c - 4)]); } }
        { LAS float* scr = (LAS float*)(F.lds + wave * 16384);
          constexpr int I_IN = 32 * 352, I_UH = 16 * 64, I_UM = 16 * 64, I_O = 32 * 64, I_G = 32 * 64, I_PP = 4 * 64;
          for (int it = gw; it < I_IN + I_PP; it += NGW) { int r = it;
              if (r < I_IN) { const int kb = r / 352, nb = r % 352; transpose_item(args.in[I_WIN], INC, kb * 64, phys2log_inproj(nb * 32), (bf16*)(ws + WS_WIN_T), D, nb * 32, kb * 64, scr, lane); continue; } r -= I_IN;
              { const int kb = r / 64, nb = r % 64; transpose_item(args.in[I_WPP], D, kb * 64, nb * 32, (bf16*)(ws + WS_WPP_T), PLE, nb * 32, kb * 64, scr, lane); } } }
    }
    SEAM(0);

    if (IN(1) && FP1) {
        { pg8::Gemm g{(const bf16*)(ws + WS_H1), (const bf16*)(ws + WS_WIN_T), D, D, D}; pg8::StaticOrder S; S.init(T, INC, F.G, (int)blockIdx.x); pg8::EpiInProj E{ws};
          pg8::gemm_phase<pg8::EpiInProj, pg8::StaticOrder, PG8_ALIGN, PG8_SP2>(F.lds, g, S, E); }
        {
            const int nbusy = ((T / 256) * (INC / 256)) % F.G, c = (int)blockIdx.x;
            if (nbusy == 0 || c >= nbusy) { const int nh = nbusy == 0 ? F.G : F.G - nbusy, hr = nbusy == 0 ? c : c - nbusy;
                { pg8::Gemm g2{(const bf16*)(ws + WS_PB), (const bf16*)(ws + WS_WPP_T), PLE, PLE, PLE}; pg8::StaticOrder S2; S2.init(T, D, nh, hr); pg8::EpiBf16Plain E2{(bf16*)(ws + WS_PP), D};
                  pg8::gemm_phase<pg8::EpiBf16Plain, pg8::StaticOrder, PG8_ALIGN, PG8_SP2>(F.lds, g2, S2, E2); }
                __syncthreads();
                { TVARS
                  LAS float* scr = (LAS float*)(F.lds + wave * 16384);
                  constexpr int I_UH = 16 * 64, I_UM = 16 * 64, I_O = 32 * 64, I_G = 32 * 64;
                  auto item1 = [&](int it) -> TrItem { TrItem q; int r = it; q.ldw = D; q.ldt = D;
                      if (r < I_UH) { const int kb = r / 64, nb = r % 64; q.src = args.in[I_WUH] + (size_t)(kb * 64) * D + nb * 32; q.dst = (bf16*)(ws + WS_WUP_T) + (size_t)(nb * 32) * D + kb * 64; return q; } r -= I_UH;
                      if (r < I_UM) { const int kb = r / 64, nb = r % 64; q.src = args.in[I_WUM] + (size_t)(kb * 64) * D + nb * 32; q.dst = (bf16*)(ws + WS_WUP_T) + (size_t)(nb * 32) * D + HW + kb * 64; return q; } r -= I_UM;
                      if (r < I_O) { const int kb = r / 64, nb = r % 64; q.src = args.in[I_WOUT] + (size_t)(kb * 64) * D + nb * 32; q.dst = (bf16*)(ws + WS_WOUT_T) + (size_t)(nb * 32) * D + kb * 64; return q; } r -= I_O;
                      { const int kb = r / 64, nb = r % 64; q.src = args.in[I_WPG] + (size_t)(kb * 64) * D + nb * 32; q.dst = (bf16*)(ws + WS_WPG_T) + (size_t)(nb * 32) * D + kb * 64; return q; } };
                  TR_PIPE(hr * NWAVES + wave, I_UH + I_UM + I_O + I_G, nh * NWAVES, item1); }
            }
        }
    }
    if (IN(1) && !FP1) {
        TVARS
        const bf16* H1 = (const bf16*)(ws + WS_H1);
        constexpr int NT1 = (T / 128) * (INC / 128), NT2 = (T / 128) * (D / 128);
        for (int it = F.vcu; it < NT1 + NT2; it += F.G) {
            float acc[8][4]; zero_acc(acc);
            const int tx = tid & 31, ty = tid >> 5;
            if (it < NT1) {
                const int tm = it / (INC / 128), tn = it % (INC / 128);
                sgemm_acc(acc, As, Bs, H1, D, tm * 128, args.in[I_WIN], INC, tn * 128, D, tid);
#pragma unroll
                for (int i = 0; i < 8; ++i) inproj_epi(ws, tm * 128 + ty * 8 + i, tn * 128 + tx * 4, acc[i]);
            } else {
                const int r = it - NT1, tm = r / (D / 128), tn = r % (D / 128);
                sgemm_acc(acc, As, Bs, (const bf16*)(ws + WS_PB), PLE, tm * 128, args.in[I_WPP], D, tn * 128, PLE, tid);
#pragma unroll
                for (int i = 0; i < 8; ++i) st_bf16x4((bf16*)(ws + WS_PP) + (size_t)(tm * 128 + ty * 8 + i) * D + tn * 128 + tx * 4, acc[i][0], acc[i][1], acc[i][2], acc[i][3]);
            }
        }
    }
    SEAM(1);

    if (IN(2) && (FHG || FMB)) {
        TVARS
        if (FHG) for (int it = F.vcu; it < 128 * NH; it += F.G) hgrn_pass_a(ws, F.lds, it, tid);
        __syncthreads();
        if (FMB) for (int it = F.vcu; it < NH * NB; it += F.G) if ((it & 31) > 0) moba_gate_lists(ws, F.ctl, F.lds, it >> 5, it & 31, tid);
    }
    if (IN(2) && !FP1) {
        TVARS
        const float* raw = (const float*)(ws + WS_TMPF); const f32x2* tr = (const f32x2*)(ws + WS_TRIG);
        for (int i = gt; i < T * 16 * 64; i += NGT) {
            const int j = i & 63, hh = (i >> 6) & 15, t = i >> 10;
            const float x1 = raw[(size_t)t * D + hh * 128 + j], x2 = raw[(size_t)t * D + hh * 128 + 64 + j];
            const f32x2 cs = tr[t * 64 + j];
            bf16* dst = (hh < 8) ? (bf16*)(ws + WS_MQ) + (size_t)t * HW + hh * 128 : (bf16*)(ws + WS_MK) + (size_t)t * HW + (hh - 8) * 128;
            dst[j] = (bf16)f2bf(x1 * cs.x - x2 * cs.y); dst[64 + j] = (bf16)f2bf(x2 * cs.x + x1 * cs.y);
        }
    }
    SEAM(2);
    if (IN(3) && (FHG || FMB)) {
        TVARS
        {
            const float* DSb = (const float*)(ws + WS_DS); const float* DEC = (const float*)(ws + WS_DEC); bf16* STb = (bf16*)(ws + WS_ST);
            constexpr int SCN = 4;
            if (FHG) for (int e0 = (F.vcu * NTHR * SCN) + tid; e0 < NH * HD * HD; e0 += F.G * NTHR * SCN) {
                float S[SCN]; const float* ds[SCN]; const float* dec[SCN]; bf16* st[SCN];
#pragma unroll
                for (int i = 0; i < SCN; ++i) { const int e = e0 + i * NTHR, h = e >> 14, rem = e & 16383, k = e & 127; S[i] = 0.f; ds[i] = DSb + h * 16384 + rem; dec[i] = DEC + h * HD + k; st[i] = STb + h * 16384 + rem; }
                for (int c0 = 0; c0 < 128; c0 += 4) {
                    float dv[4][SCN], gv[4][SCN];
#pragma unroll
                    for (int cc = 0; cc < 4; ++cc)
#pragma unroll
                        for (int i = 0; i < SCN; ++i) { dv[cc][i] = ds[i][(size_t)(c0 + cc) * 131072]; gv[cc][i] = dec[i][(c0 + cc) * 1024]; }
#pragma unroll
                    for (int cc = 0; cc < 4; ++cc)
#pragma unroll
                        for (int i = 0; i < SCN; ++i) { st[i][(size_t)(c0 + cc) * 131072] = (bf16)f2bf(S[i]); S[i] = gv[cc][i] * S[i] + dv[cc][i]; } } }
        }
        if (FMB) {
            LAS int* ust = (LAS int*)(F.lds + LDSCTL_OFF + 1024); LAS int* cn = ust + 260; volatile LAS int* cur_w = (volatile LAS int*)(ust + 520);
            __syncthreads();
            if (tid < NH * NB) cn[tid] = (int)__hip_atomic_load((unsigned*)(F.ctl + CW_MCNT) + tid, RLX_AGENT);
            __syncthreads();
            if (tid == 0) { int a = 0; for (int i = 0; i < NH * NB; ++i) { ust[i] = a; a += (cn[i] + MB_RCH - 1) / MB_RCH; } ust[NH * NB] = a; }
            __syncthreads();
            const int nch = ust[NH * NB], total = nch + NH * NB;
            for (;;) {
                if (tid == 0) *cur_w = (int)__hip_atomic_fetch_add((unsigned*)(F.ctl + 8), 1u, RLX_AGENT);
                __syncthreads();
                const int w = *cur_w;
                __syncthreads();
                if (w >= total) break;
                int idx, n; bool causal; const unsigned short* gl = (const unsigned short*)(ws + WS_GL);
                if (w < nch) { int lo2 = 0, hi2 = NH * NB - 1;
                    while (lo2 < hi2) { const int mid = (lo2 + hi2 + 1) >> 1; if (ust[mid] <= w) lo2 = mid; else hi2 = mid - 1; }
                    idx = lo2; const int r0 = (w - ust[idx]) * MB_RCH; n = cn[idx] - r0; n = n > MB_RCH ? MB_RCH : n; gl += (size_t)idx * 8192 + r0; causal = false; }
                else { idx = w - nch; n = 256; causal = true; }
                idx = __builtin_amdgcn_readfirstlane(idx); n = __builtin_amdgcn_readfirstlane(n);
                moba_kv_item(ws, F.lds, idx >> 5, idx & 31, causal, gl, n, tid);
            }
        }
    }

    if (IN(3)) {
        TVARS
        if (!FP1) { const bf16* MK = (const bf16*)(ws + WS_MK); float* km = (float*)(ws + WS_KMEAN);
          for (int i = gt; i < NB * HW; i += NGT) { const int jb = i / HW, c = i % HW; float s = 0.f;
              for (int r = 0; r < BS; ++r) s += bf2f(MK[(size_t)(jb * BS + r) * HW + c]);
              km[i] = s; km[NB * HW + i] = 0.f; } }
        if (!FHG && wave == 0 && blockIdx.x < 16) {
            const int h = blockIdx.x >> 1, v = (blockIdx.x & 1) * 64 + lane;
            const float* GH = (const float*)(ws + WS_GH) + h * HD; const bf16* QH = (const bf16*)(ws + WS_QH) + h * HD; const bf16* VH = (const bf16*)(ws + WS_VH) + h * HD + v;
            float* ORAW = (float*)(ws + WS_TMPF) + h * HD + v;
            float S[HD];
#pragma unroll
            for (int k = 0; k < HD; ++k) S[k] = 0.f;
            for (int t = 0; t < T; ++t) {
                const float iv = bf2f(VH[(size_t)t * HW]); float o = 0.f;
                const float* g = GH + (size_t)t * HW; const bf16* q = QH + (size_t)t * HW;
#pragma unroll
                for (int k = 0; k < HD; ++k) { const float f = __expf(g[k]); S[k] = f * S[k] + (1.f - f) * iv; o += S[k] * bf2f(q[k]); }
                ORAW[(size_t)t * HW] = o;
            }
        }
    }
    SEAM(3);
    if (IN(4) && (FHG || FMB)) {
        TVARS
        const bool merge_first = (F.vcu & 1) != 0;
        auto passc4 = [&]() { if (FHG) for (int it = F.vcu; it < 128 * NH; it += F.G) hgrn_pass_c(ws, F.lds, args.in[I_HNG], it, tid); };
        if (!merge_first) passc4();
        if (false) for (int it0 = F.vcu; it0 < NH * NB; it0 += F.G) if ((it0 & 31) < 16) { const int it = it0 ^ 16;
            const int h = it >> 5, cur = it & 31; const bf16* PO = (const bf16*)(ws + WS_PO); const float* PL = (const float*)(ws + WS_PLSE); bf16* AUP = (bf16*)(ws + WS_AUP);
            for (int idx = tid; idx < BS * 16; idx += NTHR) { const int t = cur * BS + (idx >> 4), dq = idx & 15, th = t * NH + h;
                const float* plp = PL + (size_t)th * 128; float ls[4]; ls[0] = plp[0]; ls[1] = plp[32]; ls[2] = plp[64]; ls[3] = plp[96];
                bool ok[4]; float M = -3.0e38f;
#pragma unroll
                for (int i = 0; i < 4; ++i) { ok[i] = fabsf(ls[i]) < 1.0e4f && fabsf(ls[i]) > 1.0e-9f; if (ok[i]) M = fmaxf(M, ls[i]); }
                float wv[4], wsum = 0.f;
#pragma unroll
                for (int i = 0; i < 4; ++i) { wv[i] = ok[i] ? __expf(ls[i] - M) : 0.f; wsum += wv[i]; }
                const float inv = wsum > 0.f ? 1.0f / wsum : 0.f;
                float acc[8] = {0.f, 0.f, 0.f, 0.f, 0.f, 0.f, 0.f, 0.f};
#pragma unroll
                for (int i = 0; i < 4; ++i) { const v4u pw = *(const v4u*)(PO + ((size_t)th * 4 + i) * HD + dq * 8); const float wi = wv[i] * inv;
                    float pv[8] = {bflo(pw.x), bfhi(pw.x), bflo(pw.y), bfhi(pw.y), bflo(pw.z), bfhi(pw.z), bflo(pw.w), bfhi(pw.w)};
#pragma unroll
                    for (int q = 0; q < 8; ++q) { const float x = fabsf(pv[q]) < 1.0e4f ? pv[q] : 0.f; acc[q] += wi * x; } }
                v4u ov; ov.x = pk2(acc[0], acc[1]); ov.y = pk2(acc[2], acc[3]); ov.z = pk2(acc[4], acc[5]); ov.w = pk2(acc[6], acc[7]);
                *(v4u*)(AUP + (size_t)t * D + HW + h * HD + dq * 8) = ov; }
        }
        if (FMB) {
            const bf16* PO = (const bf16*)(ws + WS_PO); const float* PL = (const float*)(ws + WS_PLSE); bf16* AUP = (bf16*)(ws + WS_AUP);
            for (int idx0 = gt; idx0 < T * NH * 16; idx0 += 2 * NGT) {
                float ls[2][4]; v4u pw[2][4]; int nvv[2];
#pragma unroll
                for (int u = 0; u < 2; ++u) { int idx = idx0 + u * NGT; if (idx >= T * NH * 16) idx = idx0; const int th = idx >> 4, dq = idx & 15, cur = th >> 11; nvv[u] = cur < 3 ? cur : 3;
                    const float* plp = PL + (size_t)th * 128;
#pragma unroll
                    for (int i = 0; i < 4; ++i) { ls[u][i] = plp[32 * i]; pw[u][i] = *(const v4u*)(PO + ((size_t)th * 4 + i) * HD + dq * 8); } }
#pragma unroll
                for (int u = 0; u < 2; ++u) { const int idx = idx0 + u * NGT; if (idx >= T * NH * 16) break; const int th = idx >> 4, dq = idx & 15, t = th >> 3, h = th & 7, nv = nvv[u];
                    float M = ls[u][0];
#pragma unroll
                    for (int i = 1; i < 4; ++i) if (i <= nv) M = fmaxf(M, ls[u][i]);
                    float wv[4]; wv[0] = __expf(ls[u][0] - M);
#pragma unroll
                    for (int i = 1; i < 4; ++i) wv[i] = (i <= nv) ? __expf(ls[u][i] - M) : 0.f;
                    const float inv = 1.0f / ((wv[0] + wv[1]) + (wv[2] + wv[3]));
                    float acc[8] = {0.f, 0.f, 0.f, 0.f, 0.f, 0.f, 0.f, 0.f};
#pragma unroll
                    for (int i = 0; i < 4; ++i) { v4u p = pw[u][i]; if (i > nv) { p.x = 0u; p.y = 0u; p.z = 0u; p.w = 0u; } const float wi = wv[i] * inv;
                        acc[0] += wi * bflo(p.x); acc[1] += wi * bfhi(p.x); acc[2] += wi * bflo(p.y); acc[3] += wi * bfhi(p.y); acc[4] += wi * bflo(p.z); acc[5] += wi * bfhi(p.z); acc[6] += wi * bflo(p.w); acc[7] += wi * bfhi(p.w); }
                    v4u ov; ov.x = pk2(acc[0], acc[1]); ov.y = pk2(acc[2], acc[3]); ov.z = pk2(acc[4], acc[5]); ov.w = pk2(acc[6], acc[7]);
                    *(v4u*)(AUP + (size_t)t * D + HW + h * HD + dq * 8) = ov; } }
        }
        if (merge_first) passc4();
    }

    if (IN(4)) {
        TVARS
        bf16* AUP = (bf16*)(ws + WS_AUP);
        if (!FHG) { const float* ORAW = (const float*)(ws + WS_TMPF); const bf16* OG = (const bf16*)(ws + WS_OG); const float* ng = args.in[I_HNG];
          for (int it = gw; it < T * NH; it += NGW) { const int t = it >> 3, h = it & 7; const size_t off = (size_t)t * HW + h * HD + 2 * lane;
              const f32x2 o = *(const f32x2*)(ORAW + off); const float r = 1.0f / sqrtf(wave_sum(o.x * o.x + o.y * o.y) * (1.f / HD) + EPS);
              const unsigned og = *(const unsigned*)(OG + off);
              *(unsigned*)(AUP + (size_t)t * D + h * HD + 2 * lane) = pk2(o.x * r * ng[2 * lane] * bflo(og), o.y * r * ng[2 * lane + 1] * bfhi(og)); } }
        LAS float* qs = (LAS float*)F.lds + 32768 / 4 + wave * 1280; LAS float* sc = qs + 128;
        const bf16* MQ = (const bf16*)(ws + WS_MQ); const bf16* MK = (const bf16*)(ws + WS_MK); const bf16* MV = (const bf16*)(ws + WS_MV); const float* KM = (const float*)(ws + WS_KMEAN);
        const float scale = 0.08838834764831845f;
        if (FMB != 1) for (int it = gw; it < T * NH; it += NGW) {
            const int t = it >> 3, h = it & 7, cur = t >> 8;
            { const unsigned qw = *(const unsigned*)(MQ + (size_t)t * HW + h * HD + 2 * lane); qs[2 * lane] = bflo(qw); qs[2 * lane + 1] = bfhi(qw); }
            LDS_WAIT();
            float gate = -3.0e38f;
            if (lane < NB) { gate = -1e30f; if (lane < cur) { float s0 = 0.f, s1 = 0.f; const f32x4* ka = (const f32x4*)(KM + (size_t)lane * HW + h * HD); const f32x4* kb = (const f32x4*)(KM + (size_t)(NB + lane) * HW + h * HD);
#pragma unroll
                    for (int d4 = 0; d4 < 32; ++d4) { const f32x4 a = ka[d4], b2 = kb[d4]; const LAS float* q4 = qs + 4 * d4;
                        s0 += q4[0] * (a.x + b2.x) + q4[1] * (a.y + b2.y); s1 += q4[2] * (a.z + b2.z) + q4[3] * (a.w + b2.w); }
                    gate = (s0 + s1) * (1.f / BS); } }
            int blk[4]; bool val[4]; blk[0] = cur; val[0] = true;
#pragma unroll
            for (int r = 0; r < 3; ++r) { const float mxg = wave_max(gate); const unsigned long long bm = __ballot(gate == mxg); const int sel = __ffsll((long long)bm) - 1;
                blk[r + 1] = sel; val[r + 1] = sel < cur; if (lane == sel) gate = -3.0e38f; }
            float mx = -3.0e38f;
#pragma unroll
            for (int b = 0; b < 4; ++b) if (val[b]) for (int g = 0; g < 4; ++g) {
                const int key = blk[b] * BS + g * 64 + lane; const v4u* kr = (const v4u*)(MK + (size_t)key * HW + h * HD); float s = 0.f;
#pragma unroll
                for (int c = 0; c < 16; ++c) { const v4u kw = kr[c]; const LAS float* q8 = qs + c * 8;
                    s += q8[0] * bflo(kw.x) + q8[1] * bfhi(kw.x) + q8[2] * bflo(kw.y) + q8[3] * bfhi(kw.y) + q8[4] * bflo(kw.z) + q8[5] * bfhi(kw.z) + q8[6] * bflo(kw.w) + q8[7] * bfhi(kw.w); }
                s = (b == 0 && key > t) ? -1e30f : s * scale; sc[b * 256 + g * 64 + lane] = s; mx = fmaxf(mx, s); }
            mx = wave_max(mx); float l = 0.f;
#pragma unroll
            for (int b = 0; b < 4; ++b) if (val[b]) for (int g = 0; g < 4; ++g) { const int i = b * 256 + g * 64 + lane; const float p = __expf(sc[i] - mx); sc[i] = p; l += p; }
            l = wave_sum(l); LDS_WAIT();
            float o0 = 0.f, o1 = 0.f;
#pragma unroll
            for (int b = 0; b < 4; ++b) if (val[b]) { const bf16* vb = MV + (size_t)(blk[b] * BS) * HW + h * HD + 2 * lane;
                float a0 = 0.f, a1 = 0.f, c0 = 0.f, c1 = 0.f;
#pragma unroll 1
                for (int k = 0; k < 256; k += 16) { unsigned vw[16];
#pragma unroll
                    for (int u = 0; u < 16; ++u) vw[u] = *(const unsigned*)(vb + (size_t)(k + u) * HW);
#pragma unroll
                    for (int u = 0; u < 16; u += 2) { const float p0 = sc[b * 256 + k + u], p1 = sc[b * 256 + k + u + 1];
                        a0 += p0 * bflo(vw[u]); a1 += p0 * bfhi(vw[u]); c0 += p1 * bflo(vw[u + 1]); c1 += p1 * bfhi(vw[u + 1]); } }
                o0 += a0 + c0; o1 += a1 + c1; }
            const float il = 1.0f / l;
            *(unsigned*)(AUP + (size_t)t * D + HW + h * HD + 2 * lane) = pk2(o0 * il, o1 * il);
            LDS_WAIT();
        }
    }
    SEAM(4);

    if (IN(5) && FP5) {
        pg8::StaticOrder S; S.init(T, D, F.G, (int)blockIdx.x);
        { pg8::Gemm g{(const bf16*)(ws + WS_AUP), (const bf16*)(ws + WS_WUP_T), D, D, D}; pg8::EpiUp2 E{(const bf16*)(ws + WS_GA), (const bf16*)(ws + WS_GB), (bf16*)(ws + WS_MERGED)};
          pg8::gemm_phase<pg8::EpiUp2, pg8::StaticOrder, false, PG8_SP2>(F.lds, g, S, E); }
    }
    if (IN(5) && !FP5) {
        TVARS
        const bf16* AUP = (const bf16*)(ws + WS_AUP); const bf16* GA = (const bf16*)(ws + WS_GA); const bf16* GB = (const bf16*)(ws + WS_GB); bf16* MG = (bf16*)(ws + WS_MERGED);
        for (int it = F.vcu; it < (T / 128) * (D / 128); it += F.G) {
            const int tm = it / (D / 128), tn = it % (D / 128), tx = tid & 31, ty = tid >> 5;
            float a1[8][4], a2[8][4]; zero_acc(a1); zero_acc(a2);
            sgemm_acc(a1, As, Bs, AUP, D, tm * 128, args.in[I_WUH], D, tn * 128, HW, tid);
            sgemm_acc(a2, As, Bs, AUP + HW, D, tm * 128, args.in[I_WUM], D, tn * 128, HW, tid);
#pragma unroll
            for (int i = 0; i < 8; ++i) { const size_t off = (size_t)(tm * 128 + ty * 8 + i) * D + tn * 128 + tx * 4;
                const v2u ga = *(const v2u*)(GA + off), gb = *(const v2u*)(GB + off);
                st_bf16x4(MG + off, bflo(ga.x) * a1[i][0] + bflo(gb.x) * a2[i][0], bfhi(ga.x) * a1[i][1] + bfhi(gb.x) * a2[i][1],
                          bflo(ga.y) * a1[i][2] + bflo(gb.y) * a2[i][2], bfhi(ga.y) * a1[i][3] + bfhi(gb.y) * a2[i][3]); }
        }
    }
    SEAM(5);

    if (IN(6) && FP6) {
        pg8::Gemm g{(const bf16*)(ws + WS_MERGED), (const bf16*)(ws + WS_WOUT_T), D, D, D}; pg8::StaticOrder S; S.init(T, D, F.G, (int)blockIdx.x);
        pg8::EpiResid<0> E{x, out, nullptr};
        pg8::gemm_phase<pg8::EpiResid<0>, pg8::StaticOrder, false, PG8_SP2>(F.lds, g, S, E);
    }
    if (IN(6) && !FP6) {
        TVARS
        const bf16* MG = (const bf16*)(ws + WS_MERGED);
        for (int it = F.vcu; it < (T / 128) * (D / 128); it += F.G) {
            const int tm = it / (D / 128), tn = it % (D / 128), tx = tid & 31, ty = tid >> 5;
            float acc[8][4]; zero_acc(acc);
            sgemm_acc(acc, As, Bs, MG, D, tm * 128, args.in[I_WOUT], D, tn * 128, D, tid);
#pragma unroll
            for (int i = 0; i < 8; ++i) { const size_t off = (size_t)(tm * 128 + ty * 8 + i) * D + tn * 128 + tx * 4; const f32x4 xv = *(const f32x4*)(x + off);
                f32x4 o; o.x = xv.x + acc[i][0]; o.y = xv.y + acc[i][1]; o.z = xv.z + acc[i][2]; o.w = xv.w + acc[i][3]; *(f32x4*)(out + off) = o; }
        }
    }
    SEAM(6);

    if (IN(7)) {
        TVARS
        auto conv7 = [&]() { LAS float* scr = (LAS float*)(F.lds + wave * 16384);
          for (int it = gw; it < NE * 1024; it += NGW) { const int e = it >> 10, r = it & 1023;
              { const int kb = r >> 5, n0 = (r & 31) * 32, pnl = n0 >> 8, bj = (n0 >> 7) & 1, q0 = n0 & 127;
                  transpose_item((bj ? args.in[I_WEU] : args.in[I_WEG]) + (size_t)e * D * DE, DE, kb * 64, pnl * 128 + q0, (bf16*)(ws + WS_WEGU) + (size_t)e * 1024 * D, D, n0, kb * 64, scr, lane); }
          } };
        const bool conv_first = (F.vcu & 1) == 0;
        if (conv_first) conv7();
        const float* gff = args.in[I_NFFN]; const float* wrt = (const float*)(ws + WS_WRT);
        int* EID = (int*)(ws + WS_ROUTE); int* POS = EID + 2 * T; float* RW = (float*)(POS + 2 * T);
        __syncthreads();
        LAS float* part = (LAS float*)F.lds; LAS float* lgt = (LAS float*)(F.lds + 49152); LAS float* rsc = (LAS float*)(F.lds + 57344);
        for (int rb = F.vcu; rb < T / 32; rb += F.G) { const int r0 = rb * 32;
            for (int i4 = 0; i4 < 4; ++i4) { const int m = r0 + 4 * wave + i4;
                const f32x4* xr = (const f32x4*)(out + (size_t)m * D) + lane; const f32x4* gr = (const f32x4*)gff + lane;
                f32x4 v[8]; float s = 0.f;
#pragma unroll
                for (int j = 0; j < 8; ++j) { v[j] = xr[64 * j]; s += (v[j].x * v[j].x + v[j].y * v[j].y) + (v[j].z * v[j].z + v[j].w * v[j].w); }
                f32x4 g8[8];
#pragma unroll
                for (int j = 0; j < 8; ++j) g8[j] = gr[64 * j];
                const float r = 1.0f / sqrtf(wave_sum(s) * (1.f / D) + EPS);
                unsigned long long* o8 = (unsigned long long*)((bf16*)(ws + WS_HFFN) + (size_t)m * D) + lane;
#pragma unroll
                for (int j = 0; j < 8; ++j) { const f32x4 gg = g8[j];
                    o8[64 * j] = (unsigned long long)pk2(v[j].x * r * gg.x, v[j].y * r * gg.y) | ((unsigned long long)pk2(v[j].z * r * gg.z, v[j].w * r * gg.w) << 32); }
                if (lane == 0) rsc[4 * wave + i4] = r; }
            { const int fr = lane & 15, fq = lane >> 4;
              f32x4 acc[2][3];
#pragma unroll
              for (int rt = 0; rt < 2; ++rt)
#pragma unroll
                  for (int ct = 0; ct < 3; ++ct) acc[rt][ct] = (f32x4){0.f, 0.f, 0.f, 0.f};
              const float* xa = out + (size_t)(r0 + fr) * D + wave * 256 + 4 * fq;
              const float* wb = wrt + (size_t)fr * D + wave * 256 + 4 * fq;
              const float* wb2 = wrt + (size_t)((32 + fr) > 35 ? 35 : (32 + fr)) * D + wave * 256 + 4 * fq;
#pragma unroll 2
              for (int j = 0; j < 16; ++j) {
                  const f32x4 a0 = *(const f32x4*)(xa + 16 * j), a1 = *(const f32x4*)(xa + (size_t)16 * D + 16 * j);
                  const f32x4 b0 = *(const f32x4*)(wb + 16 * j), b1 = *(const f32x4*)(wb + (size_t)16 * D + 16 * j), b2 = *(const f32x4*)(wb2 + 16 * j);
#pragma unroll
                  for (int q = 0; q < 4; ++q) {
                      acc[0][0] = __builtin_amdgcn_mfma_f32_16x16x4f32(a0[q], b0[q], acc[0][0], 0, 0, 0); acc[0][1] = __builtin_amdgcn_mfma_f32_16x16x4f32(a0[q], b1[q], acc[0][1], 0, 0, 0);
                      acc[0][2] = __builtin_amdgcn_mfma_f32_16x16x4f32(a0[q], b2[q], acc[0][2], 0, 0, 0); acc[1][0] = __builtin_amdgcn_mfma_f32_16x16x4f32(a1[q], b0[q], acc[1][0], 0, 0, 0);
                      acc[1][1] = __builtin_amdgcn_mfma_f32_16x16x4f32(a1[q], b1[q], acc[1][1], 0, 0, 0); acc[1][2] = __builtin_amdgcn_mfma_f32_16x16x4f32(a1[q], b2[q], acc[1][2], 0, 0, 0); } }
#pragma unroll
              for (int rt = 0; rt < 2; ++rt)
#pragma unroll
                  for (int ct = 0; ct < 3; ++ct)
#pragma unroll
                      for (int q = 0; q < 4; ++q) part[(wave * 32 + 16 * rt + 4 * fq + q) * 48 + 16 * ct + fr] = acc[rt][ct][q]; }
            __syncthreads();
            for (int o = tid; o < 32 * 36; o += NTHR) { const int row = o / 36, c = o - row * 36; float sum = 0.f;
#pragma unroll
                for (int w8 = 0; w8 < 8; ++w8) sum += part[(w8 * 32 + row) * 48 + c];
                lgt[row * 40 + c] = sum * rsc[row]; }
            __syncthreads();
            if (tid < 32) { const int m = r0 + tid;
                float lg[36];
#pragma unroll
                for (int c = 0; c < 36; ++c) lg[c] = lgt[tid * 40 + c];
                int gs = 0; float gm = lg[0];
#pragma unroll
                for (int c = 1; c < 4; ++c) if (lg[c] > gm) { gm = lg[c]; gs = c; }
                float gsum = 0.f;
#pragma unroll
                for (int c = 0; c < 4; ++c) gsum += expf(lg[c] - gm);
                const float pg = 1.0f / gsum;
                float el[8];
#pragma unroll
                for (int c = 0; c < 8; ++c) el[c] = (gs == 0) ? lg[4 + c] : (gs == 1) ? lg[12 + c] : (gs == 2) ? lg[20 + c] : lg[28 + c];
                int i1 = 0; float m1 = el[0];
#pragma unroll
                for (int c = 1; c < 8; ++c) if (el[c] > m1) { m1 = el[c]; i1 = c; }
                int i2 = -1; float m2 = -3.0e38f;
#pragma unroll
                for (int c = 0; c < 8; ++c) if (c != i1 && el[c] > m2) { m2 = el[c]; i2 = c; }
                if (i2 < 0) i2 = (i1 == 0) ? 1 : 0;
                const float e2 = expf(m2 - m1), w1 = pg / (1.0f + e2), w2 = pg * e2 / (1.0f + e2);
                const int ea = gs * 8 + i1, eb = gs * 8 + i2;
                const int pa = (int)__hip_atomic_fetch_add((unsigned*)(F.ctl + CW_ECNT) + ea, 1u, RLX_AGENT), pb = (int)__hip_atomic_fetch_add((unsigned*)(F.ctl + CW_ECNT) + eb, 1u, RLX_AGENT);
                EID[2 * m] = ea; EID[2 * m + 1] = eb; POS[2 * m] = pa; POS[2 * m + 1] = pb; RW[2 * m] = w1; RW[2 * m + 1] = w2; }
            __syncthreads();
        }
        if (!conv_first) { __syncthreads(); conv7(); }
    }
    SEAM(7);

    LAS int* pstart = (LAS int*)(F.lds + LDSCTL_OFF);
    if (hi > 8 && lo <= 10) {
        if (threadIdx.x == 0) { int a = 0; for (int e = 0; e < NE; ++e) { pstart[e] = a; const int c = (int)__hip_atomic_load((unsigned*)(F.ctl + CW_ECNT) + e, RLX_AGENT); pstart[40 + e] = c; a += (c + 255) / 256 * 256; } pstart[NE] = a; }
        __syncthreads();
    }

    if (IN(8)) {
        TVARS
        const int* EID = (const int*)(ws + WS_ROUTE); const int* POS = EID + 2 * T; int* rs = (int*)(ws + WS_ROWSLOT);
        for (int s = gw; s < 2 * T; s += NGW) { const int dest = pstart[EID[s]] + POS[s];
            const v4u* src = (const v4u*)((const bf16*)(ws + WS_HFFN) + (size_t)(s >> 1) * D) + lane; v4u* dst = (v4u*)((bf16*)(ws + WS_XG) + (size_t)dest * D) + lane;
            v4u rowv[4];
#pragma unroll
            for (int j = 0; j < 4; ++j) rowv[j] = src[64 * j];
#pragma unroll
            for (int j = 0; j < 4; ++j) dst[64 * j] = rowv[j];
            if (lane == 0) __hip_atomic_store(rs + dest, s, RLX_AGENT); }
    }
    SEAM(8);

    if (IN(9) && FP9) {
        pg8::Gemm g{(const bf16*)(ws + WS_XG), (const bf16*)(ws + WS_WEGU), D, D, D}; pg8::MoeOrder S{(const LAS int*)pstart, 4, F.G, (int)blockIdx.x}; pg8::EpiMoe1 E{(bf16*)(ws + WS_HMOE)};
        pg8::gemm_phase<pg8::EpiMoe1, pg8::MoeOrder, PG8_ALIGN, PG8_SP2>(F.lds, g, S, E);
        { TVARS
          const int nun = (pstart[NE] >> 8) * 4, nbusy = nun > F.G ? nun - F.G : 0, c = (int)blockIdx.x;
          __syncthreads();
          if (c >= nbusy) { const int nh = F.G - nbusy, hr = c - nbusy; LAS float* scr = (LAS float*)(F.lds + wave * 16384);
              auto item9 = [&](int it) -> TrItem { TrItem q; const int e = it >> 9, r2 = it & 511, kb = r2 >> 6, nb = r2 & 63;
                  q.src = args.in[I_WED] + (size_t)e * DE * D + (size_t)(kb * 64) * D + nb * 32; q.ldw = D; q.dst = (bf16*)(ws + WS_WED) + (size_t)e * D * DE + (size_t)(nb * 32) * DE + kb * 64; q.ldt = DE; return q; };
              TR_PIPE(hr * NWAVES + wave, NE * 512, nh * NWAVES, item9); } }
    }
    if (IN(9) && !FP9) {
        TVARS
        const int ntile = pstart[NE] / 128;
        for (int it = F.vcu; it < ntile * (DE / 128); it += F.G) {
            const int tm = it / (DE / 128), tn = it % (DE / 128), tx = tid & 31, ty = tid >> 5; int e = 0;
            for (int q = 1; q < NE; ++q) if (pstart[q] <= tm * 128) e = q;
            float a1[8][4], a2[8][4]; zero_acc(a1); zero_acc(a2);
            sgemm_acc(a1, As, Bs, (const bf16*)(ws + WS_XG), D, tm * 128, args.in[I_WEG] + (size_t)e * D * DE, DE, tn * 128, D, tid);
            sgemm_acc(a2, As, Bs, (const bf16*)(ws + WS_XG), D, tm * 128, args.in[I_WEU] + (size_t)e * D * DE, DE, tn * 128, D, tid);
#pragma unroll
            for (int i = 0; i < 8; ++i) st_bf16x4((bf16*)(ws + WS_HMOE) + (size_t)(tm * 128 + ty * 8 + i) * DE + tn * 128 + tx * 4,
                siluf_(a1[i][0]) * a2[i][0], siluf_(a1[i][1]) * a2[i][1], siluf_(a1[i][2]) * a2[i][2], siluf_(a1[i][3]) * a2[i][3]);
        }
    }
    SEAM(9);

    if (IN(10) && FP10) {
        pg8::Gemm g{(const bf16*)(ws + WS_HMOE), (const bf16*)(ws + WS_WED), DE, DE, DE}; pg8::MoeOrder S{(const LAS int*)pstart, 8, F.G, (int)blockIdx.x}; pg8::EpiMoe2 E{(bf16*)(ws + WS_Y), (const int*)(ws + WS_ROWSLOT), (const LAS int*)pstart};
        pg8::gemm_phase<pg8::EpiMoe2, pg8::MoeOrder, PG8_ALIGN, PG8_SP2>(F.lds, g, S, E);
    }
    if (IN(10) && !FP10) {
        TVARS
        const int ntile = pstart[NE] / 128; const int* rs = (const int*)(ws + WS_ROWSLOT);
        for (int it = F.vcu; it < ntile * (D / 128); it += F.G) {
            const int tm = it / (D / 128), tn = it % (D / 128), tx = tid & 31, ty = tid >> 5; int e = 0;
            for (int q = 1; q < NE; ++q) if (pstart[q] <= tm * 128) e = q;
            float acc[8][4]; zero_acc(acc);
            sgemm_acc(acc, As, Bs, (const bf16*)(ws + WS_HMOE), DE, tm * 128, args.in[I_WED] + (size_t)e * DE * D, D, tn * 128, DE, tid);
#pragma unroll
            for (int i = 0; i < 8; ++i) { const int prow = tm * 128 + ty * 8 + i;
                if (prow - pstart[e] < pstart[40 + e]) st_bf16x4((bf16*)(ws + WS_Y) + (size_t)__hip_atomic_load((int*)rs + prow, RLX_AGENT) * D + tn * 128 + tx * 4, acc[i][0], acc[i][1], acc[i][2], acc[i][3]); }
        }
    }
    SEAM(10);

    if (IN(11)) {
        TVARS
        const float* gpl = args.in[I_NPLE]; const float* RW = (const float*)((const int*)(ws + WS_ROUTE) + 4 * T);
        for (int m = gw; m < T; m += NGW) {
            f32x4* xr = (f32x4*)(out + (size_t)m * D) + lane; const f32x4* gr = (const f32x4*)gpl + lane;
            const v2u* ya = (const v2u*)((const bf16*)(ws + WS_Y) + (size_t)(2 * m) * D) + lane; const v2u* yb = (const v2u*)((const bf16*)(ws + WS_Y) + (size_t)(2 * m + 1) * D) + lane;
            const float wa = RW[2 * m], wb = RW[2 * m + 1];
            f32x4 v[8]; float s = 0.f;
#pragma unroll
            for (int j = 0; j < 8; ++j) v[j] = xr[64 * j];
            v2u ay[8], by[8]; f32x4 g8[8];
#pragma unroll
            for (int j = 0; j < 8; ++j) { ay[j] = ya[64 * j]; by[j] = yb[64 * j]; g8[j] = gr[64 * j]; }
#pragma unroll
            for (int j = 0; j < 8; ++j) { const v2u a = ay[j], b = by[j];
                v[j].x += bflo(a.x) * wa + bflo(b.x) * wb; v[j].y += bfhi(a.x) * wa + bfhi(b.x) * wb; v[j].z += bflo(a.y) * wa + bflo(b.y) * wb; v[j].w += bfhi(a.y) * wa + bfhi(b.y) * wb;
                xr[64 * j] = v[j]; s += (v[j].x * v[j].x + v[j].y * v[j].y) + (v[j].z * v[j].z + v[j].w * v[j].w); }
            const float r = 1.0f / sqrtf(wave_sum(s) * (1.f / D) + EPS);
            unsigned long long* o8 = (unsigned long long*)((bf16*)(ws + WS_HP) + (size_t)m * D) + lane;
#pragma unroll
            for (int j = 0; j < 8; ++j) { const f32x4 gg = g8[j];
                o8[64 * j] = (unsigned long long)pk2(v[j].x * r * gg.x, v[j].y * r * gg.y) | ((unsigned long long)pk2(v[j].z * r * gg.z, v[j].w * r * gg.w) << 32); }
        }
    }
    SEAM(11);

    if (IN(12) && FP12) {
        pg8::Gemm g{(const bf16*)(ws + WS_HP), (const bf16*)(ws + WS_WPG_T), D, D, D}; pg8::StaticOrder S; S.init(T, D, F.G, (int)blockIdx.x);
        pg8::EpiResid<1> E{out, out, (const bf16*)(ws + WS_PP)};
        pg8::gemm_phase<pg8::EpiResid<1>, pg8::StaticOrder, false, PG8_SP2>(F.lds, g, S, E);
    }
    if (IN(12) && !FP12) {
        TVARS
        const bf16* HP = (const bf16*)(ws + WS_HP); const bf16* PP = (const bf16*)(ws + WS_PP);
        for (int it = F.vcu; it < (T / 128) * (D / 128); it += F.G) {
            const int tm = it / (D / 128), tn = it % (D / 128), tx = tid & 31, ty = tid >> 5;
            float acc[8][4]; zero_acc(acc);
            sgemm_acc(acc, As, Bs, HP, D, tm * 128, args.in[I_WPG], D, tn * 128, D, tid);
#pragma unroll
            for (int i = 0; i < 8; ++i) { const size_t off = (size_t)(tm * 128 + ty * 8 + i) * D + tn * 128 + tx * 4; const f32x4 xv = *(const f32x4*)(out + off); const v2u pp = *(const v2u*)(PP + off);
                f32x4 o; o.x = xv.x + sigmoidf_(acc[i][0]) * bflo(pp.x); o.y = xv.y + sigmoidf_(acc[i][1]) * bfhi(pp.x); o.z = xv.z + sigmoidf_(acc[i][2]) * bflo(pp.y); o.w = xv.w + sigmoidf_(acc[i][3]) * bfhi(pp.y);
                *(f32x4*)(out + off) = o; }
        }
    }
    SEAM(12);

    if (IN(13)) {
        TVARS
        const float* gf = args.in[I_NFIN];
        for (int m = gw; m < T; m += NGW) {
            f32x4* xr = (f32x4*)(out + (size_t)m * D) + lane; const f32x4* gr = (const f32x4*)gf + lane;
            f32x4 v[8]; float s = 0.f;
#pragma unroll
            for (int j = 0; j < 8; ++j) { v[j] = xr[64 * j]; s += (v[j].x * v[j].x + v[j].y * v[j].y) + (v[j].z * v[j].z + v[j].w * v[j].w); }
            f32x4 g8[8];
#pragma unroll
            for (int j = 0; j < 8; ++j) g8[j] = gr[64 * j];
            const float r = 1.0f / sqrtf(wave_sum(s) * (1.f / D) + EPS);
#pragma unroll
            for (int j = 0; j < 8; ++j) { const f32x4 gg = g8[j]; f32x4 o; o.x = v[j].x * r * gg.x; o.y = v[j].y * r * gg.y; o.z = v[j].z * r * gg.z; o.w = v[j].w * r * gg.w; xr[64 * j] = o; }
        }
    }
#undef IN
#undef SEAM
}

extern "C" void kernel_launch(void* const* d_in, const int* in_sizes, int n_in, void* d_out, int out_size, void* d_ws, size_t ws_size, hipStream_t stream) {
    static int grid = 0;
    if (grid == 0) {
        if (n_in != 19 || in_sizes[0] != T * D || out_size != T * D || ws_size < WS_END) { fprintf(stderr, "kernel_launch: shape/workspace mismatch: n_in %d in0 %d out %d ws %zu (need %zu)\n", n_in, n_in > 0 ? in_sizes[0] : -1, out_size, ws_size, (size_t)WS_END); grid = -1; return; }
        int dev = 0, cus = 0, per_cu = 0;
        if (hipGetDevice(&dev) != hipSuccess || hipDeviceGetAttribute(&cus, hipDeviceAttributeMultiprocessorCount, dev) != hipSuccess) { grid = -1; return; }
        if (hipFuncSetAttribute((const void*)fwd, hipFuncAttributeMaxDynamicSharedMemorySize, LDS_BYTES) != hipSuccess) { fprintf(stderr, "kernel_launch: hipFuncSetAttribute failed\n"); grid = -1; return; }
        if (hipOccupancyMaxActiveBlocksPerMultiprocessor(&per_cu, (const void*)fwd, NTHR, LDS_BYTES) != hipSuccess || per_cu < 1) { fprintf(stderr, "kernel_launch: occupancy query says %d blocks per CU\n", per_cu); (void)hipGetLastError(); grid = -1; return; }
        grid = cus;
    }
    if (grid < 0) return;
    if (hipMemsetAsync((char*)d_ws + WS_CTL, 0, CTL_ZERO_BYTES, stream) != hipSuccess) return;
    Args a{};
    for (int i = 0; i < 19; ++i) a.in[i] = (const float*)d_in[i];
    a.out = (float*)d_out; a.ws = (unsigned char*)d_ws; a.pad = MBRT;
    for (int j = 0; j < 64; ++j) a.rfreq[j] = std::pow(10000.0, -(double)j / 64.0) / 6.283185307179586476925286766559;
    constexpr int NL = MK_N_LAUNCHES;
    for (int li = 0; li < NL; ++li) {
        a.ph_lo = (NL == 1) ? 0 : li; a.ph_hi = (NL == 1) ? N_PHASES : li + 1; a.li = 0;
        hipLaunchKernelGGL(fwd, dim3(grid), dim3(NTHR), LDS_BYTES, stream, a);
    }
}
```

```cpp
#include <hip/hip_runtime.h>
#include <cstdio>
#include <cstdint>
#include <cmath>

#define GAS __attribute__((address_space(1)))
#define LAS __attribute__((address_space(3)))
typedef unsigned short bf16;
typedef unsigned v4u __attribute__((ext_vector_type(4)));
typedef unsigned v2u __attribute__((ext_vector_type(2)));
typedef float f32x4 __attribute__((ext_vector_type(4)));
typedef float f32x2 __attribute__((ext_vector_type(2)));
typedef short bf16x8 __attribute__((ext_vector_type(8)));

constexpr int T = 8192, D = 2048, HW = 1024, NH = 8, HD = 128, INC = 11264, NE = 32, DE = 512, PLE = 256, NB = 32, BS = 256;
constexpr float EPS = 1e-6f;
constexpr int NWAVES = 8, NTHR = 512;
constexpr int N_PHASES = 14;
#ifndef FP1
#define FP1 1
#endif
#ifndef FP5
#define FP5 1
#endif
#ifndef FP6
#define FP6 1
#endif
#ifndef FP9
#define FP9 1
#endif
#ifndef FP10
#define FP10 1
#endif
#ifndef FP12
#define FP12 1
#endif
#ifndef FHG
#define FHG 1
#endif
#ifndef FMB
#define FMB 1
#endif
#ifndef MK_N_LAUNCHES
#define MK_N_LAUNCHES 1
#endif

constexpr size_t MiB = 1u << 20;
constexpr size_t WS_CTL = 0, CTL_ZERO_BYTES = 64 * 1024;
constexpr size_t WS_TRIG = 2 * MiB;
constexpr size_t WS_KMEAN = 6 * MiB;
constexpr size_t WS_LB = 6 * MiB + 384 * 1024;
constexpr size_t WS_WRT = 6 * MiB + 512 * 1024;
constexpr size_t WS_ROUTE = 7 * MiB;
constexpr size_t WS_ROWSLOT = 8 * MiB;
constexpr size_t WS_PB = 10 * MiB;
constexpr size_t WS_WIN_T = 16 * MiB, WS_WUP_T = 60 * MiB, WS_WOUT_T = 68 * MiB, WS_WPG_T = 76 * MiB, WS_WPP_T = 84 * MiB;
constexpr size_t WS_PP = 86 * MiB;
constexpr size_t WS_GA = 118 * MiB, WS_GB = 150 * MiB;
constexpr size_t WS_QH = 182 * MiB;
constexpr size_t WS_GH = 198 * MiB;
constexpr size_t WS_VH = 230 * MiB, WS_OG = 246 * MiB, WS_MQ = 262 * MiB, WS_MK = 278 * MiB, WS_MV = 294 * MiB;
constexpr size_t WS_H1 = 310 * MiB;
constexpr size_t WS_TMPF = 342 * MiB;
constexpr size_t WS_DEC = 14 * MiB;
constexpr size_t WS_ST = 310 * MiB;
constexpr size_t WS_DS = 342 * MiB;
constexpr size_t WS_PO = 406 * MiB;
constexpr size_t WS_PLSE = 544 * MiB;
constexpr size_t WS_MLIST = 504 * MiB;
constexpr size_t WS_CNTP = 9 * MiB;
constexpr size_t WS_AUP = 472 * MiB;
constexpr size_t WS_MERGED = 504 * MiB;
constexpr size_t WS_HFFN = 310 * MiB;
constexpr size_t WS_XG = 342 * MiB;
constexpr size_t WS_HMOE = 438 * MiB;
constexpr size_t WS_Y = 462 * MiB;
constexpr size_t WS_HP = 342 * MiB;
constexpr size_t WS_WEGU = 118 * MiB;
constexpr size_t WS_WED = 246 * MiB;
constexpr size_t WS_END = 576 * MiB;
constexpr int CW_TMO = 0, CW_CODE = 1;
constexpr int CW_ECNT = 64;
constexpr int CW_MCNT = 128;
constexpr int CW_BAR = 4096;

constexpr int RING_BYTES = 131072;
constexpr int LDSCTL_OFF = RING_BYTES, MISC_OFF = LDSCTL_OFF + 320;
constexpr int LDS_BYTES = 147456;

typedef GAS unsigned gu32;
#define RLX_AGENT __ATOMIC_RELAXED, __HIP_MEMORY_SCOPE_AGENT
#define LDS_WAIT() asm volatile("s_waitcnt lgkmcnt(0)" ::: "memory")
#define VM_WAIT() asm volatile("s_waitcnt vmcnt(0)" ::: "memory")
typedef __bf16 hwbf2 __attribute__((ext_vector_type(2)));
__device__ __forceinline__ unsigned pk2(float lo, float hi) { hwbf2 v; v.x = (__bf16)lo; v.y = (__bf16)hi; return __builtin_bit_cast(unsigned, v); }
__device__ __forceinline__ unsigned f2bf(float f) { return pk2(f, 0.f) & 0xffffu; }
__device__ __forceinline__ float bf2f(unsigned b) { return __builtin_bit_cast(float, b << 16); }
__device__ __forceinline__ float bflo(unsigned w) { return __builtin_bit_cast(float, w << 16); }
__device__ __forceinline__ float bfhi(unsigned w) { return __builtin_bit_cast(float, w & 0xffff0000u); }
__device__ __forceinline__ float sigmoidf_(float x) { return 1.0f / (1.0f + __expf(-x)); }
__device__ __forceinline__ float siluf_(float x) { return x / (1.0f + __expf(-x)); }

#define XB_TMO      128
#define XB_XCNT(j)  (256  + 64 * (j))
#define XB_XSUB(j)  (1280 + 64 * (j))
#define XB_XGEN(j)  (2304 + 64 * (j))
#define XB_TOP      3328
#define XB_TOPGEN   3392
#define XCD_BAR_WORDS 3456
#define XB_SPIN_CAP (1u << 25)
__device__ __forceinline__ unsigned xb_ld(unsigned* p)              { return __hip_atomic_load(p, __ATOMIC_RELAXED, __HIP_MEMORY_SCOPE_AGENT); }
__device__ __forceinline__ unsigned xb_add(unsigned* p, unsigned v) { return __hip_atomic_fetch_add(p, v, __ATOMIC_RELAXED, __HIP_MEMORY_SCOPE_AGENT); }
__device__ __forceinline__ unsigned xb_xcc_id() { return (unsigned)__builtin_amdgcn_s_getreg((3 << 11) | 20) & 0xFu; }
#define XB_SPIN(cond, bar) do { unsigned _sp = 0; while (cond) { __builtin_amdgcn_s_sleep(1); \
    if ((++_sp & 255u) == 0u) { if (xb_ld(&(bar)[XB_TMO])) break; if (_sp > XB_SPIN_CAP) { atomicAdd(&(bar)[XB_TMO], 1u); break; } } } } while (0)
struct XcdBarrier { unsigned* bar; unsigned x; volatile LAS unsigned* st; };
__device__ __forceinline__ XcdBarrier xcd_barrier_post(unsigned* bar, volatile LAS unsigned* st) {
    XcdBarrier b; b.bar = bar; b.x = xb_xcc_id(); b.st = st;
    if (threadIdx.x == 0) (void)xb_add(&bar[XB_XCNT(b.x)], 1u);
    return b;
}
__device__ __forceinline__ void xcd_barrier_complete(unsigned* bar, unsigned x, unsigned& nloc, unsigned& nx) {
    const unsigned G = gridDim.x * gridDim.y * gridDim.z;
    unsigned sum, cnt, mine, sp = 0u;
    for (;;) {
        sum = 0u; cnt = 0u; mine = 0u;
#pragma unroll
        for (unsigned j = 0; j < 16; ++j) { const unsigned c = xb_ld(&bar[XB_XCNT(j)]); sum += c; cnt += (c > 0u) ? 1u : 0u; mine = (j == x) ? c : mine; }
        if (sum == G) break;
        __builtin_amdgcn_s_sleep(1);
        if ((++sp & 255u) == 0u) { if (xb_ld(&bar[XB_TMO])) break; if (sp > XB_SPIN_CAP) { atomicAdd(&bar[XB_TMO], 1u); break; } }
    }
    nloc = mine > 0u ? mine : 1u; nx = cnt > 0u ? cnt : 1u;
}
__device__ __forceinline__ void xcd_barrier(const XcdBarrier& b) {
    asm volatile("s_waitcnt vmcnt(0)" ::: "memory");
    __syncthreads();
    if (threadIdx.x == 0) {
        unsigned* bar = b.bar;
        __builtin_amdgcn_s_waitcnt(0);
        unsigned nloc = b.st[0], nx = b.st[1];
        if (nloc == 0u) { xcd_barrier_complete(bar, b.x, nloc, nx); b.st[0] = nloc; b.st[1] = nx; }
        const unsigned old = xb_add(&bar[XB_XSUB(b.x)], 1u);
        const unsigned gen = old / nloc;
        if (old + 1u == (gen + 1u) * nloc) {
            __builtin_amdgcn_fence(__ATOMIC_RELEASE, "agent");
            asm volatile("s_waitcnt vmcnt(0)" ::: "memory");
            const unsigned og = xb_add(&bar[XB_TOP], 1u);
            const unsigned tg = og / nx;
            if (og + 1u == (tg + 1u) * nx) xb_add(&bar[XB_TOPGEN], 1u);
            else XB_SPIN(xb_ld(&bar[XB_TOPGEN]) == tg, bar);
            __builtin_amdgcn_fence(__ATOMIC_ACQUIRE, "agent");
            xb_add(&bar[XB_XGEN(b.x)], 1u);
            asm volatile("s_waitcnt vmcnt(0)" ::: "memory");
        } else {
            XB_SPIN(xb_ld(&bar[XB_XGEN(b.x)]) == gen, bar);
            __builtin_amdgcn_fence(__ATOMIC_ACQUIRE, "agent");
            asm volatile("s_waitcnt vmcnt(0)" ::: "memory");
        }
    }
    __syncthreads();
}

struct Args { const float* in[19]; float* out; unsigned char* ws; double rfreq[64]; int ph_lo, ph_hi, li, pad; };
enum { I_X = 0, I_P, I_NMIX, I_WIN, I_LBRAW, I_HNG, I_WUH, I_WUM, I_WOUT, I_NFFN, I_WRG, I_WRE, I_WEG, I_WEU, I_WED, I_NPLE, I_WPG, I_WPP, I_NFIN };

struct Frame {
    LAS unsigned char* lds;
    volatile LAS unsigned* MISC;
    gu32* ctl;
    int tid, lane, wave, vcu, G;
    unsigned char* ws;
};

__device__ __forceinline__ int opaque_tid() { int t = threadIdx.x; asm volatile("" : "+v"(t)); return t; }
__device__ __forceinline__ float wave_sum(float v) {
#pragma unroll
    for (int o = 1; o < 64; o <<= 1) v += __shfl_xor(v, o);
    return v;
}
__device__ __forceinline__ float wave_max(float v) {
#pragma unroll
    for (int o = 1; o < 64; o <<= 1) v = fmaxf(v, __shfl_xor(v, o));
    return v;
}

__device__ __forceinline__ void rms_row_to_bf16(int lane, const float* xrow, const float* g, bf16* orow) {
    const f32x4* xr = (const f32x4*)xrow + lane; const f32x4* gr = (const f32x4*)g + lane;
    f32x4 v[8]; float s = 0.f;
#pragma unroll
    for (int j = 0; j < 8; ++j) { v[j] = xr[64 * j]; s += (v[j].x * v[j].x + v[j].y * v[j].y) + (v[j].z * v[j].z + v[j].w * v[j].w); }
    f32x4 g8[8];
#pragma unroll
    for (int j = 0; j < 8; ++j) g8[j] = gr[64 * j];
    const float r = 1.0f / sqrtf(wave_sum(s) * (1.f / D) + EPS);
    unsigned long long* o8 = (unsigned long long*)orow + lane;
#pragma unroll
    for (int j = 0; j < 8; ++j) { const f32x4 gg = g8[j];
        o8[64 * j] = (unsigned long long)pk2(v[j].x * r * gg.x, v[j].y * r * gg.y) | ((unsigned long long)pk2(v[j].z * r * gg.z, v[j].w * r * gg.w) << 32); }
}

__device__ __forceinline__ void sgemm_acc(float (&acc)[8][4], LAS float* As, LAS float* Bs, const bf16* A, int lda, int m0, const float* W, int ldb, int n0, int K, int tid) {
    const int tx = tid & 31, ty = tid >> 5;
    const int ar = tid >> 2, akq = tid & 3;
    for (int k0 = 0; k0 < K; k0 += 16) {
        const v2u av = *(const v2u*)(A + (size_t)(m0 + ar) * lda + k0 + akq * 4);
        const f32x4 bv = *(const f32x4*)(W + (size_t)(k0 + ty) * ldb + n0 + tx * 4);
        __syncthreads();
        As[(akq * 4 + 0) * 132 + ar] = bflo(av.x); As[(akq * 4 + 1) * 132 + ar] = bfhi(av.x);
        As[(akq * 4 + 2) * 132 + ar] = bflo(av.y); As[(akq * 4 + 3) * 132 + ar] = bfhi(av.y);
        *(LAS f32x4*)(Bs + ty * 128 + tx * 4) = bv;
        __syncthreads();
#pragma unroll 4
        for (int kk = 0; kk < 16; ++kk) {
            const f32x4 a0 = *(const LAS f32x4*)(As + kk * 132 + ty * 8), a1 = *(const LAS f32x4*)(As + kk * 132 + ty * 8 + 4);
            const f32x4 b = *(const LAS f32x4*)(Bs + kk * 128 + tx * 4);
            const float a[8] = {a0.x, a0.y, a0.z, a0.w, a1.x, a1.y, a1.z, a1.w};
#pragma unroll
            for (int i = 0; i < 8; ++i) { acc[i][0] += a[i] * b.x; acc[i][1] += a[i] * b.y; acc[i][2] += a[i] * b.z; acc[i][3] += a[i] * b.w; }
        }
    }
    __syncthreads();
}
__device__ __forceinline__ void zero_acc(float (&acc)[8][4]) {
#pragma unroll
    for (int i = 0; i < 8; ++i) { acc[i][0] = 0.f; acc[i][1] = 0.f; acc[i][2] = 0.f; acc[i][3] = 0.f; }
}
__device__ __forceinline__ void st_bf16x4(bf16* p, float a, float b, float c, float d) { v2u w; w.x = pk2(a, b); w.y = pk2(c, d); *(v2u*)p = w; }

__device__ __forceinline__ void inproj_epi(unsigned char* ws, int m, int n, const float (&v)[4]) {
    if (n < 1024) { st_bf16x4((bf16*)(ws + WS_QH) + (size_t)m * HW + n, siluf_(v[0]), siluf_(v[1]), siluf_(v[2]), siluf_(v[3])); }
    else if (n < 2048) { const int c = n - 1024; const f32x4 lb = *(const f32x4*)((const float*)(ws + WS_LB) + c);
        f32x4 o; o.x = __logf(lb.x + (1.f - lb.x) * sigmoidf_(v[0])); o.y = __logf(lb.y + (1.f - lb.y) * sigmoidf_(v[1]));
        o.z = __logf(lb.z + (1.f - lb.z) * sigmoidf_(v[2])); o.w = __logf(lb.w + (1.f - lb.w) * sigmoidf_(v[3]));
        *(f32x4*)((float*)(ws + WS_GH) + (size_t)m * HW + c) = o; }
    else if (n < 3072) { st_bf16x4((bf16*)(ws + WS_VH) + (size_t)m * HW + (n - 2048), v[0], v[1], v[2], v[3]); }
    else if (n < 4096) { st_bf16x4((bf16*)(ws + WS_OG) + (size_t)m * HW + (n - 3072), siluf_(v[0]), siluf_(v[1]), siluf_(v[2]), siluf_(v[3])); }
    else if (n < 6144) { f32x4 o = {v[0], v[1], v[2], v[3]}; *(f32x4*)((float*)(ws + WS_TMPF) + (size_t)m * D + (n - 4096)) = o; }
    else if (n < 7168) { st_bf16x4((bf16*)(ws + WS_MV) + (size_t)m * HW + (n - 6144), v[0], v[1], v[2], v[3]); }
    else if (n < 9216) { st_bf16x4((bf16*)(ws + WS_GA) + (size_t)m * D + (n - 7168), sigmoidf_(v[0]), sigmoidf_(v[1]), sigmoidf_(v[2]), sigmoidf_(v[3])); }
    else { st_bf16x4((bf16*)(ws + WS_GB) + (size_t)m * D + (n - 9216), sigmoidf_(v[0]), sigmoidf_(v[1]), sigmoidf_(v[2]), sigmoidf_(v[3])); }
}


__device__ __forceinline__ void transpose_item(const float* W, int ldw, int k0, int sn0, bf16* WT, int ldt, int drow0, int dcol0, LAS float* scr, int lane) {
#pragma unroll 8
    for (int i = 0; i < 32; ++i) { const int kk = 2 * i + (lane >> 5); scr[kk * 33 + (lane & 31)] = W[(size_t)(k0 + kk) * ldw + sn0 + (lane & 31)]; }
    LDS_WAIT(); asm volatile("" ::: "memory");
    const int c = lane & 7;
#pragma unroll
    for (int j = 0; j < 4; ++j) { const int n = (lane >> 3) + 8 * j; const LAS float* sp = scr + (8 * c) * 33 + n;
        v4u o; o.x = pk2(sp[0 * 33], sp[1 * 33]); o.y = pk2(sp[2 * 33], sp[3 * 33]); o.z = pk2(sp[4 * 33], sp[5 * 33]); o.w = pk2(sp[6 * 33], sp[7 * 33]);
        *(v4u*)(WT + (size_t)(drow0 + n) * ldt + dcol0 + 8 * c) = o; }
    LDS_WAIT(); asm volatile("" ::: "memory");
}
struct TrItem { const float* src; bf16* dst; int ldw, ldt; };
__device__ __forceinline__ void tr_load(f32x4 (&v)[8], const float* src, int ldw, int lane) {
    const int kr = lane >> 3, c4 = 4 * (lane & 7);
#pragma unroll
    for (int i = 0; i < 8; ++i) v[i] = *(const f32x4*)(src + (size_t)(8 * i + kr) * ldw + c4);
}
__device__ __forceinline__ void tr_store(const f32x4 (&v)[8], bf16* dst, int ldt, LAS float* scr, int lane) {
    const int kr = lane >> 3, c4 = 4 * (lane & 7);
#pragma unroll
    for (int i = 0; i < 8; ++i) { LAS float* d = scr + (8 * i + kr) * 33 + c4; d[0] = v[i].x; d[1] = v[i].y; d[2] = v[i].z; d[3] = v[i].w; }
    LDS_WAIT(); asm volatile("" ::: "memory");
    const int c = lane & 7;
#pragma unroll
    for (int j = 0; j < 4; ++j) { const int n = (lane >> 3) + 8 * j; const LAS float* sp = scr + (8 * c) * 33 + n;
        v4u o; o.x = pk2(sp[0 * 33], sp[1 * 33]); o.y = pk2(sp[2 * 33], sp[3 * 33]); o.z = pk2(sp[4 * 33], sp[5 * 33]); o.w = pk2(sp[6 * 33], sp[7 * 33]);
        *(v4u*)(dst + (size_t)n * ldt + 8 * c) = o; }
    LDS_WAIT(); asm volatile("" ::: "memory");
}
#define TR_PIPE(first, N, step, ITEM) do { f32x4 va_[8], vb_[8]; TrItem ia_, ib_; int it_ = (first); \
    if (it_ < (N)) { ia_ = ITEM(it_); tr_load(va_, ia_.src, ia_.ldw, lane); } \
    while (it_ < (N)) { const int i2_ = it_ + (step); \
        if (i2_ < (N)) { ib_ = ITEM(i2_); tr_load(vb_, ib_.src, ib_.ldw, lane); } \
        tr_store(va_, ia_.dst, ia_.ldt, scr, lane); \
        if (i2_ >= (N)) break; \
        const int i3_ = i2_ + (step); \
        if (i3_ < (N)) { ia_ = ITEM(i3_); tr_load(va_, ia_.src, ia_.ldw, lane); } \
        tr_store(vb_, ib_.dst, ib_.ldt, scr, lane); \
        it_ = i3_; } } while (0)

__device__ __forceinline__ int phys2log_inproj(int n0) {
    const int tile = n0 >> 8; if (tile < 16 || tile >= 24) return n0;
    const int p = n0 & 255, bj = p >> 7, q = p & 127, head = 2 * ((tile - 16) & 3) + (q >> 6), d = (q & 63) + 64 * bj, which = (tile - 16) >> 2;
    return 4096 + which * 1024 + head * 128 + d;
}


typedef short v4i16_t __attribute__((ext_vector_type(4)));
__device__ __forceinline__ f32x4 mfma16(bf16x8 a, bf16x8 b, f32x4 c) { return __builtin_amdgcn_mfma_f32_16x16x32_bf16(a, b, c, 0, 0, 0); }
constexpr int HG_RED = 0, HG_BR = 2048, HG_RS = 2560, HG_KT = 4096, HG_VT = HG_KT + 128 * 144, HG_Q1 = HG_VT + 128 * 144, HG_K1 = HG_Q1 + 64 * 272, HG_Q2 = HG_K1 + 64 * 272, HG_P = HG_Q2 + 64 * 272;
static_assert(HG_P + 64 * 144 <= 131072, "hgrn lds");

__device__ __forceinline__ void hgrn_cumsum(const float* G, int col, int qt, LAS float* red, float (&gv)[16], float (&b)[16], float& btot) {
    float run = 0.f;
#pragma unroll
    for (int i = 0; i < 16; ++i) { gv[i] = G[(size_t)(16 * qt + i) * HW + col]; }
#pragma unroll
    for (int i = 0; i < 16; ++i) { run += gv[i]; b[i] = run; }
    red[qt * 128 + col] = run;
    __syncthreads();
    const float r0 = red[col], r1 = red[128 + col], r2 = red[256 + col], r3 = red[384 + col];
    const float pre = (qt > 0 ? r0 : 0.f) + (qt > 1 ? r1 : 0.f) + (qt > 2 ? r2 : 0.f);
    btot = ((r0 + r1) + r2) + r3;
#pragma unroll
    for (int i = 0; i < 16; ++i) b[i] += pre;
}
__device__ __forceinline__ void st_lds_bf16x16(LAS unsigned char* p, const float (&v)[16]) {
    v4u a, b; a.x = pk2(v[0], v[1]); a.y = pk2(v[2], v[3]); a.z = pk2(v[4], v[5]); a.w = pk2(v[6], v[7]); b.x = pk2(v[8], v[9]); b.y = pk2(v[10], v[11]); b.z = pk2(v[12], v[13]); b.w = pk2(v[14], v[15]);
    *(LAS v4u*)p = a; *(LAS v4u*)(p + 16) = b;
}
__device__ __forceinline__ void hgrn_pass_a(unsigned char* ws, LAS unsigned char* lds, int item, int tid) {
    const int c = item >> 3, h = item & 7, col = tid & 127, qt = tid >> 7, lane = tid & 63, w = tid >> 6, t0 = c * 64;
    float gv[16], b[16], btot;
    hgrn_cumsum((const float*)(ws + WS_GH) + (size_t)t0 * HW + h * HD, col, qt, (LAS float*)(lds + HG_RED), gv, b, btot);
    float kt[16], vv[16];
    const bf16* VH = (const bf16*)(ws + WS_VH) + (size_t)(t0 + 16 * qt) * HW + h * HD + col;
#pragma unroll
    for (int i = 0; i < 16; ++i) { kt[i] = (1.f - __expf(gv[i])) * __expf(btot - b[i]); vv[i] = bf2f(VH[(size_t)i * HW]); }
    st_lds_bf16x16(lds + HG_KT + col * 144 + qt * 32, kt); st_lds_bf16x16(lds + HG_VT + col * 144 + qt * 32, vv);
    if (qt == 0) ((float*)(ws + WS_DEC))[(size_t)item * HD + col] = __expf(btot);
    __syncthreads();
    const int fr = lane & 15, fq = lane >> 4;
    const bf16x8 a0 = *(const LAS bf16x8*)(lds + HG_KT + (16 * w + fr) * 144 + fq * 16), a1 = *(const LAS bf16x8*)(lds + HG_KT + (16 * w + fr) * 144 + fq * 16 + 64);
    bf16* dst = (bf16*)(ws + WS_DS) + (size_t)item * HD * HD + 16 * w + 4 * fq;
#pragma unroll
    for (int nt = 0; nt < 8; ++nt) {
        const bf16x8 b0 = *(const LAS bf16x8*)(lds + HG_VT + (16 * nt + fr) * 144 + fq * 16), b1 = *(const LAS bf16x8*)(lds + HG_VT + (16 * nt + fr) * 144 + fq * 16 + 64);
        f32x4 acc = {0.f, 0.f, 0.f, 0.f}; acc = mfma16(a0, b0, acc); acc = mfma16(a1, b1, acc);
        { v2u wv; wv.x = pk2(acc[0], acc[1]); wv.y = pk2(acc[2], acc[3]); *(v2u*)(dst + (size_t)(16 * nt + fr) * HD) = wv; }
    }
    __syncthreads();
}
__device__ __forceinline__ void hgrn_pass_c(unsigned char* ws, LAS unsigned char* lds, const float* ng, int item, int tid) {
    const int c = item >> 3, h = item & 7, col = tid & 127, qt = tid >> 7, lane = tid & 63, w = tid >> 6, t0 = c * 64, fr = lane & 15, fq = lane >> 4;
    const int fr_ = lane & 15, fq_ = lane >> 4, mt_ = w & 3, vh_ = w >> 2;
    bf16 qraw[16], vraw[16];
    { const bf16* QHp = (const bf16*)(ws + WS_QH) + (size_t)(t0 + 16 * qt) * HW + h * HD + col; const bf16* VHp = (const bf16*)(ws + WS_VH) + (size_t)(t0 + 16 * qt) * HW + h * HD + col;
#pragma unroll
      for (int i = 0; i < 16; ++i) { qraw[i] = QHp[(size_t)i * HW]; vraw[i] = VHp[(size_t)i * HW]; } }
    bf16x8 stf[4][4];
    { const bf16* STp = (const bf16*)(ws + WS_ST) + (size_t)item * HD * HD;
#pragma unroll
      for (int nt = 0; nt < 4; ++nt)
#pragma unroll
          for (int ks = 0; ks < 4; ++ks) stf[nt][ks] = *(const bf16x8*)(STp + (size_t)(16 * (4 * vh_ + nt) + fr_) * HD + fq_ * 8 + ks * 32); }
    bf16 ograw[4][4]; float ngv[4];
#pragma unroll
    for (int nt = 0; nt < 4; ++nt) ngv[nt] = ng[16 * (4 * vh_ + nt) + fr_];
#pragma unroll
    for (int r = 0; r < 4; ++r)
#pragma unroll
        for (int nt = 0; nt < 4; ++nt) ograw[r][nt] = ((const bf16*)(ws + WS_OG))[(size_t)(t0 + 16 * mt_ + 4 * fq_ + r) * HW + h * HD + 16 * (4 * vh_ + nt) + fr_];
    float gv[16], b[16], btot;
    hgrn_cumsum((const float*)(ws + WS_GH) + (size_t)t0 * HW + h * HD, col, qt, (LAS float*)(lds + HG_RED), gv, b, btot);
    LAS float* BR = (LAS float*)(lds + HG_BR);
    if (qt == 1) BR[col] = b[15];
    float vv[16];
#pragma unroll
    for (int i = 0; i < 16; ++i) vv[i] = bf2f(vraw[i]);
    st_lds_bf16x16(lds + HG_VT + col * 144 + qt * 32, vv);
    __syncthreads();
    const float bref = BR[col];
    {
#pragma unroll
      for (int i = 0; i < 16; ++i) { const float q = bf2f(qraw[i]); const int s = 16 * qt + i;
          *(LAS bf16*)(lds + HG_Q1 + s * 272 + col * 2) = (bf16)f2bf(q * __expf(b[i] - bref));
          *(LAS bf16*)(lds + HG_Q2 + s * 272 + col * 2) = (bf16)f2bf(q * __expf(b[i]));
          *(LAS bf16*)(lds + HG_K1 + s * 272 + col * 2) = (bf16)f2bf((1.f - __expf(gv[i])) * __expf(bref - b[i])); } }
    __syncthreads();
    {
        const int mt = w >> 1;
#pragma unroll
        for (int u = 0; u < 2; ++u) { const int nt = 2 * (w & 1) + u; f32x4 acc = {0.f, 0.f, 0.f, 0.f};
            if (nt <= mt) {
#pragma unroll
                for (int ks = 0; ks < 4; ++ks) { const bf16x8 a = *(const LAS bf16x8*)(lds + HG_Q1 + (16 * mt + fr) * 272 + fq * 16 + ks * 64), bb = *(const LAS bf16x8*)(lds + HG_K1 + (16 * nt + fr) * 272 + fq * 16 + ks * 64);
                    acc = mfma16(a, bb, acc); } }
            const int sidx = 16 * nt + fr;
#pragma unroll
            for (int r = 0; r < 4; ++r) { const int tr = 16 * mt + 4 * fq + r; const float pv = (nt <= mt && sidx <= tr) ? acc[r] : 0.f;
                *(LAS bf16*)(lds + HG_P + tr * 144 + sidx * 2) = (bf16)f2bf(pv); } }
    }
    __syncthreads();
    const int mt = w & 3, vh = w >> 2;
    f32x4 o[4];
#pragma unroll
    for (int nt = 0; nt < 4; ++nt) { const int vt = 4 * vh + nt; f32x4 acc = {0.f, 0.f, 0.f, 0.f};
#pragma unroll
        for (int ks = 0; ks < 2; ++ks) { const bf16x8 a = *(const LAS bf16x8*)(lds + HG_P + (16 * mt + fr) * 144 + fq * 16 + ks * 64), bb = *(const LAS bf16x8*)(lds + HG_VT + (16 * vt + fr) * 144 + fq * 16 + ks * 64);
            acc = mfma16(a, bb, acc); }
#pragma unroll
        for (int ks = 0; ks < 4; ++ks) { const bf16x8 a = *(const LAS bf16x8*)(lds + HG_Q2 + (16 * mt + fr) * 272 + fq * 16 + ks * 64); const bf16x8 bb = stf[nt][ks];
            acc = mfma16(a, bb, acc); }
        o[nt] = acc; }
    LAS float* RS = (LAS float*)(lds + HG_RS);
#pragma unroll
    for (int r = 0; r < 4; ++r) { float ss = 0.f;
#pragma unroll
        for (int nt = 0; nt < 4; ++nt) ss += o[nt][r] * o[nt][r];
        ss += __shfl_xor(ss, 1); ss += __shfl_xor(ss, 2); ss += __shfl_xor(ss, 4); ss += __shfl_xor(ss, 8);
        if (fr == 0) RS[vh * 64 + 16 * mt + 4 * fq + r] = ss; }
    __syncthreads();
    bf16* AUP = (bf16*)(ws + WS_AUP);
#pragma unroll
    for (int r = 0; r < 4; ++r) { const int tl = 16 * mt + 4 * fq + r; const float rn = 1.0f / sqrtf((RS[tl] + RS[64 + tl]) * (1.f / HD) + EPS);
#pragma unroll
        for (int nt = 0; nt < 4; ++nt) { const int v = 16 * (4 * vh + nt) + fr;
            AUP[(size_t)(t0 + tl) * D + h * HD + v] = (bf16)f2bf(o[nt][r] * rn * ngv[nt] * bf2f(ograw[r][nt])); } }
    __syncthreads();
}
__device__ __forceinline__ void moba_gate_item(unsigned char* ws, LAS unsigned char* lds, int item, int tid) {
    const int h = item >> 5, cur = item & 31, lane = tid & 63;
    if (cur == 0) return;
    LAS float* km = (LAS float*)lds;
    LAS unsigned* lcnt = (LAS unsigned*)(lds + 16384);
    if (tid < NB) lcnt[tid] = 0u;
    { const float* KM = (const float*)(ws + WS_KMEAN);
      for (int i = tid; i < NB * HD; i += NTHR) { const int j = i >> 7, d = i & 127; km[i] = (KM[(size_t)j * HW + h * HD + d] + KM[(size_t)(NB + j) * HW + h * HD + d]) * (1.f / BS); } }
    __syncthreads();
    if (tid < 256) {
        const int t = cur * BS + tid;
        const v4u* qp = (const v4u*)((const bf16*)(ws + WS_MQ) + (size_t)t * HW + h * HD);
        float g[32];
#pragma unroll
        for (int j = 0; j < 32; ++j) g[j] = 0.f;
        for (int dc = 0; dc < 16; ++dc) { const v4u qw = qp[dc]; const float q0 = bflo(qw.x), q1 = bfhi(qw.x), q2 = bflo(qw.y), q3 = bfhi(qw.y), q4 = bflo(qw.z), q5 = bfhi(qw.z), q6 = bflo(qw.w), q7 = bfhi(qw.w);
#pragma unroll
            for (int j = 0; j < 32; ++j) if (j < cur) { const f32x4 k0 = *(const LAS f32x4*)(km + j * 128 + dc * 8), k1 = *(const LAS f32x4*)(km + j * 128 + dc * 8 + 4);
                g[j] += (q0 * k0.x + q1 * k0.y + q2 * k0.z + q3 * k0.w) + (q4 * k1.x + q5 * k1.y + q6 * k1.z + q7 * k1.w); } }
#pragma unroll
        for (int j = 0; j < 32; ++j) if (j >= cur) g[j] = -3.0e38f;
        unsigned* LIST = (unsigned*)(ws + WS_MLIST);
#pragma unroll
        for (int r = 0; r < 3; ++r) {
            float best = g[0]; int bi = 0;
#pragma unroll
            for (int j = 1; j < 32; ++j) if (g[j] > best) { best = g[j]; bi = j; }
#pragma unroll
            for (int j = 0; j < 32; ++j) if (j == bi) g[j] = -3.0e38f;
            if (r < cur) {
                const int pos = (int)__hip_atomic_fetch_add(lcnt + bi, 1u, __ATOMIC_RELAXED, __HIP_MEMORY_SCOPE_WORKGROUP);
                LIST[(size_t)((h * NB + bi) * NB + cur) * 256 + pos] = ((unsigned)t << 2) | (unsigned)(r + 1);
            }
        }
    }
    __syncthreads();
    if (tid < NB) ((int*)(ws + WS_CNTP))[(h * NB + cur) * NB + tid] = (int)lcnt[tid];
    __syncthreads();
}
__device__ __forceinline__ void moba_unit(unsigned char* ws, LAS unsigned char* lds, int h, int j, int cur, bool causal, int g, int n, const LAS int* lst, int tid) {
    const int lane = tid & 63, w = tid >> 6, fr = lane & 15, fq = lane >> 4;
    const bf16* MK = (const bf16*)(ws + WS_MK) + (size_t)(j * BS) * HW + h * HD; const bf16* MV = (const bf16*)(ws + WS_MV) + (size_t)(j * BS) * HW + h * HD;
#pragma unroll
    for (int i = 0; i < 8; ++i) { const int p = i * NTHR + tid, row = p >> 4, ch = p & 15;
        const v4u kv = *(const v4u*)(MK + (size_t)row * HW + ch * 8), vv = *(const v4u*)(MV + (size_t)row * HW + ch * 8);
        *(LAS v4u*)(lds + row * 256 + ((ch ^ (row & 15)) << 4)) = kv; *(LAS v4u*)(lds + 65536 + row * 256 + ((ch ^ ((row & 7) << 1)) << 4)) = vv; }
    int t, slot; bool valid = true;
    if (causal) { t = cur * BS + g * 128 + w * 16 + fr; slot = 0; }
    else { int rr = g * 128 + w * 16 + fr; valid = rr < n; if (!valid) rr = n - 1; rr = rr < 0 ? 0 : (rr > 255 ? 255 : rr); const int e = lst[rr]; t = cur * BS + ((e >> 2) & 255); slot = e & 3; if (slot == 0) valid = false; }
    bf16x8 qa[4];
    { const bf16* qp = (const bf16*)(ws + WS_MQ) + (size_t)t * HW + h * HD + fq * 8;
#pragma unroll
      for (int ks = 0; ks < 4; ++ks) qa[ks] = *(const bf16x8*)(qp + ks * 32); }
    __syncthreads();
    const bool wact = causal || (__builtin_amdgcn_readfirstlane(g * 128 + (tid >> 6) * 16) < n);
    if (wact) {
    const int qidx = g * 128 + w * 16 + fr;
    const int ntmax = causal ? (g * 128 + w * 16 + 15) >> 4 : 15;
    f32x4 acc[16];
#pragma unroll
    for (int nt = 0; nt < 16; ++nt) { acc[nt] = (f32x4){0.f, 0.f, 0.f, 0.f};
        if (nt <= ntmax) { const int row = 16 * nt + fr;
#pragma unroll
            for (int ks = 0; ks < 4; ++ks) { const bf16x8 kf = *(const LAS bf16x8*)(lds + row * 256 + (((4 * ks + fq) ^ fr) << 4)); acc[nt] = mfma16(kf, qa[ks], acc[nt]); }
            if (causal) {
#pragma unroll
                for (int r = 0; r < 4; ++r) if (16 * nt + 4 * fq + r > qidx) acc[nt][r] = -3.0e38f; }
        } else { acc[nt] = (f32x4){-3.0e38f, -3.0e38f, -3.0e38f, -3.0e38f}; } }
    float m = -3.0e38f;
#pragma unroll
    for (int nt = 0; nt < 16; ++nt) m = fmaxf(fmaxf(fmaxf(m, acc[nt][0]), fmaxf(acc[nt][1], acc[nt][2])), acc[nt][3]);
    m = fmaxf(m, __shfl_xor(m, 16)); m = fmaxf(m, __shfl_xor(m, 32));
    const float cexp = 0.08838834764831845f * 1.4426950408889634f; float l = 0.f;
    bf16x8 pa[8];
#pragma unroll
    for (int k2 = 0; k2 < 8; ++k2) { float p[8];
#pragma unroll
        for (int r = 0; r < 4; ++r) { p[r] = __builtin_amdgcn_exp2f((acc[2 * k2][r] - m) * cexp); p[4 + r] = __builtin_amdgcn_exp2f((acc[2 * k2 + 1][r] - m) * cexp); }
        l += ((p[0] + p[1]) + (p[2] + p[3])) + ((p[4] + p[5]) + (p[6] + p[7]));
        v4u pw; pw.x = pk2(p[0], p[1]); pw.y = pk2(p[2], p[3]); pw.z = pk2(p[4], p[5]); pw.w = pk2(p[6], p[7]); pa[k2] = __builtin_bit_cast(bf16x8, pw); }
    l += __shfl_xor(l, 16); l += __shfl_xor(l, 32);
    f32x4 o[8];
    const int gl = fr >> 2, pp = fr & 3;
#pragma unroll
    for (int dt = 0; dt < 8; ++dt) o[dt] = (f32x4){0.f, 0.f, 0.f, 0.f};
#pragma unroll
    for (int k2 = 0; k2 < 8; ++k2) { const int r0 = 32 * k2 + 4 * fq + gl, r1 = r0 + 16;
#pragma unroll
        for (int dt = 0; dt < 8; ++dt) { const int ch = 2 * dt + (pp >> 1);
            const v4i16_t lo = __builtin_amdgcn_ds_read_tr16_b64_v4i16((LAS v4i16_t*)(lds + 65536 + r0 * 256 + ((ch ^ ((r0 & 7) << 1)) << 4) + 8 * (pp & 1)));
            const v4i16_t hi = __builtin_amdgcn_ds_read_tr16_b64_v4i16((LAS v4i16_t*)(lds + 65536 + r1 * 256 + ((ch ^ ((r1 & 7) << 1)) << 4) + 8 * (pp & 1)));
            bf16x8 vf; vf[0] = lo[0]; vf[1] = lo[1]; vf[2] = lo[2]; vf[3] = lo[3]; vf[4] = hi[0]; vf[5] = hi[1]; vf[6] = hi[2]; vf[7] = hi[3];
            o[dt] = mfma16(vf, pa[k2], o[dt]); } }
    const float il = 1.0f / l;
    int t2, slot2; bool valid2 = true;
    if (causal) { t2 = cur * BS + g * 128 + w * 16 + fr; slot2 = 0; }
    else { int rr = g * 128 + w * 16 + fr; valid2 = rr < n; if (!valid2) rr = n - 1; rr = rr < 0 ? 0 : (rr > 255 ? 255 : rr); const int e = lst[rr]; t2 = cur * BS + ((e >> 2) & 255); slot2 = e & 3; if (slot2 == 0) valid2 = false; }
    if (valid2) { bf16* po = (bf16*)(ws + WS_PO) + ((size_t)(t2 * NH + h) * 4 + slot2) * HD + 4 * fq;
#pragma unroll
        for (int dt = 0; dt < 8; ++dt) { v2u wv; wv.x = pk2(o[dt][0] * il, o[dt][1] * il); wv.y = pk2(o[dt][2] * il, o[dt][3] * il); *(v2u*)(po + 16 * dt) = wv; }
        if (fq == 0) ((float*)(ws + WS_PLSE))[((size_t)(t2 * NH + h) * 4 + slot2) * 32] = m * 0.08838834764831845f + __logf(l); }
    }
    __syncthreads();
}

__device__ __forceinline__ void moba_unit2(unsigned char* ws, LAS unsigned char* lds, int h, int j, bool causal, int g, int n, const unsigned short* glist, int tid) {
    const int lane = tid & 63, w = tid >> 6, fr = lane & 15, fq = lane >> 4;
    int t, slot; bool valid = true;
    if (causal) { t = j * BS + g * 128 + w * 16 + fr; slot = 0; }
    else { int rr = g * 128 + w * 16 + fr; valid = rr < n; if (!valid) rr = n - 1; rr = rr < 0 ? 0 : rr; const int e = (int)glist[rr]; t = (e >> 2) & (T - 1); slot = e & 3; if (slot == 0) valid = false; }
    bf16x8 qa[4];
    { const bf16* qp = (const bf16*)(ws + WS_MQ) + (size_t)t * HW + h * HD + fq * 8;
#pragma unroll
      for (int ks = 0; ks < 4; ++ks) qa[ks] = *(const bf16x8*)(qp + ks * 32); }
    __syncthreads();
    const bool wact = causal || (__builtin_amdgcn_readfirstlane(g * 128 + (tid >> 6) * 16) < n);
    if (wact) {
    const int qidx = g * 128 + w * 16 + fr;
    const int ntmax = causal ? (g * 128 + w * 16 + 15) >> 4 : 15;
    f32x4 acc[16];
#pragma unroll
    for (int nt = 0; nt < 16; ++nt) { acc[nt] = (f32x4){0.f, 0.f, 0.f, 0.f};
        if (nt <= ntmax) { const int row = 16 * nt + fr;
#pragma unroll
            for (int ks = 0; ks < 4; ++ks) { const bf16x8 kf = *(const LAS bf16x8*)(lds + row * 256 + (((4 * ks + fq) ^ fr) << 4)); acc[nt] = mfma16(kf, qa[ks], acc[nt]); }
            if (causal) {
#pragma unroll
                for (int r = 0; r < 4; ++r) if (16 * nt + 4 * fq + r > qidx) acc[nt][r] = -3.0e38f; }
        } else { acc[nt] = (f32x4){-3.0e38f, -3.0e38f, -3.0e38f, -3.0e38f}; } }
    float m = -3.0e38f;
#pragma unroll
    for (int nt = 0; nt < 16; ++nt) m = fmaxf(fmaxf(fmaxf(m, acc[nt][0]), fmaxf(acc[nt][1], acc[nt][2])), acc[nt][3]);
    m = fmaxf(m, __shfl_xor(m, 16)); m = fmaxf(m, __shfl_xor(m, 32));
    const float cexp = 0.08838834764831845f * 1.4426950408889634f; float l = 0.f;
    bf16x8 pa[8];
#pragma unroll
    for (int k2 = 0; k2 < 8; ++k2) { float p[8];
#pragma unroll
        for (int r = 0; r < 4; ++r) { p[r] = __builtin_amdgcn_exp2f((acc[2 * k2][r] - m) * cexp); p[4 + r] = __builtin_amdgcn_exp2f((acc[2 * k2 + 1][r] - m) * cexp); }
        l += ((p[0] + p[1]) + (p[2] + p[3])) + ((p[4] + p[5]) + (p[6] + p[7]));
        v4u pw; pw.x = pk2(p[0], p[1]); pw.y = pk2(p[2], p[3]); pw.z = pk2(p[4], p[5]); pw.w = pk2(p[6], p[7]); pa[k2] = __builtin_bit_cast(bf16x8, pw); }
    l += __shfl_xor(l, 16); l += __shfl_xor(l, 32);
    f32x4 o[8];
    const int gl = fr >> 2, pp = fr & 3;
#pragma unroll
    for (int dt = 0; dt < 8; ++dt) o[dt] = (f32x4){0.f, 0.f, 0.f, 0.f};
#pragma unroll
    for (int k2 = 0; k2 < 8; ++k2) { const int r0 = 32 * k2 + 4 * fq + gl, r1 = r0 + 16;
#pragma unroll
        for (int dt = 0; dt < 8; ++dt) { const int ch = 2 * dt + (pp >> 1);
            const v4i16_t lo = __builtin_amdgcn_ds_read_tr16_b64_v4i16((LAS v4i16_t*)(lds + 65536 + r0 * 256 + ((ch ^ ((r0 & 7) << 1)) << 4) + 8 * (pp & 1)));
            const v4i16_t hi = __builtin_amdgcn_ds_read_tr16_b64_v4i16((LAS v4i16_t*)(lds + 65536 + r1 * 256 + ((ch ^ ((r1 & 7) << 1)) << 4) + 8 * (pp & 1)));
            bf16x8 vf; vf[0] = lo[0]; vf[1] = lo[1]; vf[2] = lo[2]; vf[3] = lo[3]; vf[4] = hi[0]; vf[5] = hi[1]; vf[6] = hi[2]; vf[7] = hi[3];
            o[dt] = mfma16(vf, pa[k2], o[dt]); } }
    const float il = 1.0f / l;
    int t2, slot2; bool valid2 = true;
    if (causal) { t2 = j * BS + g * 128 + w * 16 + fr; slot2 = 0; }
    else { int rr = g * 128 + w * 16 + fr; valid2 = rr < n; if (!valid2) rr = n - 1; rr = rr < 0 ? 0 : rr; const int e = (int)glist[rr]; t2 = (e >> 2) & (T - 1); slot2 = e & 3; if (slot2 == 0) valid2 = false; }
    if (valid2) { bf16* po = (bf16*)(ws + WS_PO) + ((size_t)(t2 * NH + h) * 4 + slot2) * HD + 4 * fq;
#pragma unroll
        for (int dt = 0; dt < 8; ++dt) { v2u wv; wv.x = pk2(o[dt][0] * il, o[dt][1] * il); wv.y = pk2(o[dt][2] * il, o[dt][3] * il); *(v2u*)(po + 16 * dt) = wv; }
        if (fq == 0) ((float*)(ws + WS_PLSE))[((size_t)(t2 * NH + h) * 4 + slot2) * 32] = m * 0.08838834764831845f + __logf(l); }
    }
    __syncthreads();
}


constexpr size_t WS_GL = 16 * MiB;
constexpr int MB_RCH = 512;
__device__ __forceinline__ void moba_kv_item(unsigned char* ws, LAS unsigned char* lds, int h, int j, bool causal, const unsigned short* glist, int n, int tid) {
    const int lane = tid & 63, w = tid >> 6, fr = lane & 15, fq = lane >> 4;
    { const bf16* MK = (const bf16*)(ws + WS_MK) + (size_t)(j * BS) * HW + h * HD; const bf16* MV = (const bf16*)(ws + WS_MV) + (size_t)(j * BS) * HW + h * HD;
#pragma unroll
    for (int i = 0; i < 8; ++i) { const int p = i * NTHR + tid, row = p >> 4, ch = p & 15;
        const v4u kv = *(const v4u*)(MK + (size_t)row * HW + ch * 8), vv = *(const v4u*)(MV + (size_t)row * HW + ch * 8);
        *(LAS v4u*)(lds + row * 256 + ((ch ^ (row & 15)) << 4)) = kv; *(LAS v4u*)(lds + 65536 + row * 256 + ((ch ^ ((row & 7) << 1)) << 4)) = vv; } }
    const int ng = (n + 127) >> 7;
#define MKV_FETCH(G) do { int rr_ = (G) * 128 + w * 16 + fr; int ee_; \
        if (causal) ee_ = ((j * BS + rr_) << 2) | 0x8000; \
        else { const bool v_ = rr_ < n; if (!v_) rr_ = n - 1; rr_ = rr_ < 0 ? 0 : rr_; ee_ = (int)glist[rr_]; ee_ = (v_ && (ee_ & 3)) ? (ee_ | 0x8000) : (ee_ & 0x7fff); } \
        e_n = ee_; const bf16* qp_ = (const bf16*)(ws + WS_MQ) + (size_t)((ee_ >> 2) & (T - 1)) * HW + h * HD + fq * 8; \
        _Pragma("unroll") for (int ks_ = 0; ks_ < 4; ++ks_) qn[ks_] = *(const bf16x8*)(qp_ + ks_ * 32); } while (0)
    int e_n; bf16x8 qn[4];
    MKV_FETCH(0);
    __syncthreads();
    for (int g = 0; g < ng; ++g) {
        const int e = e_n; bf16x8 qa[4];
#pragma unroll
        for (int ks = 0; ks < 4; ++ks) qa[ks] = qn[ks];
        if (g + 1 < ng) MKV_FETCH(g + 1);
        const bool wact = causal || (__builtin_amdgcn_readfirstlane(g * 128 + w * 16) < n);
        if (wact) {
    const int qidx = g * 128 + w * 16 + fr;
    const int ntmax = causal ? (g * 128 + w * 16 + 15) >> 4 : 15;
    f32x4 acc[16];
#pragma unroll
    for (int nt = 0; nt < 16; ++nt) { acc[nt] = (f32x4){0.f, 0.f, 0.f, 0.f};
        if (nt <= ntmax) { const int row = 16 * nt + fr;
#pragma unroll
            for (int ks = 0; ks < 4; ++ks) { const bf16x8 kf = *(const LAS bf16x8*)(lds + row * 256 + (((4 * ks + fq) ^ fr) << 4)); acc[nt] = mfma16(kf, qa[ks], acc[nt]); }
            if (causal) {
#pragma unroll
                for (int r = 0; r < 4; ++r) if (16 * nt + 4 * fq + r > qidx) acc[nt][r] = -3.0e38f; }
        } else { acc[nt] = (f32x4){-3.0e38f, -3.0e38f, -3.0e38f, -3.0e38f}; } }
    float m = -3.0e38f;
#pragma unroll
    for (int nt = 0; nt < 16; ++nt) m = fmaxf(fmaxf(fmaxf(m, acc[nt][0]), fmaxf(acc[nt][1], acc[nt][2])), acc[nt][3]);
    m = fmaxf(m, __shfl_xor(m, 16)); m = fmaxf(m, __shfl_xor(m, 32));
    const float cexp = 0.08838834764831845f * 1.4426950408889634f; float l = 0.f;
    bf16x8 pa[8];
#pragma unroll
    for (int k2 = 0; k2 < 8; ++k2) { float p[8];
#pragma unroll
        for (int r = 0; r < 4; ++r) { p[r] = __builtin_amdgcn_exp2f((acc[2 * k2][r] - m) * cexp); p[4 + r] = __builtin_amdgcn_exp2f((acc[2 * k2 + 1][r] - m) * cexp); }
        l += ((p[0] + p[1]) + (p[2] + p[3])) + ((p[4] + p[5]) + (p[6] + p[7]));
        v4u pw; pw.x = pk2(p[0], p[1]); pw.y = pk2(p[2], p[3]); pw.z = pk2(p[4], p[5]); pw.w = pk2(p[6], p[7]); pa[k2] = __builtin_bit_cast(bf16x8, pw); }
    l += __shfl_xor(l, 16); l += __shfl_xor(l, 32);
    f32x4 o[8];
    const int gl = fr >> 2, pp = fr & 3;
#pragma unroll
    for (int dt = 0; dt < 8; ++dt) o[dt] = (f32x4){0.f, 0.f, 0.f, 0.f};
#pragma unroll
    for (int k2 = 0; k2 < 8; ++k2) { const int r0 = 32 * k2 + 4 * fq + gl, r1 = r0 + 16;
#pragma unroll
        for (int dt = 0; dt < 8; ++dt) { const int ch = 2 * dt + (pp >> 1);
            const v4i16_t lo = __builtin_amdgcn_ds_read_tr16_b64_v4i16((LAS v4i16_t*)(lds + 65536 + r0 * 256 + ((ch ^ ((r0 & 7) << 1)) << 4) + 8 * (pp & 1)));
            const v4i16_t hi = __builtin_amdgcn_ds_read_tr16_b64_v4i16((LAS v4i16_t*)(lds + 65536 + r1 * 256 + ((ch ^ ((r1 & 7) << 1)) << 4) + 8 * (pp & 1)));
            bf16x8 vf; vf[0] = lo[0]; vf[1] = lo[1]; vf[2] = lo[2]; vf[3] = lo[3]; vf[4] = hi[0]; vf[5] = hi[1]; vf[6] = hi[2]; vf[7] = hi[3];
            o[dt] = mfma16(vf, pa[k2], o[dt]); } }
    const float il = 1.0f / l;
    if (e & 0x8000) { const int t2 = (e >> 2) & (T - 1), slot2 = e & 3; bf16* po = (bf16*)(ws + WS_PO) + ((size_t)(t2 * NH + h) * 4 + slot2) * HD + 4 * fq;
#pragma unroll
        for (int dt = 0; dt < 8; ++dt) { v2u wv; wv.x = pk2(o[dt][0] * il, o[dt][1] * il); wv.y = pk2(o[dt][2] * il, o[dt][3] * il); *(v2u*)(po + 16 * dt) = wv; }
        if (fq == 0) ((float*)(ws + WS_PLSE))[((size_t)(t2 * NH + h) * 4 + slot2) * 32] = m * 0.08838834764831845f + __logf(l); }
        }
    }
#undef MKV_FETCH
    __syncthreads();
}
__device__ __forceinline__ void moba_gate_lists(unsigned char* ws, gu32* ctl, LAS unsigned char* lds, int h, int cur, int tid) {
    LAS float* km = (LAS float*)lds;
    LAS float* gs = (LAS float*)(lds + 17408);
    LAS unsigned short* lists = (LAS unsigned short*)(lds + 65536);
    LAS int* cnt = (LAS int*)(lds + 61440); LAS int* gbase = cnt + 32;
    unsigned sel = 0xFFFFFFu;
    if (tid < 32) cnt[tid] = 0;
    { const float* KM = (const float*)(ws + WS_KMEAN);
      for (int i = tid; i < NB * HD; i += NTHR) { const int j = i >> 7, d = i & 127; km[j * 132 + d] = (KM[(size_t)j * HW + h * HD + d] + KM[(size_t)(NB + j) * HW + h * HD + d]) * (1.f / BS); } }
    __syncthreads();
    {
        const int lane = tid & 63, w = tid >> 6, fr = lane & 15, fq = lane >> 4;
        f32x4 acc[2][2];
#pragma unroll
        for (int rt = 0; rt < 2; ++rt)
#pragma unroll
            for (int ct = 0; ct < 2; ++ct) acc[rt][ct] = (f32x4){0.f, 0.f, 0.f, 0.f};
        const bf16* qb = (const bf16*)(ws + WS_MQ) + (size_t)(cur * BS + 32 * w + fr) * HW + h * HD + 8 * fq;
#pragma unroll
        for (int J = 0; J < 4; ++J) {
            const v4u q0 = *(const v4u*)(qb + 32 * J), q1 = *(const v4u*)(qb + (size_t)16 * HW + 32 * J);
            const f32x4 k00 = *(const LAS f32x4*)(km + fr * 132 + 32 * J + 8 * fq), k01 = *(const LAS f32x4*)(km + fr * 132 + 32 * J + 8 * fq + 4);
            const f32x4 k10 = *(const LAS f32x4*)(km + (16 + fr) * 132 + 32 * J + 8 * fq), k11 = *(const LAS f32x4*)(km + (16 + fr) * 132 + 32 * J + 8 * fq + 4);
            const float a0[8] = {bflo(q0.x), bfhi(q0.x), bflo(q0.y), bfhi(q0.y), bflo(q0.z), bfhi(q0.z), bflo(q0.w), bfhi(q0.w)};
            const float a1[8] = {bflo(q1.x), bfhi(q1.x), bflo(q1.y), bfhi(q1.y), bflo(q1.z), bfhi(q1.z), bflo(q1.w), bfhi(q1.w)};
            const float b0[8] = {k00.x, k00.y, k00.z, k00.w, k01.x, k01.y, k01.z, k01.w};
            const float b1[8] = {k10.x, k10.y, k10.z, k10.w, k11.x, k11.y, k11.z, k11.w};
#pragma unroll
            for (int s8 = 0; s8 < 8; ++s8) {
                acc[0][0] = __builtin_amdgcn_mfma_f32_16x16x4f32(a0[s8], b0[s8], acc[0][0], 0, 0, 0); acc[0][1] = __builtin_amdgcn_mfma_f32_16x16x4f32(a0[s8], b1[s8], acc[0][1], 0, 0, 0);
                acc[1][0] = __builtin_amdgcn_mfma_f32_16x16x4f32(a1[s8], b0[s8], acc[1][0], 0, 0, 0); acc[1][1] = __builtin_amdgcn_mfma_f32_16x16x4f32(a1[s8], b1[s8], acc[1][1], 0, 0, 0); } }
#pragma unroll
        for (int rt = 0; rt < 2; ++rt)
#pragma unroll
            for (int ct = 0; ct < 2; ++ct)
#pragma unroll
                for (int i = 0; i < 4; ++i) gs[(32 * w + 16 * rt + 4 * fq + i) * 33 + 16 * ct + fr] = acc[rt][ct][i];
    }
    __syncthreads();
    if (tid < 256) {
        const int t = cur * BS + tid;
        float g[32];
#pragma unroll
        for (int j = 0; j < 32; ++j) g[j] = (j < cur) ? gs[tid * 33 + j] : -3.0e38f;
#pragma unroll
        for (int r = 0; r < 3; ++r) {
            float best = g[0]; int bi = 0;
#pragma unroll
            for (int j = 1; j < 32; ++j) if (g[j] > best) { best = g[j]; bi = j; }
#pragma unroll
            for (int j = 0; j < 32; ++j) if (j == bi) g[j] = -3.0e38f;
            if (r < cur) sel = (sel & ~(0xFFu << (8 * r))) | ((unsigned)bi << (8 * r));
        }
#pragma unroll
        for (int r = 0; r < 3; ++r) { const int b = (int)((sel >> (8 * r)) & 255u);
            if (b < 32) { const int pos = (int)__hip_atomic_fetch_add((LAS unsigned*)(cnt + b), 1u, __ATOMIC_RELAXED, __HIP_MEMORY_SCOPE_WORKGROUP); lists[b * 256 + (pos & 255)] = (unsigned short)((t << 2) | (r + 1)); } }
    }
    __syncthreads();
    if (tid < 32) gbase[tid] = (tid < cur && cnt[tid] > 0) ? (int)__hip_atomic_fetch_add((unsigned*)(ctl + CW_MCNT) + h * NB + tid, (unsigned)cnt[tid], RLX_AGENT) : 0;
    __syncthreads();
    { unsigned short* GL = (unsigned short*)(ws + WS_GL);
      for (int i = tid; i < NB * 256; i += NTHR) { const int j = i >> 8, q = i & 255; if (j < cur && q < cnt[j]) GL[(size_t)(h * NB + j) * 8192 + ((gbase[j] + q) & 8191)] = lists[i]; } }
    __syncthreads();
}
#ifndef MBRT
#define MBRT 31
#endif
#ifndef MB_STAGE
#define MB_STAGE 3
#endif
__device__ __forceinline__ void moba_block_item(unsigned char* ws, LAS unsigned char* lds, int h, int cur, int jlo, int jhi, int flags, int tid) {
    unsigned sel = 0xFFFFFFu;
    if (jhi > jlo) {
        LAS float* km = (LAS float*)lds;
        { const float* KM = (const float*)(ws + WS_KMEAN);
          for (int i = tid; i < NB * HD; i += NTHR) { const int j = i >> 7, d = i & 127; km[i] = (KM[(size_t)j * HW + h * HD + d] + KM[(size_t)(NB + j) * HW + h * HD + d]) * (1.f / BS); } }
        __syncthreads();
        if (tid < 256) {
            const int t = cur * BS + tid;
            const v4u* qp = (const v4u*)((const bf16*)(ws + WS_MQ) + (size_t)t * HW + h * HD);
            float g[32];
#pragma unroll
            for (int j = 0; j < 32; ++j) g[j] = 0.f;
            for (int dc = 0; dc < 16; ++dc) { const v4u qw = qp[dc]; const float q0 = bflo(qw.x), q1 = bfhi(qw.x), q2 = bflo(qw.y), q3 = bfhi(qw.y), q4 = bflo(qw.z), q5 = bfhi(qw.z), q6 = bflo(qw.w), q7 = bfhi(qw.w);
#pragma unroll
                for (int j = 0; j < 32; ++j) if (j < cur) { const f32x4 k0 = *(const LAS f32x4*)(km + j * 128 + dc * 8), k1 = *(const LAS f32x4*)(km + j * 128 + dc * 8 + 4);
                    g[j] += (q0 * k0.x + q1 * k0.y + q2 * k0.z + q3 * k0.w) + (q4 * k1.x + q5 * k1.y + q6 * k1.z + q7 * k1.w); } }
#pragma unroll
            for (int j = 0; j < 32; ++j) if (j >= cur) g[j] = -3.0e38f;
#pragma unroll
            for (int r = 0; r < 3; ++r) {
                float best = g[0]; int bi = 0;
#pragma unroll
                for (int j = 1; j < 32; ++j) if (g[j] > best) { best = g[j]; bi = j; }
#pragma unroll
                for (int j = 0; j < 32; ++j) if (j == bi) g[j] = -3.0e38f;
                if (r < cur) sel = (sel & ~(0xFFu << (8 * r))) | ((unsigned)bi << (8 * r));
            }
        }
        __syncthreads();
    }
    LAS int* lc = (LAS int*)(lds + LDSCTL_OFF + 1024); LAS int* lst = lc + 4;
    for (int jj = (flags & 1) ? -2 : jlo; jj < jhi; jj = (jj == -1) ? jlo : jj + 1) {
        const bool causal = jj < 0; const int j = causal ? cur : jj; int n = 256;
        if (!causal) {
            if (tid == 0) *lc = 0;
            __syncthreads();
            if (tid < 256) { const int slot = ((int)(sel & 255u) == j) ? 1 : ((int)((sel >> 8) & 255u) == j) ? 2 : ((int)((sel >> 16) & 255u) == j) ? 3 : 0;
                if (slot) { const int pos = (int)__hip_atomic_fetch_add((LAS unsigned*)lc, 1u, __ATOMIC_RELAXED, __HIP_MEMORY_SCOPE_WORKGROUP); lst[pos] = (tid << 2) | slot; } }
            __syncthreads();
            n = *lc;
        }
        const int g0 = causal ? jj + 2 : 0, g1 = causal ? g0 + 1 : (n + 127) >> 7;
        for (int g = g0; g < g1; ++g) moba_unit(ws, lds, h, j, cur, causal, g, n, lst, tid);
        __syncthreads();
    }
    asm volatile("s_waitcnt vmcnt(0)" ::: "memory"); __syncthreads();
    if (flags & 2) { const bf16* PO = (const bf16*)(ws + WS_PO); const float* PL = (const float*)(ws + WS_PLSE); bf16* AUP = (bf16*)(ws + WS_AUP); const int nv = cur < 3 ? cur : 3;
      for (int idx = tid; idx < BS * 16; idx += NTHR) { const int t = cur * BS + (idx >> 4), dq = idx & 15, th = t * NH + h;
          const float* plp = PL + (size_t)th * 128; float ls[4]; ls[0] = plp[0]; ls[1] = nv > 0 ? plp[32] : 0.f; ls[2] = nv > 1 ? plp[64] : 0.f; ls[3] = nv > 2 ? plp[96] : 0.f;
          float M = ls[0]; if (nv > 0) M = fmaxf(M, ls[1]); if (nv > 1) M = fmaxf(M, ls[2]); if (nv > 2) M = fmaxf(M, ls[3]);
          float wv[4]; wv[0] = __expf(ls[0] - M); wv[1] = nv > 0 ? __expf(ls[1] - M) : 0.f; wv[2] = nv > 1 ? __expf(ls[2] - M) : 0.f; wv[3] = nv > 2 ? __expf(ls[3] - M) : 0.f;
          const float inv = 1.0f / ((wv[0] + wv[1]) + (wv[2] + wv[3]));
          float acc[8] = {0.f, 0.f, 0.f, 0.f, 0.f, 0.f, 0.f, 0.f};
#pragma unroll
          for (int i = 0; i < 4; ++i) if (i <= nv) { const v4u pw = *(const v4u*)(PO + ((size_t)th * 4 + i) * HD + dq * 8); const float wi = wv[i] * inv;
              acc[0] += wi * bflo(pw.x); acc[1] += wi * bfhi(pw.x); acc[2] += wi * bflo(pw.y); acc[3] += wi * bfhi(pw.y); acc[4] += wi * bflo(pw.z); acc[5] += wi * bfhi(pw.z); acc[6] += wi * bflo(pw.w); acc[7] += wi * bfhi(pw.w); }
          v4u ov; ov.x = pk2(acc[0], acc[1]); ov.y = pk2(acc[2], acc[3]); ov.z = pk2(acc[4], acc[5]); ov.w = pk2(acc[6], acc[7]);
          *(v4u*)(AUP + (size_t)t * D + HW + h * HD + dq * 8) = ov; } }
    __syncthreads();
}

namespace pg8 {
#define PG8_LAS __attribute__((address_space(3)))
typedef unsigned short bf16_t;
typedef unsigned u32x4 __attribute__((ext_vector_type(4)));
constexpr int BM = 256, BK = 64, HALF = 128, HTB = HALF * BK * 2, STAGE_BYTES = 8 * HTB, NXCD = 8, WGM = 8;
__host__ __device__ __forceinline__ int lds_byte(int r, int c) { const int st = (r >> 4) * 2 + (c >> 5), rr = r & 15, cc = c & 31, ob = rr * 64 + cc * 2; return st * 1024 + (ob ^ (((ob >> 9) & 1) << 5)); }
__host__ __device__ __forceinline__ void stage_rc(int b, int& R, int& C) { const int st = b / 1024, sb = b % 1024, swz = sb ^ (((sb >> 9) & 1) << 5); R = (st >> 1) * 16 + swz / 64; C = (st & 1) * 32 + (swz % 64) / 2; }
__host__ __device__ __forceinline__ int perm32(int rho) { const int n = rho >> 4, i = rho & 15; return 8 * (i >> 2) + 4 * n + (i & 3); }
struct Unit { int pm, pn; };
struct Gemm { const bf16_t* A; const bf16_t* Bt; int lda, ldb, K; };
struct StaticOrder {
    int nM, nN, nwg, G, c;
    __host__ __device__ void init(int M, int N, int G_, int c_) { nM = M / BM; nN = N / BM; nwg = nM * nN; G = G_; c = c_; }
    __host__ __device__ bool next(int i, Unit& u) const {
        const long L = (long)i * G + c; if (L >= nwg) return false;
        int wgid = (int)L; { const int q = nwg / NXCD, r = nwg % NXCD, xcd = wgid % NXCD, off = wgid / NXCD; wgid = (xcd < r ? xcd * (q + 1) : r * (q + 1) + (xcd - r) * q) + off; }
        const int nig = WGM * nN, gid = wgid / nig, fm = gid * WGM, gsz = (nM - fm) < WGM ? (nM - fm) : WGM;
        u.pm = fm + ((wgid % nig) % gsz); u.pn = (wgid % nig) / gsz; return true;
    }
    __device__ __forceinline__ void a_ready(const Unit&) const {}
    __device__ __forceinline__ void done(const Unit&) const {}
};
struct MoeOrder {
    const PG8_LAS int* pstart; int npn, G, c;
    __device__ bool next(int i, Unit& u) const {
        const int L = i * G + c, ntile = pstart[32] >> 8; if (L >= ntile * npn) return false;
        const int tile = L / npn, pnl = L % npn; int e = 0;
        for (int q = 1; q < 32; ++q) if (pstart[q] <= tile * 256) e = q;
        u.pm = tile; u.pn = e * npn + pnl; return true;
    }
    __device__ __forceinline__ void a_ready(const Unit&) const {}
    __device__ __forceinline__ void done(const Unit&) const {}
};
__device__ __forceinline__ unsigned cvt_pk_bf16(float lo, float hi) { unsigned r; asm volatile("v_cvt_pk_bf16_f32 %0, %1, %2" : "=v"(r) : "v"(lo), "v"(hi)); return r; }
__device__ __forceinline__ u32x4 pack8(const f32x4& a, const f32x4& b) { u32x4 w; w.x = cvt_pk_bf16(a[0], a[1]); w.y = cvt_pk_bf16(a[2], a[3]); w.z = cvt_pk_bf16(b[0], b[1]); w.w = cvt_pk_bf16(b[2], b[3]); return w; }
__device__ __forceinline__ float bl(unsigned w) { return __builtin_bit_cast(float, w << 16); }
__device__ __forceinline__ float bh(unsigned w) { return __builtin_bit_cast(float, w & 0xffff0000u); }
__device__ __forceinline__ f32x4 sig4(const f32x4& v) { f32x4 o; for (int i = 0; i < 4; ++i) o[i] = __builtin_amdgcn_rcpf(1.0f + __expf(-v[i])); return o; }
__device__ __forceinline__ f32x4 silu4(const f32x4& v) { f32x4 o; for (int i = 0; i < 4; ++i) o[i] = v[i] * __builtin_amdgcn_rcpf(1.0f + __expf(-v[i])); return o; }

struct EpiInProj {
    static constexpr bool PERM = true, AFTER_DRAIN = false, HAS_MID = false;
    unsigned char* ws;
    __device__ __forceinline__ void mid(f32x4 (&)[2][2][4][2], const Unit&, int, int, int, int) const {}
    __device__ __forceinline__ void operator()(const f32x4 (&acc)[2][2][4][2], const Unit& u, int wr, int wc, int fr, int fq) const {
        const int pn = u.pn, row0 = u.pm * BM + wr * 64 + fr, cl = wc * 32 + 8 * fq;
        if (pn >= 16 && pn < 24) {
            const int which = (pn - 16) >> 2, head = 2 * ((pn - 16) & 3) + (wc >> 1), d = (wc & 1) * 32 + 8 * fq;
            bf16_t* dst = (bf16_t*)(ws + (which ? WS_MK : WS_MQ)) + head * HD + d;
            const f32x2* trig = (const f32x2*)(ws + WS_TRIG) + d;
            float cs[16];
#pragma unroll
            for (int i = 0; i < 16; ++i) cs[i] = 0.f;
#pragma unroll
            for (int ai = 0; ai < 2; ++ai)
#pragma unroll
                for (int mp = 0; mp < 2; ++mp) {
                    f32x4 tg[2][4];
#pragma unroll
                    for (int mm = 0; mm < 2; ++mm) { const f32x4* tp = (const f32x4*)(trig + (size_t)(row0 + ai * HALF + (2 * mp + mm) * 16) * 64);
#pragma unroll
                        for (int q = 0; q < 4; ++q) tg[mm][q] = tp[q]; }
#pragma unroll
                    for (int mm = 0; mm < 2; ++mm) { const int m = 2 * mp + mm, row = row0 + ai * HALF + m * 16;
                    u32x4 wl, wh;
                    { const f32x4 t0 = tg[mm][0], t1 = tg[mm][1]; const f32x4 x1a = acc[ai][0][m][0], x2a = acc[ai][1][m][0]; f32x4 la, ha;
                      la[0] = x1a[0] * t0[0] - x2a[0] * t0[1]; ha[0] = x2a[0] * t0[0] + x1a[0] * t0[1];
                      la[1] = x1a[1] * t0[2] - x2a[1] * t0[3]; ha[1] = x2a[1] * t0[2] + x1a[1] * t0[3];
                      la[2] = x1a[2] * t1[0] - x2a[2] * t1[1]; ha[2] = x2a[2] * t1[0] + x1a[2] * t1[1];
                      la[3] = x1a[3] * t1[2] - x2a[3] * t1[3]; ha[3] = x2a[3] * t1[2] + x1a[3] * t1[3];
                      wl.x = cvt_pk_bf16(la[0], la[1]); wl.y = cvt_pk_bf16(la[2], la[3]); wh.x = cvt_pk_bf16(ha[0], ha[1]); wh.y = cvt_pk_bf16(ha[2], ha[3]);
                      if (which) {
#pragma unroll
                          for (int i = 0; i < 4; ++i) { cs[i] += la[i]; cs[8 + i] += ha[i]; } } }
                    { const f32x4 t2 = tg[mm][2], t3 = tg[mm][3]; const f32x4 x1b = acc[ai][0][m][1], x2b = acc[ai][1][m][1]; f32x4 lb_, hb;
                      lb_[0] = x1b[0] * t2[0] - x2b[0] * t2[1]; hb[0] = x2b[0] * t2[0] + x1b[0] * t2[1];
                      lb_[1] = x1b[1] * t2[2] - x2b[1] * t2[3]; hb[1] = x2b[1] * t2[2] + x1b[1] * t2[3];
                      lb_[2] = x1b[2] * t3[0] - x2b[2] * t3[1]; hb[2] = x2b[2] * t3[0] + x1b[2] * t3[1];
                      lb_[3] = x1b[3] * t3[2] - x2b[3] * t3[3]; hb[3] = x2b[3] * t3[2] + x1b[3] * t3[3];
                      wl.z = cvt_pk_bf16(lb_[0], lb_[1]); wl.w = cvt_pk_bf16(lb_[2], lb_[3]); wh.z = cvt_pk_bf16(hb[0], hb[1]); wh.w = cvt_pk_bf16(hb[2], hb[3]);
                      if (which) {
#pragma unroll
                          for (int i = 0; i < 4; ++i) { cs[4 + i] += lb_[i]; cs[12 + i] += hb[i]; } } }
                    *(u32x4*)(dst + (size_t)row * HW) = wl; *(u32x4*)(dst + (size_t)row * HW + 64) = wh; }
                    asm volatile("" ::: "memory"); }
            if (which) {
                float* ks = (float*)(ws + WS_KMEAN) + (size_t)(wr * NB + u.pm) * HW + head * HD + d;
#pragma unroll
                for (int i = 0; i < 16; ++i) { float v = cs[i]; v += __shfl_xor(v, 1); v += __shfl_xor(v, 2); v += __shfl_xor(v, 4); v += __shfl_xor(v, 8);
                    if (fr == 0) ks[(i & 7) + 64 * (i >> 3)] = v; }
            }
            return;
        }
        int kind, ld; size_t base; int colb;
        if (pn < 4) { kind = 1; base = WS_QH; ld = HW; colb = pn * 256; }
        else if (pn < 8) { kind = 3; base = WS_GH; ld = HW; colb = (pn - 4) * 256; }
        else if (pn < 12) { kind = 0; base = WS_VH; ld = HW; colb = (pn - 8) * 256; }
        else if (pn < 16) { kind = 1; base = WS_OG; ld = HW; colb = (pn - 12) * 256; }
        else if (pn < 28) { kind = 0; base = WS_MV; ld = HW; colb = (pn - 24) * 256; }
        else if (pn < 36) { kind = 2; base = WS_GA; ld = D; colb = (pn - 28) * 256; }
        else { kind = 2; base = WS_GB; ld = D; colb = (pn - 36) * 256; }
        if (kind == 3) {
            const float* lbp = (const float*)(ws + WS_LB) + colb + cl; float* dst = (float*)(ws + base) + colb + cl;
#pragma unroll
            for (int bj = 0; bj < 2; ++bj) { const f32x4 l0 = *(const f32x4*)(lbp + bj * HALF), l1 = *(const f32x4*)(lbp + bj * HALF + 4);
#pragma unroll
                for (int ai = 0; ai < 2; ++ai)
#pragma unroll
                    for (int m = 0; m < 4; ++m) { const int row = row0 + ai * HALF + m * 16; const f32x4 s0 = sig4(acc[ai][bj][m][0]), s1 = sig4(acc[ai][bj][m][1]); f32x4 o0, o1;
#pragma unroll
                        for (int i = 0; i < 4; ++i) { o0[i] = __logf(l0[i] + (1.f - l0[i]) * s0[i]); o1[i] = __logf(l1[i] + (1.f - l1[i]) * s1[i]); }
                        float* p = dst + (size_t)row * ld + bj * HALF; *(f32x4*)p = o0; *(f32x4*)(p + 4) = o1; } }
            return;
        }
        bf16_t* dst = (bf16_t*)(ws + base) + colb + cl;
#pragma unroll
        for (int ai = 0; ai < 2; ++ai)
#pragma unroll
            for (int m = 0; m < 4; ++m) { const int row = row0 + ai * HALF + m * 16;
#pragma unroll
                for (int bj = 0; bj < 2; ++bj) { f32x4 v0 = acc[ai][bj][m][0], v1 = acc[ai][bj][m][1];
                    if (kind == 1) { v0 = silu4(v0); v1 = silu4(v1); } else if (kind == 2) { v0 = sig4(v0); v1 = sig4(v1); }
                    *(u32x4*)(dst + (size_t)row * ld + bj * HALF) = pack8(v0, v1); } }
    }
};
struct EpiBf16Plain {
    static constexpr bool PERM = true, AFTER_DRAIN = false, HAS_MID = false;
    bf16_t* O; int ld;
    __device__ __forceinline__ void mid(f32x4 (&)[2][2][4][2], const Unit&, int, int, int, int) const {}
    __device__ __forceinline__ void operator()(const f32x4 (&acc)[2][2][4][2], const Unit& u, int wr, int wc, int fr, int fq) const {
        const int row0 = u.pm * BM + wr * 64 + fr, col0 = u.pn * BM + wc * 32 + 8 * fq;
#pragma unroll
        for (int ai = 0; ai < 2; ++ai)
#pragma unroll
            for (int m = 0; m < 4; ++m)
#pragma unroll
                for (int bj = 0; bj < 2; ++bj) *(u32x4*)(O + (size_t)(row0 + ai * HALF + m * 16) * ld + col0 + bj * HALF) = pack8(acc[ai][bj][m][0], acc[ai][bj][m][1]);
    }
};
template <int PASS> struct EpiUp {
    static constexpr bool PERM = true, AFTER_DRAIN = false, HAS_MID = false;
    const bf16_t* GT; bf16_t* O;
    __device__ __forceinline__ void mid(f32x4 (&)[2][2][4][2], const Unit&, int, int, int, int) const {}
    __device__ __forceinline__ void operator()(const f32x4 (&acc)[2][2][4][2], const Unit& u, int wr, int wc, int fr, int fq) const {
        const int row0 = u.pm * BM + wr * 64 + fr, col0 = u.pn * BM + wc * 32 + 8 * fq;
#pragma unroll
        for (int ai = 0; ai < 2; ++ai)
#pragma unroll
            for (int m = 0; m < 4; ++m) {
#pragma unroll
                for (int bj = 0; bj < 2; ++bj) { const size_t off = (size_t)(row0 + ai * HALF + m * 16) * D + col0 + bj * HALF; const u32x4 b = *(const u32x4*)(GT + off);
                    f32x4 v0 = acc[ai][bj][m][0], v1 = acc[ai][bj][m][1];
                    v0[0] *= bl(b.x); v0[1] *= bh(b.x); v0[2] *= bl(b.y); v0[3] *= bh(b.y); v1[0] *= bl(b.z); v1[1] *= bh(b.z); v1[2] *= bl(b.w); v1[3] *= bh(b.w);
                    if (PASS == 1) { const u32x4 p = *(const u32x4*)(O + off);
                        v0[0] += bl(p.x); v0[1] += bh(p.x); v0[2] += bl(p.y); v0[3] += bh(p.y); v1[0] += bl(p.z); v1[1] += bh(p.z); v1[2] += bl(p.w); v1[3] += bh(p.w); }
                    *(u32x4*)(O + off) = pack8(v0, v1); }
                asm volatile("" ::: "memory"); }
    }
};
struct EpiUp2 {
    static constexpr bool PERM = true, AFTER_DRAIN = false, HAS_MID = true;
    const bf16_t* GA; const bf16_t* GB; bf16_t* O;
    __device__ __forceinline__ void mid(f32x4 (&acc)[2][2][4][2], const Unit& u, int wr, int wc, int fr_, int fq_) const {
        int fr = fr_, fq = fq_; asm volatile("" : "+v"(fr), "+v"(fq));
        const int row0 = u.pm * BM + wr * 64 + fr, col0 = u.pn * BM + wc * 32 + 8 * fq;
#pragma unroll
        for (int ai = 0; ai < 2; ++ai) {
#pragma unroll
            for (int m = 0; m < 4; ++m) {
#pragma unroll
                for (int bj = 0; bj < 2; ++bj) { const size_t off = (size_t)(row0 + ai * HALF + m * 16) * D + col0 + bj * HALF; const u32x4 a = *(const u32x4*)(GA + off), b = *(const u32x4*)(GB + off);
                    const float lo = 8.673617379884035e-19f;
                    acc[ai][bj][m][0][0] *= bl(a.x) * __builtin_amdgcn_rcpf(fmaxf(bl(b.x), lo)); acc[ai][bj][m][0][1] *= bh(a.x) * __builtin_amdgcn_rcpf(fmaxf(bh(b.x), lo));
                    acc[ai][bj][m][0][2] *= bl(a.y) * __builtin_amdgcn_rcpf(fmaxf(bl(b.y), lo)); acc[ai][bj][m][0][3] *= bh(a.y) * __builtin_amdgcn_rcpf(fmaxf(bh(b.y), lo));
                    acc[ai][bj][m][1][0] *= bl(a.z) * __builtin_amdgcn_rcpf(fmaxf(bl(b.z), lo)); acc[ai][bj][m][1][1] *= bh(a.z) * __builtin_amdgcn_rcpf(fmaxf(bh(b.z), lo));
                    acc[ai][bj][m][1][2] *= bl(a.w) * __builtin_amdgcn_rcpf(fmaxf(bl(b.w), lo)); acc[ai][bj][m][1][3] *= bh(a.w) * __builtin_amdgcn_rcpf(fmaxf(bh(b.w), lo)); }
                asm volatile("" ::: "memory"); } }
    }
    __device__ __forceinline__ void operator()(const f32x4 (&acc)[2][2][4][2], const Unit& u, int wr, int wc, int fr, int fq) const {
        const int row0 = u.pm * BM + wr * 64 + fr, col0 = u.pn * BM + wc * 32 + 8 * fq;
        const float lo = 8.673617379884035e-19f;
#pragma unroll
        for (int ai = 0; ai < 2; ++ai) {
            u32x4 gb[4][2];
#pragma unroll
            for (int m = 0; m < 4; ++m)
#pragma unroll
                for (int bj = 0; bj < 2; ++bj) gb[m][bj] = *(const u32x4*)(GB + (size_t)(row0 + ai * HALF + m * 16) * D + col0 + bj * HALF);
#pragma unroll
            for (int m = 0; m < 4; ++m)
#pragma unroll
                for (int bj = 0; bj < 2; ++bj) { const size_t off = (size_t)(row0 + ai * HALF + m * 16) * D + col0 + bj * HALF; const u32x4 b = gb[m][bj];
                    f32x4 v0 = acc[ai][bj][m][0], v1 = acc[ai][bj][m][1];
                    v0[0] *= fmaxf(bl(b.x), lo); v0[1] *= fmaxf(bh(b.x), lo); v0[2] *= fmaxf(bl(b.y), lo); v0[3] *= fmaxf(bh(b.y), lo); v1[0] *= fmaxf(bl(b.z), lo); v1[1] *= fmaxf(bh(b.z), lo); v1[2] *= fmaxf(bl(b.w), lo); v1[3] *= fmaxf(bh(b.w), lo);
                    *(u32x4*)(O + off) = pack8(v0, v1); }
            asm volatile("" ::: "memory"); }
    }
};
template <int MODE  > struct EpiResid {
    static constexpr bool PERM = false, AFTER_DRAIN = false, HAS_MID = false;
    static constexpr int RG = (MODE == 0) ? 4 : 2;
    const float* base; float* out; const bf16_t* PP;
    __device__ __forceinline__ void mid(f32x4 (&)[2][2][4][2], const Unit&, int, int, int, int) const {}
    __device__ __forceinline__ void operator()(const f32x4 (&acc)[2][2][4][2], const Unit& u, int wr, int wc, int fr, int fq) const {
        const int row0 = u.pm * BM + wr * 64 + fr, col0 = u.pn * BM + wc * 32 + 4 * fq;
#pragma unroll
        for (int ai = 0; ai < 2; ++ai)
#pragma unroll
            for (int mp = 0; mp < 4 / RG; ++mp) {
                f32x4 bs[RG][2][2]; v2u pw[RG][2][2];
#pragma unroll
                for (int mm = 0; mm < RG; ++mm)
#pragma unroll
                    for (int bj = 0; bj < 2; ++bj)
#pragma unroll
                        for (int n = 0; n < 2; ++n) { const size_t off = (size_t)(row0 + ai * HALF + (RG * mp + mm) * 16) * D + col0 + bj * HALF + n * 16; bs[mm][bj][n] = *(const f32x4*)(base + off);
                            if (MODE == 1) pw[mm][bj][n] = *(const v2u*)(PP + off); }
#pragma unroll
                for (int mm = 0; mm < RG; ++mm)
#pragma unroll
                    for (int bj = 0; bj < 2; ++bj)
#pragma unroll
                        for (int n = 0; n < 2; ++n) { const size_t off = (size_t)(row0 + ai * HALF + (RG * mp + mm) * 16) * D + col0 + bj * HALF + n * 16; f32x4 v = acc[ai][bj][RG * mp + mm][n];
                            if (MODE == 1) { const unsigned p0 = pw[mm][bj][n].x, p1 = pw[mm][bj][n].y; v = sig4(v); v[0] *= bl(p0); v[1] *= bh(p0); v[2] *= bl(p1); v[3] *= bh(p1); }
                            *(f32x4*)(out + off) = bs[mm][bj][n] + v; }
                asm volatile("" ::: "memory"); }
    }
};
struct EpiMoe1 {
    static constexpr bool PERM = true, AFTER_DRAIN = false, HAS_MID = false;
    bf16_t* H;
    __device__ __forceinline__ void mid(f32x4 (&)[2][2][4][2], const Unit&, int, int, int, int) const {}
    __device__ __forceinline__ void operator()(const f32x4 (&acc)[2][2][4][2], const Unit& u, int wr, int wc, int fr, int fq) const {
        const int row0 = u.pm * BM + wr * 64 + fr, col0 = (u.pn & 3) * 128 + wc * 32 + 8 * fq;
#pragma unroll
        for (int ai = 0; ai < 2; ++ai)
#pragma unroll
            for (int m = 0; m < 4; ++m) { const f32x4 g0 = silu4(acc[ai][0][m][0]), g1 = silu4(acc[ai][0][m][1]);
                *(u32x4*)(H + (size_t)(row0 + ai * HALF + m * 16) * DE + col0) = pack8(g0 * acc[ai][1][m][0], g1 * acc[ai][1][m][1]); }
    }
};
struct EpiMoe2 {
    static constexpr bool PERM = true, AFTER_DRAIN = false, HAS_MID = false;
    bf16_t* Y; const int* rowslot; const PG8_LAS int* pstart;
    __device__ __forceinline__ void mid(f32x4 (&)[2][2][4][2], const Unit&, int, int, int, int) const {}
    __device__ __forceinline__ void operator()(const f32x4 (&acc)[2][2][4][2], const Unit& u, int wr, int wc, int fr, int fq) const {
        const int row0 = u.pm * BM + wr * 64 + fr, col0 = (u.pn & 7) * 256 + wc * 32 + 8 * fq;
        const int e = u.pn >> 3, ps = pstart[e], pc = pstart[40 + e];
        int slot[2][4];
#pragma unroll
        for (int ai = 0; ai < 2; ++ai)
#pragma unroll
            for (int m = 0; m < 4; ++m) { const int prow = row0 + ai * HALF + m * 16; slot[ai][m] = (prow - ps < pc) ? __hip_atomic_load((int*)rowslot + prow, RLX_AGENT) : -1; }
#pragma unroll
        for (int ai = 0; ai < 2; ++ai)
#pragma unroll
            for (int m = 0; m < 4; ++m) if (slot[ai][m] >= 0) {
#pragma unroll
                for (int bj = 0; bj < 2; ++bj) *(u32x4*)(Y + (size_t)slot[ai][m] * D + col0 + bj * HALF) = pack8(acc[ai][bj][m][0], acc[ai][bj][m][1]); }
    }
};

template <class Epi, class Sched, bool ALIGN_EPI = false, bool SP2 = false>
__device__ __forceinline__ void gemm_phase(PG8_LAS unsigned char* lds, const Gemm g, const Sched& S, const Epi& E) {
    const int tid = threadIdx.x, wid = __builtin_amdgcn_readfirstlane(tid >> 6), lane = tid & 63, wr = wid >> 2, wc = wid & 3, fr = lane & 15, fq = lane >> 4;
    const int K = g.K, nt = K / BK;
    unsigned voffA[2], voffB[2];
#pragma unroll
    for (int i = 0; i < 2; ++i) { int R, C; stage_rc(tid * 16 + i * 8192, R, C); const int Rb = Epi::PERM ? ((R & ~31) + perm32(R & 31)) : R;
        voffA[i] = (unsigned)(R * g.lda + C) * 2u; voffB[i] = (unsigned)(Rb * g.ldb + C) * 2u; }
    const size_t kstep = (size_t)(BK * 2);
    const size_t hstepA = (size_t)HALF * g.lda * 2, hstepB = (size_t)HALF * g.ldb * 2;
    const size_t tstepA = 2 * hstepA, tstepB = 2 * hstepB;
    const unsigned ldsw = (unsigned)wid * 1024u;
    const int aoff = lds_byte(wr * 64 + fr, fq * 8), boff = lds_byte(wc * 32 + fr, fq * 8);
#define PG8_SA(b, h) (((b) * 2 + (h)) * HTB)
#define PG8_SB(b, h) ((4 + (b) * 2 + (h)) * HTB)
#define PG8_STAGE(bufoff, gbase, voff) do { _Pragma("unroll") for (int _i = 0; _i < 2; ++_i) \
        __builtin_amdgcn_global_load_lds((const unsigned*)((const char*)(gbase) + (voff)[_i]), (PG8_LAS unsigned*)(lds + (bufoff) + ldsw + _i * 8192), 16, 0, 0); } while (0)
#define PG8_LDA(dst, b, h) do { _Pragma("unroll") for (int m = 0; m < 4; ++m) _Pragma("unroll") for (int k = 0; k < 2; ++k) dst[m][k] = *(const PG8_LAS bf16x8*)(lds + PG8_SA(b, h) + aoff + m * 2048 + k * 1024); } while (0)
#define PG8_LDB(dst, b, h) do { _Pragma("unroll") for (int n = 0; n < 2; ++n) _Pragma("unroll") for (int k = 0; k < 2; ++k) dst[n][k] = *(const PG8_LAS bf16x8*)(lds + PG8_SB(b, h) + boff + n * 2048 + k * 1024); } while (0)
#define PG8_MMA(ai, bj, At, Bt) do { __builtin_amdgcn_s_setprio(1); _Pragma("unroll") for (int m = 0; m < 4; ++m) _Pragma("unroll") for (int n = 0; n < 2; ++n) _Pragma("unroll") for (int k = 0; k < 2; ++k) \
        acc[ai][bj][m][n] = __builtin_amdgcn_mfma_f32_16x16x32_bf16(Bt[n][k], At[m][k], acc[ai][bj][m][n], 0, 0, 0); __builtin_amdgcn_s_setprio(0); } while (0)
#define PG8_WAIT_V(n) asm volatile("s_waitcnt vmcnt(" #n ")" ::: "memory")
#define PG8_WAIT_L(n) asm volatile("s_waitcnt lgkmcnt(" #n ")" ::: "memory")
#define PG8_BAR __builtin_amdgcn_s_barrier()
#define PG8_SCHED __builtin_amdgcn_sched_barrier(0)
    Unit cur, nxt; int ui = 0;
    if (!S.next(0, cur)) return;
    f32x4 acc[2][2][4][2];
#pragma unroll
    for (int a = 0; a < 2; ++a)
#pragma unroll
        for (int b = 0; b < 2; ++b)
#pragma unroll
            for (int m = 0; m < 4; ++m)
#pragma unroll
                for (int n = 0; n < 2; ++n) acc[a][b][m][n] = (f32x4){0.f, 0.f, 0.f, 0.f};
    bf16x8 At[4][2], B0[2][2], B1[2][2];
    const char* cA = (const char*)g.A + (size_t)cur.pm * tstepA; const char* cB = (const char*)g.Bt + (size_t)cur.pn * tstepB;
    S.a_ready(cur);
    if constexpr (SP2) {
        PG8_STAGE(PG8_SB(0, 0), cB, voffB); PG8_STAGE(PG8_SB(0, 1), cB + hstepB, voffB); PG8_STAGE(PG8_SA(0, 0), cA, voffA); PG8_STAGE(PG8_SA(0, 1), cA + hstepA, voffA);
        if (wr == 1) PG8_BAR;
        PG8_WAIT_V(2); PG8_BAR;
        PG8_STAGE(PG8_SB(1, 0), cB + kstep, voffB); PG8_STAGE(PG8_SA(1, 0), cA + kstep, voffA); PG8_STAGE(PG8_SB(1, 1), cB + hstepB + kstep, voffB);
        PG8_WAIT_V(6); PG8_BAR;
    } else {
        PG8_STAGE(PG8_SB(0, 0), cB, voffB); PG8_STAGE(PG8_SA(0, 0), cA, voffA); PG8_STAGE(PG8_SB(0, 1), cB + hstepB, voffB); PG8_STAGE(PG8_SA(0, 1), cA + hstepA, voffA);
        if (wr == 1) PG8_BAR;
        PG8_WAIT_V(4); PG8_BAR;
        PG8_STAGE(PG8_SB(1, 0), cB + kstep, voffB); PG8_STAGE(PG8_SA(1, 0), cA + kstep, voffA); PG8_STAGE(PG8_SB(1, 1), cB + hstepB + kstep, voffB);
        PG8_WAIT_V(6); PG8_BAR;
    }
    for (;;) {
        const bool has_next = S.next(ui + 1, nxt);
        const char* nA = has_next ? (const char*)g.A + (size_t)nxt.pm * tstepA : cA; const char* nB = has_next ? (const char*)g.Bt + (size_t)nxt.pn * tstepB : cB;
        for (int t = 0; t < nt; t += 2) {
            const bool last = (t == nt - 2);
            if constexpr (Epi::HAS_MID) { if (t == (nt >> 1)) E.mid(acc, cur, wr, wc, fr, fq); }
            const char* a1 = cA + (size_t)(t + 1) * kstep;
            const char* a2 = last ? nA : cA + (size_t)(t + 2) * kstep; const char* b2 = last ? nB : cB + (size_t)(t + 2) * kstep;
            const char* a3 = a2 + kstep; const char* b3 = b2 + kstep;
            if (last && has_next) S.a_ready(nxt);
            if constexpr (SP2) {
            PG8_LDB(B0, 0, 0); PG8_LDB(B1, 0, 1); PG8_SCHED; PG8_LDA(At, 0, 0); PG8_STAGE(PG8_SA(1, 1), a1 + hstepA, voffA);
            PG8_WAIT_V(8); PG8_WAIT_L(0); PG8_BAR; PG8_MMA(0, 0, At, B0); PG8_MMA(0, 1, At, B1); PG8_BAR; PG8_SCHED;
            PG8_LDA(At, 0, 1); PG8_STAGE(PG8_SB(0, 0), b2, voffB); PG8_STAGE(PG8_SB(0, 1), b2 + hstepB, voffB); PG8_STAGE(PG8_SA(0, 0), a2, voffA);
            PG8_WAIT_V(8); PG8_WAIT_L(0); PG8_BAR; PG8_MMA(1, 0, At, B0); PG8_MMA(1, 1, At, B1); PG8_BAR; PG8_SCHED;
            PG8_LDB(B0, 1, 0); PG8_LDB(B1, 1, 1); PG8_SCHED; PG8_LDA(At, 1, 0); PG8_STAGE(PG8_SA(0, 1), a2 + hstepA, voffA);
            PG8_WAIT_V(8); PG8_WAIT_L(0); PG8_BAR; PG8_MMA(0, 0, At, B0); PG8_MMA(0, 1, At, B1); PG8_BAR; PG8_SCHED;
            PG8_LDA(At, 1, 1); PG8_STAGE(PG8_SB(1, 0), b3, voffB); PG8_STAGE(PG8_SB(1, 1), b3 + hstepB, voffB); PG8_STAGE(PG8_SA(1, 0), a3, voffA);
            PG8_WAIT_V(8); PG8_WAIT_L(0); PG8_BAR; PG8_MMA(1, 0, At, B0); PG8_MMA(1, 1, At, B1); PG8_BAR; PG8_SCHED;
            } else {
            PG8_LDB(B0, 0, 0); PG8_SCHED; PG8_LDA(At, 0, 0); PG8_STAGE(PG8_SA(1, 1), a1 + hstepA, voffA);
            PG8_WAIT_L(8); PG8_BAR; PG8_WAIT_L(0); PG8_MMA(0, 0, At, B0); PG8_BAR; PG8_SCHED;
            PG8_LDB(B1, 0, 1); PG8_STAGE(PG8_SB(0, 0), b2, voffB);
            PG8_BAR; PG8_WAIT_L(0); PG8_MMA(0, 1, At, B1); PG8_BAR;
            PG8_LDA(At, 0, 1); PG8_STAGE(PG8_SA(0, 0), a2, voffA);
            PG8_BAR; PG8_WAIT_L(0); PG8_MMA(1, 0, At, B0); PG8_BAR; PG8_SCHED;
            PG8_STAGE(PG8_SB(0, 1), b2 + hstepB, voffB);
            PG8_WAIT_V(6); PG8_BAR; PG8_MMA(1, 1, At, B1); PG8_BAR;
            PG8_LDB(B0, 1, 0); PG8_SCHED; PG8_LDA(At, 1, 0); PG8_STAGE(PG8_SA(0, 1), a2 + hstepA, voffA);
            PG8_WAIT_L(8); PG8_BAR; PG8_WAIT_L(0); PG8_MMA(0, 0, At, B0); PG8_BAR; PG8_SCHED;
            PG8_LDB(B1, 1, 1); PG8_STAGE(PG8_SB(1, 0), b3, voffB);
            PG8_BAR; PG8_WAIT_L(0); PG8_MMA(0, 1, At, B1); PG8_BAR;
            PG8_LDA(At, 1, 1); PG8_STAGE(PG8_SA(1, 0), a3, voffA);
            PG8_BAR; PG8_WAIT_L(0); PG8_MMA(1, 0, At, B0); PG8_BAR; PG8_SCHED;
            PG8_STAGE(PG8_SB(1, 1), b3 + hstepB, voffB);
            PG8_WAIT_V(6); PG8_BAR; PG8_MMA(1, 1, At, B1); PG8_BAR;
            }
        }
        if constexpr (ALIGN_EPI) { if (wr == 0) PG8_BAR; }
        if constexpr (!Epi::AFTER_DRAIN) { E(acc, cur, wr, wc, fr, fq); S.done(cur); }
        if (!has_next) break;
#pragma unroll
        for (int a = 0; a < 2; ++a)
#pragma unroll
            for (int b = 0; b < 2; ++b)
#pragma unroll
                for (int m = 0; m < 4; ++m)
#pragma unroll
                    for (int n = 0; n < 2; ++n) acc[a][b][m][n] = (f32x4){0.f, 0.f, 0.f, 0.f};
        cur = nxt; cA = nA; cB = nB; ++ui;
        if constexpr (ALIGN_EPI) { if (wr == 1) PG8_BAR; }
    }
    PG8_WAIT_V(0);
    if constexpr (!ALIGN_EPI) { if (wr == 0) PG8_BAR; }
    PG8_BAR;
    if constexpr (Epi::AFTER_DRAIN) { E.fused(acc, cur, wr, wc, fr, fq, lds, wid, lane); S.done(cur); }
#undef PG8_SA
#undef PG8_SB
#undef PG8_STAGE
#undef PG8_LDA
#undef PG8_LDB
#undef PG8_MMA
#undef PG8_WAIT_V
#undef PG8_WAIT_L
#undef PG8_BAR
#undef PG8_SCHED
}

}
#define PG8_SP2 true
#define PG8_ALIGN true

__global__ void __launch_bounds__(NTHR, 2) fwd(Args args) {
    extern __shared__ __attribute__((aligned(16))) unsigned char lds[];
    Frame F;
    F.lds = (LAS unsigned char*)lds;
    F.MISC = (volatile LAS unsigned*)(F.lds + MISC_OFF);
    F.tid = 0; F.lane = 0; F.wave = __builtin_amdgcn_readfirstlane(threadIdx.x >> 6);
    F.G = gridDim.x; { const int bx = blockIdx.x; F.vcu = (F.G % 8 == 0) ? (bx % 8) * (F.G / 8) + bx / 8 : bx; }
    unsigned char* ws = args.ws; F.ws = ws;
    F.ctl = (gu32*)(ws + WS_CTL);
    for (int u = threadIdx.x; u < (LDS_BYTES - LDSCTL_OFF) / 4; u += NTHR) ((LAS unsigned*)(F.lds + LDSCTL_OFF))[u] = 0u;
    __syncthreads();
    XcdBarrier bar = xcd_barrier_post((unsigned*)(F.ctl + CW_BAR) + args.li * XCD_BAR_WORDS, F.MISC + 8);
    const int lo = args.ph_lo, hi = args.ph_hi;
#define IN(k) (lo <= (k) && (k) < hi)
#define SEAM(k) do { if (IN(k) && IN((k) + 1)) xcd_barrier(bar); } while (0)
    const int wave = F.wave;
    const int gw = F.vcu * NWAVES + wave, NGW = F.G * NWAVES;
    const int NGT = F.G * NTHR;
#define TVARS const int tid = opaque_tid(); const int lane = tid & 63; const int gt = blockIdx.x * NTHR + tid; (void)lane; (void)gt;
    LAS float* As = (LAS float*)F.lds; LAS float* Bs = As + 16 * 132;
    const float* x = args.in[I_X];
    float* out = args.out;

    if (IN(0)) {
        TVARS
        for (int m = gw; m < T; m += NGW) rms_row_to_bf16(lane, x + (size_t)m * D, args.in[I_NMIX], (bf16*)(ws + WS_H1) + (size_t)m * D);
        { const f32x4* p4 = (const f32x4*)args.in[I_P]; v2u* o = (v2u*)(ws + WS_PB);
          for (int i = gt; i < T * PLE / 4; i += NGT) { const f32x4 v = p4[i]; v2u w; w.x = pk2(v.x, v.y); w.y = pk2(v.z, v.w); o[i] = w; } }
        { f32x2* tr = (f32x2*)(ws + WS_TRIG);
          for (int i = gt; i < T * 64; i += NGT) { const int pos = i >> 6, j = i & 63; double r = (double)pos * args.rfreq[j]; r -= floor(r); if (r > 0.5) r -= 1.0;
              const float rf = (float)r; f32x2 cs; cs.x = __builtin_amdgcn_cosf(rf); cs.y = __builtin_amdgcn_sinf(rf); tr[i] = cs; } }
        { float* lb = (float*)(ws + WS_LB); const float* raw = args.in[I_LBRAW];
          for (int c = gt; c < HW; c += NGT) lb[c] = 1.0f / (1.0f + expf(raw[HW + c] - raw[c])); }
        { float* wrt = (float*)(ws + WS_WRT); const float* wg = args.in[I_WRG]; const float* we = args.in[I_WRE];
          for (int i = gt; i < 36 * D; i += NGT) { const int c = i / D, k = i % D; wrt[i] = args.in[I_NFFN][k] * ((c < 4) ? wg[k * 4 + c] : we[k * NE + (c - 4)]); } }
        { LAS float* scr = (LAS float*)(F.lds + wave * 16384);
          constexpr int I_IN = 32 * 352, I_UH = 16 * 64, I_UM = 16 * 64, I_O = 32 * 64, I_G = 32 * 64, I_PP = 4 * 64;
          for (int it = gw; it < I_IN + I_PP; it += NGW) { int r = it;
              if (r < I_IN) { const int kb = r / 352, nb = r % 352; transpose_item(args.in[I_WIN], INC, kb * 64, phys2log_inproj(nb * 32), (bf16*)(ws + WS_WIN_T), D, nb * 32, kb * 64, scr, lane); continue; } r -= I_IN;
              { const int kb = r / 64, nb = r % 64; transpose_item(args.in[I_WPP], D, kb * 64, nb * 32, (bf16*)(ws + WS_WPP_T), PLE, nb * 32, kb * 64, scr, lane); } } }
    }
    SEAM(0);

    if (IN(1) && FP1) {
        { pg8::Gemm g{(const bf16*)(ws + WS_H1), (const bf16*)(ws + WS_WIN_T), D, D, D}; pg8::StaticOrder S; S.init(T, INC, F.G, (int)blockIdx.x); pg8::EpiInProj E{ws};
          pg8::gemm_phase<pg8::EpiInProj, pg8::StaticOrder, PG8_ALIGN, PG8_SP2>(F.lds, g, S, E); }
        {
            const int nbusy = ((T / 256) * (INC / 256)) % F.G, c = (int)blockIdx.x;
            if (nbusy == 0 || c >= nbusy) { const int nh = nbusy == 0 ? F.G : F.G - nbusy, hr = nbusy == 0 ? c : c - nbusy;
                { pg8::Gemm g2{(const bf16*)(ws + WS_PB), (const bf16*)(ws + WS_WPP_T), PLE, PLE, PLE}; pg8::StaticOrder S2; S2.init(T, D, nh, hr); pg8::EpiBf16Plain E2{(bf16*)(ws + WS_PP), D};
                  pg8::gemm_phase<pg8::EpiBf16Plain, pg8::StaticOrder, PG8_ALIGN, PG8_SP2>(F.lds, g2, S2, E2); }
                __syncthreads();
                { TVARS
                  LAS float* scr = (LAS float*)(F.lds + wave * 16384);
                  constexpr int I_UH = 16 * 64, I_UM = 16 * 64, I_O = 32 * 64, I_G = 32 * 64;
                  auto item1 = [&](int it) -> TrItem { TrItem q; int r = it; q.ldw = D; q.ldt = D;
                      if (r < I_UH) { const int kb = r / 64, nb = r % 64; q.src = args.in[I_WUH] + (size_t)(kb * 64) * D + nb * 32; q.dst = (bf16*)(ws + WS_WUP_T) + (size_t)(nb * 32) * D + kb * 64; return q; } r -= I_UH;
                      if (r < I_UM) { const int kb = r / 64, nb = r % 64; q.src = args.in[I_WUM] + (size_t)(kb * 64) * D + nb * 32; q.dst = (bf16*)(ws + WS_WUP_T) + (size_t)(nb * 32) * D + HW + kb * 64; return q; } r -= I_UM;
                      if (r < I_O) { const int kb = r / 64, nb = r % 64; q.src = args.in[I_WOUT] + (size_t)(kb * 64) * D + nb * 32; q.dst = (bf16*)(ws + WS_WOUT_T) + (size_t)(nb * 32) * D + kb * 64; return q; } r -= I_O;
                      { const int kb = r / 64, nb = r % 64; q.src = args.in[I_WPG] + (size_t)(kb * 64) * D + nb * 32; q.dst = (bf16*)(ws + WS_WPG_T) + (size_t)(nb * 32) * D + kb * 64; return q; } };
                  TR_PIPE(hr * NWAVES + wave, I_UH + I_UM + I_O + I_G, nh * NWAVES, item1); }
            }
        }
    }
    if (IN(1) && !FP1) {
        TVARS
        const bf16* H1 = (const bf16*)(ws + WS_H1);
        constexpr int NT1 = (T / 128) * (INC / 128), NT2 = (T / 128) * (D / 128);
        for (int it = F.vcu; it < NT1 + NT2; it += F.G) {
            float acc[8][4]; zero_acc(acc);
            const int tx = tid & 31, ty = tid >> 5;
            if (it < NT1) {
                const int tm = it / (INC / 128), tn = it % (INC / 128);
                sgemm_acc(acc, As, Bs, H1, D, tm * 128, args.in[I_WIN], INC, tn * 128, D, tid);
#pragma unroll
                for (int i = 0; i < 8; ++i) inproj_epi(ws, tm * 128 + ty * 8 + i, tn * 128 + tx * 4, acc[i]);
            } else {
                const int r = it - NT1, tm = r / (D / 128), tn = r % (D / 128);
                sgemm_acc(acc, As, Bs, (const bf16*)(ws + WS_PB), PLE, tm * 128, args.in[I_WPP], D, tn * 128, PLE, tid);
#pragma unroll
                for (int i = 0; i < 8; ++i) st_bf16x4((bf16*)(ws + WS_PP) + (size_t)(tm * 128 + ty * 8 + i) * D + tn * 128 + tx * 4, acc[i][0], acc[i][1], acc[i][2], acc[i][3]);
            }
        }
    }
    SEAM(1);

    if (IN(2) && (FHG || FMB)) {
        TVARS
        if (FHG) for (int it = F.vcu; it < 128 * NH; it += F.G) hgrn_pass_a(ws, F.lds, it, tid);
        __syncthreads();
        if (FMB) for (int it = F.vcu; it < NH * NB; it += F.G) if ((it & 31) > 0) moba_gate_lists(ws, F.ctl, F.lds, it >> 5, it & 31, tid);
    }
    if (IN(2) && !FP1) {
        TVARS
        const float* raw = (const float*)(ws + WS_TMPF); const f32x2* tr = (const f32x2*)(ws + WS_TRIG);
        for (int i = gt; i < T * 16 * 64; i += NGT) {
            const int j = i & 63, hh = (i >> 6) & 15, t = i >> 10;
            const float x1 = raw[(size_t)t * D + hh * 128 + j], x2 = raw[(size_t)t * D + hh * 128 + 64 + j];
            const f32x2 cs = tr[t * 64 + j];
            bf16* dst = (hh < 8) ? (bf16*)(ws + WS_MQ) + (size_t)t * HW + hh * 128 : (bf16*)(ws + WS_MK) + (size_t)t * HW + (hh - 8) * 128;
            dst[j] = (bf16)f2bf(x1 * cs.x - x2 * cs.y); dst[64 + j] = (bf16)f2bf(x2 * cs.x + x1 * cs.y);
        }
    }
    SEAM(2);
    if (IN(3) && (FHG || FMB)) {
        TVARS
        {
            const bf16* DSb = (const bf16*)(ws + WS_DS); const float* DEC = (const float*)(ws + WS_DEC); bf16* STb = (bf16*)(ws + WS_ST);
            constexpr int SCN = 4;
            if (FHG) for (int e0 = (F.vcu * NTHR * SCN) + tid; e0 < NH * HD * HD; e0 += F.G * NTHR * SCN) {
                float S[SCN]; const bf16* ds[SCN]; const float* dec[SCN]; bf16* st[SCN];
#pragma unroll
                for (int i = 0; i < SCN; ++i) { const int e = e0 + i * NTHR, h = e >> 14, rem = e & 16383, k = e & 127; S[i] = 0.f; ds[i] = DSb + h * 16384 + rem; dec[i] = DEC + h * HD + k; st[i] = STb + h * 16384 + rem; }
                for (int c0 = 0; c0 < 128; c0 += 4) {
                    float dv[4][SCN], gv[4][SCN];
#pragma unroll
                    for (int cc = 0; cc < 4; ++cc)
#pragma unroll
                        for (int i = 0; i < SCN; ++i) { dv[cc][i] = bf2f(ds[i][(size_t)(c0 + cc) * 131072]); gv[cc][i] = dec[i][(c0 + cc) * 1024]; }
#pragma unroll
                    for (int cc = 0; cc < 4; ++cc)
#pragma unroll
                        for (int i = 0; i < SCN; ++i) { st[i][(size_t)(c0 + cc) * 131072] = (bf16)f2bf(S[i]); S[i] = gv[cc][i] * S[i] + dv[cc][i]; } } }
        }
        if (FMB) {
            LAS int* ust = (LAS int*)(F.lds + LDSCTL_OFF + 1024); LAS int* cn = ust + 260; volatile LAS int* cur_w = (volatile LAS int*)(ust + 520);
            __syncthreads();
            if (tid < NH * NB) cn[tid] = (int)__hip_atomic_load((unsigned*)(F.ctl + CW_MCNT) + tid, RLX_AGENT);
            __syncthreads();
            if (tid == 0) { int a = 0; for (int i = 0; i < NH * NB; ++i) { ust[i] = a; a += (cn[i] + MB_RCH - 1) / MB_RCH; } ust[NH * NB] = a; }
            __syncthreads();
            const int nch = ust[NH * NB], total = nch + NH * NB;
            for (;;) {
                if (tid == 0) *cur_w = (int)__hip_atomic_fetch_add((unsigned*)(F.ctl + 8), 1u, RLX_AGENT);
                __syncthreads();
                const int w = *cur_w;
                __syncthreads();
                if (w >= total) break;
                int idx, n; bool causal; const unsigned short* gl = (const unsigned short*)(ws + WS_GL);
                if (w < nch) { int lo2 = 0, hi2 = NH * NB - 1;
                    while (lo2 < hi2) { const int mid = (lo2 + hi2 + 1) >> 1; if (ust[mid] <= w) lo2 = mid; else hi2 = mid - 1; }
                    idx = lo2; const int r0 = (w - ust[idx]) * MB_RCH; n = cn[idx] - r0; n = n > MB_RCH ? MB_RCH : n; gl += (size_t)idx * 8192 + r0; causal = false; }
                else { idx = w - nch; n = 256; causal = true; }
                idx = __builtin_amdgcn_readfirstlane(idx); n = __builtin_amdgcn_readfirstlane(n);
                moba_kv_item(ws, F.lds, idx >> 5, idx & 31, causal, gl, n, tid);
            }
        }
    }

    if (IN(3)) {
        TVARS
        if (!FP1) { const bf16* MK = (const bf16*)(ws + WS_MK); float* km = (float*)(ws + WS_KMEAN);
          for (int i = gt; i < NB * HW; i += NGT) { const int jb = i / HW, c = i % HW; float s = 0.f;
              for (int r = 0; r < BS; ++r) s += bf2f(MK[(size_t)(jb * BS + r) * HW + c]);
              km[i] = s; km[NB * HW + i] = 0.f; } }
        if (!FHG && wave == 0 && blockIdx.x < 16) {
            const int h = blockIdx.x >> 1, v = (blockIdx.x & 1) * 64 + lane;
            const float* GH = (const float*)(ws + WS_GH) + h * HD; const bf16* QH = (const bf16*)(ws + WS_QH) + h * HD; const bf16* VH = (const bf16*)(ws + WS_VH) + h * HD + v;
            float* ORAW = (float*)(ws + WS_TMPF) + h * HD + v;
            float S[HD];
#pragma unroll
            for (int k = 0; k < HD; ++k) S[k] = 0.f;
            for (int t = 0; t < T; ++t) {
                const float iv = bf2f(VH[(size_t)t * HW]); float o = 0.f;
                const float* g = GH + (size_t)t * HW; const bf16* q = QH + (size_t)t * HW;
#pragma unroll
                for (int k = 0; k < HD; ++k) { const float f = __expf(g[k]); S[k] = f * S[k] + (1.f - f) * iv; o += S[k] * bf2f(q[k]); }
                ORAW[(size_t)t * HW] = o;
            }
        }
    }
    SEAM(3);
    if (IN(4) && (FHG || FMB)) {
        TVARS
        const bool merge_first = (F.vcu & 1) != 0;
        auto passc4 = [&]() { if (FHG) for (int it = F.vcu; it < 128 * NH; it += F.G) hgrn_pass_c(ws, F.lds, args.in[I_HNG], it, tid); };
        if (!merge_first) passc4();
        if (false) for (int it0 = F.vcu; it0 < NH * NB; it0 += F.G) if ((it0 & 31) < 16) { const int it = it0 ^ 16;
            const int h = it >> 5, cur = it & 31; const bf16* PO = (const bf16*)(ws + WS_PO); const float* PL = (const float*)(ws + WS_PLSE); bf16* AUP = (bf16*)(ws + WS_AUP);
            for (int idx = tid; idx < BS * 16; idx += NTHR) { const int t = cur * BS + (idx >> 4), dq = idx & 15, th = t * NH + h;
                const float* plp = PL + (size_t)th * 128; float ls[4]; ls[0] = plp[0]; ls[1] = plp[32]; ls[2] = plp[64]; ls[3] = plp[96];
                bool ok[4]; float M = -3.0e38f;
#pragma unroll
                for (int i = 0; i < 4; ++i) { ok[i] = fabsf(ls[i]) < 1.0e4f && fabsf(ls[i]) > 1.0e-9f; if (ok[i]) M = fmaxf(M, ls[i]); }
                float wv[4], wsum = 0.f;
#pragma unroll
                for (int i = 0; i < 4; ++i) { wv[i] = ok[i] ? __expf(ls[i] - M) : 0.f; wsum += wv[i]; }
                const float inv = wsum > 0.f ? 1.0f / wsum : 0.f;
                float acc[8] = {0.f, 0.f, 0.f, 0.f, 0.f, 0.f, 0.f, 0.f};
#pragma unroll
                for (int i = 0; i < 4; ++i) { const v4u pw = *(const v4u*)(PO + ((size_t)th * 4 + i) * HD + dq * 8); const float wi = wv[i] * inv;
                    float pv[8] = {bflo(pw.x), bfhi(pw.x), bflo(pw.y), bfhi(pw.y), bflo(pw.z), bfhi(pw.z), bflo(pw.w), bfhi(pw.w)};
#pragma unroll
                    for (int q = 0; q < 8; ++q) { const float x = fabsf(pv[q]) < 1.0e4f ? pv[q] : 0.f; acc[q] += wi * x; } }
                v4u ov; ov.x = pk2(acc[0], acc[1]); ov.y = pk2(acc[2], acc[3]); ov.z = pk2(acc[4], acc[5]); ov.w = pk2(acc[6], acc[7]);
                *(v4u*)(AUP + (size_t)t * D + HW + h * HD + dq * 8) = ov; }
        }
        if (FMB) {
            const bf16* PO = (const bf16*)(ws + WS_PO); const float* PL = (const float*)(ws + WS_PLSE); bf16* AUP = (bf16*)(ws + WS_AUP);
            for (int idx0 = gt; idx0 < T * NH * 16; idx0 += 2 * NGT) {
                float ls[2][4]; v4u pw[2][4]; int nvv[2];
#pragma unroll
                for (int u = 0; u < 2; ++u) { int idx = idx0 + u * NGT; if (idx >= T * NH * 16) idx = idx0; const int th = idx >> 4, dq = idx & 15, cur = th >> 11; nvv[u] = cur < 3 ? cur : 3;
                    const float* plp = PL + (size_t)th * 128;
#pragma unroll
                    for (int i = 0; i < 4; ++i) { ls[u][i] = plp[32 * i]; pw[u][i] = *(const v4u*)(PO + ((size_t)th * 4 + i) * HD + dq * 8); } }
#pragma unroll
                for (int u = 0; u < 2; ++u) { const int idx = idx0 + u * NGT; if (idx >= T * NH * 16) break; const int th = idx >> 4, dq = idx & 15, t = th >> 3, h = th & 7, nv = nvv[u];
                    float M = ls[u][0];
#pragma unroll
                    for (int i = 1; i < 4; ++i) if (i <= nv) M = fmaxf(M, ls[u][i]);
                    float wv[4]; wv[0] = __expf(ls[u][0] - M);
#pragma unroll
                    for (int i = 1; i < 4; ++i) wv[i] = (i <= nv) ? __expf(ls[u][i] - M) : 0.f;
                    const float inv = 1.0f / ((wv[0] + wv[1]) + (wv[2] + wv[3]));
                    float acc[8] = {0.f, 0.f, 0.f, 0.f, 0.f, 0.f, 0.f, 0.f};
#pragma unroll
                    for (int i = 0; i < 4; ++i) { v4u p = pw[u][i]; if (i > nv) { p.x = 0u; p.y = 0u; p.z = 0u; p.w = 0u; } const float wi = wv[i] * inv;
                        acc[0] += wi * bflo(p.x); acc[1] += wi * bfhi(p.x); acc[2] += wi * bflo(p.y); acc[3] += wi * bfhi(p.y); acc[4] += wi * bflo(p.z); acc[5] += wi * bfhi(p.z); acc[6] += wi * bflo(p.w); acc[7] += wi * bfhi(p.w); }
                    v4u ov; ov.x = pk2(acc[0], acc[1]); ov.y = pk2(acc[2], acc[3]); ov.z = pk2(acc[4], acc[5]); ov.w = pk2(acc[6], acc[7]);
                    *(v4u*)(AUP + (size_t)t * D + HW + h * HD + dq * 8) = ov; } }
        }
        if (merge_first) passc4();
    }

    if (IN(4)) {
        TVARS
        bf16* AUP = (bf16*)(ws + WS_AUP);
        if (!FHG) { const float* ORAW = (const float*)(ws + WS_TMPF); const bf16* OG = (const bf16*)(ws + WS_OG); const float* ng = args.in[I_HNG];
          for (int it = gw; it < T * NH; it += NGW) { const int t = it >> 3, h = it & 7; const size_t off = (size_t)t * HW + h * HD + 2 * lane;
              const f32x2 o = *(const f32x2*)(ORAW + off); const float r = 1.0f / sqrtf(wave_sum(o.x * o.x + o.y * o.y) * (1.f / HD) + EPS);
              const unsigned og = *(const unsigned*)(OG + off);
              *(unsigned*)(AUP + (size_t)t * D + h * HD + 2 * lane) = pk2(o.x * r * ng[2 * lane] * bflo(og), o.y * r * ng[2 * lane + 1] * bfhi(og)); } }
        LAS float* qs = (LAS float*)F.lds + 32768 / 4 + wave * 1280; LAS float* sc = qs + 128;
        const bf16* MQ = (const bf16*)(ws + WS_MQ); const bf16* MK = (const bf16*)(ws + WS_MK); const bf16* MV = (const bf16*)(ws + WS_MV); const float* KM = (const float*)(ws + WS_KMEAN);
        const float scale = 0.08838834764831845f;
        if (FMB != 1) for (int it = gw; it < T * NH; it += NGW) {
            const int t = it >> 3, h = it & 7, cur = t >> 8;
            { const unsigned qw = *(const unsigned*)(MQ + (size_t)t * HW + h * HD + 2 * lane); qs[2 * lane] = bflo(qw); qs[2 * lane + 1] = bfhi(qw); }
            LDS_WAIT();
            float gate = -3.0e38f;
            if (lane < NB) { gate = -1e30f; if (lane < cur) { float s0 = 0.f, s1 = 0.f; const f32x4* ka = (const f32x4*)(KM + (size_t)lane * HW + h * HD); const f32x4* kb = (const f32x4*)(KM + (size_t)(NB + lane) * HW + h * HD);
#pragma unroll
                    for (int d4 = 0; d4 < 32; ++d4) { const f32x4 a = ka[d4], b2 = kb[d4]; const LAS float* q4 = qs + 4 * d4;
                        s0 += q4[0] * (a.x + b2.x) + q4[1] * (a.y + b2.y); s1 += q4[2] * (a.z + b2.z) + q4[3] * (a.w + b2.w); }
                    gate = (s0 + s1) * (1.f / BS); } }
            int blk[4]; bool val[4]; blk[0] = cur; val[0] = true;
#pragma unroll
            for (int r = 0; r < 3; ++r) { const float mxg = wave_max(gate); const unsigned long long bm = __ballot(gate == mxg); const int sel = __ffsll((long long)bm) - 1;
                blk[r + 1] = sel; val[r + 1] = sel < cur; if (lane == sel) gate = -3.0e38f; }
            float mx = -3.0e38f;
#pragma unroll
            for (int b = 0; b < 4; ++b) if (val[b]) for (int g = 0; g < 4; ++g) {
                const int key = blk[b] * BS + g * 64 + lane; const v4u* kr = (const v4u*)(MK + (size_t)key * HW + h * HD); float s = 0.f;
#pragma unroll
                for (int c = 0; c < 16; ++c) { const v4u kw = kr[c]; const LAS float* q8 = qs + c * 8;
                    s += q8[0] * bflo(kw.x) + q8[1] * bfhi(kw.x) + q8[2] * bflo(kw.y) + q8[3] * bfhi(kw.y) + q8[4] * bflo(kw.z) + q8[5] * bfhi(kw.z) + q8[6] * bflo(kw.w) + q8[7] * bfhi(kw.w); }
                s = (b == 0 && key > t) ? -1e30f : s * scale; sc[b * 256 + g * 64 + lane] = s; mx = fmaxf(mx, s); }
            mx = wave_max(mx); float l = 0.f;
#pragma unroll
            for (int b = 0; b < 4; ++b) if (val[b]) for (int g = 0; g < 4; ++g) { const int i = b * 256 + g * 64 + lane; const float p = __expf(sc[i] - mx); sc[i] = p; l += p; }
            l = wave_sum(l); LDS_WAIT();
            float o0 = 0.f, o1 = 0.f;
#pragma unroll
            for (int b = 0; b < 4; ++b) if (val[b]) { const bf16* vb = MV + (size_t)(blk[b] * BS) * HW + h * HD + 2 * lane;
                float a0 = 0.f, a1 = 0.f, c0 = 0.f, c1 = 0.f;
#pragma unroll 1
                for (int k = 0; k < 256; k += 16) { unsigned vw[16];
#pragma unroll
                    for (int u = 0; u < 16; ++u) vw[u] = *(const unsigned*)(vb + (size_t)(k + u) * HW);
#pragma unroll
                    for (int u = 0; u < 16; u += 2) { const float p0 = sc[b * 256 + k + u], p1 = sc[b * 256 + k + u + 1];
                        a0 += p0 * bflo(vw[u]); a1 += p0 * bfhi(vw[u]); c0 += p1 * bflo(vw[u + 1]); c1 += p1 * bfhi(vw[u + 1]); } }
                o0 += a0 + c0; o1 += a1 + c1; }
            const float il = 1.0f / l;
            *(unsigned*)(AUP + (size_t)t * D + HW + h * HD + 2 * lane) = pk2(o0 * il, o1 * il);
            LDS_WAIT();
        }
    }
    SEAM(4);

    if (IN(5) && FP5) {
        pg8::StaticOrder S; S.init(T, D, F.G, (int)blockIdx.x);
        { pg8::Gemm g{(const bf16*)(ws + WS_AUP), (const bf16*)(ws + WS_WUP_T), D, D, D}; pg8::EpiUp2 E{(const bf16*)(ws + WS_GA), (const bf16*)(ws + WS_GB), (bf16*)(ws + WS_MERGED)};
          pg8::gemm_phase<pg8::EpiUp2, pg8::StaticOrder, false, PG8_SP2>(F.lds, g, S, E); }
    }
    if (IN(5) && !FP5) {
        TVARS
        const bf16* AUP = (const bf16*)(ws + WS_AUP); const bf16* GA = (const bf16*)(ws + WS_GA); const bf16* GB = (const bf16*)(ws + WS_GB); bf16* MG = (bf16*)(ws + WS_MERGED);
        for (int it = F.vcu; it < (T / 128) * (D / 128); it += F.G) {
            const int tm = it / (D / 128), tn = it % (D / 128), tx = tid & 31, ty = tid >> 5;
            float a1[8][4], a2[8][4]; zero_acc(a1); zero_acc(a2);
            sgemm_acc(a1, As, Bs, AUP, D, tm * 128, args.in[I_WUH], D, tn * 128, HW, tid);
            sgemm_acc(a2, As, Bs, AUP + HW, D, tm * 128, args.in[I_WUM], D, tn * 128, HW, tid);
#pragma unroll
            for (int i = 0; i < 8; ++i) { const size_t off = (size_t)(tm * 128 + ty * 8 + i) * D + tn * 128 + tx * 4;
                const v2u ga = *(const v2u*)(GA + off), gb = *(const v2u*)(GB + off);
                st_bf16x4(MG + off, bflo(ga.x) * a1[i][0] + bflo(gb.x) * a2[i][0], bfhi(ga.x) * a1[i][1] + bfhi(gb.x) * a2[i][1],
                          bflo(ga.y) * a1[i][2] + bflo(gb.y) * a2[i][2], bfhi(ga.y) * a1[i][3] + bfhi(gb.y) * a2[i][3]); }
        }
    }
    SEAM(5);

    if (IN(6) && FP6) {
        pg8::Gemm g{(const bf16*)(ws + WS_MERGED), (const bf16*)(ws + WS_WOUT_T), D, D, D}; pg8::StaticOrder S; S.init(T, D, F.G, (int)blockIdx.x);
        pg8::EpiResid<0> E{x, out, nullptr};
        pg8::gemm_phase<pg8::EpiResid<0>, pg8::StaticOrder, false, PG8_SP2>(F.lds, g, S, E);
    }
    if (IN(6) && !FP6) {
        TVARS
        const bf16* MG = (const bf16*)(ws + WS_MERGED);
        for (int it = F.vcu; it < (T / 128) * (D / 128); it += F.G) {
            const int tm = it / (D / 128), tn = it % (D / 128), tx = tid & 31, ty = tid >> 5;
            float acc[8][4]; zero_acc(acc);
            sgemm_acc(acc, As, Bs, MG, D, tm * 128, args.in[I_WOUT], D, tn * 128, D, tid);
#pragma unroll
            for (int i = 0; i < 8; ++i) { const size_t off = (size_t)(tm * 128 + ty * 8 + i) * D + tn * 128 + tx * 4; const f32x4 xv = *(const f32x4*)(x + off);
                f32x4 o; o.x = xv.x + acc[i][0]; o.y = xv.y + acc[i][1]; o.z = xv.z + acc[i][2]; o.w = xv.w + acc[i][3]; *(f32x4*)(out + off) = o; }
        }
    }
    SEAM(6);

    if (IN(7)) {
        TVARS
        auto conv7 = [&]() { LAS float* scr = (LAS float*)(F.lds + wave * 16384);
          for (int it = gw; it < NE * 1024; it += NGW) { const int e = it >> 10, r = it & 1023;
              { const int kb = r >> 5, n0 = (r & 31) * 32, pnl = n0 >> 8, bj = (n0 >> 7) & 1, q0 = n0 & 127;
                  transpose_item((bj ? args.in[I_WEU] : args.in[I_WEG]) + (size_t)e * D * DE, DE, kb * 64, pnl * 128 + q0, (bf16*)(ws + WS_WEGU) + (size_t)e * 1024 * D, D, n0, kb * 64, scr, lane); }
          } };
        const bool conv_first = (F.vcu & 1) == 0;
        if (conv_first) conv7();
        const float* gff = args.in[I_NFFN]; const float* wrt = (const float*)(ws + WS_WRT);
        int* EID = (int*)(ws + WS_ROUTE); int* POS = EID + 2 * T; float* RW = (float*)(POS + 2 * T);
        __syncthreads();
        LAS float* part = (LAS float*)F.lds; LAS float* lgt = (LAS float*)(F.lds + 49152); LAS float* rsc = (LAS float*)(F.lds + 57344);
        for (int rb = F.vcu; rb < T / 32; rb += F.G) { const int r0 = rb * 32;
            for (int i4 = 0; i4 < 4; ++i4) { const int m = r0 + 4 * wave + i4;
                const f32x4* xr = (const f32x4*)(out + (size_t)m * D) + lane; const f32x4* gr = (const f32x4*)gff + lane;
                f32x4 v[8]; float s = 0.f;
#pragma unroll
                for (int j = 0; j < 8; ++j) { v[j] = xr[64 * j]; s += (v[j].x * v[j].x + v[j].y * v[j].y) + (v[j].z * v[j].z + v[j].w * v[j].w); }
                f32x4 g8[8];
#pragma unroll
                for (int j = 0; j < 8; ++j) g8[j] = gr[64 * j];
                const float r = 1.0f / sqrtf(wave_sum(s) * (1.f / D) + EPS);
                unsigned long long* o8 = (unsigned long long*)((bf16*)(ws + WS_HFFN) + (size_t)m * D) + lane;
#pragma unroll
                for (int j = 0; j < 8; ++j) { const f32x4 gg = g8[j];
                    o8[64 * j] = (unsigned long long)pk2(v[j].x * r * gg.x, v[j].y * r * gg.y) | ((unsigned long long)pk2(v[j].z * r * gg.z, v[j].w * r * gg.w) << 32); }
                if (lane == 0) rsc[4 * wave + i4] = r; }
            { const int fr = lane & 15, fq = lane >> 4;
              f32x4 acc[2][3];
#pragma unroll
              for (int rt = 0; rt < 2; ++rt)
#pragma unroll
                  for (int ct = 0; ct < 3; ++ct) acc[rt][ct] = (f32x4){0.f, 0.f, 0.f, 0.f};
              const float* xa = out + (size_t)(r0 + fr) * D + wave * 256 + 4 * fq;
              const float* wb = wrt + (size_t)fr * D + wave * 256 + 4 * fq;
              const float* wb2 = wrt + (size_t)((32 + fr) > 35 ? 35 : (32 + fr)) * D + wave * 256 + 4 * fq;
#pragma unroll 2
              for (int j = 0; j < 16; ++j) {
                  const f32x4 a0 = *(const f32x4*)(xa + 16 * j), a1 = *(const f32x4*)(xa + (size_t)16 * D + 16 * j);
                  const f32x4 b0 = *(const f32x4*)(wb + 16 * j), b1 = *(const f32x4*)(wb + (size_t)16 * D + 16 * j), b2 = *(const f32x4*)(wb2 + 16 * j);
#pragma unroll
                  for (int q = 0; q < 4; ++q) {
                      acc[0][0] = __builtin_amdgcn_mfma_f32_16x16x4f32(a0[q], b0[q], acc[0][0], 0, 0, 0); acc[0][1] = __builtin_amdgcn_mfma_f32_16x16x4f32(a0[q], b1[q], acc[0][1], 0, 0, 0);
                      acc[0][2] = __builtin_amdgcn_mfma_f32_16x16x4f32(a0[q], b2[q], acc[0][2], 0, 0, 0); acc[1][0] = __builtin_amdgcn_mfma_f32_16x16x4f32(a1[q], b0[q], acc[1][0], 0, 0, 0);
                      acc[1][1] = __builtin_amdgcn_mfma_f32_16x16x4f32(a1[q], b1[q], acc[1][1], 0, 0, 0); acc[1][2] = __builtin_amdgcn_mfma_f32_16x16x4f32(a1[q], b2[q], acc[1][2], 0, 0, 0); } }
#pragma unroll
              for (int rt = 0; rt < 2; ++rt)
#pragma unroll
                  for (int ct = 0; ct < 3; ++ct)
#pragma unroll
                      for (int q = 0; q < 4; ++q) part[(wave * 32 + 16 * rt + 4 * fq + q) * 48 + 16 * ct + fr] = acc[rt][ct][q]; }
            __syncthreads();
            for (int o = tid; o < 32 * 36; o += NTHR) { const int row = o / 36, c = o - row * 36; float sum = 0.f;
#pragma unroll
                for (int w8 = 0; w8 < 8; ++w8) sum += part[(w8 * 32 + row) * 48 + c];
                lgt[row * 40 + c] = sum * rsc[row]; }
            __syncthreads();
            if (tid < 32) { const int m = r0 + tid;
                float lg[36];
#pragma unroll
                for (int c = 0; c < 36; ++c) lg[c] = lgt[tid * 40 + c];
                int gs = 0; float gm = lg[0];
#pragma unroll
                for (int c = 1; c < 4; ++c) if (lg[c] > gm) { gm = lg[c]; gs = c; }
                float gsum = 0.f;
#pragma unroll
                for (int c = 0; c < 4; ++c) gsum += expf(lg[c] - gm);
                const float pg = 1.0f / gsum;
                float el[8];
#pragma unroll
                for (int c = 0; c < 8; ++c) el[c] = (gs == 0) ? lg[4 + c] : (gs == 1) ? lg[12 + c] : (gs == 2) ? lg[20 + c] : lg[28 + c];
                int i1 = 0; float m1 = el[0];
#pragma unroll
                for (int c = 1; c < 8; ++c) if (el[c] > m1) { m1 = el[c]; i1 = c; }
                int i2 = -1; float m2 = -3.0e38f;
#pragma unroll
                for (int c = 0; c < 8; ++c) if (c != i1 && el[c] > m2) { m2 = el[c]; i2 = c; }
                if (i2 < 0) i2 = (i1 == 0) ? 1 : 0;
                const float e2 = expf(m2 - m1), w1 = pg / (1.0f + e2), w2 = pg * e2 / (1.0f + e2);
                const int ea = gs * 8 + i1, eb = gs * 8 + i2;
                const int pa = (int)__hip_atomic_fetch_add((unsigned*)(F.ctl + CW_ECNT) + ea, 1u, RLX_AGENT), pb = (int)__hip_atomic_fetch_add((unsigned*)(F.ctl + CW_ECNT) + eb, 1u, RLX_AGENT);
                EID[2 * m] = ea; EID[2 * m + 1] = eb; POS[2 * m] = pa; POS[2 * m + 1] = pb; RW[2 * m] = w1; RW[2 * m + 1] = w2; }
            __syncthreads();
        }
        if (!conv_first) { __syncthreads(); conv7(); }
    }
    SEAM(7);

    LAS int* pstart = (LAS int*)(F.lds + LDSCTL_OFF);
    if (hi > 8 && lo <= 10) {
        if (threadIdx.x == 0) { int a = 0; for (int e = 0; e < NE; ++e) { pstart[e] = a; const int c = (int)__hip_atomic_load((unsigned*)(F.ctl + CW_ECNT) + e, RLX_AGENT); pstart[40 + e] = c; a += (c + 255) / 256 * 256; } pstart[NE] = a; }
        __syncthreads();
    }

    if (IN(8)) {
        TVARS
        const int* EID = (const int*)(ws + WS_ROUTE); const int* POS = EID + 2 * T; int* rs = (int*)(ws + WS_ROWSLOT);
        for (int s = gw; s < 2 * T; s += NGW) { const int dest = pstart[EID[s]] + POS[s];
            const v4u* src = (const v4u*)((const bf16*)(ws + WS_HFFN) + (size_t)(s >> 1) * D) + lane; v4u* dst = (v4u*)((bf16*)(ws + WS_XG) + (size_t)dest * D) + lane;
            v4u rowv[4];
#pragma unroll
            for (int j = 0; j < 4; ++j) rowv[j] = src[64 * j];
#pragma unroll
            for (int j = 0; j < 4; ++j) dst[64 * j] = rowv[j];
            if (lane == 0) __hip_atomic_store(rs + dest, s, RLX_AGENT); }
    }
    SEAM(8);

    if (IN(9) && FP9) {
        pg8::Gemm g{(const bf16*)(ws + WS_XG), (const bf16*)(ws + WS_WEGU), D, D, D}; pg8::MoeOrder S{(const LAS int*)pstart, 4, F.G, (int)blockIdx.x}; pg8::EpiMoe1 E{(bf16*)(ws + WS_HMOE)};
        pg8::gemm_phase<pg8::EpiMoe1, pg8::MoeOrder, PG8_ALIGN, PG8_SP2>(F.lds, g, S, E);
        { TVARS
          const int nun = (pstart[NE] >> 8) * 4, nbusy = nun > F.G ? nun - F.G : 0, c = (int)blockIdx.x;
          __syncthreads();
          if (c >= nbusy) { const int nh = F.G - nbusy, hr = c - nbusy; LAS float* scr = (LAS float*)(F.lds + wave * 16384);
              auto item9 = [&](int it) -> TrItem { TrItem q; const int e = it >> 9, r2 = it & 511, kb = r2 >> 6, nb = r2 & 63;
                  q.src = args.in[I_WED] + (size_t)e * DE * D + (size_t)(kb * 64) * D + nb * 32; q.ldw = D; q.dst = (bf16*)(ws + WS_WED) + (size_t)e * D * DE + (size_t)(nb * 32) * DE + kb * 64; q.ldt = DE; return q; };
              TR_PIPE(hr * NWAVES + wave, NE * 512, nh * NWAVES, item9); } }
    }
    if (IN(9) && !FP9) {
        TVARS
        const int ntile = pstart[NE] / 128;
        for (int it = F.vcu; it < ntile * (DE / 128); it += F.G) {
            const int tm = it / (DE / 128), tn = it % (DE / 128), tx = tid & 31, ty = tid >> 5; int e = 0;
            for (int q = 1; q < NE; ++q) if (pstart[q] <= tm * 128) e = q;
            float a1[8][4], a2[8][4]; zero_acc(a1); zero_acc(a2);
            sgemm_acc(a1, As, Bs, (const bf16*)(ws + WS_XG), D, tm * 128, args.in[I_WEG] + (size_t)e * D * DE, DE, tn * 128, D, tid);
            sgemm_acc(a2, As, Bs, (const bf16*)(ws + WS_XG), D, tm * 128, args.in[I_WEU] + (size_t)e * D * DE, DE, tn * 128, D, tid);
#pragma unroll
            for (int i = 0; i < 8; ++i) st_bf16x4((bf16*)(ws + WS_HMOE) + (size_t)(tm * 128 + ty * 8 + i) * DE + tn * 128 + tx * 4,
                siluf_(a1[i][0]) * a2[i][0], siluf_(a1[i][1]) * a2[i][1], siluf_(a1[i][2]) * a2[i][2], siluf_(a1[i][3]) * a2[i][3]);
        }
    }
    SEAM(9);

    if (IN(10) && FP10) {
        pg8::Gemm g{(const bf16*)(ws + WS_HMOE), (const bf16*)(ws + WS_WED), DE, DE, DE}; pg8::MoeOrder S{(const LAS int*)pstart, 8, F.G, (int)blockIdx.x}; pg8::EpiMoe2 E{(bf16*)(ws + WS_Y), (const int*)(ws + WS_ROWSLOT), (const LAS int*)pstart};
        pg8::gemm_phase<pg8::EpiMoe2, pg8::MoeOrder, PG8_ALIGN, PG8_SP2>(F.lds, g, S, E);
    }
    if (IN(10) && !FP10) {
        TVARS
        const int ntile = pstart[NE] / 128; const int* rs = (const int*)(ws + WS_ROWSLOT);
        for (int it = F.vcu; it < ntile * (D / 128); it += F.G) {
            const int tm = it / (D / 128), tn = it % (D / 128), tx = tid & 31, ty = tid >> 5; int e = 0;
            for (int q = 1; q < NE; ++q) if (pstart[q] <= tm * 128) e = q;
            float acc[8][4]; zero_acc(acc);
            sgemm_acc(acc, As, Bs, (const bf16*)(ws + WS_HMOE), DE, tm * 128, args.in[I_WED] + (size_t)e * DE * D, D, tn * 128, DE, tid);
#pragma unroll
            for (int i = 0; i < 8; ++i) { const int prow = tm * 128 + ty * 8 + i;
                if (prow - pstart[e] < pstart[40 + e]) st_bf16x4((bf16*)(ws + WS_Y) + (size_t)__hip_atomic_load((int*)rs + prow, RLX_AGENT) * D + tn * 128 + tx * 4, acc[i][0], acc[i][1], acc[i][2], acc[i][3]); }
        }
    }
    SEAM(10);

    if (IN(11)) {
        TVARS
        const float* gpl = args.in[I_NPLE]; const float* RW = (const float*)((const int*)(ws + WS_ROUTE) + 4 * T);
        for (int m = gw; m < T; m += NGW) {
            f32x4* xr = (f32x4*)(out + (size_t)m * D) + lane; const f32x4* gr = (const f32x4*)gpl + lane;
            const v2u* ya = (const v2u*)((const bf16*)(ws + WS_Y) + (size_t)(2 * m) * D) + lane; const v2u* yb = (const v2u*)((const bf16*)(ws + WS_Y) + (size_t)(2 * m + 1) * D) + lane;
            const float wa = RW[2 * m], wb = RW[2 * m + 1];
            f32x4 v[8]; float s = 0.f;
#pragma unroll
            for (int j = 0; j < 8; ++j) v[j] = xr[64 * j];
            v2u ay[8], by[8]; f32x4 g8[8];
#pragma unroll
            for (int j = 0; j < 8; ++j) { ay[j] = ya[64 * j]; by[j] = yb[64 * j]; g8[j] = gr[64 * j]; }
#pragma unroll
            for (int j = 0; j < 8; ++j) { const v2u a = ay[j], b = by[j];
                v[j].x += bflo(a.x) * wa + bflo(b.x) * wb; v[j].y += bfhi(a.x) * wa + bfhi(b.x) * wb; v[j].z += bflo(a.y) * wa + bflo(b.y) * wb; v[j].w += bfhi(a.y) * wa + bfhi(b.y) * wb;
                xr[64 * j] = v[j]; s += (v[j].x * v[j].x + v[j].y * v[j].y) + (v[j].z * v[j].z + v[j].w * v[j].w); }
            const float r = 1.0f / sqrtf(wave_sum(s) * (1.f / D) + EPS);
            unsigned long long* o8 = (unsigned long long*)((bf16*)(ws + WS_HP) + (size_t)m * D) + lane;
#pragma unroll
            for (int j = 0; j < 8; ++j) { const f32x4 gg = g8[j];
                o8[64 * j] = (unsigned long long)pk2(v[j].x * r * gg.x, v[j].y * r * gg.y) | ((unsigned long long)pk2(v[j].z * r * gg.z, v[j].w * r * gg.w) << 32); }
        }
    }
    SEAM(11);

    if (IN(12) && FP12) {
        pg8::Gemm g{(const bf16*)(ws + WS_HP), (const bf16*)(ws + WS_WPG_T), D, D, D}; pg8::StaticOrder S; S.init(T, D, F.G, (int)blockIdx.x);
        pg8::EpiResid<1> E{out, out, (const bf16*)(ws + WS_PP)};
        pg8::gemm_phase<pg8::EpiResid<1>, pg8::StaticOrder, false, PG8_SP2>(F.lds, g, S, E);
    }
    if (IN(12) && !FP12) {
        TVARS
        const bf16* HP = (const bf16*)(ws + WS_HP); const bf16* PP = (const bf16*)(ws + WS_PP);
        for (int it = F.vcu; it < (T / 128) * (D / 128); it += F.G) {
            const int tm = it / (D / 128), tn = it % (D / 128), tx = tid & 31, ty = tid >> 5;
            float acc[8][4]; zero_acc(acc);
            sgemm_acc(acc, As, Bs, HP, D, tm * 128, args.in[I_WPG], D, tn * 128, D, tid);
#pragma unroll
            for (int i = 0; i < 8; ++i) { const size_t off = (size_t)(tm * 128 + ty * 8 + i) * D + tn * 128 + tx * 4; const f32x4 xv = *(const f32x4*)(out + off); const v2u pp = *(const v2u*)(PP + off);
                f32x4 o; o.x = xv.x + sigmoidf_(acc[i][0]) * bflo(pp.x); o.y = xv.y + sigmoidf_(acc[i][1]) * bfhi(pp.x); o.z = xv.z + sigmoidf_(acc[i][2]) * bflo(pp.y); o.w = xv.w + sigmoidf_(acc[i][3]) * bfhi(pp.y);
                *(f32x4*)(out + off) = o; }
        }
    }
    SEAM(12);

    if (IN(13)) {
        TVARS
        const float* gf = args.in[I_NFIN];
        for (int m = gw; m < T; m += NGW) {
            f32x4* xr = (f32x4*)(out + (size_t)m * D) + lane; const f32x4* gr = (const f32x4*)gf + lane;
            f32x4 v[8]; float s = 0.f;
#pragma unroll
            for (int j = 0; j < 8; ++j) { v[j] = xr[64 * j]; s += (v[j].x * v[j].x + v[j].y * v[j].y) + (v[j].z * v[j].z + v[j].w * v[j].w); }
            f32x4 g8[8];
#pragma unroll
            for (int j = 0; j < 8; ++j) g8[j] = gr[64 * j];
            const float r = 1.0f / sqrtf(wave_sum(s) * (1.f / D) + EPS);
#pragma unroll
            for (int j = 0; j < 8; ++j) { const f32x4 gg = g8[j]; f32x4 o; o.x = v[j].x * r * gg.x; o.y = v[j].y * r * gg.y; o.z = v[j].z * r * gg.z; o.w = v[j].w * r * gg.w; xr[64 * j] = o; }
        }
    }
#undef IN
#undef SEAM
}

extern "C" void kernel_launch(void* const* d_in, const int* in_sizes, int n_in, void* d_out, int out_size, void* d_ws, size_t ws_size, hipStream_t stream) {
    static int grid = 0;
    if (grid == 0) {
        if (n_in != 19 || in_sizes[0] != T * D || out_size != T * D || ws_size < WS_END) { fprintf(stderr, "kernel_launch: shape/workspace mismatch: n_in %d in0 %d out %d ws %zu (need %zu)\n", n_in, n_in > 0 ? in_sizes[0] : -1, out_size, ws_size, (size_t)WS_END); grid = -1; return; }
        int dev = 0, cus = 0, per_cu = 0;
        if (hipGetDevice(&dev) != hipSuccess || hipDeviceGetAttribute(&cus, hipDeviceAttributeMultiprocessorCount, dev) != hipSuccess) { grid = -1; return; }
        if (hipFuncSetAttribute((const void*)fwd, hipFuncAttributeMaxDynamicSharedMemorySize, LDS_BYTES) != hipSuccess) { fprintf(stderr, "kernel_launch: hipFuncSetAttribute failed\n"); grid = -1; return; }
        if (hipOccupancyMaxActiveBlocksPerMultiprocessor(&per_cu, (const void*)fwd, NTHR, LDS_BYTES) != hipSuccess || per_cu < 1) { fprintf(stderr, "kernel_launch: occupancy query says %d blocks per CU\n", per_cu); (void)hipGetLastError(); grid = -1; return; }
        grid = cus;
    }
    if (grid < 0) return;
    if (hipMemsetAsync((char*)d_ws + WS_CTL, 0, CTL_ZERO_BYTES, stream) != hipSuccess) return;
    Args a{};
    for (int i = 0; i < 19; ++i) a.in[i] = (const float*)d_in[i];
    a.out = (float*)d_out; a.ws = (unsigned char*)d_ws; a.pad = MBRT;
    for (int j = 0; j < 64; ++j) a.rfreq[j] = std::pow(10000.0, -(double)j / 64.0) / 6.283185307179586476925286766559;
    constexpr int NL = MK_N_LAUNCHES;
    for (int li = 0; li < NL; ++li) {
        a.ph_lo = (NL == 1) ? 0 : li; a.ph_hi = (NL == 1) ? N_PHASES : li + 1; a.li = 0;
        hipLaunchKernelGGL(fwd, dim3(grid), dim3(NTHR), LDS_BYTES, stream, a);
    }
}
```

```cpp
#include <hip/hip_runtime.h>
#include <cstdio>
#include <cstdint>
#include <cmath>

#define GAS __attribute__((address_space(1)))
#define LAS __attribute__((address_space(3)))
typedef unsigned short bf16;
typedef unsigned v4u __attribute__((ext_vector_type(4)));
typedef unsigned v2u __attribute__((ext_vector_type(2)));
typedef float f32x4 __attribute__((ext_vector_type(4)));
typedef float f32x2 __attribute__((ext_vector_type(2)));
typedef short bf16x8 __attribute__((ext_vector_type(8)));

constexpr int T = 8192, D = 2048, HW = 1024, NH = 8, HD = 128, INC = 11264, NE = 32, DE = 512, PLE = 256, NB = 32, BS = 256;
constexpr float EPS = 1e-6f;
constexpr int NWAVES = 8, NTHR = 512;
constexpr int N_PHASES = 14;
#ifndef FP1
#define FP1 1
#endif
#ifndef FP5
#define FP5 1
#endif
#ifndef FP6
#define FP6 1
#endif
#ifndef FP9
#define FP9 1
#endif
#ifndef FP10
#define FP10 1
#endif
#ifndef FP12
#define FP12 1
#endif
#ifndef FHG
#define FHG 1
#endif
#ifndef FMB
#define FMB 1
#endif
#ifndef MK_N_LAUNCHES
#define MK_N_LAUNCHES 1
#endif

constexpr size_t MiB = 1u << 20;
constexpr size_t WS_CTL = 0, CTL_ZERO_BYTES = 64 * 1024;
constexpr size_t WS_TRIG = 2 * MiB;
constexpr size_t WS_KMEAN = 6 * MiB;
constexpr size_t WS_LB = 6 * MiB + 384 * 1024;
constexpr size_t WS_WRT = 6 * MiB + 512 * 1024;
constexpr size_t WS_ROUTE = 7 * MiB;
constexpr size_t WS_ROWSLOT = 8 * MiB;
constexpr size_t WS_PB = 10 * MiB;
constexpr size_t WS_WIN_T = 16 * MiB, WS_WUP_T = 60 * MiB, WS_WOUT_T = 68 * MiB, WS_WPG_T = 76 * MiB, WS_WPP_T = 84 * MiB;
constexpr size_t WS_PP = 86 * MiB;
constexpr size_t WS_GA = 118 * MiB, WS_GB = 150 * MiB;
constexpr size_t WS_QH = 182 * MiB;
constexpr size_t WS_GH = 198 * MiB;
constexpr size_t WS_XR = 16 * MiB;
constexpr size_t WS_VH = 230 * MiB, WS_OG = 246 * MiB, WS_MQ = 262 * MiB, WS_MK = 278 * MiB, WS_MV = 294 * MiB;
constexpr size_t WS_H1 = 310 * MiB;
constexpr size_t WS_TMPF = 342 * MiB;
constexpr size_t WS_DEC = 14 * MiB;
constexpr size_t WS_ST = 310 * MiB;
constexpr size_t WS_DS = 342 * MiB;
constexpr size_t WS_PO = 406 * MiB;
constexpr size_t WS_PLSE = 544 * MiB;
constexpr size_t WS_MLIST = 504 * MiB;
constexpr size_t WS_CNTP = 9 * MiB;
constexpr size_t WS_AUP = 472 * MiB;
constexpr size_t WS_MERGED = 504 * MiB;
constexpr size_t WS_HFFN = 310 * MiB;
constexpr size_t WS_XG = 342 * MiB;
constexpr size_t WS_HMOE = 438 * MiB;
constexpr size_t WS_Y = 462 * MiB;
constexpr size_t WS_HP = 342 * MiB;
constexpr size_t WS_WEGU = 118 * MiB;
constexpr size_t WS_WED = 246 * MiB;
constexpr size_t WS_END = 576 * MiB;
constexpr int CW_TMO = 0, CW_CODE = 1;
constexpr int CW_ECNT = 64;
constexpr int CW_MCNT = 128;
constexpr int CW_BAR = 4096;

constexpr int RING_BYTES = 131072;
constexpr int LDSCTL_OFF = RING_BYTES, MISC_OFF = LDSCTL_OFF + 320;
constexpr int LDS_BYTES = 147456;

typedef GAS unsigned gu32;
#define RLX_AGENT __ATOMIC_RELAXED, __HIP_MEMORY_SCOPE_AGENT
#define LDS_WAIT() asm volatile("s_waitcnt lgkmcnt(0)" ::: "memory")
#define VM_WAIT() asm volatile("s_waitcnt vmcnt(0)" ::: "memory")
typedef __bf16 hwbf2 __attribute__((ext_vector_type(2)));
__device__ __forceinline__ unsigned pk2(float lo, float hi) { hwbf2 v; v.x = (__bf16)lo; v.y = (__bf16)hi; return __builtin_bit_cast(unsigned, v); }
__device__ __forceinline__ unsigned f2bf(float f) { return pk2(f, 0.f) & 0xffffu; }
__device__ __forceinline__ float bf2f(unsigned b) { return __builtin_bit_cast(float, b << 16); }
__device__ __forceinline__ float bflo(unsigned w) { return __builtin_bit_cast(float, w << 16); }
__device__ __forceinline__ float bfhi(unsigned w) { return __builtin_bit_cast(float, w & 0xffff0000u); }
__device__ __forceinline__ float sigmoidf_(float x) { return 1.0f / (1.0f + __expf(-x)); }
__device__ __forceinline__ float siluf_(float x) { return x / (1.0f + __expf(-x)); }

#define XB_TMO      128
#define XB_XCNT(j)  (256  + 64 * (j))
#define XB_XSUB(j)  (1280 + 64 * (j))
#define XB_XGEN(j)  (2304 + 64 * (j))
#define XB_TOP      3328
#define XB_TOPGEN   3392
#define XCD_BAR_WORDS 3456
#define XB_SPIN_CAP (1u << 25)
__device__ __forceinline__ unsigned xb_ld(unsigned* p)              { return __hip_atomic_load(p, __ATOMIC_RELAXED, __HIP_MEMORY_SCOPE_AGENT); }
__device__ __forceinline__ unsigned xb_add(unsigned* p, unsigned v) { return __hip_atomic_fetch_add(p, v, __ATOMIC_RELAXED, __HIP_MEMORY_SCOPE_AGENT); }
__device__ __forceinline__ unsigned xb_xcc_id() { return (unsigned)__builtin_amdgcn_s_getreg((3 << 11) | 20) & 0xFu; }
#define XB_SPIN(cond, bar) do { unsigned _sp = 0; while (cond) { __builtin_amdgcn_s_sleep(1); \
    if ((++_sp & 255u) == 0u) { if (xb_ld(&(bar)[XB_TMO])) break; if (_sp > XB_SPIN_CAP) { atomicAdd(&(bar)[XB_TMO], 1u); break; } } } } while (0)
struct XcdBarrier { unsigned* bar; unsigned x; volatile LAS unsigned* st; };
__device__ __forceinline__ XcdBarrier xcd_barrier_post(unsigned* bar, volatile LAS unsigned* st) {
    XcdBarrier b; b.bar = bar; b.x = xb_xcc_id(); b.st = st;
    if (threadIdx.x == 0) (void)xb_add(&bar[XB_XCNT(b.x)], 1u);
    return b;
}
__device__ __forceinline__ void xcd_barrier_complete(unsigned* bar, unsigned x, unsigned& nloc, unsigned& nx) {
    const unsigned G = gridDim.x * gridDim.y * gridDim.z;
    unsigned sum, cnt, mine, sp = 0u;
    for (;;) {
        sum = 0u; cnt = 0u; mine = 0u;
#pragma unroll
        for (unsigned j = 0; j < 16; ++j) { const unsigned c = xb_ld(&bar[XB_XCNT(j)]); sum += c; cnt += (c > 0u) ? 1u : 0u; mine = (j == x) ? c : mine; }
        if (sum == G) break;
        __builtin_amdgcn_s_sleep(1);
        if ((++sp & 255u) == 0u) { if (xb_ld(&bar[XB_TMO])) break; if (sp > XB_SPIN_CAP) { atomicAdd(&bar[XB_TMO], 1u); break; } }
    }
    nloc = mine > 0u ? mine : 1u; nx = cnt > 0u ? cnt : 1u;
}
__device__ __forceinline__ void xcd_barrier(const XcdBarrier& b) {
    asm volatile("s_waitcnt vmcnt(0)" ::: "memory");
    __syncthreads();
    if (threadIdx.x == 0) {
        unsigned* bar = b.bar;
        __builtin_amdgcn_s_waitcnt(0);
        unsigned nloc = b.st[0], nx = b.st[1];
        if (nloc == 0u) { xcd_barrier_complete(bar, b.x, nloc, nx); b.st[0] = nloc; b.st[1] = nx; }
        const unsigned old = xb_add(&bar[XB_XSUB(b.x)], 1u);
        const unsigned gen = old / nloc;
        if (old + 1u == (gen + 1u) * nloc) {
            __builtin_amdgcn_fence(__ATOMIC_RELEASE, "agent");
            asm volatile("s_waitcnt vmcnt(0)" ::: "memory");
            const unsigned og = xb_add(&bar[XB_TOP], 1u);
            const unsigned tg = og / nx;
            if (og + 1u == (tg + 1u) * nx) xb_add(&bar[XB_TOPGEN], 1u);
            else XB_SPIN(xb_ld(&bar[XB_TOPGEN]) == tg, bar);
            __builtin_amdgcn_fence(__ATOMIC_ACQUIRE, "agent");
            xb_add(&bar[XB_XGEN(b.x)], 1u);
            asm volatile("s_waitcnt vmcnt(0)" ::: "memory");
        } else {
            XB_SPIN(xb_ld(&bar[XB_XGEN(b.x)]) == gen, bar);
            __builtin_amdgcn_fence(__ATOMIC_ACQUIRE, "agent");
            asm volatile("s_waitcnt vmcnt(0)" ::: "memory");
        }
    }
    __syncthreads();
}

struct Args { const float* in[19]; float* out; unsigned char* ws; double rfreq[64]; int ph_lo, ph_hi, li, pad; };
enum { I_X = 0, I_P, I_NMIX, I_WIN, I_LBRAW, I_HNG, I_WUH, I_WUM, I_WOUT, I_NFFN, I_WRG, I_WRE, I_WEG, I_WEU, I_WED, I_NPLE, I_WPG, I_WPP, I_NFIN };

struct Frame {
    LAS unsigned char* lds;
    volatile LAS unsigned* MISC;
    gu32* ctl;
    int tid, lane, wave, vcu, G;
    unsigned char* ws;
};

__device__ __forceinline__ int opaque_tid() { int t = threadIdx.x; asm volatile("" : "+v"(t)); return t; }
__device__ __forceinline__ float wave_sum(float v) {
#pragma unroll
    for (int o = 1; o < 64; o <<= 1) v += __shfl_xor(v, o);
    return v;
}
__device__ __forceinline__ float wave_max(float v) {
#pragma unroll
    for (int o = 1; o < 64; o <<= 1) v = fmaxf(v, __shfl_xor(v, o));
    return v;
}

__device__ __forceinline__ void rms_row_to_bf16(int lane, const float* xrow, const float* g, bf16* orow) {
    const f32x4* xr = (const f32x4*)xrow + lane; const f32x4* gr = (const f32x4*)g + lane;
    f32x4 v[8]; float s = 0.f;
#pragma unroll
    for (int j = 0; j < 8; ++j) { v[j] = xr[64 * j]; s += (v[j].x * v[j].x + v[j].y * v[j].y) + (v[j].z * v[j].z + v[j].w * v[j].w); }
    f32x4 g8[8];
#pragma unroll
    for (int j = 0; j < 8; ++j) g8[j] = gr[64 * j];
    const float r = 1.0f / sqrtf(wave_sum(s) * (1.f / D) + EPS);
    unsigned long long* o8 = (unsigned long long*)orow + lane;
#pragma unroll
    for (int j = 0; j < 8; ++j) { const f32x4 gg = g8[j];
        o8[64 * j] = (unsigned long long)pk2(v[j].x * r * gg.x, v[j].y * r * gg.y) | ((unsigned long long)pk2(v[j].z * r * gg.z, v[j].w * r * gg.w) << 32); }
}

__device__ __forceinline__ void sgemm_acc(float (&acc)[8][4], LAS float* As, LAS float* Bs, const bf16* A, int lda, int m0, const float* W, int ldb, int n0, int K, int tid) {
    const int tx = tid & 31, ty = tid >> 5;
    const int ar = tid >> 2, akq = tid & 3;
    for (int k0 = 0; k0 < K; k0 += 16) {
        const v2u av = *(const v2u*)(A + (size_t)(m0 + ar) * lda + k0 + akq * 4);
        const f32x4 bv = *(const f32x4*)(W + (size_t)(k0 + ty) * ldb + n0 + tx * 4);
        __syncthreads();
        As[(akq * 4 + 0) * 132 + ar] = bflo(av.x); As[(akq * 4 + 1) * 132 + ar] = bfhi(av.x);
        As[(akq * 4 + 2) * 132 + ar] = bflo(av.y); As[(akq * 4 + 3) * 132 + ar] = bfhi(av.y);
        *(LAS f32x4*)(Bs + ty * 128 + tx * 4) = bv;
        __syncthreads();
#pragma unroll 4
        for (int kk = 0; kk < 16; ++kk) {
            const f32x4 a0 = *(const LAS f32x4*)(As + kk * 132 + ty * 8), a1 = *(const LAS f32x4*)(As + kk * 132 + ty * 8 + 4);
            const f32x4 b = *(const LAS f32x4*)(Bs + kk * 128 + tx * 4);
            const float a[8] = {a0.x, a0.y, a0.z, a0.w, a1.x, a1.y, a1.z, a1.w};
#pragma unroll
            for (int i = 0; i < 8; ++i) { acc[i][0] += a[i] * b.x; acc[i][1] += a[i] * b.y; acc[i][2] += a[i] * b.z; acc[i][3] += a[i] * b.w; }
        }
    }
    __syncthreads();
}
__device__ __forceinline__ void zero_acc(float (&acc)[8][4]) {
#pragma unroll
    for (int i = 0; i < 8; ++i) { acc[i][0] = 0.f; acc[i][1] = 0.f; acc[i][2] = 0.f; acc[i][3] = 0.f; }
}
__device__ __forceinline__ void st_bf16x4(bf16* p, float a, float b, float c, float d) { v2u w; w.x = pk2(a, b); w.y = pk2(c, d); *(v2u*)p = w; }

__device__ __forceinline__ void inproj_epi(unsigned char* ws, int m, int n, const float (&v)[4]) {
    if (n < 1024) { st_bf16x4((bf16*)(ws + WS_QH) + (size_t)m * HW + n, siluf_(v[0]), siluf_(v[1]), siluf_(v[2]), siluf_(v[3])); }
    else if (n < 2048) { const int c = n - 1024; const f32x4 lb = *(const f32x4*)((const float*)(ws + WS_LB) + c);
        f32x4 o; o.x = __logf(lb.x + (1.f - lb.x) * sigmoidf_(v[0])); o.y = __logf(lb.y + (1.f - lb.y) * sigmoidf_(v[1]));
        o.z = __logf(lb.z + (1.f - lb.z) * sigmoidf_(v[2])); o.w = __logf(lb.w + (1.f - lb.w) * sigmoidf_(v[3]));
        *(f32x4*)((float*)(ws + WS_GH) + (size_t)m * HW + c) = o; }
    else if (n < 3072) { st_bf16x4((bf16*)(ws + WS_VH) + (size_t)m * HW + (n - 2048), v[0], v[1], v[2], v[3]); }
    else if (n < 4096) { st_bf16x4((bf16*)(ws + WS_OG) + (size_t)m * HW + (n - 3072), siluf_(v[0]), siluf_(v[1]), siluf_(v[2]), siluf_(v[3])); }
    else if (n < 6144) { f32x4 o = {v[0], v[1], v[2], v[3]}; *(f32x4*)((float*)(ws + WS_TMPF) + (size_t)m * D + (n - 4096)) = o; }
    else if (n < 7168) { st_bf16x4((bf16*)(ws + WS_MV) + (size_t)m * HW + (n - 6144), v[0], v[1], v[2], v[3]); }
    else if (n < 9216) { st_bf16x4((bf16*)(ws + WS_GA) + (size_t)m * D + (n - 7168), sigmoidf_(v[0]), sigmoidf_(v[1]), sigmoidf_(v[2]), sigmoidf_(v[3])); }
    else { st_bf16x4((bf16*)(ws + WS_GB) + (size_t)m * D + (n - 9216), sigmoidf_(v[0]), sigmoidf_(v[1]), sigmoidf_(v[2]), sigmoidf_(v[3])); }
}


__device__ __forceinline__ void transpose_item(const float* W, int ldw, int k0, int sn0, bf16* WT, int ldt, int drow0, int dcol0, LAS float* scr, int lane) {
#pragma unroll 8
    for (int i = 0; i < 32; ++i) { const int kk = 2 * i + (lane >> 5); scr[kk * 33 + (lane & 31)] = W[(size_t)(k0 + kk) * ldw + sn0 + (lane & 31)]; }
    LDS_WAIT(); asm volatile("" ::: "memory");
    const int c = lane & 7;
#pragma unroll
    for (int j = 0; j < 4; ++j) { const int n = (lane >> 3) + 8 * j; const LAS float* sp = scr + (8 * c) * 33 + n;
        v4u o; o.x = pk2(sp[0 * 33], sp[1 * 33]); o.y = pk2(sp[2 * 33], sp[3 * 33]); o.z = pk2(sp[4 * 33], sp[5 * 33]); o.w = pk2(sp[6 * 33], sp[7 * 33]);
        *(v4u*)(WT + (size_t)(drow0 + n) * ldt + dcol0 + 8 * c) = o; }
    LDS_WAIT(); asm volatile("" ::: "memory");
}
struct TrItem { const float* src; bf16* dst; int ldw, ldt; };
__device__ __forceinline__ void tr_load(f32x4 (&v)[8], const float* src, int ldw, int lane) {
    const int kr = lane >> 3, c4 = 4 * (lane & 7);
#pragma unroll
    for (int i = 0; i < 8; ++i) v[i] = *(const f32x4*)(src + (size_t)(8 * i + kr) * ldw + c4);
}
__device__ __forceinline__ void tr_store(const f32x4 (&v)[8], bf16* dst, int ldt, LAS float* scr, int lane) {
    const int kr = lane >> 3, c4 = 4 * (lane & 7);
#pragma unroll
    for (int i = 0; i < 8; ++i) { LAS float* d = scr + (8 * i + kr) * 33 + c4; d[0] = v[i].x; d[1] = v[i].y; d[2] = v[i].z; d[3] = v[i].w; }
    LDS_WAIT(); asm volatile("" ::: "memory");
    const int c = lane & 7;
#pragma unroll
    for (int j = 0; j < 4; ++j) { const int n = (lane >> 3) + 8 * j; const LAS float* sp = scr + (8 * c) * 33 + n;
        v4u o; o.x = pk2(sp[0 * 33], sp[1 * 33]); o.y = pk2(sp[2 * 33], sp[3 * 33]); o.z = pk2(sp[4 * 33], sp[5 * 33]); o.w = pk2(sp[6 * 33], sp[7 * 33]);
        *(v4u*)(dst + (size_t)n * ldt + 8 * c) = o; }
    LDS_WAIT(); asm volatile("" ::: "memory");
}
#define TR_PIPE(first, N, step, ITEM) do { f32x4 va_[8], vb_[8]; TrItem ia_, ib_; int it_ = (first); \
    if (it_ < (N)) { ia_ = ITEM(it_); tr_load(va_, ia_.src, ia_.ldw, lane); } \
    while (it_ < (N)) { const int i2_ = it_ + (step); \
        if (i2_ < (N)) { ib_ = ITEM(i2_); tr_load(vb_, ib_.src, ib_.ldw, lane); } \
        tr_store(va_, ia_.dst, ia_.ldt, scr, lane); \
        if (i2_ >= (N)) break; \
        const int i3_ = i2_ + (step); \
        if (i3_ < (N)) { ia_ = ITEM(i3_); tr_load(va_, ia_.src, ia_.ldw, lane); } \
        tr_store(vb_, ib_.dst, ib_.ldt, scr, lane); \
        it_ = i3_; } } while (0)

__device__ __forceinline__ int phys2log_inproj(int n0) {
    const int tile = n0 >> 8; if (tile < 16 || tile >= 24) return n0;
    const int p = n0 & 255, bj = p >> 7, q = p & 127, head = 2 * ((tile - 16) & 3) + (q >> 6), d = (q & 63) + 64 * bj, which = (tile - 16) >> 2;
    return 4096 + which * 1024 + head * 128 + d;
}


typedef short v4i16_t __attribute__((ext_vector_type(4)));
__device__ __forceinline__ f32x4 mfma16(bf16x8 a, bf16x8 b, f32x4 c) { return __builtin_amdgcn_mfma_f32_16x16x32_bf16(a, b, c, 0, 0, 0); }
constexpr int HG_RED = 0, HG_BR = 2048, HG_RS = 2560, HG_KT = 4096, HG_VT = HG_KT + 128 * 144, HG_Q1 = HG_VT + 128 * 144, HG_K1 = HG_Q1 + 64 * 272, HG_Q2 = HG_K1 + 64 * 272, HG_P = HG_Q2 + 64 * 272;
static_assert(HG_P + 64 * 144 <= 131072, "hgrn lds");

__device__ __forceinline__ void hgrn_cumsum(const float* G, int col, int qt, LAS float* red, float (&gv)[16], float (&b)[16], float& btot) {
    float run = 0.f;
#pragma unroll
    for (int i = 0; i < 16; ++i) { gv[i] = G[(size_t)(16 * qt + i) * HW + col]; }
#pragma unroll
    for (int i = 0; i < 16; ++i) { run += gv[i]; b[i] = run; }
    red[qt * 128 + col] = run;
    __syncthreads();
    const float r0 = red[col], r1 = red[128 + col], r2 = red[256 + col], r3 = red[384 + col];
    const float pre = (qt > 0 ? r0 : 0.f) + (qt > 1 ? r1 : 0.f) + (qt > 2 ? r2 : 0.f);
    btot = ((r0 + r1) + r2) + r3;
#pragma unroll
    for (int i = 0; i < 16; ++i) b[i] += pre;
}
__device__ __forceinline__ void st_lds_bf16x16(LAS unsigned char* p, const float (&v)[16]) {
    v4u a, b; a.x = pk2(v[0], v[1]); a.y = pk2(v[2], v[3]); a.z = pk2(v[4], v[5]); a.w = pk2(v[6], v[7]); b.x = pk2(v[8], v[9]); b.y = pk2(v[10], v[11]); b.z = pk2(v[12], v[13]); b.w = pk2(v[14], v[15]);
    *(LAS v4u*)p = a; *(LAS v4u*)(p + 16) = b;
}
__device__ __forceinline__ void hgrn_pass_a(unsigned char* ws, LAS unsigned char* lds, int item, int tid) {
    const int c = item >> 3, h = item & 7, col = tid & 127, qt = tid >> 7, lane = tid & 63, w = tid >> 6, t0 = c * 64;
    float gv[16], b[16], btot;
    hgrn_cumsum((const float*)(ws + WS_GH) + (size_t)t0 * HW + h * HD, col, qt, (LAS float*)(lds + HG_RED), gv, b, btot);
    float kt[16], vv[16];
    const bf16* VH = (const bf16*)(ws + WS_VH) + (size_t)(t0 + 16 * qt) * HW + h * HD + col;
#pragma unroll
    for (int i = 0; i < 16; ++i) { kt[i] = (1.f - __expf(gv[i])) * __expf(btot - b[i]); vv[i] = bf2f(VH[(size_t)i * HW]); }
    st_lds_bf16x16(lds + HG_KT + col * 144 + qt * 32, kt); st_lds_bf16x16(lds + HG_VT + col * 144 + qt * 32, vv);
    if (qt == 0) ((float*)(ws + WS_DEC))[(size_t)item * HD + col] = __expf(btot);
    __syncthreads();
    const int fr = lane & 15, fq = lane >> 4;
    const bf16x8 a0 = *(const LAS bf16x8*)(lds + HG_KT + (16 * w + fr) * 144 + fq * 16), a1 = *(const LAS bf16x8*)(lds + HG_KT + (16 * w + fr) * 144 + fq * 16 + 64);
    bf16* dst = (bf16*)(ws + WS_DS) + (size_t)item * HD * HD + 16 * w + 4 * fq;
#pragma unroll
    for (int nt = 0; nt < 8; ++nt) {
        const bf16x8 b0 = *(const LAS bf16x8*)(lds + HG_VT + (16 * nt + fr) * 144 + fq * 16), b1 = *(const LAS bf16x8*)(lds + HG_VT + (16 * nt + fr) * 144 + fq * 16 + 64);
        f32x4 acc = {0.f, 0.f, 0.f, 0.f}; acc = mfma16(a0, b0, acc); acc = mfma16(a1, b1, acc);
        { v2u wv; wv.x = pk2(acc[0], acc[1]); wv.y = pk2(acc[2], acc[3]); *(v2u*)(dst + (size_t)(16 * nt + fr) * HD) = wv; }
    }
    __syncthreads();
}
__device__ __forceinline__ void hgrn_pass_c(unsigned char* ws, LAS unsigned char* lds, const float* ng, int item, int tid) {
    const int c = item >> 3, h = item & 7, col = tid & 127, qt = tid >> 7, lane = tid & 63, w = tid >> 6, t0 = c * 64, fr = lane & 15, fq = lane >> 4;
    const int fr_ = lane & 15, fq_ = lane >> 4, mt_ = w & 3, vh_ = w >> 2;
    bf16 qraw[16], vraw[16];
    { const bf16* QHp = (const bf16*)(ws + WS_QH) + (size_t)(t0 + 16 * qt) * HW + h * HD + col; const bf16* VHp = (const bf16*)(ws + WS_VH) + (size_t)(t0 + 16 * qt) * HW + h * HD + col;
#pragma unroll
      for (int i = 0; i < 16; ++i) { qraw[i] = QHp[(size_t)i * HW]; vraw[i] = VHp[(size_t)i * HW]; } }
    bf16x8 stf[4][4];
    { const bf16* STp = (const bf16*)(ws + WS_ST) + (size_t)item * HD * HD;
#pragma unroll
      for (int nt = 0; nt < 4; ++nt)
#pragma unroll
          for (int ks = 0; ks < 4; ++ks) stf[nt][ks] = *(const bf16x8*)(STp + (size_t)(16 * (4 * vh_ + nt) + fr_) * HD + fq_ * 8 + ks * 32); }
    bf16 ograw[4][4]; float ngv[4];
#pragma unroll
    for (int nt = 0; nt < 4; ++nt) ngv[nt] = ng[16 * (4 * vh_ + nt) + fr_];
#pragma unroll
    for (int r = 0; r < 4; ++r)
#pragma unroll
        for (int nt = 0; nt < 4; ++nt) ograw[r][nt] = ((const bf16*)(ws + WS_OG))[(size_t)(t0 + 16 * mt_ + 4 * fq_ + r) * HW + h * HD + 16 * (4 * vh_ + nt) + fr_];
    float gv[16], b[16], btot;
    hgrn_cumsum((const float*)(ws + WS_GH) + (size_t)t0 * HW + h * HD, col, qt, (LAS float*)(lds + HG_RED), gv, b, btot);
    LAS float* BR = (LAS float*)(lds + HG_BR);
    if (qt == 1) BR[col] = b[15];
    float vv[16];
#pragma unroll
    for (int i = 0; i < 16; ++i) vv[i] = bf2f(vraw[i]);
    st_lds_bf16x16(lds + HG_VT + col * 144 + qt * 32, vv);
    __syncthreads();
    const float bref = BR[col];
    {
#pragma unroll
      for (int i = 0; i < 16; ++i) { const float q = bf2f(qraw[i]); const int s = 16 * qt + i;
          *(LAS bf16*)(lds + HG_Q1 + s * 272 + col * 2) = (bf16)f2bf(q * __expf(b[i] - bref));
          *(LAS bf16*)(lds + HG_Q2 + s * 272 + col * 2) = (bf16)f2bf(q * __expf(b[i]));
          *(LAS bf16*)(lds + HG_K1 + s * 272 + col * 2) = (bf16)f2bf((1.f - __expf(gv[i])) * __expf(bref - b[i])); } }
    __syncthreads();
    {
        const int mt = w >> 1;
#pragma unroll
        for (int u = 0; u < 2; ++u) { const int nt = 2 * (w & 1) + u; f32x4 acc = {0.f, 0.f, 0.f, 0.f};
            if (nt <= mt) {
#pragma unroll
                for (int ks = 0; ks < 4; ++ks) { const bf16x8 a = *(const LAS bf16x8*)(lds + HG_Q1 + (16 * mt + fr) * 272 + fq * 16 + ks * 64), bb = *(const LAS bf16x8*)(lds + HG_K1 + (16 * nt + fr) * 272 + fq * 16 + ks * 64);
                    acc = mfma16(a, bb, acc); } }
            const int sidx = 16 * nt + fr;
#pragma unroll
            for (int r = 0; r < 4; ++r) { const int tr = 16 * mt + 4 * fq + r; const float pv = (nt <= mt && sidx <= tr) ? acc[r] : 0.f;
                *(LAS bf16*)(lds + HG_P + tr * 144 + sidx * 2) = (bf16)f2bf(pv); } }
    }
    __syncthreads();
    const int mt = w & 3, vh = w >> 2;
    f32x4 o[4];
#pragma unroll
    for (int nt = 0; nt < 4; ++nt) { const int vt = 4 * vh + nt; f32x4 acc = {0.f, 0.f, 0.f, 0.f};
#pragma unroll
        for (int ks = 0; ks < 2; ++ks) { const bf16x8 a = *(const LAS bf16x8*)(lds + HG_P + (16 * mt + fr) * 144 + fq * 16 + ks * 64), bb = *(const LAS bf16x8*)(lds + HG_VT + (16 * vt + fr) * 144 + fq * 16 + ks * 64);
            acc = mfma16(a, bb, acc); }
#pragma unroll
        for (int ks = 0; ks < 4; ++ks) { const bf16x8 a = *(const LAS bf16x8*)(lds + HG_Q2 + (16 * mt + fr) * 272 + fq * 16 + ks * 64); const bf16x8 bb = stf[nt][ks];
            acc = mfma16(a, bb, acc); }
        o[nt] = acc; }
    LAS float* RS = (LAS float*)(lds + HG_RS);
#pragma unroll
    for (int r = 0; r < 4; ++r) { float ss = 0.f;
#pragma unroll
        for (int nt = 0; nt < 4; ++nt) ss += o[nt][r] * o[nt][r];
        ss += __shfl_xor(ss, 1); ss += __shfl_xor(ss, 2); ss += __shfl_xor(ss, 4); ss += __shfl_xor(ss, 8);
        if (fr == 0) RS[vh * 64 + 16 * mt + 4 * fq + r] = ss; }
    __syncthreads();
    bf16* AUP = (bf16*)(ws + WS_AUP);
#pragma unroll
    for (int r = 0; r < 4; ++r) { const int tl = 16 * mt + 4 * fq + r; const float rn = 1.0f / sqrtf((RS[tl] + RS[64 + tl]) * (1.f / HD) + EPS);
#pragma unroll
        for (int nt = 0; nt < 4; ++nt) { const int v = 16 * (4 * vh + nt) + fr;
            AUP[(size_t)(t0 + tl) * D + h * HD + v] = (bf16)f2bf(o[nt][r] * rn * ngv[nt] * bf2f(ograw[r][nt])); } }
    __syncthreads();
}
__device__ __forceinline__ void moba_gate_item(unsigned char* ws, LAS unsigned char* lds, int item, int tid) {
    const int h = item >> 5, cur = item & 31, lane = tid & 63;
    if (cur == 0) return;
    LAS float* km = (LAS float*)lds;
    LAS unsigned* lcnt = (LAS unsigned*)(lds + 16384);
    if (tid < NB) lcnt[tid] = 0u;
    { const float* KM = (const float*)(ws + WS_KMEAN);
      for (int i = tid; i < NB * HD; i += NTHR) { const int j = i >> 7, d = i & 127; km[i] = (KM[(size_t)j * HW + h * HD + d] + KM[(size_t)(NB + j) * HW + h * HD + d]) * (1.f / BS); } }
    __syncthreads();
    if (tid < 256) {
        const int t = cur * BS + tid;
        const v4u* qp = (const v4u*)((const bf16*)(ws + WS_MQ) + (size_t)t * HW + h * HD);
        float g[32];
#pragma unroll
        for (int j = 0; j < 32; ++j) g[j] = 0.f;
        for (int dc = 0; dc < 16; ++dc) { const v4u qw = qp[dc]; const float q0 = bflo(qw.x), q1 = bfhi(qw.x), q2 = bflo(qw.y), q3 = bfhi(qw.y), q4 = bflo(qw.z), q5 = bfhi(qw.z), q6 = bflo(qw.w), q7 = bfhi(qw.w);
#pragma unroll
            for (int j = 0; j < 32; ++j) if (j < cur) { const f32x4 k0 = *(const LAS f32x4*)(km + j * 128 + dc * 8), k1 = *(const LAS f32x4*)(km + j * 128 + dc * 8 + 4);
                g[j] += (q0 * k0.x + q1 * k0.y + q2 * k0.z + q3 * k0.w) + (q4 * k1.x + q5 * k1.y + q6 * k1.z + q7 * k1.w); } }
#pragma unroll
        for (int j = 0; j < 32; ++j) if (j >= cur) g[j] = -3.0e38f;
        unsigned* LIST = (unsigned*)(ws + WS_MLIST);
#pragma unroll
        for (int r = 0; r < 3; ++r) {
            float best = g[0]; int bi = 0;
#pragma unroll
            for (int j = 1; j < 32; ++j) if (g[j] > best) { best = g[j]; bi = j; }
#pragma unroll
            for (int j = 0; j < 32; ++j) if (j == bi) g[j] = -3.0e38f;
            if (r < cur) {
                const int pos = (int)__hip_atomic_fetch_add(lcnt + bi, 1u, __ATOMIC_RELAXED, __HIP_MEMORY_SCOPE_WORKGROUP);
                LIST[(size_t)((h * NB + bi) * NB + cur) * 256 + pos] = ((unsigned)t << 2) | (unsigned)(r + 1);
            }
        }
    }
    __syncthreads();
    if (tid < NB) ((int*)(ws + WS_CNTP))[(h * NB + cur) * NB + tid] = (int)lcnt[tid];
    __syncthreads();
}
__device__ __forceinline__ void moba_unit(unsigned char* ws, LAS unsigned char* lds, int h, int j, int cur, bool causal, int g, int n, const LAS int* lst, int tid) {
    const int lane = tid & 63, w = tid >> 6, fr = lane & 15, fq = lane >> 4;
    const bf16* MK = (const bf16*)(ws + WS_MK) + (size_t)(j * BS) * HW + h * HD; const bf16* MV = (const bf16*)(ws + WS_MV) + (size_t)(j * BS) * HW + h * HD;
#pragma unroll
    for (int i = 0; i < 8; ++i) { const int p = i * NTHR + tid, row = p >> 4, ch = p & 15;
        const v4u kv = *(const v4u*)(MK + (size_t)row * HW + ch * 8), vv = *(const v4u*)(MV + (size_t)row * HW + ch * 8);
        *(LAS v4u*)(lds + row * 256 + ((ch ^ (row & 15)) << 4)) = kv; *(LAS v4u*)(lds + 65536 + row * 256 + ((ch ^ ((row & 7) << 1)) << 4)) = vv; }
    int t, slot; bool valid = true;
    if (causal) { t = cur * BS + g * 128 + w * 16 + fr; slot = 0; }
    else { int rr = g * 128 + w * 16 + fr; valid = rr < n; if (!valid) rr = n - 1; rr = rr < 0 ? 0 : (rr > 255 ? 255 : rr); const int e = lst[rr]; t = cur * BS + ((e >> 2) & 255); slot = e & 3; if (slot == 0) valid = false; }
    bf16x8 qa[4];
    { const bf16* qp = (const bf16*)(ws + WS_MQ) + (size_t)t * HW + h * HD + fq * 8;
#pragma unroll
      for (int ks = 0; ks < 4; ++ks) qa[ks] = *(const bf16x8*)(qp + ks * 32); }
    __syncthreads();
    const bool wact = causal || (__builtin_amdgcn_readfirstlane(g * 128 + (tid >> 6) * 16) < n);
    if (wact) {
    const int qidx = g * 128 + w * 16 + fr;
    const int ntmax = causal ? (g * 128 + w * 16 + 15) >> 4 : 15;
    f32x4 acc[16];
#pragma unroll
    for (int nt = 0; nt < 16; ++nt) { acc[nt] = (f32x4){0.f, 0.f, 0.f, 0.f};
        if (nt <= ntmax) { const int row = 16 * nt + fr;
#pragma unroll
            for (int ks = 0; ks < 4; ++ks) { const bf16x8 kf = *(const LAS bf16x8*)(lds + row * 256 + (((4 * ks + fq) ^ fr) << 4)); acc[nt] = mfma16(kf, qa[ks], acc[nt]); }
            if (causal) {
#pragma unroll
                for (int r = 0; r < 4; ++r) if (16 * nt + 4 * fq + r > qidx) acc[nt][r] = -3.0e38f; }
        } else { acc[nt] = (f32x4){-3.0e38f, -3.0e38f, -3.0e38f, -3.0e38f}; } }
    float m = -3.0e38f;
#pragma unroll
    for (int nt = 0; nt < 16; ++nt) m = fmaxf(fmaxf(fmaxf(m, acc[nt][0]), fmaxf(acc[nt][1], acc[nt][2])), acc[nt][3]);
    m = fmaxf(m, __shfl_xor(m, 16)); m = fmaxf(m, __shfl_xor(m, 32));
    const float cexp = 0.08838834764831845f * 1.4426950408889634f; float l = 0.f;
    bf16x8 pa[8];
#pragma unroll
    for (int k2 = 0; k2 < 8; ++k2) { float p[8];
#pragma unroll
        for (int r = 0; r < 4; ++r) { p[r] = __builtin_amdgcn_exp2f((acc[2 * k2][r] - m) * cexp); p[4 + r] = __builtin_amdgcn_exp2f((acc[2 * k2 + 1][r] - m) * cexp); }
        l += ((p[0] + p[1]) + (p[2] + p[3])) + ((p[4] + p[5]) + (p[6] + p[7]));
        v4u pw; pw.x = pk2(p[0], p[1]); pw.y = pk2(p[2], p[3]); pw.z = pk2(p[4], p[5]); pw.w = pk2(p[6], p[7]); pa[k2] = __builtin_bit_cast(bf16x8, pw); }
    l += __shfl_xor(l, 16); l += __shfl_xor(l, 32);
    f32x4 o[8];
    const int gl = fr >> 2, pp = fr & 3;
#pragma unroll
    for (int dt = 0; dt < 8; ++dt) o[dt] = (f32x4){0.f, 0.f, 0.f, 0.f};
#pragma unroll
    for (int k2 = 0; k2 < 8; ++k2) { const int r0 = 32 * k2 + 4 * fq + gl, r1 = r0 + 16;
#pragma unroll
        for (int dt = 0; dt < 8; ++dt) { const int ch = 2 * dt + (pp >> 1);
            const v4i16_t lo = __builtin_amdgcn_ds_read_tr16_b64_v4i16((LAS v4i16_t*)(lds + 65536 + r0 * 256 + ((ch ^ ((r0 & 7) << 1)) << 4) + 8 * (pp & 1)));
            const v4i16_t hi = __builtin_amdgcn_ds_read_tr16_b64_v4i16((LAS v4i16_t*)(lds + 65536 + r1 * 256 + ((ch ^ ((r1 & 7) << 1)) << 4) + 8 * (pp & 1)));
            bf16x8 vf; vf[0] = lo[0]; vf[1] = lo[1]; vf[2] = lo[2]; vf[3] = lo[3]; vf[4] = hi[0]; vf[5] = hi[1]; vf[6] = hi[2]; vf[7] = hi[3];
            o[dt] = mfma16(vf, pa[k2], o[dt]); } }
    const float il = 1.0f / l;
    int t2, slot2; bool valid2 = true;
    if (causal) { t2 = cur * BS + g * 128 + w * 16 + fr; slot2 = 0; }
    else { int rr = g * 128 + w * 16 + fr; valid2 = rr < n; if (!valid2) rr = n - 1; rr = rr < 0 ? 0 : (rr > 255 ? 255 : rr); const int e = lst[rr]; t2 = cur * BS + ((e >> 2) & 255); slot2 = e & 3; if (slot2 == 0) valid2 = false; }
    if (valid2) { bf16* po = (bf16*)(ws + WS_PO) + ((size_t)(t2 * NH + h) * 4 + slot2) * HD + 4 * fq;
#pragma unroll
        for (int dt = 0; dt < 8; ++dt) { v2u wv; wv.x = pk2(o[dt][0] * il, o[dt][1] * il); wv.y = pk2(o[dt][2] * il, o[dt][3] * il); *(v2u*)(po + 16 * dt) = wv; }
        if (fq == 0) ((float*)(ws + WS_PLSE))[((size_t)(t2 * NH + h) * 4 + slot2) * 32] = m * 0.08838834764831845f + __logf(l); }
    }
    __syncthreads();
}

__device__ __forceinline__ void moba_unit2(unsigned char* ws, LAS unsigned char* lds, int h, int j, bool causal, int g, int n, const unsigned short* glist, int tid) {
    const int lane = tid & 63, w = tid >> 6, fr = lane & 15, fq = lane >> 4;
    int t, slot; bool valid = true;
    if (causal) { t = j * BS + g * 128 + w * 16 + fr; slot = 0; }
    else { int rr = g * 128 + w * 16 + fr; valid = rr < n; if (!valid) rr = n - 1; rr = rr < 0 ? 0 : rr; const int e = (int)glist[rr]; t = (e >> 2) & (T - 1); slot = e & 3; if (slot == 0) valid = false; }
    bf16x8 qa[4];
    { const bf16* qp = (const bf16*)(ws + WS_MQ) + (size_t)t * HW + h * HD + fq * 8;
#pragma unroll
      for (int ks = 0; ks < 4; ++ks) qa[ks] = *(const bf16x8*)(qp + ks * 32); }
    __syncthreads();
    const bool wact = causal || (__builtin_amdgcn_readfirstlane(g * 128 + (tid >> 6) * 16) < n);
    if (wact) {
    const int qidx = g * 128 + w * 16 + fr;
    const int ntmax = causal ? (g * 128 + w * 16 + 15) >> 4 : 15;
    f32x4 acc[16];
#pragma unroll
    for (int nt = 0; nt < 16; ++nt) { acc[nt] = (f32x4){0.f, 0.f, 0.f, 0.f};
        if (nt <= ntmax) { const int row = 16 * nt + fr;
#pragma unroll
            for (int ks = 0; ks < 4; ++ks) { const bf16x8 kf = *(const LAS bf16x8*)(lds + row * 256 + (((4 * ks + fq) ^ fr) << 4)); acc[nt] = mfma16(kf, qa[ks], acc[nt]); }
            if (causal) {
#pragma unroll
                for (int r = 0; r < 4; ++r) if (16 * nt + 4 * fq + r > qidx) acc[nt][r] = -3.0e38f; }
        } else { acc[nt] = (f32x4){-3.0e38f, -3.0e38f, -3.0e38f, -3.0e38f}; } }
    float m = -3.0e38f;
#pragma unroll
    for (int nt = 0; nt < 16; ++nt) m = fmaxf(fmaxf(fmaxf(m, acc[nt][0]), fmaxf(acc[nt][1], acc[nt][2])), acc[nt][3]);
    m = fmaxf(m, __shfl_xor(m, 16)); m = fmaxf(m, __shfl_xor(m, 32));
    const float cexp = 0.08838834764831845f * 1.4426950408889634f; float l = 0.f;
    bf16x8 pa[8];
#pragma unroll
    for (int k2 = 0; k2 < 8; ++k2) { float p[8];
#pragma unroll
        for (int r = 0; r < 4; ++r) { p[r] = __builtin_amdgcn_exp2f((acc[2 * k2][r] - m) * cexp); p[4 + r] = __builtin_amdgcn_exp2f((acc[2 * k2 + 1][r] - m) * cexp); }
        l += ((p[0] + p[1]) + (p[2] + p[3])) + ((p[4] + p[5]) + (p[6] + p[7]));
        v4u pw; pw.x = pk2(p[0], p[1]); pw.y = pk2(p[2], p[3]); pw.z = pk2(p[4], p[5]); pw.w = pk2(p[6], p[7]); pa[k2] = __builtin_bit_cast(bf16x8, pw); }
    l += __shfl_xor(l, 16); l += __shfl_xor(l, 32);
    f32x4 o[8];
    const int gl = fr >> 2, pp = fr & 3;
#pragma unroll
    for (int dt = 0; dt < 8; ++dt) o[dt] = (f32x4){0.f, 0.f, 0.f, 0.f};
#pragma unroll
    for (int k2 = 0; k2 < 8; ++k2) { const int r0 = 32 * k2 + 4 * fq + gl, r1 = r0 + 16;
#pragma unroll
        for (int dt = 0; dt < 8; ++dt) { const int ch = 2 * dt + (pp >> 1);
            const v4i16_t lo = __builtin_amdgcn_ds_read_tr16_b64_v4i16((LAS v4i16_t*)(lds + 65536 + r0 * 256 + ((ch ^ ((r0 & 7) << 1)) << 4) + 8 * (pp & 1)));
            const v4i16_t hi = __builtin_amdgcn_ds_read_tr16_b64_v4i16((LAS v4i16_t*)(lds + 65536 + r1 * 256 + ((ch ^ ((r1 & 7) << 1)) << 4) + 8 * (pp & 1)));
            bf16x8 vf; vf[0] = lo[0]; vf[1] = lo[1]; vf[2] = lo[2]; vf[3] = lo[3]; vf[4] = hi[0]; vf[5] = hi[1]; vf[6] = hi[2]; vf[7] = hi[3];
            o[dt] = mfma16(vf, pa[k2], o[dt]); } }
    const float il = 1.0f / l;
    int t2, slot2; bool valid2 = true;
    if (causal) { t2 = j * BS + g * 128 + w * 16 + fr; slot2 = 0; }
    else { int rr = g * 128 + w * 16 + fr; valid2 = rr < n; if (!valid2) rr = n - 1; rr = rr < 0 ? 0 : rr; const int e = (int)glist[rr]; t2 = (e >> 2) & (T - 1); slot2 = e & 3; if (slot2 == 0) valid2 = false; }
    if (valid2) { bf16* po = (bf16*)(ws + WS_PO) + ((size_t)(t2 * NH + h) * 4 + slot2) * HD + 4 * fq;
#pragma unroll
        for (int dt = 0; dt < 8; ++dt) { v2u wv; wv.x = pk2(o[dt][0] * il, o[dt][1] * il); wv.y = pk2(o[dt][2] * il, o[dt][3] * il); *(v2u*)(po + 16 * dt) = wv; }
        if (fq == 0) ((float*)(ws + WS_PLSE))[((size_t)(t2 * NH + h) * 4 + slot2) * 32] = m * 0.08838834764831845f + __logf(l); }
    }
    __syncthreads();
}


constexpr size_t WS_GL = 16 * MiB;
constexpr int MB_RCH = 512;
__device__ __forceinline__ void moba_kv_item(unsigned char* ws, LAS unsigned char* lds, int h, int j, bool causal, const unsigned short* glist, int n, int tid) {
    const int lane = tid & 63, w = tid >> 6, fr = lane & 15, fq = lane >> 4;
    { const bf16* MK = (const bf16*)(ws + WS_MK) + (size_t)(j * BS) * HW + h * HD; const bf16* MV = (const bf16*)(ws + WS_MV) + (size_t)(j * BS) * HW + h * HD;
#pragma unroll
    for (int i = 0; i < 8; ++i) { const int p = i * NTHR + tid, row = p >> 4, ch = p & 15;
        const v4u kv = *(const v4u*)(MK + (size_t)row * HW + ch * 8), vv = *(const v4u*)(MV + (size_t)row * HW + ch * 8);
        *(LAS v4u*)(lds + row * 256 + ((ch ^ (row & 15)) << 4)) = kv; *(LAS v4u*)(lds + 65536 + row * 256 + ((ch ^ ((row & 7) << 1)) << 4)) = vv; } }
    const int ng = (n + 127) >> 7;
#define MKV_FETCH(G) do { int rr_ = (G) * 128 + w * 16 + fr; int ee_; \
        if (causal) ee_ = ((j * BS + rr_) << 2) | 0x8000; \
        else { const bool v_ = rr_ < n; if (!v_) rr_ = n - 1; rr_ = rr_ < 0 ? 0 : rr_; ee_ = (int)glist[rr_]; ee_ = (v_ && (ee_ & 3)) ? (ee_ | 0x8000) : (ee_ & 0x7fff); } \
        e_n = ee_; const bf16* qp_ = (const bf16*)(ws + WS_MQ) + (size_t)((ee_ >> 2) & (T - 1)) * HW + h * HD + fq * 8; \
        _Pragma("unroll") for (int ks_ = 0; ks_ < 4; ++ks_) qn[ks_] = *(const bf16x8*)(qp_ + ks_ * 32); } while (0)
    int e_n; bf16x8 qn[4];
    MKV_FETCH(0);
    __syncthreads();
    for (int g = 0; g < ng; ++g) {
        const int e = e_n; bf16x8 qa[4];
#pragma unroll
        for (int ks = 0; ks < 4; ++ks) qa[ks] = qn[ks];
        if (g + 1 < ng) MKV_FETCH(g + 1);
        const bool wact = causal || (__builtin_amdgcn_readfirstlane(g * 128 + w * 16) < n);
        if (wact) {
    const int qidx = g * 128 + w * 16 + fr;
    const int ntmax = causal ? (g * 128 + w * 16 + 15) >> 4 : 15;
    f32x4 acc[16];
#pragma unroll
    for (int nt = 0; nt < 16; ++nt) { acc[nt] = (f32x4){0.f, 0.f, 0.f, 0.f};
        if (nt <= ntmax) { const int row = 16 * nt + fr;
#pragma unroll
            for (int ks = 0; ks < 4; ++ks) { const bf16x8 kf = *(const LAS bf16x8*)(lds + row * 256 + (((4 * ks + fq) ^ fr) << 4)); acc[nt] = mfma16(kf, qa[ks], acc[nt]); }
            if (causal) {
#pragma unroll
                for (int r = 0; r < 4; ++r) if (16 * nt + 4 * fq + r > qidx) acc[nt][r] = -3.0e38f; }
        } else { acc[nt] = (f32x4){-3.0e38f, -3.0e38f, -3.0e38f, -3.0e38f}; } }
    float m = -3.0e38f;
#pragma unroll
    for (int nt = 0; nt < 16; ++nt) m = fmaxf(fmaxf(fmaxf(m, acc[nt][0]), fmaxf(acc[nt][1], acc[nt][2])), acc[nt][3]);
    m = fmaxf(m, __shfl_xor(m, 16)); m = fmaxf(m, __shfl_xor(m, 32));
    const float cexp = 0.08838834764831845f * 1.4426950408889634f; float l = 0.f;
    bf16x8 pa[8];
#pragma unroll
    for (int k2 = 0; k2 < 8; ++k2) { float p[8];
#pragma unroll
        for (int r = 0; r < 4; ++r) { p[r] = __builtin_amdgcn_exp2f((acc[2 * k2][r] - m) * cexp); p[4 + r] = __builtin_amdgcn_exp2f((acc[2 * k2 + 1][r] - m) * cexp); }
        l += ((p[0] + p[1]) + (p[2] + p[3])) + ((p[4] + p[5]) + (p[6] + p[7]));
        v4u pw; pw.x = pk2(p[0], p[1]); pw.y = pk2(p[2], p[3]); pw.z = pk2(p[4], p[5]); pw.w = pk2(p[6], p[7]); pa[k2] = __builtin_bit_cast(bf16x8, pw); }
    l += __shfl_xor(l, 16); l += __shfl_xor(l, 32);
    f32x4 o[8];
    const int gl = fr >> 2, pp = fr & 3;
#pragma unroll
    for (int dt = 0; dt < 8; ++dt) o[dt] = (f32x4){0.f, 0.f, 0.f, 0.f};
#pragma unroll
    for (int k2 = 0; k2 < 8; ++k2) { const int r0 = 32 * k2 + 4 * fq + gl, r1 = r0 + 16;
#pragma unroll
        for (int dt = 0; dt < 8; ++dt) { const int ch = 2 * dt + (pp >> 1);
            const v4i16_t lo = __builtin_amdgcn_ds_read_tr16_b64_v4i16((LAS v4i16_t*)(lds + 65536 + r0 * 256 + ((ch ^ ((r0 & 7) << 1)) << 4) + 8 * (pp & 1)));
            const v4i16_t hi = __builtin_amdgcn_ds_read_tr16_b64_v4i16((LAS v4i16_t*)(lds + 65536 + r1 * 256 + ((ch ^ ((r1 & 7) << 1)) << 4) + 8 * (pp & 1)));
            bf16x8 vf; vf[0] = lo[0]; vf[1] = lo[1]; vf[2] = lo[2]; vf[3] = lo[3]; vf[4] = hi[0]; vf[5] = hi[1]; vf[6] = hi[2]; vf[7] = hi[3];
            o[dt] = mfma16(vf, pa[k2], o[dt]); } }
    const float il = 1.0f / l;
    if (e & 0x8000) { const int t2 = (e >> 2) & (T - 1), slot2 = e & 3; bf16* po = (bf16*)(ws + WS_PO) + ((size_t)(t2 * NH + h) * 4 + slot2) * HD + 4 * fq;
#pragma unroll
        for (int dt = 0; dt < 8; ++dt) { v2u wv; wv.x = pk2(o[dt][0] * il, o[dt][1] * il); wv.y = pk2(o[dt][2] * il, o[dt][3] * il); *(v2u*)(po + 16 * dt) = wv; }
        if (fq == 0) ((float*)(ws + WS_PLSE))[(size_t)(t2 * NH + h) * 4 + slot2] = m * 0.08838834764831845f + __logf(l); }
        }
    }
#undef MKV_FETCH
    __syncthreads();
}
__device__ __forceinline__ void moba_gate_lists(unsigned char* ws, gu32* ctl, LAS unsigned char* lds, int h, int cur, int tid) {
    LAS float* km = (LAS float*)lds;
    LAS float* gs = (LAS float*)(lds + 17408);
    LAS unsigned short* lists = (LAS unsigned short*)(lds + 65536);
    LAS int* cnt = (LAS int*)(lds + 61440); LAS int* gbase = cnt + 32;
    unsigned sel = 0xFFFFFFu;
    if (tid < 32) cnt[tid] = 0;
    { const float* KM = (const float*)(ws + WS_KMEAN);
      for (int i = tid; i < NB * HD; i += NTHR) { const int j = i >> 7, d = i & 127; km[j * 132 + d] = (KM[(size_t)j * HW + h * HD + d] + KM[(size_t)(NB + j) * HW + h * HD + d]) * (1.f / BS); } }
    __syncthreads();
    {
        const int lane = tid & 63, w = tid >> 6, fr = lane & 15, fq = lane >> 4;
        f32x4 acc[2][2];
#pragma unroll
        for (int rt = 0; rt < 2; ++rt)
#pragma unroll
            for (int ct = 0; ct < 2; ++ct) acc[rt][ct] = (f32x4){0.f, 0.f, 0.f, 0.f};
        const bf16* qb = (const bf16*)(ws + WS_MQ) + (size_t)(cur * BS + 32 * w + fr) * HW + h * HD + 8 * fq;
#pragma unroll
        for (int J = 0; J < 4; ++J) {
            const v4u q0 = *(const v4u*)(qb + 32 * J), q1 = *(const v4u*)(qb + (size_t)16 * HW + 32 * J);
            const f32x4 k00 = *(const LAS f32x4*)(km + fr * 132 + 32 * J + 8 * fq), k01 = *(const LAS f32x4*)(km + fr * 132 + 32 * J + 8 * fq + 4);
            const f32x4 k10 = *(const LAS f32x4*)(km + (16 + fr) * 132 + 32 * J + 8 * fq), k11 = *(const LAS f32x4*)(km + (16 + fr) * 132 + 32 * J + 8 * fq + 4);
            const float a0[8] = {bflo(q0.x), bfhi(q0.x), bflo(q0.y), bfhi(q0.y), bflo(q0.z), bfhi(q0.z), bflo(q0.w), bfhi(q0.w)};
            const float a1[8] = {bflo(q1.x), bfhi(q1.x), bflo(q1.y), bfhi(q1.y), bflo(q1.z), bfhi(q1.z), bflo(q1.w), bfhi(q1.w)};
            const float b0[8] = {k00.x, k00.y, k00.z, k00.w, k01.x, k01.y, k01.z, k01.w};
            const float b1[8] = {k10.x, k10.y, k10.z, k10.w, k11.x, k11.y, k11.z, k11.w};
#pragma unroll
            for (int s8 = 0; s8 < 8; ++s8) {
                acc[0][0] = __builtin_amdgcn_mfma_f32_16x16x4f32(a0[s8], b0[s8], acc[0][0], 0, 0, 0); acc[0][1] = __builtin_amdgcn_mfma_f32_16x16x4f32(a0[s8], b1[s8], acc[0][1], 0, 0, 0);
                acc[1][0] = __builtin_amdgcn_mfma_f32_16x16x4f32(a1[s8], b0[s8], acc[1][0], 0, 0, 0); acc[1][1] = __builtin_amdgcn_mfma_f32_16x16x4f32(a1[s8], b1[s8], acc[1][1], 0, 0, 0); } }
#pragma unroll
        for (int rt = 0; rt < 2; ++rt)
#pragma unroll
            for (int ct = 0; ct < 2; ++ct)
#pragma unroll
                for (int i = 0; i < 4; ++i) gs[(32 * w + 16 * rt + 4 * fq + i) * 33 + 16 * ct + fr] = acc[rt][ct][i];
    }
    __syncthreads();
    if (tid < 256) {
        const int t = cur * BS + tid;
        float g[32];
#pragma unroll
        for (int j = 0; j < 32; ++j) g[j] = (j < cur) ? gs[tid * 33 + j] : -3.0e38f;
#pragma unroll
        for (int r = 0; r < 3; ++r) {
            float best = g[0]; int bi = 0;
#pragma unroll
            for (int j = 1; j < 32; ++j) if (g[j] > best) { best = g[j]; bi = j; }
#pragma unroll
            for (int j = 0; j < 32; ++j) if (j == bi) g[j] = -3.0e38f;
            if (r < cur) sel = (sel & ~(0xFFu << (8 * r))) | ((unsigned)bi << (8 * r));
        }
#pragma unroll
        for (int r = 0; r < 3; ++r) { const int b = (int)((sel >> (8 * r)) & 255u);
            if (b < 32) { const int pos = (int)__hip_atomic_fetch_add((LAS unsigned*)(cnt + b), 1u, __ATOMIC_RELAXED, __HIP_MEMORY_SCOPE_WORKGROUP); lists[b * 256 + (pos & 255)] = (unsigned short)((t << 2) | (r + 1)); } }
    }
    __syncthreads();
    if (tid < 32) gbase[tid] = (tid < cur && cnt[tid] > 0) ? (int)__hip_atomic_fetch_add((unsigned*)(ctl + CW_MCNT) + h * NB + tid, (unsigned)cnt[tid], RLX_AGENT) : 0;
    __syncthreads();
    { unsigned short* GL = (unsigned short*)(ws + WS_GL);
      for (int i = tid; i < NB * 256; i += NTHR) { const int j = i >> 8, q = i & 255; if (j < cur && q < cnt[j]) GL[(size_t)(h * NB + j) * 8192 + ((gbase[j] + q) & 8191)] = lists[i]; } }
    __syncthreads();
}
#ifndef MBRT
#define MBRT 31
#endif
#ifndef MB_STAGE
#define MB_STAGE 3
#endif
__device__ __forceinline__ void moba_block_item(unsigned char* ws, LAS unsigned char* lds, int h, int cur, int jlo, int jhi, int flags, int tid) {
    unsigned sel = 0xFFFFFFu;
    if (jhi > jlo) {
        LAS float* km = (LAS float*)lds;
        { const float* KM = (const float*)(ws + WS_KMEAN);
          for (int i = tid; i < NB * HD; i += NTHR) { const int j = i >> 7, d = i & 127; km[i] = (KM[(size_t)j * HW + h * HD + d] + KM[(size_t)(NB + j) * HW + h * HD + d]) * (1.f / BS); } }
        __syncthreads();
        if (tid < 256) {
            const int t = cur * BS + tid;
            const v4u* qp = (const v4u*)((const bf16*)(ws + WS_MQ) + (size_t)t * HW + h * HD);
            float g[32];
#pragma unroll
            for (int j = 0; j < 32; ++j) g[j] = 0.f;
            for (int dc = 0; dc < 16; ++dc) { const v4u qw = qp[dc]; const float q0 = bflo(qw.x), q1 = bfhi(qw.x), q2 = bflo(qw.y), q3 = bfhi(qw.y), q4 = bflo(qw.z), q5 = bfhi(qw.z), q6 = bflo(qw.w), q7 = bfhi(qw.w);
#pragma unroll
                for (int j = 0; j < 32; ++j) if (j < cur) { const f32x4 k0 = *(const LAS f32x4*)(km + j * 128 + dc * 8), k1 = *(const LAS f32x4*)(km + j * 128 + dc * 8 + 4);
                    g[j] += (q0 * k0.x + q1 * k0.y + q2 * k0.z + q3 * k0.w) + (q4 * k1.x + q5 * k1.y + q6 * k1.z + q7 * k1.w); } }
#pragma unroll
            for (int j = 0; j < 32; ++j) if (j >= cur) g[j] = -3.0e38f;
#pragma unroll
            for (int r = 0; r < 3; ++r) {
                float best = g[0]; int bi = 0;
#pragma unroll
                for (int j = 1; j < 32; ++j) if (g[j] > best) { best = g[j]; bi = j; }
#pragma unroll
                for (int j = 0; j < 32; ++j) if (j == bi) g[j] = -3.0e38f;
                if (r < cur) sel = (sel & ~(0xFFu << (8 * r))) | ((unsigned)bi << (8 * r));
            }
        }
        __syncthreads();
    }
    LAS int* lc = (LAS int*)(lds + LDSCTL_OFF + 1024); LAS int* lst = lc + 4;
    for (int jj = (flags & 1) ? -2 : jlo; jj < jhi; jj = (jj == -1) ? jlo : jj + 1) {
        const bool causal = jj < 0; const int j = causal ? cur : jj; int n = 256;
        if (!causal) {
            if (tid == 0) *lc = 0;
            __syncthreads();
            if (tid < 256) { const int slot = ((int)(sel & 255u) == j) ? 1 : ((int)((sel >> 8) & 255u) == j) ? 2 : ((int)((sel >> 16) & 255u) == j) ? 3 : 0;
                if (slot) { const int pos = (int)__hip_atomic_fetch_add((LAS unsigned*)lc, 1u, __ATOMIC_RELAXED, __HIP_MEMORY_SCOPE_WORKGROUP); lst[pos] = (tid << 2) | slot; } }
            __syncthreads();
            n = *lc;
        }
        const int g0 = causal ? jj + 2 : 0, g1 = causal ? g0 + 1 : (n + 127) >> 7;
        for (int g = g0; g < g1; ++g) moba_unit(ws, lds, h, j, cur, causal, g, n, lst, tid);
        __syncthreads();
    }
    asm volatile("s_waitcnt vmcnt(0)" ::: "memory"); __syncthreads();
    if (flags & 2) { const bf16* PO = (const bf16*)(ws + WS_PO); const float* PL = (const float*)(ws + WS_PLSE); bf16* AUP = (bf16*)(ws + WS_AUP); const int nv = cur < 3 ? cur : 3;
      for (int idx = tid; idx < BS * 16; idx += NTHR) { const int t = cur * BS + (idx >> 4), dq = idx & 15, th = t * NH + h;
          const float* plp = PL + (size_t)th * 128; float ls[4]; ls[0] = plp[0]; ls[1] = nv > 0 ? plp[32] : 0.f; ls[2] = nv > 1 ? plp[64] : 0.f; ls[3] = nv > 2 ? plp[96] : 0.f;
          float M = ls[0]; if (nv > 0) M = fmaxf(M, ls[1]); if (nv > 1) M = fmaxf(M, ls[2]); if (nv > 2) M = fmaxf(M, ls[3]);
          float wv[4]; wv[0] = __expf(ls[0] - M); wv[1] = nv > 0 ? __expf(ls[1] - M) : 0.f; wv[2] = nv > 1 ? __expf(ls[2] - M) : 0.f; wv[3] = nv > 2 ? __expf(ls[3] - M) : 0.f;
          const float inv = 1.0f / ((wv[0] + wv[1]) + (wv[2] + wv[3]));
          float acc[8] = {0.f, 0.f, 0.f, 0.f, 0.f, 0.f, 0.f, 0.f};
#pragma unroll
          for (int i = 0; i < 4; ++i) if (i <= nv) { const v4u pw = *(const v4u*)(PO + ((size_t)th * 4 + i) * HD + dq * 8); const float wi = wv[i] * inv;
              acc[0] += wi * bflo(pw.x); acc[1] += wi * bfhi(pw.x); acc[2] += wi * bflo(pw.y); acc[3] += wi * bfhi(pw.y); acc[4] += wi * bflo(pw.z); acc[5] += wi * bfhi(pw.z); acc[6] += wi * bflo(pw.w); acc[7] += wi * bfhi(pw.w); }
          v4u ov; ov.x = pk2(acc[0], acc[1]); ov.y = pk2(acc[2], acc[3]); ov.z = pk2(acc[4], acc[5]); ov.w = pk2(acc[6], acc[7]);
          *(v4u*)(AUP + (size_t)t * D + HW + h * HD + dq * 8) = ov; } }
    __syncthreads();
}

namespace pg8 {
#define PG8_LAS __attribute__((address_space(3)))
typedef unsigned short bf16_t;
typedef unsigned u32x4 __attribute__((ext_vector_type(4)));
constexpr int BM = 256, BK = 64, HALF = 128, HTB = HALF * BK * 2, STAGE_BYTES = 8 * HTB, NXCD = 8, WGM = 8;
__host__ __device__ __forceinline__ int lds_byte(int r, int c) { const int st = (r >> 4) * 2 + (c >> 5), rr = r & 15, cc = c & 31, ob = rr * 64 + cc * 2; return st * 1024 + (ob ^ (((ob >> 9) & 1) << 5)); }
__host__ __device__ __forceinline__ void stage_rc(int b, int& R, int& C) { const int st = b / 1024, sb = b % 1024, swz = sb ^ (((sb >> 9) & 1) << 5); R = (st >> 1) * 16 + swz / 64; C = (st & 1) * 32 + (swz % 64) / 2; }
__host__ __device__ __forceinline__ int perm32(int rho) { const int n = rho >> 4, i = rho & 15; return 8 * (i >> 2) + 4 * n + (i & 3); }
struct Unit { int pm, pn; };
struct Gemm { const bf16_t* A; const bf16_t* Bt; int lda, ldb, K; };
struct StaticOrder {
    int nM, nN, nwg, G, c;
    __host__ __device__ void init(int M, int N, int G_, int c_) { nM = M / BM; nN = N / BM; nwg = nM * nN; G = G_; c = c_; }
    __host__ __device__ bool next(int i, Unit& u) const {
        const long L = (long)i * G + c; if (L >= nwg) return false;
        int wgid = (int)L; { const int q = nwg / NXCD, r = nwg % NXCD, xcd = wgid % NXCD, off = wgid / NXCD; wgid = (xcd < r ? xcd * (q + 1) : r * (q + 1) + (xcd - r) * q) + off; }
        const int nig = WGM * nN, gid = wgid / nig, fm = gid * WGM, gsz = (nM - fm) < WGM ? (nM - fm) : WGM;
        u.pm = fm + ((wgid % nig) % gsz); u.pn = (wgid % nig) / gsz; return true;
    }
    __device__ __forceinline__ void a_ready(const Unit&) const {}
    __device__ __forceinline__ void done(const Unit&) const {}
};
struct MoeOrder {
    const PG8_LAS int* pstart; int npn, G, c;
    __device__ bool next(int i, Unit& u) const {
        const int L = i * G + c, ntile = pstart[32] >> 8; if (L >= ntile * npn) return false;
        const int tile = L / npn, pnl = L % npn; int e = 0;
        for (int q = 1; q < 32; ++q) if (pstart[q] <= tile * 256) e = q;
        u.pm = tile; u.pn = e * npn + pnl; return true;
    }
    __device__ __forceinline__ void a_ready(const Unit&) const {}
    __device__ __forceinline__ void done(const Unit&) const {}
};
__device__ __forceinline__ unsigned cvt_pk_bf16(float lo, float hi) { unsigned r; asm volatile("v_cvt_pk_bf16_f32 %0, %1, %2" : "=v"(r) : "v"(lo), "v"(hi)); return r; }
__device__ __forceinline__ u32x4 pack8(const f32x4& a, const f32x4& b) { u32x4 w; w.x = cvt_pk_bf16(a[0], a[1]); w.y = cvt_pk_bf16(a[2], a[3]); w.z = cvt_pk_bf16(b[0], b[1]); w.w = cvt_pk_bf16(b[2], b[3]); return w; }
__device__ __forceinline__ float bl(unsigned w) { return __builtin_bit_cast(float, w << 16); }
__device__ __forceinline__ float bh(unsigned w) { return __builtin_bit_cast(float, w & 0xffff0000u); }
__device__ __forceinline__ f32x4 sig4(const f32x4& v) { f32x4 o; for (int i = 0; i < 4; ++i) o[i] = __builtin_amdgcn_rcpf(1.0f + __expf(-v[i])); return o; }
__device__ __forceinline__ f32x4 silu4(const f32x4& v) { f32x4 o; for (int i = 0; i < 4; ++i) o[i] = v[i] * __builtin_amdgcn_rcpf(1.0f + __expf(-v[i])); return o; }

struct EpiInProj {
    static constexpr bool PERM = true, AFTER_DRAIN = false, HAS_MID = false;
    unsigned char* ws;
    __device__ __forceinline__ void mid(f32x4 (&)[2][2][4][2], const Unit&, int, int, int, int) const {}
    __device__ __forceinline__ void operator()(const f32x4 (&acc)[2][2][4][2], const Unit& u, int wr, int wc, int fr, int fq) const {
        const int pn = u.pn, row0 = u.pm * BM + wr * 64 + fr, cl = wc * 32 + 8 * fq;
        if (pn >= 16 && pn < 24) {
            const int which = (pn - 16) >> 2, head = 2 * ((pn - 16) & 3) + (wc >> 1), d = (wc & 1) * 32 + 8 * fq;
            bf16_t* dst = (bf16_t*)(ws + (which ? WS_MK : WS_MQ)) + head * HD + d;
            const f32x2* trig = (const f32x2*)(ws + WS_TRIG) + d;
            float cs[16];
#pragma unroll
            for (int i = 0; i < 16; ++i) cs[i] = 0.f;
#pragma unroll
            for (int ai = 0; ai < 2; ++ai)
#pragma unroll
                for (int mp = 0; mp < 2; ++mp) {
                    f32x4 tg[2][4];
#pragma unroll
                    for (int mm = 0; mm < 2; ++mm) { const f32x4* tp = (const f32x4*)(trig + (size_t)(row0 + ai * HALF + (2 * mp + mm) * 16) * 64);
#pragma unroll
                        for (int q = 0; q < 4; ++q) tg[mm][q] = tp[q]; }
#pragma unroll
                    for (int mm = 0; mm < 2; ++mm) { const int m = 2 * mp + mm, row = row0 + ai * HALF + m * 16;
                    u32x4 wl, wh;
                    { const f32x4 t0 = tg[mm][0], t1 = tg[mm][1]; const f32x4 x1a = acc[ai][0][m][0], x2a = acc[ai][1][m][0]; f32x4 la, ha;
                      la[0] = x1a[0] * t0[0] - x2a[0] * t0[1]; ha[0] = x2a[0] * t0[0] + x1a[0] * t0[1];
                      la[1] = x1a[1] * t0[2] - x2a[1] * t0[3]; ha[1] = x2a[1] * t0[2] + x1a[1] * t0[3];
                      la[2] = x1a[2] * t1[0] - x2a[2] * t1[1]; ha[2] = x2a[2] * t1[0] + x1a[2] * t1[1];
                      la[3] = x1a[3] * t1[2] - x2a[3] * t1[3]; ha[3] = x2a[3] * t1[2] + x1a[3] * t1[3];
                      wl.x = cvt_pk_bf16(la[0], la[1]); wl.y = cvt_pk_bf16(la[2], la[3]); wh.x = cvt_pk_bf16(ha[0], ha[1]); wh.y = cvt_pk_bf16(ha[2], ha[3]);
                      if (which) {
#pragma unroll
                          for (int i = 0; i < 4; ++i) { cs[i] += la[i]; cs[8 + i] += ha[i]; } } }
                    { const f32x4 t2 = tg[mm][2], t3 = tg[mm][3]; const f32x4 x1b = acc[ai][0][m][1], x2b = acc[ai][1][m][1]; f32x4 lb_, hb;
                      lb_[0] = x1b[0] * t2[0] - x2b[0] * t2[1]; hb[0] = x2b[0] * t2[0] + x1b[0] * t2[1];
                      lb_[1] = x1b[1] * t2[2] - x2b[1] * t2[3]; hb[1] = x2b[1] * t2[2] + x1b[1] * t2[3];
                      lb_[2] = x1b[2] * t3[0] - x2b[2] * t3[1]; hb[2] = x2b[2] * t3[0] + x1b[2] * t3[1];
                      lb_[3] = x1b[3] * t3[2] - x2b[3] * t3[3]; hb[3] = x2b[3] * t3[2] + x1b[3] * t3[3];
                      wl.z = cvt_pk_bf16(lb_[0], lb_[1]); wl.w = cvt_pk_bf16(lb_[2], lb_[3]); wh.z = cvt_pk_bf16(hb[0], hb[1]); wh.w = cvt_pk_bf16(hb[2], hb[3]);
                      if (which) {
#pragma unroll
                          for (int i = 0; i < 4; ++i) { cs[4 + i] += lb_[i]; cs[12 + i] += hb[i]; } } }
                    *(u32x4*)(dst + (size_t)row * HW) = wl; *(u32x4*)(dst + (size_t)row * HW + 64) = wh; }
                    asm volatile("" ::: "memory"); }
            if (which) {
                float* ks = (float*)(ws + WS_KMEAN) + (size_t)(wr * NB + u.pm) * HW + head * HD + d;
#pragma unroll
                for (int i = 0; i < 16; ++i) { float v = cs[i]; v += __shfl_xor(v, 1); v += __shfl_xor(v, 2); v += __shfl_xor(v, 4); v += __shfl_xor(v, 8);
                    if (fr == 0) ks[(i & 7) + 64 * (i >> 3)] = v; }
            }
            return;
        }
        int kind, ld; size_t base; int colb;
        if (pn < 4) { kind = 1; base = WS_QH; ld = HW; colb = pn * 256; }
        else if (pn < 8) { kind = 3; base = WS_GH; ld = HW; colb = (pn - 4) * 256; }
        else if (pn < 12) { kind = 0; base = WS_VH; ld = HW; colb = (pn - 8) * 256; }
        else if (pn < 16) { kind = 1; base = WS_OG; ld = HW; colb = (pn - 12) * 256; }
        else if (pn < 28) { kind = 0; base = WS_MV; ld = HW; colb = (pn - 24) * 256; }
        else if (pn < 36) { kind = 2; base = WS_GA; ld = D; colb = (pn - 28) * 256; }
        else { kind = 2; base = WS_GB; ld = D; colb = (pn - 36) * 256; }
        if (kind == 3) {
            const float* lbp = (const float*)(ws + WS_LB) + colb + cl; float* dst = (float*)(ws + base) + colb + cl;
#pragma unroll
            for (int bj = 0; bj < 2; ++bj) { const f32x4 l0 = *(const f32x4*)(lbp + bj * HALF), l1 = *(const f32x4*)(lbp + bj * HALF + 4);
#pragma unroll
                for (int ai = 0; ai < 2; ++ai)
#pragma unroll
                    for (int m = 0; m < 4; ++m) { const int row = row0 + ai * HALF + m * 16; const f32x4 s0 = sig4(acc[ai][bj][m][0]), s1 = sig4(acc[ai][bj][m][1]); f32x4 o0, o1;
#pragma unroll
                        for (int i = 0; i < 4; ++i) { o0[i] = __logf(l0[i] + (1.f - l0[i]) * s0[i]); o1[i] = __logf(l1[i] + (1.f - l1[i]) * s1[i]); }
                        float* p = dst + (size_t)row * ld + bj * HALF; *(f32x4*)p = o0; *(f32x4*)(p + 4) = o1; } }
            return;
        }
        bf16_t* dst = (bf16_t*)(ws + base) + colb + cl;
#pragma unroll
        for (int ai = 0; ai < 2; ++ai)
#pragma unroll
            for (int m = 0; m < 4; ++m) { const int row = row0 + ai * HALF + m * 16;
#pragma unroll
                for (int bj = 0; bj < 2; ++bj) { f32x4 v0 = acc[ai][bj][m][0], v1 = acc[ai][bj][m][1];
                    if (kind == 1) { v0 = silu4(v0); v1 = silu4(v1); } else if (kind == 2) { v0 = sig4(v0); v1 = sig4(v1); }
                    *(u32x4*)(dst + (size_t)row * ld + bj * HALF) = pack8(v0, v1); } }
    }
};
struct EpiBf16Plain {
    static constexpr bool PERM = true, AFTER_DRAIN = false, HAS_MID = false;
    bf16_t* O; int ld;
    __device__ __forceinline__ void mid(f32x4 (&)[2][2][4][2], const Unit&, int, int, int, int) const {}
    __device__ __forceinline__ void operator()(const f32x4 (&acc)[2][2][4][2], const Unit& u, int wr, int wc, int fr, int fq) const {
        const int row0 = u.pm * BM + wr * 64 + fr, col0 = u.pn * BM + wc * 32 + 8 * fq;
#pragma unroll
        for (int ai = 0; ai < 2; ++ai)
#pragma unroll
            for (int m = 0; m < 4; ++m)
#pragma unroll
                for (int bj = 0; bj < 2; ++bj) *(u32x4*)(O + (size_t)(row0 + ai * HALF + m * 16) * ld + col0 + bj * HALF) = pack8(acc[ai][bj][m][0], acc[ai][bj][m][1]);
    }
};
template <int PASS> struct EpiUp {
    static constexpr bool PERM = true, AFTER_DRAIN = false, HAS_MID = false;
    const bf16_t* GT; bf16_t* O;
    __device__ __forceinline__ void mid(f32x4 (&)[2][2][4][2], const Unit&, int, int, int, int) const {}
    __device__ __forceinline__ void operator()(const f32x4 (&acc)[2][2][4][2], const Unit& u, int wr, int wc, int fr, int fq) const {
        const int row0 = u.pm * BM + wr * 64 + fr, col0 = u.pn * BM + wc * 32 + 8 * fq;
#pragma unroll
        for (int ai = 0; ai < 2; ++ai)
#pragma unroll
            for (int m = 0; m < 4; ++m) {
#pragma unroll
                for (int bj = 0; bj < 2; ++bj) { const size_t off = (size_t)(row0 + ai * HALF + m * 16) * D + col0 + bj * HALF; const u32x4 b = *(const u32x4*)(GT + off);
                    f32x4 v0 = acc[ai][bj][m][0], v1 = acc[ai][bj][m][1];
                    v0[0] *= bl(b.x); v0[1] *= bh(b.x); v0[2] *= bl(b.y); v0[3] *= bh(b.y); v1[0] *= bl(b.z); v1[1] *= bh(b.z); v1[2] *= bl(b.w); v1[3] *= bh(b.w);
                    if (PASS == 1) { const u32x4 p = *(const u32x4*)(O + off);
                        v0[0] += bl(p.x); v0[1] += bh(p.x); v0[2] += bl(p.y); v0[3] += bh(p.y); v1[0] += bl(p.z); v1[1] += bh(p.z); v1[2] += bl(p.w); v1[3] += bh(p.w); }
                    *(u32x4*)(O + off) = pack8(v0, v1); }
                asm volatile("" ::: "memory"); }
    }
};
struct EpiUp2 {
    static constexpr bool PERM = true, AFTER_DRAIN = false, HAS_MID = true;
    const bf16_t* GA; const bf16_t* GB; bf16_t* O;
    __device__ __forceinline__ void mid(f32x4 (&acc)[2][2][4][2], const Unit& u, int wr, int wc, int fr_, int fq_) const {
        int fr = fr_, fq = fq_; asm volatile("" : "+v"(fr), "+v"(fq));
        const int row0 = u.pm * BM + wr * 64 + fr, col0 = u.pn * BM + wc * 32 + 8 * fq;
#pragma unroll
        for (int ai = 0; ai < 2; ++ai) {
#pragma unroll
            for (int m = 0; m < 4; ++m) {
#pragma unroll
                for (int bj = 0; bj < 2; ++bj) { const size_t off = (size_t)(row0 + ai * HALF + m * 16) * D + col0 + bj * HALF; const u32x4 a = *(const u32x4*)(GA + off), b = *(const u32x4*)(GB + off);
                    const float lo = 8.673617379884035e-19f;
                    acc[ai][bj][m][0][0] *= bl(a.x) * __builtin_amdgcn_rcpf(fmaxf(bl(b.x), lo)); acc[ai][bj][m][0][1] *= bh(a.x) * __builtin_amdgcn_rcpf(fmaxf(bh(b.x), lo));
                    acc[ai][bj][m][0][2] *= bl(a.y) * __builtin_amdgcn_rcpf(fmaxf(bl(b.y), lo)); acc[ai][bj][m][0][3] *= bh(a.y) * __builtin_amdgcn_rcpf(fmaxf(bh(b.y), lo));
                    acc[ai][bj][m][1][0] *= bl(a.z) * __builtin_amdgcn_rcpf(fmaxf(bl(b.z), lo)); acc[ai][bj][m][1][1] *= bh(a.z) * __builtin_amdgcn_rcpf(fmaxf(bh(b.z), lo));
                    acc[ai][bj][m][1][2] *= bl(a.w) * __builtin_amdgcn_rcpf(fmaxf(bl(b.w), lo)); acc[ai][bj][m][1][3] *= bh(a.w) * __builtin_amdgcn_rcpf(fmaxf(bh(b.w), lo)); }
                asm volatile("" ::: "memory"); } }
    }
    __device__ __forceinline__ void operator()(const f32x4 (&acc)[2][2][4][2], const Unit& u, int wr, int wc, int fr, int fq) const {
        const int row0 = u.pm * BM + wr * 64 + fr, col0 = u.pn * BM + wc * 32 + 8 * fq;
        const float lo = 8.673617379884035e-19f;
#pragma unroll
        for (int ai = 0; ai < 2; ++ai) {
            u32x4 gb[4][2];
#pragma unroll
            for (int m = 0; m < 4; ++m)
#pragma unroll
                for (int bj = 0; bj < 2; ++bj) gb[m][bj] = *(const u32x4*)(GB + (size_t)(row0 + ai * HALF + m * 16) * D + col0 + bj * HALF);
#pragma unroll
            for (int m = 0; m < 4; ++m)
#pragma unroll
                for (int bj = 0; bj < 2; ++bj) { const size_t off = (size_t)(row0 + ai * HALF + m * 16) * D + col0 + bj * HALF; const u32x4 b = gb[m][bj];
                    f32x4 v0 = acc[ai][bj][m][0], v1 = acc[ai][bj][m][1];
                    v0[0] *= fmaxf(bl(b.x), lo); v0[1] *= fmaxf(bh(b.x), lo); v0[2] *= fmaxf(bl(b.y), lo); v0[3] *= fmaxf(bh(b.y), lo); v1[0] *= fmaxf(bl(b.z), lo); v1[1] *= fmaxf(bh(b.z), lo); v1[2] *= fmaxf(bl(b.w), lo); v1[3] *= fmaxf(bh(b.w), lo);
                    *(u32x4*)(O + off) = pack8(v0, v1); }
            asm volatile("" ::: "memory"); }
    }
};
template <int MODE  > struct EpiResid {
    static constexpr bool PERM = false, AFTER_DRAIN = false, HAS_MID = false;
    static constexpr int RG = (MODE == 0) ? 4 : 2;
    const float* base; float* out; const bf16_t* PP;
    __device__ __forceinline__ void mid(f32x4 (&)[2][2][4][2], const Unit&, int, int, int, int) const {}
    __device__ __forceinline__ void operator()(const f32x4 (&acc)[2][2][4][2], const Unit& u, int wr, int wc, int fr, int fq) const {
        const int row0 = u.pm * BM + wr * 64 + fr, col0 = u.pn * BM + wc * 32 + 4 * fq;
#pragma unroll
        for (int ai = 0; ai < 2; ++ai)
#pragma unroll
            for (int mp = 0; mp < 4 / RG; ++mp) {
                f32x4 bs[RG][2][2]; v2u pw[RG][2][2];
#pragma unroll
                for (int mm = 0; mm < RG; ++mm)
#pragma unroll
                    for (int bj = 0; bj < 2; ++bj)
#pragma unroll
                        for (int n = 0; n < 2; ++n) { const size_t off = (size_t)(row0 + ai * HALF + (RG * mp + mm) * 16) * D + col0 + bj * HALF + n * 16; bs[mm][bj][n] = *(const f32x4*)(base + off);
                            if (MODE == 1) pw[mm][bj][n] = *(const v2u*)(PP + off); }
#pragma unroll
                for (int mm = 0; mm < RG; ++mm)
#pragma unroll
                    for (int bj = 0; bj < 2; ++bj)
#pragma unroll
                        for (int n = 0; n < 2; ++n) { const size_t off = (size_t)(row0 + ai * HALF + (RG * mp + mm) * 16) * D + col0 + bj * HALF + n * 16; f32x4 v = acc[ai][bj][RG * mp + mm][n];
                            if (MODE == 1) { const unsigned p0 = pw[mm][bj][n].x, p1 = pw[mm][bj][n].y; v = sig4(v); v[0] *= bl(p0); v[1] *= bh(p0); v[2] *= bl(p1); v[3] *= bh(p1); }
                            *(f32x4*)(out + off) = bs[mm][bj][n] + v; }
                asm volatile("" ::: "memory"); }
    }
};
template <int MODE  > struct EpiResidB {
    static constexpr bool PERM = true, AFTER_DRAIN = false, HAS_MID = false;
    const float* basef; bf16_t* XR; const bf16_t* PP;
    __device__ __forceinline__ void mid(f32x4 (&)[2][2][4][2], const Unit&, int, int, int, int) const {}
    __device__ __forceinline__ void operator()(const f32x4 (&acc)[2][2][4][2], const Unit& u, int wr, int wc, int fr, int fq) const {
        const int row0 = u.pm * BM + wr * 64 + fr, col0 = u.pn * BM + wc * 32 + 8 * fq;
#pragma unroll
        for (int ai = 0; ai < 2; ++ai) {
            if (MODE == 0) {
                f32x4 b0[4][2], b1[4][2];
#pragma unroll
                for (int m = 0; m < 4; ++m)
#pragma unroll
                    for (int bj = 0; bj < 2; ++bj) { const float* p = basef + (size_t)(row0 + ai * HALF + m * 16) * D + col0 + bj * HALF; b0[m][bj] = *(const f32x4*)p; b1[m][bj] = *(const f32x4*)(p + 4); }
#pragma unroll
                for (int m = 0; m < 4; ++m)
#pragma unroll
                    for (int bj = 0; bj < 2; ++bj) *(u32x4*)(XR + (size_t)(row0 + ai * HALF + m * 16) * D + col0 + bj * HALF) = pack8(b0[m][bj] + acc[ai][bj][m][0], b1[m][bj] + acc[ai][bj][m][1]);
            } else {
                u32x4 xb[4][2], pb[4][2];
#pragma unroll
                for (int m = 0; m < 4; ++m)
#pragma unroll
                    for (int bj = 0; bj < 2; ++bj) { const size_t off = (size_t)(row0 + ai * HALF + m * 16) * D + col0 + bj * HALF; xb[m][bj] = *(const u32x4*)(XR + off); pb[m][bj] = *(const u32x4*)(PP + off); }
#pragma unroll
                for (int m = 0; m < 4; ++m)
#pragma unroll
                    for (int bj = 0; bj < 2; ++bj) { const u32x4 xv = xb[m][bj], pv = pb[m][bj]; f32x4 v0 = sig4(acc[ai][bj][m][0]), v1 = sig4(acc[ai][bj][m][1]);
                        v0[0] = bl(xv.x) + v0[0] * bl(pv.x); v0[1] = bh(xv.x) + v0[1] * bh(pv.x); v0[2] = bl(xv.y) + v0[2] * bl(pv.y); v0[3] = bh(xv.y) + v0[3] * bh(pv.y);
                        v1[0] = bl(xv.z) + v1[0] * bl(pv.z); v1[1] = bh(xv.z) + v1[1] * bh(pv.z); v1[2] = bl(xv.w) + v1[2] * bl(pv.w); v1[3] = bh(xv.w) + v1[3] * bh(pv.w);
                        *(u32x4*)(XR + (size_t)(row0 + ai * HALF + m * 16) * D + col0 + bj * HALF) = pack8(v0, v1); }
            }
            asm volatile("" ::: "memory"); }
    }
};
struct EpiMoe1 {
    static constexpr bool PERM = true, AFTER_DRAIN = false, HAS_MID = false;
    bf16_t* H;
    __device__ __forceinline__ void mid(f32x4 (&)[2][2][4][2], const Unit&, int, int, int, int) const {}
    __device__ __forceinline__ void operator()(const f32x4 (&acc)[2][2][4][2], const Unit& u, int wr, int wc, int fr, int fq) const {
        const int row0 = u.pm * BM + wr * 64 + fr, col0 = (u.pn & 3) * 128 + wc * 32 + 8 * fq;
#pragma unroll
        for (int ai = 0; ai < 2; ++ai)
#pragma unroll
            for (int m = 0; m < 4; ++m) { const f32x4 g0 = silu4(acc[ai][0][m][0]), g1 = silu4(acc[ai][0][m][1]);
                *(u32x4*)(H + (size_t)(row0 + ai * HALF + m * 16) * DE + col0) = pack8(g0 * acc[ai][1][m][0], g1 * acc[ai][1][m][1]); }
    }
};
struct EpiMoe2 {
    static constexpr bool PERM = true, AFTER_DRAIN = false, HAS_MID = false;
    bf16_t* Y; const int* rowslot; const PG8_LAS int* pstart;
    __device__ __forceinline__ void mid(f32x4 (&)[2][2][4][2], const Unit&, int, int, int, int) const {}
    __device__ __forceinline__ void operator()(const f32x4 (&acc)[2][2][4][2], const Unit& u, int wr, int wc, int fr, int fq) const {
        const int row0 = u.pm * BM + wr * 64 + fr, col0 = (u.pn & 7) * 256 + wc * 32 + 8 * fq;
        const int e = u.pn >> 3, ps = pstart[e], pc = pstart[40 + e];
        int slot[2][4];
#pragma unroll
        for (int ai = 0; ai < 2; ++ai)
#pragma unroll
            for (int m = 0; m < 4; ++m) { const int prow = row0 + ai * HALF + m * 16; slot[ai][m] = (prow - ps < pc) ? __hip_atomic_load((int*)rowslot + prow, RLX_AGENT) : -1; }
#pragma unroll
        for (int ai = 0; ai < 2; ++ai)
#pragma unroll
            for (int m = 0; m < 4; ++m) if (slot[ai][m] >= 0) {
#pragma unroll
                for (int bj = 0; bj < 2; ++bj) *(u32x4*)(Y + (size_t)slot[ai][m] * D + col0 + bj * HALF) = pack8(acc[ai][bj][m][0], acc[ai][bj][m][1]); }
    }
};

template <class Epi, class Sched, bool ALIGN_EPI = false, bool SP2 = false>
__device__ __forceinline__ void gemm_phase(PG8_LAS unsigned char* lds, const Gemm g, const Sched& S, const Epi& E) {
    const int tid = threadIdx.x, wid = __builtin_amdgcn_readfirstlane(tid >> 6), lane = tid & 63, wr = wid >> 2, wc = wid & 3, fr = lane & 15, fq = lane >> 4;
    const int K = g.K, nt = K / BK;
    unsigned voffA[2], voffB[2];
#pragma unroll
    for (int i = 0; i < 2; ++i) { int R, C; stage_rc(tid * 16 + i * 8192, R, C); const int Rb = Epi::PERM ? ((R & ~31) + perm32(R & 31)) : R;
        voffA[i] = (unsigned)(R * g.lda + C) * 2u; voffB[i] = (unsigned)(Rb * g.ldb + C) * 2u; }
    const size_t kstep = (size_t)(BK * 2);
    const size_t hstepA = (size_t)HALF * g.lda * 2, hstepB = (size_t)HALF * g.ldb * 2;
    const size_t tstepA = 2 * hstepA, tstepB = 2 * hstepB;
    const unsigned ldsw = (unsigned)wid * 1024u;
    const int aoff = lds_byte(wr * 64 + fr, fq * 8), boff = lds_byte(wc * 32 + fr, fq * 8);
#define PG8_SA(b, h) (((b) * 2 + (h)) * HTB)
#define PG8_SB(b, h) ((4 + (b) * 2 + (h)) * HTB)
#define PG8_STAGE(bufoff, gbase, voff) do { _Pragma("unroll") for (int _i = 0; _i < 2; ++_i) \
        __builtin_amdgcn_global_load_lds((const unsigned*)((const char*)(gbase) + (voff)[_i]), (PG8_LAS unsigned*)(lds + (bufoff) + ldsw + _i * 8192), 16, 0, 0); } while (0)
#define PG8_LDA(dst, b, h) do { _Pragma("unroll") for (int m = 0; m < 4; ++m) _Pragma("unroll") for (int k = 0; k < 2; ++k) dst[m][k] = *(const PG8_LAS bf16x8*)(lds + PG8_SA(b, h) + aoff + m * 2048 + k * 1024); } while (0)
#define PG8_LDB(dst, b, h) do { _Pragma("unroll") for (int n = 0; n < 2; ++n) _Pragma("unroll") for (int k = 0; k < 2; ++k) dst[n][k] = *(const PG8_LAS bf16x8*)(lds + PG8_SB(b, h) + boff + n * 2048 + k * 1024); } while (0)
#define PG8_MMA(ai, bj, At, Bt) do { __builtin_amdgcn_s_setprio(1); _Pragma("unroll") for (int m = 0; m < 4; ++m) _Pragma("unroll") for (int n = 0; n < 2; ++n) _Pragma("unroll") for (int k = 0; k < 2; ++k) \
        acc[ai][bj][m][n] = __builtin_amdgcn_mfma_f32_16x16x32_bf16(Bt[n][k], At[m][k], acc[ai][bj][m][n], 0, 0, 0); __builtin_amdgcn_s_setprio(0); } while (0)
#define PG8_WAIT_V(n) asm volatile("s_waitcnt vmcnt(" #n ")" ::: "memory")
#define PG8_WAIT_L(n) asm volatile("s_waitcnt lgkmcnt(" #n ")" ::: "memory")
#define PG8_BAR __builtin_amdgcn_s_barrier()
#define PG8_SCHED __builtin_amdgcn_sched_barrier(0)
    Unit cur, nxt; int ui = 0;
    if (!S.next(0, cur)) return;
    f32x4 acc[2][2][4][2];
#pragma unroll
    for (int a = 0; a < 2; ++a)
#pragma unroll
        for (int b = 0; b < 2; ++b)
#pragma unroll
            for (int m = 0; m < 4; ++m)
#pragma unroll
                for (int n = 0; n < 2; ++n) acc[a][b][m][n] = (f32x4){0.f, 0.f, 0.f, 0.f};
    bf16x8 At[4][2], B0[2][2], B1[2][2];
    const char* cA = (const char*)g.A + (size_t)cur.pm * tstepA; const char* cB = (const char*)g.Bt + (size_t)cur.pn * tstepB;
    S.a_ready(cur);
    if constexpr (SP2) {
        PG8_STAGE(PG8_SB(0, 0), cB, voffB); PG8_STAGE(PG8_SB(0, 1), cB + hstepB, voffB); PG8_STAGE(PG8_SA(0, 0), cA, voffA); PG8_STAGE(PG8_SA(0, 1), cA + hstepA, voffA);
        if (wr == 1) PG8_BAR;
        PG8_WAIT_V(2); PG8_BAR;
        PG8_STAGE(PG8_SB(1, 0), cB + kstep, voffB); PG8_STAGE(PG8_SA(1, 0), cA + kstep, voffA); PG8_STAGE(PG8_SB(1, 1), cB + hstepB + kstep, voffB);
        PG8_WAIT_V(6); PG8_BAR;
    } else {
        PG8_STAGE(PG8_SB(0, 0), cB, voffB); PG8_STAGE(PG8_SA(0, 0), cA, voffA); PG8_STAGE(PG8_SB(0, 1), cB + hstepB, voffB); PG8_STAGE(PG8_SA(0, 1), cA + hstepA, voffA);
        if (wr == 1) PG8_BAR;
        PG8_WAIT_V(4); PG8_BAR;
        PG8_STAGE(PG8_SB(1, 0), cB + kstep, voffB); PG8_STAGE(PG8_SA(1, 0), cA + kstep, voffA); PG8_STAGE(PG8_SB(1, 1), cB + hstepB + kstep, voffB);
        PG8_WAIT_V(6); PG8_BAR;
    }
    for (;;) {
        const bool has_next = S.next(ui + 1, nxt);
        const char* nA = has_next ? (const char*)g.A + (size_t)nxt.pm * tstepA : cA; const char* nB = has_next ? (const char*)g.Bt + (size_t)nxt.pn * tstepB : cB;
        for (int t = 0; t < nt; t += 2) {
            const bool last = (t == nt - 2);
            if constexpr (Epi::HAS_MID) { if (t == (nt >> 1)) E.mid(acc, cur, wr, wc, fr, fq); }
            const char* a1 = cA + (size_t)(t + 1) * kstep;
            const char* a2 = last ? nA : cA + (size_t)(t + 2) * kstep; const char* b2 = last ? nB : cB + (size_t)(t + 2) * kstep;
            const char* a3 = a2 + kstep; const char* b3 = b2 + kstep;
            if (last && has_next) S.a_ready(nxt);
            if constexpr (SP2) {
            PG8_LDB(B0, 0, 0); PG8_LDB(B1, 0, 1); PG8_SCHED; PG8_LDA(At, 0, 0); PG8_STAGE(PG8_SA(1, 1), a1 + hstepA, voffA);
            PG8_WAIT_V(8); PG8_WAIT_L(0); PG8_BAR; PG8_MMA(0, 0, At, B0); PG8_MMA(0, 1, At, B1); PG8_BAR; PG8_SCHED;
            PG8_LDA(At, 0, 1); PG8_STAGE(PG8_SB(0, 0), b2, voffB); PG8_STAGE(PG8_SB(0, 1), b2 + hstepB, voffB); PG8_STAGE(PG8_SA(0, 0), a2, voffA);
            PG8_WAIT_V(8); PG8_WAIT_L(0); PG8_BAR; PG8_MMA(1, 0, At, B0); PG8_MMA(1, 1, At, B1); PG8_BAR; PG8_SCHED;
            PG8_LDB(B0, 1, 0); PG8_LDB(B1, 1, 1); PG8_SCHED; PG8_LDA(At, 1, 0); PG8_STAGE(PG8_SA(0, 1), a2 + hstepA, voffA);
            PG8_WAIT_V(8); PG8_WAIT_L(0); PG8_BAR; PG8_MMA(0, 0, At, B0); PG8_MMA(0, 1, At, B1); PG8_BAR; PG8_SCHED;
            PG8_LDA(At, 1, 1); PG8_STAGE(PG8_SB(1, 0), b3, voffB); PG8_STAGE(PG8_SB(1, 1), b3 + hstepB, voffB); PG8_STAGE(PG8_SA(1, 0), a3, voffA);
            PG8_WAIT_V(8); PG8_WAIT_L(0); PG8_BAR; PG8_MMA(1, 0, At, B0); PG8_MMA(1, 1, At, B1); PG8_BAR; PG8_SCHED;
            } else {
            PG8_LDB(B0, 0, 0); PG8_SCHED; PG8_LDA(At, 0, 0); PG8_STAGE(PG8_SA(1, 1), a1 + hstepA, voffA);
            PG8_WAIT_L(8); PG8_BAR; PG8_WAIT_L(0); PG8_MMA(0, 0, At, B0); PG8_BAR; PG8_SCHED;
            PG8_LDB(B1, 0, 1); PG8_STAGE(PG8_SB(0, 0), b2, voffB);
            PG8_BAR; PG8_WAIT_L(0); PG8_MMA(0, 1, At, B1); PG8_BAR;
            PG8_LDA(At, 0, 1); PG8_STAGE(PG8_SA(0, 0), a2, voffA);
            PG8_BAR; PG8_WAIT_L(0); PG8_MMA(1, 0, At, B0); PG8_BAR; PG8_SCHED;
            PG8_STAGE(PG8_SB(0, 1), b2 + hstepB, voffB);
            PG8_WAIT_V(6); PG8_BAR; PG8_MMA(1, 1, At, B1); PG8_BAR;
            PG8_LDB(B0, 1, 0); PG8_SCHED; PG8_LDA(At, 1, 0); PG8_STAGE(PG8_SA(0, 1), a2 + hstepA, voffA);
            PG8_WAIT_L(8); PG8_BAR; PG8_WAIT_L(0); PG8_MMA(0, 0, At, B0); PG8_BAR; PG8_SCHED;
            PG8_LDB(B1, 1, 1); PG8_STAGE(PG8_SB(1, 0), b3, voffB);
            PG8_BAR; PG8_WAIT_L(0); PG8_MMA(0, 1, At, B1); PG8_BAR;
            PG8_LDA(At, 1, 1); PG8_STAGE(PG8_SA(1, 0), a3, voffA);
            PG8_BAR; PG8_WAIT_L(0); PG8_MMA(1, 0, At, B0); PG8_BAR; PG8_SCHED;
            PG8_STAGE(PG8_SB(1, 1), b3 + hstepB, voffB);
            PG8_WAIT_V(6); PG8_BAR; PG8_MMA(1, 1, At, B1); PG8_BAR;
            }
        }
        if constexpr (ALIGN_EPI) { if (wr == 0) PG8_BAR; }
        if constexpr (!Epi::AFTER_DRAIN) { E(acc, cur, wr, wc, fr, fq); S.done(cur); }
        if (!has_next) break;
#pragma unroll
        for (int a = 0; a < 2; ++a)
#pragma unroll
            for (int b = 0; b < 2; ++b)
#pragma unroll
                for (int m = 0; m < 4; ++m)
#pragma unroll
                    for (int n = 0; n < 2; ++n) acc[a][b][m][n] = (f32x4){0.f, 0.f, 0.f, 0.f};
        cur = nxt; cA = nA; cB = nB; ++ui;
        if constexpr (ALIGN_EPI) { if (wr == 1) PG8_BAR; }
    }
    PG8_WAIT_V(0);
    if constexpr (!ALIGN_EPI) { if (wr == 0) PG8_BAR; }
    PG8_BAR;
    if constexpr (Epi::AFTER_DRAIN) { E.fused(acc, cur, wr, wc, fr, fq, lds, wid, lane); S.done(cur); }
#undef PG8_SA
#undef PG8_SB
#undef PG8_STAGE
#undef PG8_LDA
#undef PG8_LDB
#undef PG8_MMA
#undef PG8_WAIT_V
#undef PG8_WAIT_L
#undef PG8_BAR
#undef PG8_SCHED
}

}
#define PG8_SP2 true
#define PG8_ALIGN true

__global__ void __launch_bounds__(NTHR, 2) fwd(Args args) {
    extern __shared__ __attribute__((aligned(16))) unsigned char lds[];
    Frame F;
    F.lds = (LAS unsigned char*)lds;
    F.MISC = (volatile LAS unsigned*)(F.lds + MISC_OFF);
    F.tid = 0; F.lane = 0; F.wave = __builtin_amdgcn_readfirstlane(threadIdx.x >> 6);
    F.G = gridDim.x; { const int bx = blockIdx.x; F.vcu = (F.G % 8 == 0) ? (bx % 8) * (F.G / 8) + bx / 8 : bx; }
    unsigned char* ws = args.ws; F.ws = ws;
    F.ctl = (gu32*)(ws + WS_CTL);
    for (int u = threadIdx.x; u < (LDS_BYTES - LDSCTL_OFF) / 4; u += NTHR) ((LAS unsigned*)(F.lds + LDSCTL_OFF))[u] = 0u;
    __syncthreads();
    XcdBarrier bar = xcd_barrier_post((unsigned*)(F.ctl + CW_BAR) + args.li * XCD_BAR_WORDS, F.MISC + 8);
    const int lo = args.ph_lo, hi = args.ph_hi;
#define IN(k) (lo <= (k) && (k) < hi)
#define SEAM(k) do { if (IN(k) && IN((k) + 1)) xcd_barrier(bar); } while (0)
    const int wave = F.wave;
    const int gw = F.vcu * NWAVES + wave, NGW = F.G * NWAVES;
    const int NGT = F.G * NTHR;
#define TVARS const int tid = opaque_tid(); const int lane = tid & 63; const int gt = blockIdx.x * NTHR + tid; (void)lane; (void)gt;
    LAS float* As = (LAS float*)F.lds; LAS float* Bs = As + 16 * 132;
    const float* x = args.in[I_X];
    float* out = args.out;

    if (IN(0)) {
        TVARS
        for (int m = gw; m < T; m += NGW) rms_row_to_bf16(lane, x + (size_t)m * D, args.in[I_NMIX], (bf16*)(ws + WS_H1) + (size_t)m * D);
        { const f32x4* p4 = (const f32x4*)args.in[I_P]; v2u* o = (v2u*)(ws + WS_PB);
          for (int i = gt; i < T * PLE / 4; i += NGT) { const f32x4 v = p4[i]; v2u w; w.x = pk2(v.x, v.y); w.y = pk2(v.z, v.w); o[i] = w; } }
        { f32x2* tr = (f32x2*)(ws + WS_TRIG);
          for (int i = gt; i < T * 64; i += NGT) { const int pos = i >> 6, j = i & 63; double r = (double)pos * args.rfreq[j]; r -= floor(r); if (r > 0.5) r -= 1.0;
              const float rf = (float)r; f32x2 cs; cs.x = __builtin_amdgcn_cosf(rf); cs.y = __builtin_amdgcn_sinf(rf); tr[i] = cs; } }
        { float* lb = (float*)(ws + WS_LB); const float* raw = args.in[I_LBRAW];
          for (int c = gt; c < HW; c += NGT) lb[c] = 1.0f / (1.0f + expf(raw[HW + c] - raw[c])); }
        { float* wrt = (float*)(ws + WS_WRT); const float* wg = args.in[I_WRG]; const float* we = args.in[I_WRE];
          for (int i = gt; i < 36 * D; i += NGT) { const int c = i / D, k = i % D; wrt[i] = args.in[I_NFFN][k] * ((c < 4) ? wg[k * 4 + c] : we[k * NE + (c - 4)]); } }
        { LAS float* scr = (LAS float*)(F.lds + wave * 16384);
          constexpr int I_IN = 32 * 352, I_UH = 16 * 64, I_UM = 16 * 64, I_O = 32 * 64, I_G = 32 * 64, I_PP = 4 * 64;
          for (int it = gw; it < I_IN + I_PP; it += NGW) { int r = it;
              if (r < I_IN) { const int kb = r / 352, nb = r % 352; transpose_item(args.in[I_WIN], INC, kb * 64, phys2log_inproj(nb * 32), (bf16*)(ws + WS_WIN_T), D, nb * 32, kb * 64, scr, lane); continue; } r -= I_IN;
              { const int kb = r / 64, nb = r % 64; transpose_item(args.in[I_WPP], D, kb * 64, nb * 32, (bf16*)(ws + WS_WPP_T), PLE, nb * 32, kb * 64, scr, lane); } } }
    }
    SEAM(0);

    if (IN(1) && FP1) {
        { pg8::Gemm g{(const bf16*)(ws + WS_H1), (const bf16*)(ws + WS_WIN_T), D, D, D}; pg8::StaticOrder S; S.init(T, INC, F.G, (int)blockIdx.x); pg8::EpiInProj E{ws};
          pg8::gemm_phase<pg8::EpiInProj, pg8::StaticOrder, PG8_ALIGN, PG8_SP2>(F.lds, g, S, E); }
        {
            const int nbusy = ((T / 256) * (INC / 256)) % F.G, c = (int)blockIdx.x;
            if (nbusy == 0 || c >= nbusy) { const int nh = nbusy == 0 ? F.G : F.G - nbusy, hr = nbusy == 0 ? c : c - nbusy;
                { pg8::Gemm g2{(const bf16*)(ws + WS_PB), (const bf16*)(ws + WS_WPP_T), PLE, PLE, PLE}; pg8::StaticOrder S2; S2.init(T, D, nh, hr); pg8::EpiBf16Plain E2{(bf16*)(ws + WS_PP), D};
                  pg8::gemm_phase<pg8::EpiBf16Plain, pg8::StaticOrder, PG8_ALIGN, PG8_SP2>(F.lds, g2, S2, E2); }
                __syncthreads();
                { TVARS
                  LAS float* scr = (LAS float*)(F.lds + wave * 16384);
                  constexpr int I_UH = 16 * 64, I_UM = 16 * 64, I_O = 32 * 64, I_G = 32 * 64;
                  auto item1 = [&](int it) -> TrItem { TrItem q; int r = it; q.ldw = D; q.ldt = D;
                      if (r < I_UH) { const int kb = r / 64, nb = r % 64; q.src = args.in[I_WUH] + (size_t)(kb * 64) * D + nb * 32; q.dst = (bf16*)(ws + WS_WUP_T) + (size_t)(nb * 32) * D + kb * 64; return q; } r -= I_UH;
                      if (r < I_UM) { const int kb = r / 64, nb = r % 64; q.src = args.in[I_WUM] + (size_t)(kb * 64) * D + nb * 32; q.dst = (bf16*)(ws + WS_WUP_T) + (size_t)(nb * 32) * D + HW + kb * 64; return q; } r -= I_UM;
                      if (r < I_O) { const int kb = r / 64, nb = r % 64; q.src = args.in[I_WOUT] + (size_t)(kb * 64) * D + nb * 32; q.dst = (bf16*)(ws + WS_WOUT_T) + (size_t)(nb * 32) * D + kb * 64; return q; } r -= I_O;
                      { const int kb = r / 64, nb = r % 64; q.src = args.in[I_WPG] + (size_t)(kb * 64) * D + nb * 32; q.dst = (bf16*)(ws + WS_WPG_T) + (size_t)(nb * 32) * D + kb * 64; return q; } };
                  TR_PIPE(hr * NWAVES + wave, I_UH + I_UM + I_O + I_G, nh * NWAVES, item1); }
            }
        }
    }
    if (IN(1) && !FP1) {
        TVARS
        const bf16* H1 = (const bf16*)(ws + WS_H1);
        constexpr int NT1 = (T / 128) * (INC / 128), NT2 = (T / 128) * (D / 128);
        for (int it = F.vcu; it < NT1 + NT2; it += F.G) {
            float acc[8][4]; zero_acc(acc);
            const int tx = tid & 31, ty = tid >> 5;
            if (it < NT1) {
                const int tm = it / (INC / 128), tn = it % (INC / 128);
                sgemm_acc(acc, As, Bs, H1, D, tm * 128, args.in[I_WIN], INC, tn * 128, D, tid);
#pragma unroll
                for (int i = 0; i < 8; ++i) inproj_epi(ws, tm * 128 + ty * 8 + i, tn * 128 + tx * 4, acc[i]);
            } else {
                const int r = it - NT1, tm = r / (D / 128), tn = r % (D / 128);
                sgemm_acc(acc, As, Bs, (const bf16*)(ws + WS_PB), PLE, tm * 128, args.in[I_WPP], D, tn * 128, PLE, tid);
#pragma unroll
                for (int i = 0; i < 8; ++i) st_bf16x4((bf16*)(ws + WS_PP) + (size_t)(tm * 128 + ty * 8 + i) * D + tn * 128 + tx * 4, acc[i][0], acc[i][1], acc[i][2], acc[i][3]);
            }
        }
    }
    SEAM(1);

    if (IN(2) && (FHG || FMB)) {
        TVARS
        if (FHG) for (int it = F.vcu; it < 128 * NH; it += F.G) hgrn_pass_a(ws, F.lds, it, tid);
        __syncthreads();
        if (FMB) for (int it = F.vcu; it < NH * NB; it += F.G) if ((it & 31) > 0) moba_gate_lists(ws, F.ctl, F.lds, it >> 5, it & 31, tid);
    }
    if (IN(2) && !FP1) {
        TVARS
        const float* raw = (const float*)(ws + WS_TMPF); const f32x2* tr = (const f32x2*)(ws + WS_TRIG);
        for (int i = gt; i < T * 16 * 64; i += NGT) {
            const int j = i & 63, hh = (i >> 6) & 15, t = i >> 10;
            const float x1 = raw[(size_t)t * D + hh * 128 + j], x2 = raw[(size_t)t * D + hh * 128 + 64 + j];
            const f32x2 cs = tr[t * 64 + j];
            bf16* dst = (hh < 8) ? (bf16*)(ws + WS_MQ) + (size_t)t * HW + hh * 128 : (bf16*)(ws + WS_MK) + (size_t)t * HW + (hh - 8) * 128;
            dst[j] = (bf16)f2bf(x1 * cs.x - x2 * cs.y); dst[64 + j] = (bf16)f2bf(x2 * cs.x + x1 * cs.y);
        }
    }
    SEAM(2);
    if (IN(3) && (FHG || FMB)) {
        TVARS
        {
            const bf16* DSb = (const bf16*)(ws + WS_DS); const float* DEC = (const float*)(ws + WS_DEC); bf16* STb = (bf16*)(ws + WS_ST);
            constexpr int SCN = 4;
            if (FHG) for (int e0 = (F.vcu * NTHR * SCN) + tid; e0 < NH * HD * HD; e0 += F.G * NTHR * SCN) {
                float S[SCN]; const bf16* ds[SCN]; const float* dec[SCN]; bf16* st[SCN];
#pragma unroll
                for (int i = 0; i < SCN; ++i) { const int e = e0 + i * NTHR, h = e >> 14, rem = e & 16383, k = e & 127; S[i] = 0.f; ds[i] = DSb + h * 16384 + rem; dec[i] = DEC + h * HD + k; st[i] = STb + h * 16384 + rem; }
                for (int c0 = 0; c0 < 128; c0 += 4) {
                    float dv[4][SCN], gv[4][SCN];
#pragma unroll
                    for (int cc = 0; cc < 4; ++cc)
#pragma unroll
                        for (int i = 0; i < SCN; ++i) { dv[cc][i] = bf2f(ds[i][(size_t)(c0 + cc) * 131072]); gv[cc][i] = dec[i][(c0 + cc) * 1024]; }
#pragma unroll
                    for (int cc = 0; cc < 4; ++cc)
#pragma unroll
                        for (int i = 0; i < SCN; ++i) { st[i][(size_t)(c0 + cc) * 131072] = (bf16)f2bf(S[i]); S[i] = gv[cc][i] * S[i] + dv[cc][i]; } } }
        }
        if (FMB) {
            LAS int* ust = (LAS int*)(F.lds + LDSCTL_OFF + 1024); LAS int* cn = ust + 260; volatile LAS int* cur_w = (volatile LAS int*)(ust + 520);
            __syncthreads();
            if (tid < NH * NB) cn[tid] = (int)__hip_atomic_load((unsigned*)(F.ctl + CW_MCNT) + tid, RLX_AGENT);
            __syncthreads();
            if (tid == 0) { int a = 0; for (int i = 0; i < NH * NB; ++i) { ust[i] = a; a += (cn[i] + MB_RCH - 1) / MB_RCH; } ust[NH * NB] = a; }
            __syncthreads();
            const int nch = ust[NH * NB], total = nch + NH * NB;
            for (;;) {
                if (tid == 0) *cur_w = (int)__hip_atomic_fetch_add((unsigned*)(F.ctl + 8), 1u, RLX_AGENT);
                __syncthreads();
                const int w = *cur_w;
                __syncthreads();
                if (w >= total) break;
                int idx, n; bool causal; const unsigned short* gl = (const unsigned short*)(ws + WS_GL);
                if (w < nch) { int lo2 = 0, hi2 = NH * NB - 1;
                    while (lo2 < hi2) { const int mid = (lo2 + hi2 + 1) >> 1; if (ust[mid] <= w) lo2 = mid; else hi2 = mid - 1; }
                    idx = lo2; const int r0 = (w - ust[idx]) * MB_RCH; n = cn[idx] - r0; n = n > MB_RCH ? MB_RCH : n; gl += (size_t)idx * 8192 + r0; causal = false; }
                else { idx = w - nch; n = 256; causal = true; }
                idx = __builtin_amdgcn_readfirstlane(idx); n = __builtin_amdgcn_readfirstlane(n);
                moba_kv_item(ws, F.lds, idx >> 5, idx & 31, causal, gl, n, tid);
            }
        }
    }

    if (IN(3)) {
        TVARS
        if (!FP1) { const bf16* MK = (const bf16*)(ws + WS_MK); float* km = (float*)(ws + WS_KMEAN);
          for (int i = gt; i < NB * HW; i += NGT) { const int jb = i / HW, c = i % HW; float s = 0.f;
              for (int r = 0; r < BS; ++r) s += bf2f(MK[(size_t)(jb * BS + r) * HW + c]);
              km[i] = s; km[NB * HW + i] = 0.f; } }
        if (!FHG && wave == 0 && blockIdx.x < 16) {
            const int h = blockIdx.x >> 1, v = (blockIdx.x & 1) * 64 + lane;
            const float* GH = (const float*)(ws + WS_GH) + h * HD; const bf16* QH = (const bf16*)(ws + WS_QH) + h * HD; const bf16* VH = (const bf16*)(ws + WS_VH) + h * HD + v;
            float* ORAW = (float*)(ws + WS_TMPF) + h * HD + v;
            float S[HD];
#pragma unroll
            for (int k = 0; k < HD; ++k) S[k] = 0.f;
            for (int t = 0; t < T; ++t) {
                const float iv = bf2f(VH[(size_t)t * HW]); float o = 0.f;
                const float* g = GH + (size_t)t * HW; const bf16* q = QH + (size_t)t * HW;
#pragma unroll
                for (int k = 0; k < HD; ++k) { const float f = __expf(g[k]); S[k] = f * S[k] + (1.f - f) * iv; o += S[k] * bf2f(q[k]); }
                ORAW[(size_t)t * HW] = o;
            }
        }
    }
    SEAM(3);
    if (IN(4) && (FHG || FMB)) {
        TVARS
        const bool merge_first = (F.vcu & 1) != 0;
        auto passc4 = [&]() { if (FHG) for (int it = F.vcu; it < 128 * NH; it += F.G) hgrn_pass_c(ws, F.lds, args.in[I_HNG], it, tid); };
        if (!merge_first) passc4();
        if (false) for (int it0 = F.vcu; it0 < NH * NB; it0 += F.G) if ((it0 & 31) < 16) { const int it = it0 ^ 16;
            const int h = it >> 5, cur = it & 31; const bf16* PO = (const bf16*)(ws + WS_PO); const float* PL = (const float*)(ws + WS_PLSE); bf16* AUP = (bf16*)(ws + WS_AUP);
            for (int idx = tid; idx < BS * 16; idx += NTHR) { const int t = cur * BS + (idx >> 4), dq = idx & 15, th = t * NH + h;
                const float* plp = PL + (size_t)th * 128; float ls[4]; ls[0] = plp[0]; ls[1] = plp[32]; ls[2] = plp[64]; ls[3] = plp[96];
                bool ok[4]; float M = -3.0e38f;
#pragma unroll
                for (int i = 0; i < 4; ++i) { ok[i] = fabsf(ls[i]) < 1.0e4f && fabsf(ls[i]) > 1.0e-9f; if (ok[i]) M = fmaxf(M, ls[i]); }
                float wv[4], wsum = 0.f;
#pragma unroll
                for (int i = 0; i < 4; ++i) { wv[i] = ok[i] ? __expf(ls[i] - M) : 0.f; wsum += wv[i]; }
                const float inv = wsum > 0.f ? 1.0f / wsum : 0.f;
                float acc[8] = {0.f, 0.f, 0.f, 0.f, 0.f, 0.f, 0.f, 0.f};
#pragma unroll
                for (int i = 0; i < 4; ++i) { const v4u pw = *(const v4u*)(PO + ((size_t)th * 4 + i) * HD + dq * 8); const float wi = wv[i] * inv;
                    float pv[8] = {bflo(pw.x), bfhi(pw.x), bflo(pw.y), bfhi(pw.y), bflo(pw.z), bfhi(pw.z), bflo(pw.w), bfhi(pw.w)};
#pragma unroll
                    for (int q = 0; q < 8; ++q) { const float x = fabsf(pv[q]) < 1.0e4f ? pv[q] : 0.f; acc[q] += wi * x; } }
                v4u ov; ov.x = pk2(acc[0], acc[1]); ov.y = pk2(acc[2], acc[3]); ov.z = pk2(acc[4], acc[5]); ov.w = pk2(acc[6], acc[7]);
                *(v4u*)(AUP + (size_t)t * D + HW + h * HD + dq * 8) = ov; }
        }
        if (FMB) {
            const bf16* PO = (const bf16*)(ws + WS_PO); const float* PL = (const float*)(ws + WS_PLSE); bf16* AUP = (bf16*)(ws + WS_AUP);
            for (int idx0 = gt; idx0 < T * NH * 16; idx0 += 2 * NGT) {
                float ls[2][4]; v4u pw[2][4]; int nvv[2];
#pragma unroll
                for (int u = 0; u < 2; ++u) { int idx = idx0 + u * NGT; if (idx >= T * NH * 16) idx = idx0; const int th = idx >> 4, dq = idx & 15, cur = th >> 11; nvv[u] = cur < 3 ? cur : 3;
                    const f32x4 l4 = *(const f32x4*)(PL + (size_t)th * 4);
#pragma unroll
                    for (int i = 0; i < 4; ++i) { ls[u][i] = l4[i]; pw[u][i] = *(const v4u*)(PO + ((size_t)th * 4 + i) * HD + dq * 8); } }
#pragma unroll
                for (int u = 0; u < 2; ++u) { const int idx = idx0 + u * NGT; if (idx >= T * NH * 16) break; const int th = idx >> 4, dq = idx & 15, t = th >> 3, h = th & 7, nv = nvv[u];
                    float M = ls[u][0];
#pragma unroll
                    for (int i = 1; i < 4; ++i) if (i <= nv) M = fmaxf(M, ls[u][i]);
                    float wv[4]; wv[0] = __expf(ls[u][0] - M);
#pragma unroll
                    for (int i = 1; i < 4; ++i) wv[i] = (i <= nv) ? __expf(ls[u][i] - M) : 0.f;
                    const float inv = 1.0f / ((wv[0] + wv[1]) + (wv[2] + wv[3]));
                    float acc[8] = {0.f, 0.f, 0.f, 0.f, 0.f, 0.f, 0.f, 0.f};
#pragma unroll
                    for (int i = 0; i < 4; ++i) { v4u p = pw[u][i]; if (i > nv) { p.x = 0u; p.y = 0u; p.z = 0u; p.w = 0u; } const float wi = wv[i] * inv;
                        acc[0] += wi * bflo(p.x); acc[1] += wi * bfhi(p.x); acc[2] += wi * bflo(p.y); acc[3] += wi * bfhi(p.y); acc[4] += wi * bflo(p.z); acc[5] += wi * bfhi(p.z); acc[6] += wi * bflo(p.w); acc[7] += wi * bfhi(p.w); }
                    v4u ov; ov.x = pk2(acc[0], acc[1]); ov.y = pk2(acc[2], acc[3]); ov.z = pk2(acc[4], acc[5]); ov.w = pk2(acc[6], acc[7]);
                    *(v4u*)(AUP + (size_t)t * D + HW + h * HD + dq * 8) = ov; } }
        }
        if (merge_first) passc4();
    }

    if (IN(4)) {
        TVARS
        bf16* AUP = (bf16*)(ws + WS_AUP);
        if (!FHG) { const float* ORAW = (const float*)(ws + WS_TMPF); const bf16* OG = (const bf16*)(ws + WS_OG); const float* ng = args.in[I_HNG];
          for (int it = gw; it < T * NH; it += NGW) { const int t = it >> 3, h = it & 7; const size_t off = (size_t)t * HW + h * HD + 2 * lane;
              const f32x2 o = *(const f32x2*)(ORAW + off); const float r = 1.0f / sqrtf(wave_sum(o.x * o.x + o.y * o.y) * (1.f / HD) + EPS);
              const unsigned og = *(const unsigned*)(OG + off);
              *(unsigned*)(AUP + (size_t)t * D + h * HD + 2 * lane) = pk2(o.x * r * ng[2 * lane] * bflo(og), o.y * r * ng[2 * lane + 1] * bfhi(og)); } }
        LAS float* qs = (LAS float*)F.lds + 32768 / 4 + wave * 1280; LAS float* sc = qs + 128;
        const bf16* MQ = (const bf16*)(ws + WS_MQ); const bf16* MK = (const bf16*)(ws + WS_MK); const bf16* MV = (const bf16*)(ws + WS_MV); const float* KM = (const float*)(ws + WS_KMEAN);
        const float scale = 0.08838834764831845f;
        if (FMB != 1) for (int it = gw; it < T * NH; it += NGW) {
            const int t = it >> 3, h = it & 7, cur = t >> 8;
            { const unsigned qw = *(const unsigned*)(MQ + (size_t)t * HW + h * HD + 2 * lane); qs[2 * lane] = bflo(qw); qs[2 * lane + 1] = bfhi(qw); }
            LDS_WAIT();
            float gate = -3.0e38f;
            if (lane < NB) { gate = -1e30f; if (lane < cur) { float s0 = 0.f, s1 = 0.f; const f32x4* ka = (const f32x4*)(KM + (size_t)lane * HW + h * HD); const f32x4* kb = (const f32x4*)(KM + (size_t)(NB + lane) * HW + h * HD);
#pragma unroll
                    for (int d4 = 0; d4 < 32; ++d4) { const f32x4 a = ka[d4], b2 = kb[d4]; const LAS float* q4 = qs + 4 * d4;
                        s0 += q4[0] * (a.x + b2.x) + q4[1] * (a.y + b2.y); s1 += q4[2] * (a.z + b2.z) + q4[3] * (a.w + b2.w); }
                    gate = (s0 + s1) * (1.f / BS); } }
            int blk[4]; bool val[4]; blk[0] = cur; val[0] = true;
#pragma unroll
            for (int r = 0; r < 3; ++r) { const float mxg = wave_max(gate); const unsigned long long bm = __ballot(gate == mxg); const int sel = __ffsll((long long)bm) - 1;
                blk[r + 1] = sel; val[r + 1] = sel < cur; if (lane == sel) gate = -3.0e38f; }
            float mx = -3.0e38f;
#pragma unroll
            for (int b = 0; b < 4; ++b) if (val[b]) for (int g = 0; g < 4; ++g) {
                const int key = blk[b] * BS + g * 64 + lane; const v4u* kr = (const v4u*)(MK + (size_t)key * HW + h * HD); float s = 0.f;
#pragma unroll
                for (int c = 0; c < 16; ++c) { const v4u kw = kr[c]; const LAS float* q8 = qs + c * 8;
                    s += q8[0] * bflo(kw.x) + q8[1] * bfhi(kw.x) + q8[2] * bflo(kw.y) + q8[3] * bfhi(kw.y) + q8[4] * bflo(kw.z) + q8[5] * bfhi(kw.z) + q8[6] * bflo(kw.w) + q8[7] * bfhi(kw.w); }
                s = (b == 0 && key > t) ? -1e30f : s * scale; sc[b * 256 + g * 64 + lane] = s; mx = fmaxf(mx, s); }
            mx = wave_max(mx); float l = 0.f;
#pragma unroll
            for (int b = 0; b < 4; ++b) if (val[b]) for (int g = 0; g < 4; ++g) { const int i = b * 256 + g * 64 + lane; const float p = __expf(sc[i] - mx); sc[i] = p; l += p; }
            l = wave_sum(l); LDS_WAIT();
            float o0 = 0.f, o1 = 0.f;
#pragma unroll
            for (int b = 0; b < 4; ++b) if (val[b]) { const bf16* vb = MV + (size_t)(blk[b] * BS) * HW + h * HD + 2 * lane;
                float a0 = 0.f, a1 = 0.f, c0 = 0.f, c1 = 0.f;
#pragma unroll 1
                for (int k = 0; k < 256; k += 16) { unsigned vw[16];
#pragma unroll
                    for (int u = 0; u < 16; ++u) vw[u] = *(const unsigned*)(vb + (size_t)(k + u) * HW);
#pragma unroll
                    for (int u = 0; u < 16; u += 2) { const float p0 = sc[b * 256 + k + u], p1 = sc[b * 256 + k + u + 1];
                        a0 += p0 * bflo(vw[u]); a1 += p0 * bfhi(vw[u]); c0 += p1 * bflo(vw[u + 1]); c1 += p1 * bfhi(vw[u + 1]); } }
                o0 += a0 + c0; o1 += a1 + c1; }
            const float il = 1.0f / l;
            *(unsigned*)(AUP + (size_t)t * D + HW + h * HD + 2 * lane) = pk2(o0 * il, o1 * il);
            LDS_WAIT();
        }
    }
    SEAM(4);

    if (IN(5) && FP5) {
        pg8::StaticOrder S; S.init(T, D, F.G, (int)blockIdx.x);
        { pg8::Gemm g{(const bf16*)(ws + WS_AUP), (const bf16*)(ws + WS_WUP_T), D, D, D}; pg8::EpiUp2 E{(const bf16*)(ws + WS_GA), (const bf16*)(ws + WS_GB), (bf16*)(ws + WS_MERGED)};
          pg8::gemm_phase<pg8::EpiUp2, pg8::StaticOrder, false, PG8_SP2>(F.lds, g, S, E); }
    }
    if (IN(5) && !FP5) {
        TVARS
        const bf16* AUP = (const bf16*)(ws + WS_AUP); const bf16* GA = (const bf16*)(ws + WS_GA); const bf16* GB = (const bf16*)(ws + WS_GB); bf16* MG = (bf16*)(ws + WS_MERGED);
        for (int it = F.vcu; it < (T / 128) * (D / 128); it += F.G) {
            const int tm = it / (D / 128), tn = it % (D / 128), tx = tid & 31, ty = tid >> 5;
            float a1[8][4], a2[8][4]; zero_acc(a1); zero_acc(a2);
            sgemm_acc(a1, As, Bs, AUP, D, tm * 128, args.in[I_WUH], D, tn * 128, HW, tid);
            sgemm_acc(a2, As, Bs, AUP + HW, D, tm * 128, args.in[I_WUM], D, tn * 128, HW, tid);
#pragma unroll
            for (int i = 0; i < 8; ++i) { const size_t off = (size_t)(tm * 128 + ty * 8 + i) * D + tn * 128 + tx * 4;
                const v2u ga = *(const v2u*)(GA + off), gb = *(const v2u*)(GB + off);
                st_bf16x4(MG + off, bflo(ga.x) * a1[i][0] + bflo(gb.x) * a2[i][0], bfhi(ga.x) * a1[i][1] + bfhi(gb.x) * a2[i][1],
                          bflo(ga.y) * a1[i][2] + bflo(gb.y) * a2[i][2], bfhi(ga.y) * a1[i][3] + bfhi(gb.y) * a2[i][3]); }
        }
    }
    SEAM(5);

    if (IN(6) && FP6) {
        pg8::Gemm g{(const bf16*)(ws + WS_MERGED), (const bf16*)(ws + WS_WOUT_T), D, D, D}; pg8::StaticOrder S; S.init(T, D, F.G, (int)blockIdx.x);
        pg8::EpiResidB<0> E{x, (bf16*)(ws + WS_XR), nullptr};
        pg8::gemm_phase<pg8::EpiResidB<0>, pg8::StaticOrder, false, PG8_SP2>(F.lds, g, S, E);
    }
    if (IN(6) && !FP6) {
        TVARS
        const bf16* MG = (const bf16*)(ws + WS_MERGED);
        for (int it = F.vcu; it < (T / 128) * (D / 128); it += F.G) {
            const int tm = it / (D / 128), tn = it % (D / 128), tx = tid & 31, ty = tid >> 5;
            float acc[8][4]; zero_acc(acc);
            sgemm_acc(acc, As, Bs, MG, D, tm * 128, args.in[I_WOUT], D, tn * 128, D, tid);
#pragma unroll
            for (int i = 0; i < 8; ++i) { const size_t off = (size_t)(tm * 128 + ty * 8 + i) * D + tn * 128 + tx * 4; const f32x4 xv = *(const f32x4*)(x + off);
                f32x4 o; o.x = xv.x + acc[i][0]; o.y = xv.y + acc[i][1]; o.z = xv.z + acc[i][2]; o.w = xv.w + acc[i][3]; *(f32x4*)(out + off) = o; }
        }
    }
    SEAM(6);

    if (IN(7)) {
        TVARS
        auto conv7 = [&]() { LAS float* scr = (LAS float*)(F.lds + wave * 16384);
          for (int it = gw; it < NE * 1024; it += NGW) { const int e = it >> 10, r = it & 1023;
              { const int kb = r >> 5, n0 = (r & 31) * 32, pnl = n0 >> 8, bj = (n0 >> 7) & 1, q0 = n0 & 127;
                  transpose_item((bj ? args.in[I_WEU] : args.in[I_WEG]) + (size_t)e * D * DE, DE, kb * 64, pnl * 128 + q0, (bf16*)(ws + WS_WEGU) + (size_t)e * 1024 * D, D, n0, kb * 64, scr, lane); }
          } };
        const bool conv_first = (F.vcu & 1) == 0;
        if (conv_first) conv7();
        const float* gff = args.in[I_NFFN]; const float* wrt = (const float*)(ws + WS_WRT);
        int* EID = (int*)(ws + WS_ROUTE); int* POS = EID + 2 * T; float* RW = (float*)(POS + 2 * T);
        __syncthreads();
        LAS float* part = (LAS float*)F.lds; LAS float* lgt = (LAS float*)(F.lds + 49152); LAS float* rsc = (LAS float*)(F.lds + 57344);
        for (int rb = F.vcu; rb < T / 32; rb += F.G) { const int r0 = rb * 32;
            for (int i4 = 0; i4 < 4; ++i4) { const int m = r0 + 4 * wave + i4;
                const v2u* xr = (const v2u*)((const bf16*)(ws + WS_XR) + (size_t)m * D) + lane; const f32x4* gr = (const f32x4*)gff + lane;
                f32x4 v[8]; float s = 0.f;
#pragma unroll
                for (int j = 0; j < 8; ++j) { const v2u w2 = xr[64 * j]; v[j].x = bflo(w2.x); v[j].y = bfhi(w2.x); v[j].z = bflo(w2.y); v[j].w = bfhi(w2.y); s += (v[j].x * v[j].x + v[j].y * v[j].y) + (v[j].z * v[j].z + v[j].w * v[j].w); }
                f32x4 g8[8];
#pragma unroll
                for (int j = 0; j < 8; ++j) g8[j] = gr[64 * j];
                const float r = 1.0f / sqrtf(wave_sum(s) * (1.f / D) + EPS);
                unsigned long long* o8 = (unsigned long long*)((bf16*)(ws + WS_HFFN) + (size_t)m * D) + lane;
#pragma unroll
                for (int j = 0; j < 8; ++j) { const f32x4 gg = g8[j];
                    o8[64 * j] = (unsigned long long)pk2(v[j].x * r * gg.x, v[j].y * r * gg.y) | ((unsigned long long)pk2(v[j].z * r * gg.z, v[j].w * r * gg.w) << 32); }
                if (lane == 0) rsc[4 * wave + i4] = r; }
            { const int fr = lane & 15, fq = lane >> 4;
              f32x4 acc[2][3];
#pragma unroll
              for (int rt = 0; rt < 2; ++rt)
#pragma unroll
                  for (int ct = 0; ct < 3; ++ct) acc[rt][ct] = (f32x4){0.f, 0.f, 0.f, 0.f};
              const bf16* xa = (const bf16*)(ws + WS_XR) + (size_t)(r0 + fr) * D + wave * 256 + 4 * fq;
              const float* wb = wrt + (size_t)fr * D + wave * 256 + 4 * fq;
              const float* wb2 = wrt + (size_t)((32 + fr) > 35 ? 35 : (32 + fr)) * D + wave * 256 + 4 * fq;
#pragma unroll 2
              for (int j = 0; j < 16; ++j) {
                  const v2u aw0 = *(const v2u*)(xa + 16 * j), aw1 = *(const v2u*)(xa + (size_t)16 * D + 16 * j);
                  const f32x4 a0 = {bflo(aw0.x), bfhi(aw0.x), bflo(aw0.y), bfhi(aw0.y)}, a1 = {bflo(aw1.x), bfhi(aw1.x), bflo(aw1.y), bfhi(aw1.y)};
                  const f32x4 b0 = *(const f32x4*)(wb + 16 * j), b1 = *(const f32x4*)(wb + (size_t)16 * D + 16 * j), b2 = *(const f32x4*)(wb2 + 16 * j);
#pragma unroll
                  for (int q = 0; q < 4; ++q) {
                      acc[0][0] = __builtin_amdgcn_mfma_f32_16x16x4f32(a0[q], b0[q], acc[0][0], 0, 0, 0); acc[0][1] = __builtin_amdgcn_mfma_f32_16x16x4f32(a0[q], b1[q], acc[0][1], 0, 0, 0);
                      acc[0][2] = __builtin_amdgcn_mfma_f32_16x16x4f32(a0[q], b2[q], acc[0][2], 0, 0, 0); acc[1][0] = __builtin_amdgcn_mfma_f32_16x16x4f32(a1[q], b0[q], acc[1][0], 0, 0, 0);
                      acc[1][1] = __builtin_amdgcn_mfma_f32_16x16x4f32(a1[q], b1[q], acc[1][1], 0, 0, 0); acc[1][2] = __builtin_amdgcn_mfma_f32_16x16x4f32(a1[q], b2[q], acc[1][2], 0, 0, 0); } }
#pragma unroll
              for (int rt = 0; rt < 2; ++rt)
#pragma unroll
                  for (int ct = 0; ct < 3; ++ct)
#pragma unroll
                      for (int q = 0; q < 4; ++q) part[(wave * 32 + 16 * rt + 4 * fq + q) * 48 + 16 * ct + fr] = acc[rt][ct][q]; }
            __syncthreads();
            for (int o = tid; o < 32 * 36; o += NTHR) { const int row = o / 36, c = o - row * 36; float sum = 0.f;
#pragma unroll
                for (int w8 = 0; w8 < 8; ++w8) sum += part[(w8 * 32 + row) * 48 + c];
                lgt[row * 40 + c] = sum * rsc[row]; }
            __syncthreads();
            if (tid < 32) { const int m = r0 + tid;
                float lg[36];
#pragma unroll
                for (int c = 0; c < 36; ++c) lg[c] = lgt[tid * 40 + c];
                int gs = 0; float gm = lg[0];
#pragma unroll
                for (int c = 1; c < 4; ++c) if (lg[c] > gm) { gm = lg[c]; gs = c; }
                float gsum = 0.f;
#pragma unroll
                for (int c = 0; c < 4; ++c) gsum += expf(lg[c] - gm);
                const float pg = 1.0f / gsum;
                float el[8];
#pragma unroll
                for (int c = 0; c < 8; ++c) el[c] = (gs == 0) ? lg[4 + c] : (gs == 1) ? lg[12 + c] : (gs == 2) ? lg[20 + c] : lg[28 + c];
                int i1 = 0; float m1 = el[0];
#pragma unroll
                for (int c = 1; c < 8; ++c) if (el[c] > m1) { m1 = el[c]; i1 = c; }
                int i2 = -1; float m2 = -3.0e38f;
#pragma unroll
                for (int c = 0; c < 8; ++c) if (c != i1 && el[c] > m2) { m2 = el[c]; i2 = c; }
                if (i2 < 0) i2 = (i1 == 0) ? 1 : 0;
                const float e2 = expf(m2 - m1), w1 = pg / (1.0f + e2), w2 = pg * e2 / (1.0f + e2);
                const int ea = gs * 8 + i1, eb = gs * 8 + i2;
                const int pa = (int)__hip_atomic_fetch_add((unsigned*)(F.ctl + CW_ECNT) + ea, 1u, RLX_AGENT), pb = (int)__hip_atomic_fetch_add((unsigned*)(F.ctl + CW_ECNT) + eb, 1u, RLX_AGENT);
                EID[2 * m] = ea; EID[2 * m + 1] = eb; POS[2 * m] = pa; POS[2 * m + 1] = pb; RW[2 * m] = w1; RW[2 * m + 1] = w2; }
            __syncthreads();
        }
        if (!conv_first) { __syncthreads(); conv7(); }
    }
    SEAM(7);

    LAS int* pstart = (LAS int*)(F.lds + LDSCTL_OFF);
    if (hi > 8 && lo <= 10) {
        if (threadIdx.x == 0) { int a = 0; for (int e = 0; e < NE; ++e) { pstart[e] = a; const int c = (int)__hip_atomic_load((unsigned*)(F.ctl + CW_ECNT) + e, RLX_AGENT); pstart[40 + e] = c; a += (c + 255) / 256 * 256; } pstart[NE] = a; }
        __syncthreads();
    }

    if (IN(8)) {
        TVARS
        const int* EID = (const int*)(ws + WS_ROUTE); const int* POS = EID + 2 * T; int* rs = (int*)(ws + WS_ROWSLOT);
        for (int s = gw; s < 2 * T; s += NGW) { const int dest = pstart[EID[s]] + POS[s];
            const v4u* src = (const v4u*)((const bf16*)(ws + WS_HFFN) + (size_t)(s >> 1) * D) + lane; v4u* dst = (v4u*)((bf16*)(ws + WS_XG) + (size_t)dest * D) + lane;
            v4u rowv[4];
#pragma unroll
            for (int j = 0; j < 4; ++j) rowv[j] = src[64 * j];
#pragma unroll
            for (int j = 0; j < 4; ++j) dst[64 * j] = rowv[j];
            if (lane == 0) __hip_atomic_store(rs + dest, s, RLX_AGENT); }
    }
    SEAM(8);

    if (IN(9) && FP9) {
        pg8::Gemm g{(const bf16*)(ws + WS_XG), (const bf16*)(ws + WS_WEGU), D, D, D}; pg8::MoeOrder S{(const LAS int*)pstart, 4, F.G, (int)blockIdx.x}; pg8::EpiMoe1 E{(bf16*)(ws + WS_HMOE)};
        pg8::gemm_phase<pg8::EpiMoe1, pg8::MoeOrder, PG8_ALIGN, PG8_SP2>(F.lds, g, S, E);
        { TVARS
          const int nun = (pstart[NE] >> 8) * 4, nbusy = nun > F.G ? nun - F.G : 0, c = (int)blockIdx.x;
          __syncthreads();
          if (c >= nbusy) { const int nh = F.G - nbusy, hr = c - nbusy; LAS float* scr = (LAS float*)(F.lds + wave * 16384);
              auto item9 = [&](int it) -> TrItem { TrItem q; const int e = it >> 9, r2 = it & 511, kb = r2 >> 6, nb = r2 & 63;
                  q.src = args.in[I_WED] + (size_t)e * DE * D + (size_t)(kb * 64) * D + nb * 32; q.ldw = D; q.dst = (bf16*)(ws + WS_WED) + (size_t)e * D * DE + (size_t)(nb * 32) * DE + kb * 64; q.ldt = DE; return q; };
              TR_PIPE(hr * NWAVES + wave, NE * 512, nh * NWAVES, item9); } }
    }
    if (IN(9) && !FP9) {
        TVARS
        const int ntile = pstart[NE] / 128;
        for (int it = F.vcu; it < ntile * (DE / 128); it += F.G) {
            const int tm = it / (DE / 128), tn = it % (DE / 128), tx = tid & 31, ty = tid >> 5; int e = 0;
            for (int q = 1; q < NE; ++q) if (pstart[q] <= tm * 128) e = q;
            float a1[8][4], a2[8][4]; zero_acc(a1); zero_acc(a2);
            sgemm_acc(a1, As, Bs, (const bf16*)(ws + WS_XG), D, tm * 128, args.in[I_WEG] + (size_t)e * D * DE, DE, tn * 128, D, tid);
            sgemm_acc(a2, As, Bs, (const bf16*)(ws + WS_XG), D, tm * 128, args.in[I_WEU] + (size_t)e * D * DE, DE, tn * 128, D, tid);
#pragma unroll
            for (int i = 0; i < 8; ++i) st_bf16x4((bf16*)(ws + WS_HMOE) + (size_t)(tm * 128 + ty * 8 + i) * DE + tn * 128 + tx * 4,
                siluf_(a1[i][0]) * a2[i][0], siluf_(a1[i][1]) * a2[i][1], siluf_(a1[i][2]) * a2[i][2], siluf_(a1[i][3]) * a2[i][3]);
        }
    }
    SEAM(9);

    if (IN(10) && FP10) {
        pg8::Gemm g{(const bf16*)(ws + WS_HMOE), (const bf16*)(ws + WS_WED), DE, DE, DE}; pg8::MoeOrder S{(const LAS int*)pstart, 8, F.G, (int)blockIdx.x}; pg8::EpiMoe2 E{(bf16*)(ws + WS_Y), (const int*)(ws + WS_ROWSLOT), (const LAS int*)pstart};
        pg8::gemm_phase<pg8::EpiMoe2, pg8::MoeOrder, PG8_ALIGN, PG8_SP2>(F.lds, g, S, E);
    }
    if (IN(10) && !FP10) {
        TVARS
        const int ntile = pstart[NE] / 128; const int* rs = (const int*)(ws + WS_ROWSLOT);
        for (int it = F.vcu; it < ntile * (D / 128); it += F.G) {
            const int tm = it / (D / 128), tn = it % (D / 128), tx = tid & 31, ty = tid >> 5; int e = 0;
            for (int q = 1; q < NE; ++q) if (pstart[q] <= tm * 128) e = q;
            float acc[8][4]; zero_acc(acc);
            sgemm_acc(acc, As, Bs, (const bf16*)(ws + WS_HMOE), DE, tm * 128, args.in[I_WED] + (size_t)e * DE * D, D, tn * 128, DE, tid);
#pragma unroll
            for (int i = 0; i < 8; ++i) { const int prow = tm * 128 + ty * 8 + i;
                if (prow - pstart[e] < pstart[40 + e]) st_bf16x4((bf16*)(ws + WS_Y) + (size_t)__hip_atomic_load((int*)rs + prow, RLX_AGENT) * D + tn * 128 + tx * 4, acc[i][0], acc[i][1], acc[i][2], acc[i][3]); }
        }
    }
    SEAM(10);

    if (IN(11)) {
        TVARS
        const float* gpl = args.in[I_NPLE]; const float* RW = (const float*)((const int*)(ws + WS_ROUTE) + 4 * T);
        for (int m = gw; m < T; m += NGW) {
            v2u* xr = (v2u*)((bf16*)(ws + WS_XR) + (size_t)m * D) + lane; const f32x4* gr = (const f32x4*)gpl + lane;
            const v2u* ya = (const v2u*)((const bf16*)(ws + WS_Y) + (size_t)(2 * m) * D) + lane; const v2u* yb = (const v2u*)((const bf16*)(ws + WS_Y) + (size_t)(2 * m + 1) * D) + lane;
            const float wa = RW[2 * m], wb = RW[2 * m + 1];
            f32x4 v[8]; float s = 0.f;
#pragma unroll
            for (int j = 0; j < 8; ++j) { const v2u w2 = xr[64 * j]; v[j].x = bflo(w2.x); v[j].y = bfhi(w2.x); v[j].z = bflo(w2.y); v[j].w = bfhi(w2.y); }
            v2u ay[8], by[8]; f32x4 g8[8];
#pragma unroll
            for (int j = 0; j < 8; ++j) { ay[j] = ya[64 * j]; by[j] = yb[64 * j]; g8[j] = gr[64 * j]; }
#pragma unroll
            for (int j = 0; j < 8; ++j) { const v2u a = ay[j], b = by[j];
                v[j].x += bflo(a.x) * wa + bflo(b.x) * wb; v[j].y += bfhi(a.x) * wa + bfhi(b.x) * wb; v[j].z += bflo(a.y) * wa + bflo(b.y) * wb; v[j].w += bfhi(a.y) * wa + bfhi(b.y) * wb;
                { v2u w2; w2.x = pk2(v[j].x, v[j].y); w2.y = pk2(v[j].z, v[j].w); xr[64 * j] = w2; } s += (v[j].x * v[j].x + v[j].y * v[j].y) + (v[j].z * v[j].z + v[j].w * v[j].w); }
            const float r = 1.0f / sqrtf(wave_sum(s) * (1.f / D) + EPS);
            unsigned long long* o8 = (unsigned long long*)((bf16*)(ws + WS_HP) + (size_t)m * D) + lane;
#pragma unroll
            for (int j = 0; j < 8; ++j) { const f32x4 gg = g8[j];
                o8[64 * j] = (unsigned long long)pk2(v[j].x * r * gg.x, v[j].y * r * gg.y) | ((unsigned long long)pk2(v[j].z * r * gg.z, v[j].w * r * gg.w) << 32); }
        }
    }
    SEAM(11);

    if (IN(12) && FP12) {
        pg8::Gemm g{(const bf16*)(ws + WS_HP), (const bf16*)(ws + WS_WPG_T), D, D, D}; pg8::StaticOrder S; S.init(T, D, F.G, (int)blockIdx.x);
        pg8::EpiResidB<1> E{nullptr, (bf16*)(ws + WS_XR), (const bf16*)(ws + WS_PP)};
        pg8::gemm_phase<pg8::EpiResidB<1>, pg8::StaticOrder, false, PG8_SP2>(F.lds, g, S, E);
    }
    if (IN(12) && !FP12) {
        TVARS
        const bf16* HP = (const bf16*)(ws + WS_HP); const bf16* PP = (const bf16*)(ws + WS_PP);
        for (int it = F.vcu; it < (T / 128) * (D / 128); it += F.G) {
            const int tm = it / (D / 128), tn = it % (D / 128), tx = tid & 31, ty = tid >> 5;
            float acc[8][4]; zero_acc(acc);
            sgemm_acc(acc, As, Bs, HP, D, tm * 128, args.in[I_WPG], D, tn * 128, D, tid);
#pragma unroll
            for (int i = 0; i < 8; ++i) { const size_t off = (size_t)(tm * 128 + ty * 8 + i) * D + tn * 128 + tx * 4; const f32x4 xv = *(const f32x4*)(out + off); const v2u pp = *(const v2u*)(PP + off);
                f32x4 o; o.x = xv.x + sigmoidf_(acc[i][0]) * bflo(pp.x); o.y = xv.y + sigmoidf_(acc[i][1]) * bfhi(pp.x); o.z = xv.z + sigmoidf_(acc[i][2]) * bflo(pp.y); o.w = xv.w + sigmoidf_(acc[i][3]) * bfhi(pp.y);
                *(f32x4*)(out + off) = o; }
        }
    }
    SEAM(12);

    if (IN(13)) {
        TVARS
        const float* gf = args.in[I_NFIN];
        for (int m = gw; m < T; m += NGW) {
            f32x4* xr = (f32x4*)(out + (size_t)m * D) + lane; const f32x4* gr = (const f32x4*)gf + lane; const v2u* xb = (const v2u*)((const bf16*)(ws + WS_XR) + (size_t)m * D) + lane;
            f32x4 v[8]; float s = 0.f;
#pragma unroll
            for (int j = 0; j < 8; ++j) { const v2u w2 = xb[64 * j]; v[j].x = bflo(w2.x); v[j].y = bfhi(w2.x); v[j].z = bflo(w2.y); v[j].w = bfhi(w2.y); s += (v[j].x * v[j].x + v[j].y * v[j].y) + (v[j].z * v[j].z + v[j].w * v[j].w); }
            f32x4 g8[8];
#pragma unroll
            for (int j = 0; j < 8; ++j) g8[j] = gr[64 * j];
            const float r = 1.0f / sqrtf(wave_sum(s) * (1.f / D) + EPS);
#pragma unroll
            for (int j = 0; j < 8; ++j) { const f32x4 gg = g8[j]; f32x4 o; o.x = v[j].x * r * gg.x; o.y = v[j].y * r * gg.y; o.z = v[j].z * r * gg.z; o.w = v[j].w * r * gg.w; xr[64 * j] = o; }
        }
    }
#undef IN
#undef SEAM
}

extern "C" void kernel_launch(void* const* d_in, const int* in_sizes, int n_in, void* d_out, int out_size, void* d_ws, size_t ws_size, hipStream_t stream) {
    static int grid = 0;
    if (grid == 0) {
        if (n_in != 19 || in_sizes[0] != T * D || out_size != T * D || ws_size < WS_END) { fprintf(stderr, "kernel_launch: shape/workspace mismatch: n_in %d in0 %d out %d ws %zu (need %zu)\n", n_in, n_in > 0 ? in_sizes[0] : -1, out_size, ws_size, (size_t)WS_END); grid = -1; return; }
        int dev = 0, cus = 0, per_cu = 0;
        if (hipGetDevice(&dev) != hipSuccess || hipDeviceGetAttribute(&cus, hipDeviceAttributeMultiprocessorCount, dev) != hipSuccess) { grid = -1; return; }
        if (hipFuncSetAttribute((const void*)fwd, hipFuncAttributeMaxDynamicSharedMemorySize, LDS_BYTES) != hipSuccess) { fprintf(stderr, "kernel_launch: hipFuncSetAttribute failed\n"); grid = -1; return; }
        if (hipOccupancyMaxActiveBlocksPerMultiprocessor(&per_cu, (const void*)fwd, NTHR, LDS_BYTES) != hipSuccess || per_cu < 1) { fprintf(stderr, "kernel_launch: occupancy query says %d blocks per CU\n", per_cu); (void)hipGetLastError(); grid = -1; return; }
        grid = cus;
    }
    if (grid < 0) return;
    if (hipMemsetAsync((char*)d_ws + WS_CTL, 0, CTL_ZERO_BYTES, stream) != hipSuccess) return;
    Args a{};
    for (int i = 0; i < 19; ++i) a.in[i] = (const float*)d_in[i];
    a.out = (float*)d_out; a.ws = (unsigned char*)d_ws; a.pad = MBRT;
    for (int j = 0; j < 64; ++j) a.rfreq[j] = std::pow(10000.0, -(double)j / 64.0) / 6.283185307179586476925286766559;
    constexpr int NL = MK_N_LAUNCHES;
    for (int li = 0; li < NL; ++li) {
        a.ph_lo = (NL == 1) ? 0 : li; a.ph_hi = (NL == 1) ? N_PHASES : li + 1; a.li = 0;
        hipLaunchKernelGGL(fwd, dim3(grid), dim3(NTHR), LDS_BYTES, stream, a);
    }
}
```

```cpp
#include <hip/hip_runtime.h>
#include <cstdio>
#include <cstdint>
#include <cmath>

#define GAS __attribute__((address_space(1)))
#define LAS __attribute__((address_space(3)))
typedef unsigned short bf16;
typedef unsigned v4u __attribute__((ext_vector_type(4)));
typedef unsigned v2u __attribute__((ext_vector_type(2)));
typedef float f32x4 __attribute__((ext_vector_type(4)));
typedef float f32x2 __attribute__((ext_vector_type(2)));
typedef short bf16x8 __attribute__((ext_vector_type(8)));

constexpr int T = 8192, D = 2048, HW = 1024, NH = 8, HD = 128, INC = 11264, NE = 32, DE = 512, PLE = 256, NB = 32, BS = 256;
constexpr float EPS = 1e-6f;
constexpr int NWAVES = 8, NTHR = 512;
constexpr int N_PHASES = 14;
#ifndef FP1
#define FP1 1
#endif
#ifndef FP5
#define FP5 1
#endif
#ifndef FP6
#define FP6 1
#endif
#ifndef FP9
#define FP9 1
#endif
#ifndef FP10
#define FP10 1
#endif
#ifndef FP12
#define FP12 1
#endif
#ifndef FHG
#define FHG 1
#endif
#ifndef FMB
#define FMB 1
#endif
#ifndef MK_N_LAUNCHES
#define MK_N_LAUNCHES 1
#endif

constexpr size_t MiB = 1u << 20;
constexpr size_t WS_CTL = 0, CTL_ZERO_BYTES = 64 * 1024;
constexpr size_t WS_TRIG = 2 * MiB;
constexpr size_t WS_KMEAN = 6 * MiB;
constexpr size_t WS_LB = 6 * MiB + 384 * 1024;
constexpr size_t WS_WRT = 6 * MiB + 512 * 1024;
constexpr size_t WS_ROUTE = 7 * MiB;
constexpr size_t WS_ROWSLOT = 8 * MiB;
constexpr size_t WS_PB = 10 * MiB;
constexpr size_t WS_WIN_T = 16 * MiB, WS_WUP_T = 60 * MiB, WS_WOUT_T = 68 * MiB, WS_WPG_T = 76 * MiB, WS_WPP_T = 84 * MiB;
constexpr size_t WS_PP = 86 * MiB;
constexpr size_t WS_GA = 118 * MiB, WS_GB = 150 * MiB;
constexpr size_t WS_QH = 182 * MiB;
constexpr size_t WS_GH = 198 * MiB;
constexpr size_t WS_RN = 9 * MiB;
constexpr size_t WS_XR = 16 * MiB;
constexpr size_t WS_VH = 230 * MiB, WS_OG = 246 * MiB, WS_MQ = 262 * MiB, WS_MK = 278 * MiB, WS_MV = 294 * MiB;
constexpr size_t WS_H1 = 310 * MiB;
constexpr size_t WS_TMPF = 342 * MiB;
constexpr size_t WS_DEC = 14 * MiB;
constexpr size_t WS_ST = 310 * MiB;
constexpr size_t WS_DS = 342 * MiB;
constexpr size_t WS_PO = 406 * MiB;
constexpr size_t WS_PLSE = 544 * MiB;
constexpr size_t WS_MLIST = 504 * MiB;
constexpr size_t WS_CNTP = 9 * MiB;
constexpr size_t WS_AUP = 472 * MiB;
constexpr size_t WS_MERGED = 504 * MiB;
constexpr size_t WS_HFFN = 310 * MiB;
constexpr size_t WS_XG = 342 * MiB;
constexpr size_t WS_HMOE = 438 * MiB;
constexpr size_t WS_Y = 462 * MiB;
constexpr size_t WS_HP = 342 * MiB;
constexpr size_t WS_WEGU = 118 * MiB;
constexpr size_t WS_WED = 246 * MiB;
constexpr size_t WS_END = 576 * MiB;
constexpr int CW_TMO = 0, CW_CODE = 1;
constexpr int CW_ECNT = 64;
constexpr int CW_MCNT = 128;
constexpr int CW_BAR = 4096;

constexpr int RING_BYTES = 131072;
constexpr int LDSCTL_OFF = RING_BYTES, MISC_OFF = LDSCTL_OFF + 320;
constexpr int LDS_BYTES = 147456;

typedef GAS unsigned gu32;
#define RLX_AGENT __ATOMIC_RELAXED, __HIP_MEMORY_SCOPE_AGENT
#define LDS_WAIT() asm volatile("s_waitcnt lgkmcnt(0)" ::: "memory")
#define VM_WAIT() asm volatile("s_waitcnt vmcnt(0)" ::: "memory")
typedef __bf16 hwbf2 __attribute__((ext_vector_type(2)));
__device__ __forceinline__ unsigned pk2(float lo, float hi) { hwbf2 v; v.x = (__bf16)lo; v.y = (__bf16)hi; return __builtin_bit_cast(unsigned, v); }
__device__ __forceinline__ unsigned f2bf(float f) { return pk2(f, 0.f) & 0xffffu; }
__device__ __forceinline__ float bf2f(unsigned b) { return __builtin_bit_cast(float, b << 16); }
__device__ __forceinline__ float bflo(unsigned w) { return __builtin_bit_cast(float, w << 16); }
__device__ __forceinline__ float bfhi(unsigned w) { return __builtin_bit_cast(float, w & 0xffff0000u); }
__device__ __forceinline__ float sigmoidf_(float x) { return 1.0f / (1.0f + __expf(-x)); }
__device__ __forceinline__ float siluf_(float x) { return x / (1.0f + __expf(-x)); }

#define XB_TMO      128
#define XB_XCNT(j)  (256  + 64 * (j))
#define XB_XSUB(j)  (1280 + 64 * (j))
#define XB_XGEN(j)  (2304 + 64 * (j))
#define XB_TOP      3328
#define XB_TOPGEN   3392
#define XCD_BAR_WORDS 3456
#define XB_SPIN_CAP (1u << 25)
__device__ __forceinline__ unsigned xb_ld(unsigned* p)              { return __hip_atomic_load(p, __ATOMIC_RELAXED, __HIP_MEMORY_SCOPE_AGENT); }
__device__ __forceinline__ unsigned xb_add(unsigned* p, unsigned v) { return __hip_atomic_fetch_add(p, v, __ATOMIC_RELAXED, __HIP_MEMORY_SCOPE_AGENT); }
__device__ __forceinline__ unsigned xb_xcc_id() { return (unsigned)__builtin_amdgcn_s_getreg((3 << 11) | 20) & 0xFu; }
#define XB_SPIN(cond, bar) do { unsigned _sp = 0; while (cond) { __builtin_amdgcn_s_sleep(1); \
    if ((++_sp & 255u) == 0u) { if (xb_ld(&(bar)[XB_TMO])) break; if (_sp > XB_SPIN_CAP) { atomicAdd(&(bar)[XB_TMO], 1u); break; } } } } while (0)
struct XcdBarrier { unsigned* bar; unsigned x; volatile LAS unsigned* st; };
__device__ __forceinline__ XcdBarrier xcd_barrier_post(unsigned* bar, volatile LAS unsigned* st) {
    XcdBarrier b; b.bar = bar; b.x = xb_xcc_id(); b.st = st;
    if (threadIdx.x == 0) (void)xb_add(&bar[XB_XCNT(b.x)], 1u);
    return b;
}
__device__ __forceinline__ void xcd_barrier_complete(unsigned* bar, unsigned x, unsigned& nloc, unsigned& nx) {
    const unsigned G = gridDim.x * gridDim.y * gridDim.z;
    unsigned sum, cnt, mine, sp = 0u;
    for (;;) {
        sum = 0u; cnt = 0u; mine = 0u;
#pragma unroll
        for (unsigned j = 0; j < 16; ++j) { const unsigned c = xb_ld(&bar[XB_XCNT(j)]); sum += c; cnt += (c > 0u) ? 1u : 0u; mine = (j == x) ? c : mine; }
        if (sum == G) break;
        __builtin_amdgcn_s_sleep(1);
        if ((++sp & 255u) == 0u) { if (xb_ld(&bar[XB_TMO])) break; if (sp > XB_SPIN_CAP) { atomicAdd(&bar[XB_TMO], 1u); break; } }
    }
    nloc = mine > 0u ? mine : 1u; nx = cnt > 0u ? cnt : 1u;
}
__device__ __forceinline__ void xcd_barrier(const XcdBarrier& b) {
    asm volatile("s_waitcnt vmcnt(0)" ::: "memory");
    __syncthreads();
    if (threadIdx.x == 0) {
        unsigned* bar = b.bar;
        __builtin_amdgcn_s_waitcnt(0);
        unsigned nloc = b.st[0], nx = b.st[1];
        if (nloc == 0u) { xcd_barrier_complete(bar, b.x, nloc, nx); b.st[0] = nloc; b.st[1] = nx; }
        const unsigned old = xb_add(&bar[XB_XSUB(b.x)], 1u);
        const unsigned gen = old / nloc;
        if (old + 1u == (gen + 1u) * nloc) {
            __builtin_amdgcn_fence(__ATOMIC_RELEASE, "agent");
            asm volatile("s_waitcnt vmcnt(0)" ::: "memory");
            const unsigned og = xb_add(&bar[XB_TOP], 1u);
            const unsigned tg = og / nx;
            if (og + 1u == (tg + 1u) * nx) xb_add(&bar[XB_TOPGEN], 1u);
            else XB_SPIN(xb_ld(&bar[XB_TOPGEN]) == tg, bar);
            __builtin_amdgcn_fence(__ATOMIC_ACQUIRE, "agent");
            xb_add(&bar[XB_XGEN(b.x)], 1u);
            asm volatile("s_waitcnt vmcnt(0)" ::: "memory");
        } else {
            XB_SPIN(xb_ld(&bar[XB_XGEN(b.x)]) == gen, bar);
            __builtin_amdgcn_fence(__ATOMIC_ACQUIRE, "agent");
            asm volatile("s_waitcnt vmcnt(0)" ::: "memory");
        }
    }
    __syncthreads();
}

struct Args { const float* in[19]; float* out; unsigned char* ws; double rfreq[64]; int ph_lo, ph_hi, li, pad; };
enum { I_X = 0, I_P, I_NMIX, I_WIN, I_LBRAW, I_HNG, I_WUH, I_WUM, I_WOUT, I_NFFN, I_WRG, I_WRE, I_WEG, I_WEU, I_WED, I_NPLE, I_WPG, I_WPP, I_NFIN };

struct Frame {
    LAS unsigned char* lds;
    volatile LAS unsigned* MISC;
    gu32* ctl;
    int tid, lane, wave, vcu, G;
    unsigned char* ws;
};

__device__ __forceinline__ int opaque_tid() { int t = threadIdx.x; asm volatile("" : "+v"(t)); return t; }
__device__ __forceinline__ float wave_sum(float v) {
#pragma unroll
    for (int o = 1; o < 64; o <<= 1) v += __shfl_xor(v, o);
    return v;
}
__device__ __forceinline__ float wave_max(float v) {
#pragma unroll
    for (int o = 1; o < 64; o <<= 1) v = fmaxf(v, __shfl_xor(v, o));
    return v;
}

__device__ __forceinline__ void rms_row_to_bf16(int lane, const float* xrow, const float* g, bf16* orow) {
    const f32x4* xr = (const f32x4*)xrow + lane; const f32x4* gr = (const f32x4*)g + lane;
    f32x4 v[8]; float s = 0.f;
#pragma unroll
    for (int j = 0; j < 8; ++j) { v[j] = xr[64 * j]; s += (v[j].x * v[j].x + v[j].y * v[j].y) + (v[j].z * v[j].z + v[j].w * v[j].w); }
    f32x4 g8[8];
#pragma unroll
    for (int j = 0; j < 8; ++j) g8[j] = gr[64 * j];
    const float r = 1.0f / sqrtf(wave_sum(s) * (1.f / D) + EPS);
    unsigned long long* o8 = (unsigned long long*)orow + lane;
#pragma unroll
    for (int j = 0; j < 8; ++j) { const f32x4 gg = g8[j];
        o8[64 * j] = (unsigned long long)pk2(v[j].x * r * gg.x, v[j].y * r * gg.y) | ((unsigned long long)pk2(v[j].z * r * gg.z, v[j].w * r * gg.w) << 32); }
}

__device__ __forceinline__ void sgemm_acc(float (&acc)[8][4], LAS float* As, LAS float* Bs, const bf16* A, int lda, int m0, const float* W, int ldb, int n0, int K, int tid) {
    const int tx = tid & 31, ty = tid >> 5;
    const int ar = tid >> 2, akq = tid & 3;
    for (int k0 = 0; k0 < K; k0 += 16) {
        const v2u av = *(const v2u*)(A + (size_t)(m0 + ar) * lda + k0 + akq * 4);
        const f32x4 bv = *(const f32x4*)(W + (size_t)(k0 + ty) * ldb + n0 + tx * 4);
        __syncthreads();
        As[(akq * 4 + 0) * 132 + ar] = bflo(av.x); As[(akq * 4 + 1) * 132 + ar] = bfhi(av.x);
        As[(akq * 4 + 2) * 132 + ar] = bflo(av.y); As[(akq * 4 + 3) * 132 + ar] = bfhi(av.y);
        *(LAS f32x4*)(Bs + ty * 128 + tx * 4) = bv;
        __syncthreads();
#pragma unroll 4
        for (int kk = 0; kk < 16; ++kk) {
            const f32x4 a0 = *(const LAS f32x4*)(As + kk * 132 + ty * 8), a1 = *(const LAS f32x4*)(As + kk * 132 + ty * 8 + 4);
            const f32x4 b = *(const LAS f32x4*)(Bs + kk * 128 + tx * 4);
            const float a[8] = {a0.x, a0.y, a0.z, a0.w, a1.x, a1.y, a1.z, a1.w};
#pragma unroll
            for (int i = 0; i < 8; ++i) { acc[i][0] += a[i] * b.x; acc[i][1] += a[i] * b.y; acc[i][2] += a[i] * b.z; acc[i][3] += a[i] * b.w; }
        }
    }
    __syncthreads();
}
__device__ __forceinline__ void zero_acc(float (&acc)[8][4]) {
#pragma unroll
    for (int i = 0; i < 8; ++i) { acc[i][0] = 0.f; acc[i][1] = 0.f; acc[i][2] = 0.f; acc[i][3] = 0.f; }
}
__device__ __forceinline__ void st_bf16x4(bf16* p, float a, float b, float c, float d) { v2u w; w.x = pk2(a, b); w.y = pk2(c, d); *(v2u*)p = w; }

__device__ __forceinline__ void inproj_epi(unsigned char* ws, int m, int n, const float (&v)[4]) {
    if (n < 1024) { st_bf16x4((bf16*)(ws + WS_QH) + (size_t)m * HW + n, siluf_(v[0]), siluf_(v[1]), siluf_(v[2]), siluf_(v[3])); }
    else if (n < 2048) { const int c = n - 1024; const f32x4 lb = *(const f32x4*)((const float*)(ws + WS_LB) + c);
        f32x4 o; o.x = __logf(lb.x + (1.f - lb.x) * sigmoidf_(v[0])); o.y = __logf(lb.y + (1.f - lb.y) * sigmoidf_(v[1]));
        o.z = __logf(lb.z + (1.f - lb.z) * sigmoidf_(v[2])); o.w = __logf(lb.w + (1.f - lb.w) * sigmoidf_(v[3]));
        *(f32x4*)((float*)(ws + WS_GH) + (size_t)m * HW + c) = o; }
    else if (n < 3072) { st_bf16x4((bf16*)(ws + WS_VH) + (size_t)m * HW + (n - 2048), v[0], v[1], v[2], v[3]); }
    else if (n < 4096) { st_bf16x4((bf16*)(ws + WS_OG) + (size_t)m * HW + (n - 3072), siluf_(v[0]), siluf_(v[1]), siluf_(v[2]), siluf_(v[3])); }
    else if (n < 6144) { f32x4 o = {v[0], v[1], v[2], v[3]}; *(f32x4*)((float*)(ws + WS_TMPF) + (size_t)m * D + (n - 4096)) = o; }
    else if (n < 7168) { st_bf16x4((bf16*)(ws + WS_MV) + (size_t)m * HW + (n - 6144), v[0], v[1], v[2], v[3]); }
    else if (n < 9216) { st_bf16x4((bf16*)(ws + WS_GA) + (size_t)m * D + (n - 7168), sigmoidf_(v[0]), sigmoidf_(v[1]), sigmoidf_(v[2]), sigmoidf_(v[3])); }
    else { st_bf16x4((bf16*)(ws + WS_GB) + (size_t)m * D + (n - 9216), sigmoidf_(v[0]), sigmoidf_(v[1]), sigmoidf_(v[2]), sigmoidf_(v[3])); }
}


__device__ __forceinline__ void transpose_item(const float* W, int ldw, int k0, int sn0, bf16* WT, int ldt, int drow0, int dcol0, LAS float* scr, int lane) {
#pragma unroll 8
    for (int i = 0; i < 32; ++i) { const int kk = 2 * i + (lane >> 5); scr[kk * 33 + (lane & 31)] = W[(size_t)(k0 + kk) * ldw + sn0 + (lane & 31)]; }
    LDS_WAIT(); asm volatile("" ::: "memory");
    const int c = lane & 7;
#pragma unroll
    for (int j = 0; j < 4; ++j) { const int n = (lane >> 3) + 8 * j; const LAS float* sp = scr + (8 * c) * 33 + n;
        v4u o; o.x = pk2(sp[0 * 33], sp[1 * 33]); o.y = pk2(sp[2 * 33], sp[3 * 33]); o.z = pk2(sp[4 * 33], sp[5 * 33]); o.w = pk2(sp[6 * 33], sp[7 * 33]);
        *(v4u*)(WT + (size_t)(drow0 + n) * ldt + dcol0 + 8 * c) = o; }
    LDS_WAIT(); asm volatile("" ::: "memory");
}
struct TrItem { const float* src; bf16* dst; int ldw, ldt; const float* gk; };
__device__ __forceinline__ void tr_load(f32x4 (&v)[8], const float* src, int ldw, int lane) {
    const int kr = lane >> 3, c4 = 4 * (lane & 7);
#pragma unroll
    for (int i = 0; i < 8; ++i) v[i] = *(const f32x4*)(src + (size_t)(8 * i + kr) * ldw + c4);
}
__device__ __forceinline__ void tr_store(const f32x4 (&v)[8], bf16* dst, int ldt, LAS float* scr, int lane) {
    const int kr = lane >> 3, c4 = 4 * (lane & 7);
#pragma unroll
    for (int i = 0; i < 8; ++i) { LAS float* d = scr + (8 * i + kr) * 33 + c4; d[0] = v[i].x; d[1] = v[i].y; d[2] = v[i].z; d[3] = v[i].w; }
    LDS_WAIT(); asm volatile("" ::: "memory");
    const int c = lane & 7;
#pragma unroll
    for (int j = 0; j < 4; ++j) { const int n = (lane >> 3) + 8 * j; const LAS float* sp = scr + (8 * c) * 33 + n;
        v4u o; o.x = pk2(sp[0 * 33], sp[1 * 33]); o.y = pk2(sp[2 * 33], sp[3 * 33]); o.z = pk2(sp[4 * 33], sp[5 * 33]); o.w = pk2(sp[6 * 33], sp[7 * 33]);
        *(v4u*)(dst + (size_t)n * ldt + 8 * c) = o; }
    LDS_WAIT(); asm volatile("" ::: "memory");
}
__device__ __forceinline__ void tr_scale(f32x4 (&v)[8], const float* gk, int lane) {
    const int kr = lane >> 3; float gq[8];
#pragma unroll
    for (int i = 0; i < 8; ++i) gq[i] = gk[8 * i + kr];
#pragma unroll
    for (int i = 0; i < 8; ++i) { v[i].x *= gq[i]; v[i].y *= gq[i]; v[i].z *= gq[i]; v[i].w *= gq[i]; }
}
#define TR_PIPE(first, N, step, ITEM) do { f32x4 va_[8], vb_[8]; TrItem ia_, ib_; int it_ = (first); \
    if (it_ < (N)) { ia_ = ITEM(it_); tr_load(va_, ia_.src, ia_.ldw, lane); } \
    while (it_ < (N)) { const int i2_ = it_ + (step); \
        if (i2_ < (N)) { ib_ = ITEM(i2_); tr_load(vb_, ib_.src, ib_.ldw, lane); } \
        if (ia_.gk) tr_scale(va_, ia_.gk, lane); \
        tr_store(va_, ia_.dst, ia_.ldt, scr, lane); \
        if (i2_ >= (N)) break; \
        const int i3_ = i2_ + (step); \
        if (i3_ < (N)) { ia_ = ITEM(i3_); tr_load(va_, ia_.src, ia_.ldw, lane); } \
        if (ib_.gk) tr_scale(vb_, ib_.gk, lane); \
        tr_store(vb_, ib_.dst, ib_.ldt, scr, lane); \
        it_ = i3_; } } while (0)

__device__ __forceinline__ int phys2log_inproj(int n0) {
    const int tile = n0 >> 8; if (tile < 16 || tile >= 24) return n0;
    const int p = n0 & 255, bj = p >> 7, q = p & 127, head = 2 * ((tile - 16) & 3) + (q >> 6), d = (q & 63) + 64 * bj, which = (tile - 16) >> 2;
    return 4096 + which * 1024 + head * 128 + d;
}


typedef short v4i16_t __attribute__((ext_vector_type(4)));
__device__ __forceinline__ f32x4 mfma16(bf16x8 a, bf16x8 b, f32x4 c) { return __builtin_amdgcn_mfma_f32_16x16x32_bf16(a, b, c, 0, 0, 0); }
constexpr int HG_RED = 0, HG_BR = 2048, HG_RS = 2560, HG_KT = 4096, HG_VT = HG_KT + 128 * 144, HG_Q1 = HG_VT + 128 * 144, HG_K1 = HG_Q1 + 64 * 272, HG_Q2 = HG_K1 + 64 * 272, HG_P = HG_Q2 + 64 * 272;
static_assert(HG_P + 64 * 144 <= 131072, "hgrn lds");

__device__ __forceinline__ void hgrn_cumsum(const float* G, int col, int qt, LAS float* red, float (&gv)[16], float (&b)[16], float& btot) {
    float run = 0.f;
#pragma unroll
    for (int i = 0; i < 16; ++i) { gv[i] = G[(size_t)(16 * qt + i) * HW + col]; }
#pragma unroll
    for (int i = 0; i < 16; ++i) { run += gv[i]; b[i] = run; }
    red[qt * 128 + col] = run;
    __syncthreads();
    const float r0 = red[col], r1 = red[128 + col], r2 = red[256 + col], r3 = red[384 + col];
    const float pre = (qt > 0 ? r0 : 0.f) + (qt > 1 ? r1 : 0.f) + (qt > 2 ? r2 : 0.f);
    btot = ((r0 + r1) + r2) + r3;
#pragma unroll
    for (int i = 0; i < 16; ++i) b[i] += pre;
}
__device__ __forceinline__ void st_lds_bf16x16(LAS unsigned char* p, const float (&v)[16]) {
    v4u a, b; a.x = pk2(v[0], v[1]); a.y = pk2(v[2], v[3]); a.z = pk2(v[4], v[5]); a.w = pk2(v[6], v[7]); b.x = pk2(v[8], v[9]); b.y = pk2(v[10], v[11]); b.z = pk2(v[12], v[13]); b.w = pk2(v[14], v[15]);
    *(LAS v4u*)p = a; *(LAS v4u*)(p + 16) = b;
}
__device__ __forceinline__ void hgrn_pass_a(unsigned char* ws, LAS unsigned char* lds, int item, int tid) {
    const int c = item >> 3, h = item & 7, col = tid & 127, qt = tid >> 7, lane = tid & 63, w = tid >> 6, t0 = c * 64;
    float gv[16], b[16], btot;
    hgrn_cumsum((const float*)(ws + WS_GH) + (size_t)t0 * HW + h * HD, col, qt, (LAS float*)(lds + HG_RED), gv, b, btot);
    float kt[16], vv[16];
    const bf16* VH = (const bf16*)(ws + WS_VH) + (size_t)(t0 + 16 * qt) * HW + h * HD + col;
#pragma unroll
    for (int i = 0; i < 16; ++i) { kt[i] = (1.f - __expf(gv[i])) * __expf(btot - b[i]); vv[i] = bf2f(VH[(size_t)i * HW]); }
    st_lds_bf16x16(lds + HG_KT + col * 144 + qt * 32, kt); st_lds_bf16x16(lds + HG_VT + col * 144 + qt * 32, vv);
    if (qt == 0) ((float*)(ws + WS_DEC))[(size_t)item * HD + col] = __expf(btot);
    __syncthreads();
    const int fr = lane & 15, fq = lane >> 4;
    const bf16x8 a0 = *(const LAS bf16x8*)(lds + HG_KT + (16 * w + fr) * 144 + fq * 16), a1 = *(const LAS bf16x8*)(lds + HG_KT + (16 * w + fr) * 144 + fq * 16 + 64);
    bf16* dst = (bf16*)(ws + WS_DS) + (size_t)item * HD * HD + 16 * w + 4 * fq;
#pragma unroll
    for (int nt = 0; nt < 8; ++nt) {
        const bf16x8 b0 = *(const LAS bf16x8*)(lds + HG_VT + (16 * nt + fr) * 144 + fq * 16), b1 = *(const LAS bf16x8*)(lds + HG_VT + (16 * nt + fr) * 144 + fq * 16 + 64);
        f32x4 acc = {0.f, 0.f, 0.f, 0.f}; acc = mfma16(a0, b0, acc); acc = mfma16(a1, b1, acc);
        { v2u wv; wv.x = pk2(acc[0], acc[1]); wv.y = pk2(acc[2], acc[3]); *(v2u*)(dst + (size_t)(16 * nt + fr) * HD) = wv; }
    }
    __syncthreads();
}
__device__ __forceinline__ void hgrn_pass_c(unsigned char* ws, LAS unsigned char* lds, const float* ng, int item, int tid) {
    const int c = item >> 3, h = item & 7, col = tid & 127, qt = tid >> 7, lane = tid & 63, w = tid >> 6, t0 = c * 64, fr = lane & 15, fq = lane >> 4;
    const int fr_ = lane & 15, fq_ = lane >> 4, mt_ = w & 3, vh_ = w >> 2;
    bf16 qraw[16], vraw[16];
    { const bf16* QHp = (const bf16*)(ws + WS_QH) + (size_t)(t0 + 16 * qt) * HW + h * HD + col; const bf16* VHp = (const bf16*)(ws + WS_VH) + (size_t)(t0 + 16 * qt) * HW + h * HD + col;
#pragma unroll
      for (int i = 0; i < 16; ++i) { qraw[i] = QHp[(size_t)i * HW]; vraw[i] = VHp[(size_t)i * HW]; } }
    bf16x8 stf[4][4];
    { const bf16* STp = (const bf16*)(ws + WS_ST) + (size_t)item * HD * HD;
#pragma unroll
      for (int nt = 0; nt < 4; ++nt)
#pragma unroll
          for (int ks = 0; ks < 4; ++ks) stf[nt][ks] = *(const bf16x8*)(STp + (size_t)(16 * (4 * vh_ + nt) + fr_) * HD + fq_ * 8 + ks * 32); }
    bf16 ograw[4][4]; float ngv[4];
#pragma unroll
    for (int nt = 0; nt < 4; ++nt) ngv[nt] = ng[16 * (4 * vh_ + nt) + fr_];
#pragma unroll
    for (int r = 0; r < 4; ++r)
#pragma unroll
        for (int nt = 0; nt < 4; ++nt) ograw[r][nt] = ((const bf16*)(ws + WS_OG))[(size_t)(t0 + 16 * mt_ + 4 * fq_ + r) * HW + h * HD + 16 * (4 * vh_ + nt) + fr_];
    float gv[16], b[16], btot;
    hgrn_cumsum((const float*)(ws + WS_GH) + (size_t)t0 * HW + h * HD, col, qt, (LAS float*)(lds + HG_RED), gv, b, btot);
    LAS float* BR = (LAS float*)(lds + HG_BR);
    if (qt == 1) BR[col] = b[15];
    float vv[16];
#pragma unroll
    for (int i = 0; i < 16; ++i) vv[i] = bf2f(vraw[i]);
    st_lds_bf16x16(lds + HG_VT + col * 144 + qt * 32, vv);
    __syncthreads();
    const float bref = BR[col];
    {
#pragma unroll
      for (int i = 0; i < 16; ++i) { const float q = bf2f(qraw[i]); const int s = 16 * qt + i;
          *(LAS bf16*)(lds + HG_Q1 + s * 272 + col * 2) = (bf16)f2bf(q * __expf(b[i] - bref));
          *(LAS bf16*)(lds + HG_Q2 + s * 272 + col * 2) = (bf16)f2bf(q * __expf(b[i]));
          *(LAS bf16*)(lds + HG_K1 + s * 272 + col * 2) = (bf16)f2bf((1.f - __expf(gv[i])) * __expf(bref - b[i])); } }
    __syncthreads();
    {
        const int mt = w >> 1;
#pragma unroll
        for (int u = 0; u < 2; ++u) { const int nt = 2 * (w & 1) + u; f32x4 acc = {0.f, 0.f, 0.f, 0.f};
            if (nt <= mt) {
#pragma unroll
                for (int ks = 0; ks < 4; ++ks) { const bf16x8 a = *(const LAS bf16x8*)(lds + HG_Q1 + (16 * mt + fr) * 272 + fq * 16 + ks * 64), bb = *(const LAS bf16x8*)(lds + HG_K1 + (16 * nt + fr) * 272 + fq * 16 + ks * 64);
                    acc = mfma16(a, bb, acc); } }
            const int sidx = 16 * nt + fr;
#pragma unroll
            for (int r = 0; r < 4; ++r) { const int tr = 16 * mt + 4 * fq + r; const float pv = (nt <= mt && sidx <= tr) ? acc[r] : 0.f;
                *(LAS bf16*)(lds + HG_P + tr * 144 + sidx * 2) = (bf16)f2bf(pv); } }
    }
    __syncthreads();
    const int mt = w & 3, vh = w >> 2;
    f32x4 o[4];
#pragma unroll
    for (int nt = 0; nt < 4; ++nt) { const int vt = 4 * vh + nt; f32x4 acc = {0.f, 0.f, 0.f, 0.f};
#pragma unroll
        for (int ks = 0; ks < 2; ++ks) { const bf16x8 a = *(const LAS bf16x8*)(lds + HG_P + (16 * mt + fr) * 144 + fq * 16 + ks * 64), bb = *(const LAS bf16x8*)(lds + HG_VT + (16 * vt + fr) * 144 + fq * 16 + ks * 64);
            acc = mfma16(a, bb, acc); }
#pragma unroll
        for (int ks = 0; ks < 4; ++ks) { const bf16x8 a = *(const LAS bf16x8*)(lds + HG_Q2 + (16 * mt + fr) * 272 + fq * 16 + ks * 64); const bf16x8 bb = stf[nt][ks];
            acc = mfma16(a, bb, acc); }
        o[nt] = acc; }
    LAS float* RS = (LAS float*)(lds + HG_RS);
#pragma unroll
    for (int r = 0; r < 4; ++r) { float ss = 0.f;
#pragma unroll
        for (int nt = 0; nt < 4; ++nt) ss += o[nt][r] * o[nt][r];
        ss += __shfl_xor(ss, 1); ss += __shfl_xor(ss, 2); ss += __shfl_xor(ss, 4); ss += __shfl_xor(ss, 8);
        if (fr == 0) RS[vh * 64 + 16 * mt + 4 * fq + r] = ss; }
    __syncthreads();
    bf16* AUP = (bf16*)(ws + WS_AUP);
#pragma unroll
    for (int r = 0; r < 4; ++r) { const int tl = 16 * mt + 4 * fq + r; const float rn = 1.0f / sqrtf((RS[tl] + RS[64 + tl]) * (1.f / HD) + EPS);
#pragma unroll
        for (int nt = 0; nt < 4; ++nt) { const int v = 16 * (4 * vh + nt) + fr;
            AUP[(size_t)(t0 + tl) * D + h * HD + v] = (bf16)f2bf(o[nt][r] * rn * ngv[nt] * bf2f(ograw[r][nt])); } }
    __syncthreads();
}
__device__ __forceinline__ void moba_gate_item(unsigned char* ws, LAS unsigned char* lds, int item, int tid) {
    const int h = item >> 5, cur = item & 31, lane = tid & 63;
    if (cur == 0) return;
    LAS float* km = (LAS float*)lds;
    LAS unsigned* lcnt = (LAS unsigned*)(lds + 16384);
    if (tid < NB) lcnt[tid] = 0u;
    { const float* KM = (const float*)(ws + WS_KMEAN);
      for (int i = tid; i < NB * HD; i += NTHR) { const int j = i >> 7, d = i & 127; km[i] = (KM[(size_t)j * HW + h * HD + d] + KM[(size_t)(NB + j) * HW + h * HD + d]) * (1.f / BS); } }
    __syncthreads();
    if (tid < 256) {
        const int t = cur * BS + tid;
        const v4u* qp = (const v4u*)((const bf16*)(ws + WS_MQ) + (size_t)t * HW + h * HD);
        float g[32];
#pragma unroll
        for (int j = 0; j < 32; ++j) g[j] = 0.f;
        for (int dc = 0; dc < 16; ++dc) { const v4u qw = qp[dc]; const float q0 = bflo(qw.x), q1 = bfhi(qw.x), q2 = bflo(qw.y), q3 = bfhi(qw.y), q4 = bflo(qw.z), q5 = bfhi(qw.z), q6 = bflo(qw.w), q7 = bfhi(qw.w);
#pragma unroll
            for (int j = 0; j < 32; ++j) if (j < cur) { const f32x4 k0 = *(const LAS f32x4*)(km + j * 128 + dc * 8), k1 = *(const LAS f32x4*)(km + j * 128 + dc * 8 + 4);
                g[j] += (q0 * k0.x + q1 * k0.y + q2 * k0.z + q3 * k0.w) + (q4 * k1.x + q5 * k1.y + q6 * k1.z + q7 * k1.w); } }
#pragma unroll
        for (int j = 0; j < 32; ++j) if (j >= cur) g[j] = -3.0e38f;
        unsigned* LIST = (unsigned*)(ws + WS_MLIST);
#pragma unroll
        for (int r = 0; r < 3; ++r) {
            float best = g[0]; int bi = 0;
#pragma unroll
            for (int j = 1; j < 32; ++j) if (g[j] > best) { best = g[j]; bi = j; }
#pragma unroll
            for (int j = 0; j < 32; ++j) if (j == bi) g[j] = -3.0e38f;
            if (r < cur) {
                const int pos = (int)__hip_atomic_fetch_add(lcnt + bi, 1u, __ATOMIC_RELAXED, __HIP_MEMORY_SCOPE_WORKGROUP);
                LIST[(size_t)((h * NB + bi) * NB + cur) * 256 + pos] = ((unsigned)t << 2) | (unsigned)(r + 1);
            }
        }
    }
    __syncthreads();
    if (tid < NB) ((int*)(ws + WS_CNTP))[(h * NB + cur) * NB + tid] = (int)lcnt[tid];
    __syncthreads();
}
__device__ __forceinline__ void moba_unit(unsigned char* ws, LAS unsigned char* lds, int h, int j, int cur, bool causal, int g, int n, const LAS int* lst, int tid) {
    const int lane = tid & 63, w = tid >> 6, fr = lane & 15, fq = lane >> 4;
    const bf16* MK = (const bf16*)(ws + WS_MK) + (size_t)(j * BS) * HW + h * HD; const bf16* MV = (const bf16*)(ws + WS_MV) + (size_t)(j * BS) * HW + h * HD;
#pragma unroll
    for (int i = 0; i < 8; ++i) { const int p = i * NTHR + tid, row = p >> 4, ch = p & 15;
        const v4u kv = *(const v4u*)(MK + (size_t)row * HW + ch * 8), vv = *(const v4u*)(MV + (size_t)row * HW + ch * 8);
        *(LAS v4u*)(lds + row * 256 + ((ch ^ (row & 15)) << 4)) = kv; *(LAS v4u*)(lds + 65536 + row * 256 + ((ch ^ ((row & 7) << 1)) << 4)) = vv; }
    int t, slot; bool valid = true;
    if (causal) { t = cur * BS + g * 128 + w * 16 + fr; slot = 0; }
    else { int rr = g * 128 + w * 16 + fr; valid = rr < n; if (!valid) rr = n - 1; rr = rr < 0 ? 0 : (rr > 255 ? 255 : rr); const int e = lst[rr]; t = cur * BS + ((e >> 2) & 255); slot = e & 3; if (slot == 0) valid = false; }
    bf16x8 qa[4];
    { const bf16* qp = (const bf16*)(ws + WS_MQ) + (size_t)t * HW + h * HD + fq * 8;
#pragma unroll
      for (int ks = 0; ks < 4; ++ks) qa[ks] = *(const bf16x8*)(qp + ks * 32); }
    __syncthreads();
    const bool wact = causal || (__builtin_amdgcn_readfirstlane(g * 128 + (tid >> 6) * 16) < n);
    if (wact) {
    const int qidx = g * 128 + w * 16 + fr;
    const int ntmax = causal ? (g * 128 + w * 16 + 15) >> 4 : 15;
    f32x4 acc[16];
#pragma unroll
    for (int nt = 0; nt < 16; ++nt) { acc[nt] = (f32x4){0.f, 0.f, 0.f, 0.f};
        if (nt <= ntmax) { const int row = 16 * nt + fr;
#pragma unroll
            for (int ks = 0; ks < 4; ++ks) { const bf16x8 kf = *(const LAS bf16x8*)(lds + row * 256 + (((4 * ks + fq) ^ fr) << 4)); acc[nt] = mfma16(kf, qa[ks], acc[nt]); }
            if (causal) {
#pragma unroll
                for (int r = 0; r < 4; ++r) if (16 * nt + 4 * fq + r > qidx) acc[nt][r] = -3.0e38f; }
        } else { acc[nt] = (f32x4){-3.0e38f, -3.0e38f, -3.0e38f, -3.0e38f}; } }
    float m = -3.0e38f;
#pragma unroll
    for (int nt = 0; nt < 16; ++nt) m = fmaxf(fmaxf(fmaxf(m, acc[nt][0]), fmaxf(acc[nt][1], acc[nt][2])), acc[nt][3]);
    m = fmaxf(m, __shfl_xor(m, 16)); m = fmaxf(m, __shfl_xor(m, 32));
    const float cexp = 0.08838834764831845f * 1.4426950408889634f; float l = 0.f;
    bf16x8 pa[8];
#pragma unroll
    for (int k2 = 0; k2 < 8; ++k2) { float p[8];
#pragma unroll
        for (int r = 0; r < 4; ++r) { p[r] = __builtin_amdgcn_exp2f((acc[2 * k2][r] - m) * cexp); p[4 + r] = __builtin_amdgcn_exp2f((acc[2 * k2 + 1][r] - m) * cexp); }
        l += ((p[0] + p[1]) + (p[2] + p[3])) + ((p[4] + p[5]) + (p[6] + p[7]));
        v4u pw; pw.x = pk2(p[0], p[1]); pw.y = pk2(p[2], p[3]); pw.z = pk2(p[4], p[5]); pw.w = pk2(p[6], p[7]); pa[k2] = __builtin_bit_cast(bf16x8, pw); }
    l += __shfl_xor(l, 16); l += __shfl_xor(l, 32);
    f32x4 o[8];
    const int gl = fr >> 2, pp = fr & 3;
#pragma unroll
    for (int dt = 0; dt < 8; ++dt) o[dt] = (f32x4){0.f, 0.f, 0.f, 0.f};
#pragma unroll
    for (int k2 = 0; k2 < 8; ++k2) { const int r0 = 32 * k2 + 4 * fq + gl, r1 = r0 + 16;
#pragma unroll
        for (int dt = 0; dt < 8; ++dt) { const int ch = 2 * dt + (pp >> 1);
            const v4i16_t lo = __builtin_amdgcn_ds_read_tr16_b64_v4i16((LAS v4i16_t*)(lds + 65536 + r0 * 256 + ((ch ^ ((r0 & 7) << 1)) << 4) + 8 * (pp & 1)));
            const v4i16_t hi = __builtin_amdgcn_ds_read_tr16_b64_v4i16((LAS v4i16_t*)(lds + 65536 + r1 * 256 + ((ch ^ ((r1 & 7) << 1)) << 4) + 8 * (pp & 1)));
            bf16x8 vf; vf[0] = lo[0]; vf[1] = lo[1]; vf[2] = lo[2]; vf[3] = lo[3]; vf[4] = hi[0]; vf[5] = hi[1]; vf[6] = hi[2]; vf[7] = hi[3];
            o[dt] = mfma16(vf, pa[k2], o[dt]); } }
    const float il = 1.0f / l;
    int t2, slot2; bool valid2 = true;
    if (causal) { t2 = cur * BS + g * 128 + w * 16 + fr; slot2 = 0; }
    else { int rr = g * 128 + w * 16 + fr; valid2 = rr < n; if (!valid2) rr = n - 1; rr = rr < 0 ? 0 : (rr > 255 ? 255 : rr); const int e = lst[rr]; t2 = cur * BS + ((e >> 2) & 255); slot2 = e & 3; if (slot2 == 0) valid2 = false; }
    if (valid2) { bf16* po = (bf16*)(ws + WS_PO) + ((size_t)(t2 * NH + h) * 4 + slot2) * HD + 4 * fq;
#pragma unroll
        for (int dt = 0; dt < 8; ++dt) { v2u wv; wv.x = pk2(o[dt][0] * il, o[dt][1] * il); wv.y = pk2(o[dt][2] * il, o[dt][3] * il); *(v2u*)(po + 16 * dt) = wv; }
        if (fq == 0) ((float*)(ws + WS_PLSE))[((size_t)(t2 * NH + h) * 4 + slot2) * 32] = m * 0.08838834764831845f + __logf(l); }
    }
    __syncthreads();
}

__device__ __forceinline__ void moba_unit2(unsigned char* ws, LAS unsigned char* lds, int h, int j, bool causal, int g, int n, const unsigned short* glist, int tid) {
    const int lane = tid & 63, w = tid >> 6, fr = lane & 15, fq = lane >> 4;
    int t, slot; bool valid = true;
    if (causal) { t = j * BS + g * 128 + w * 16 + fr; slot = 0; }
    else { int rr = g * 128 + w * 16 + fr; valid = rr < n; if (!valid) rr = n - 1; rr = rr < 0 ? 0 : rr; const int e = (int)glist[rr]; t = (e >> 2) & (T - 1); slot = e & 3; if (slot == 0) valid = false; }
    bf16x8 qa[4];
    { const bf16* qp = (const bf16*)(ws + WS_MQ) + (size_t)t * HW + h * HD + fq * 8;
#pragma unroll
      for (int ks = 0; ks < 4; ++ks) qa[ks] = *(const bf16x8*)(qp + ks * 32); }
    __syncthreads();
    const bool wact = causal || (__builtin_amdgcn_readfirstlane(g * 128 + (tid >> 6) * 16) < n);
    if (wact) {
    const int qidx = g * 128 + w * 16 + fr;
    const int ntmax = causal ? (g * 128 + w * 16 + 15) >> 4 : 15;
    f32x4 acc[16];
#pragma unroll
    for (int nt = 0; nt < 16; ++nt) { acc[nt] = (f32x4){0.f, 0.f, 0.f, 0.f};
        if (nt <= ntmax) { const int row = 16 * nt + fr;
#pragma unroll
            for (int ks = 0; ks < 4; ++ks) { const bf16x8 kf = *(const LAS bf16x8*)(lds + row * 256 + (((4 * ks + fq) ^ fr) << 4)); acc[nt] = mfma16(kf, qa[ks], acc[nt]); }
            if (causal) {
#pragma unroll
                for (int r = 0; r < 4; ++r) if (16 * nt + 4 * fq + r > qidx) acc[nt][r] = -3.0e38f; }
        } else { acc[nt] = (f32x4){-3.0e38f, -3.0e38f, -3.0e38f, -3.0e38f}; } }
    float m = -3.0e38f;
#pragma unroll
    for (int nt = 0; nt < 16; ++nt) m = fmaxf(fmaxf(fmaxf(m, acc[nt][0]), fmaxf(acc[nt][1], acc[nt][2])), acc[nt][3]);
    m = fmaxf(m, __shfl_xor(m, 16)); m = fmaxf(m, __shfl_xor(m, 32));
    const float cexp = 0.08838834764831845f * 1.4426950408889634f; float l = 0.f;
    bf16x8 pa[8];
#pragma unroll
    for (int k2 = 0; k2 < 8; ++k2) { float p[8];
#pragma unroll
        for (int r = 0; r < 4; ++r) { p[r] = __builtin_amdgcn_exp2f((acc[2 * k2][r] - m) * cexp); p[4 + r] = __builtin_amdgcn_exp2f((acc[2 * k2 + 1][r] - m) * cexp); }
        l += ((p[0] + p[1]) + (p[2] + p[3])) + ((p[4] + p[5]) + (p[6] + p[7]));
        v4u pw; pw.x = pk2(p[0], p[1]); pw.y = pk2(p[2], p[3]); pw.z = pk2(p[4], p[5]); pw.w = pk2(p[6], p[7]); pa[k2] = __builtin_bit_cast(bf16x8, pw); }
    l += __shfl_xor(l, 16); l += __shfl_xor(l, 32);
    f32x4 o[8];
    const int gl = fr >> 2, pp = fr & 3;
#pragma unroll
    for (int dt = 0; dt < 8; ++dt) o[dt] = (f32x4){0.f, 0.f, 0.f, 0.f};
#pragma unroll
    for (int k2 = 0; k2 < 8; ++k2) { const int r0 = 32 * k2 + 4 * fq + gl, r1 = r0 + 16;
#pragma unroll
        for (int dt = 0; dt < 8; ++dt) { const int ch = 2 * dt + (pp >> 1);
            const v4i16_t lo = __builtin_amdgcn_ds_read_tr16_b64_v4i16((LAS v4i16_t*)(lds + 65536 + r0 * 256 + ((ch ^ ((r0 & 7) << 1)) << 4) + 8 * (pp & 1)));
            const v4i16_t hi = __builtin_amdgcn_ds_read_tr16_b64_v4i16((LAS v4i16_t*)(lds + 65536 + r1 * 256 + ((ch ^ ((r1 & 7) << 1)) << 4) + 8 * (pp & 1)));
            bf16x8 vf; vf[0] = lo[0]; vf[1] = lo[1]; vf[2] = lo[2]; vf[3] = lo[3]; vf[4] = hi[0]; vf[5] = hi[1]; vf[6] = hi[2]; vf[7] = hi[3];
            o[dt] = mfma16(vf, pa[k2], o[dt]); } }
    const float il = 1.0f / l;
    int t2, slot2; bool valid2 = true;
    if (causal) { t2 = j * BS + g * 128 + w * 16 + fr; slot2 = 0; }
    else { int rr = g * 128 + w * 16 + fr; valid2 = rr < n; if (!valid2) rr = n - 1; rr = rr < 0 ? 0 : rr; const int e = (int)glist[rr]; t2 = (e >> 2) & (T - 1); slot2 = e & 3; if (slot2 == 0) valid2 = false; }
    if (valid2) { bf16* po = (bf16*)(ws + WS_PO) + ((size_t)(t2 * NH + h) * 4 + slot2) * HD + 4 * fq;
#pragma unroll
        for (int dt = 0; dt < 8; ++dt) { v2u wv; wv.x = pk2(o[dt][0] * il, o[dt][1] * il); wv.y = pk2(o[dt][2] * il, o[dt][3] * il); *(v2u*)(po + 16 * dt) = wv; }
        if (fq == 0) ((float*)(ws + WS_PLSE))[((size_t)(t2 * NH + h) * 4 + slot2) * 32] = m * 0.08838834764831845f + __logf(l); }
    }
    __syncthreads();
}


constexpr size_t WS_GL = 16 * MiB;
constexpr int MB_RCH = 512;
__device__ __forceinline__ void moba_kv_item(unsigned char* ws, LAS unsigned char* lds, int h, int j, bool causal, const unsigned short* glist, int n, int tid) {
    const int lane = tid & 63, w = tid >> 6, fr = lane & 15, fq = lane >> 4;
    { const bf16* MK = (const bf16*)(ws + WS_MK) + (size_t)(j * BS) * HW + h * HD; const bf16* MV = (const bf16*)(ws + WS_MV) + (size_t)(j * BS) * HW + h * HD;
#pragma unroll
    for (int i = 0; i < 8; ++i) { const int p = i * NTHR + tid, row = p >> 4, ch = p & 15;
        const v4u kv = *(const v4u*)(MK + (size_t)row * HW + ch * 8), vv = *(const v4u*)(MV + (size_t)row * HW + ch * 8);
        *(LAS v4u*)(lds + row * 256 + ((ch ^ (row & 15)) << 4)) = kv; *(LAS v4u*)(lds + 65536 + row * 256 + ((ch ^ ((row & 7) << 1)) << 4)) = vv; } }
    const int ng = (n + 127) >> 7;
#define MKV_FETCH(G) do { int rr_ = (G) * 128 + w * 16 + fr; int ee_; \
        if (causal) ee_ = ((j * BS + rr_) << 2) | 0x8000; \
        else { const bool v_ = rr_ < n; if (!v_) rr_ = n - 1; rr_ = rr_ < 0 ? 0 : rr_; ee_ = (int)glist[rr_]; ee_ = (v_ && (ee_ & 3)) ? (ee_ | 0x8000) : (ee_ & 0x7fff); } \
        e_n = ee_; const bf16* qp_ = (const bf16*)(ws + WS_MQ) + (size_t)((ee_ >> 2) & (T - 1)) * HW + h * HD + fq * 8; \
        _Pragma("unroll") for (int ks_ = 0; ks_ < 4; ++ks_) qn[ks_] = *(const bf16x8*)(qp_ + ks_ * 32); } while (0)
    int e_n; bf16x8 qn[4];
    MKV_FETCH(0);
    __syncthreads();
    for (int g = 0; g < ng; ++g) {
        const int e = e_n; bf16x8 qa[4];
#pragma unroll
        for (int ks = 0; ks < 4; ++ks) qa[ks] = qn[ks];
        if (g + 1 < ng) MKV_FETCH(g + 1);
        const bool wact = causal || (__builtin_amdgcn_readfirstlane(g * 128 + w * 16) < n);
        if (wact) {
    const int qidx = g * 128 + w * 16 + fr;
    const int ntmax = causal ? (g * 128 + w * 16 + 15) >> 4 : 15;
    f32x4 acc[16];
#pragma unroll
    for (int nt = 0; nt < 16; ++nt) { acc[nt] = (f32x4){0.f, 0.f, 0.f, 0.f};
        if (nt <= ntmax) { const int row = 16 * nt + fr;
#pragma unroll
            for (int ks = 0; ks < 4; ++ks) { const bf16x8 kf = *(const LAS bf16x8*)(lds + row * 256 + (((4 * ks + fq) ^ fr) << 4)); acc[nt] = mfma16(kf, qa[ks], acc[nt]); }
            if (causal) {
#pragma unroll
                for (int r = 0; r < 4; ++r) if (16 * nt + 4 * fq + r > qidx) acc[nt][r] = -3.0e38f; }
        } else { acc[nt] = (f32x4){-3.0e38f, -3.0e38f, -3.0e38f, -3.0e38f}; } }
    float m = -3.0e38f;
#pragma unroll
    for (int nt = 0; nt < 16; ++nt) m = fmaxf(fmaxf(fmaxf(m, acc[nt][0]), fmaxf(acc[nt][1], acc[nt][2])), acc[nt][3]);
    m = fmaxf(m, __shfl_xor(m, 16)); m = fmaxf(m, __shfl_xor(m, 32));
    const float cexp = 0.08838834764831845f * 1.4426950408889634f; float l = 0.f;
    bf16x8 pa[8];
#pragma unroll
    for (int k2 = 0; k2 < 8; ++k2) { float p[8];
#pragma unroll
        for (int r = 0; r < 4; ++r) { p[r] = __builtin_amdgcn_exp2f((acc[2 * k2][r] - m) * cexp); p[4 + r] = __builtin_amdgcn_exp2f((acc[2 * k2 + 1][r] - m) * cexp); }
        l += ((p[0] + p[1]) + (p[2] + p[3])) + ((p[4] + p[5]) + (p[6] + p[7]));
        v4u pw; pw.x = pk2(p[0], p[1]); pw.y = pk2(p[2], p[3]); pw.z = pk2(p[4], p[5]); pw.w = pk2(p[6], p[7]); pa[k2] = __builtin_bit_cast(bf16x8, pw); }
    l += __shfl_xor(l, 16); l += __shfl_xor(l, 32);
    f32x4 o[8];
    const int gl = fr >> 2, pp = fr & 3;
#pragma unroll
    for (int dt = 0; dt < 8; ++dt) o[dt] = (f32x4){0.f, 0.f, 0.f, 0.f};
#pragma unroll
    for (int k2 = 0; k2 < 8; ++k2) { const int r0 = 32 * k2 + 4 * fq + gl, r1 = r0 + 16;
#pragma unroll
        for (int dt = 0; dt < 8; ++dt) { const int ch = 2 * dt + (pp >> 1);
            const v4i16_t lo = __builtin_amdgcn_ds_read_tr16_b64_v4i16((LAS v4i16_t*)(lds + 65536 + r0 * 256 + ((ch ^ ((r0 & 7) << 1)) << 4) + 8 * (pp & 1)));
            const v4i16_t hi = __builtin_amdgcn_ds_read_tr16_b64_v4i16((LAS v4i16_t*)(lds + 65536 + r1 * 256 + ((ch ^ ((r1 & 7) << 1)) << 4) + 8 * (pp & 1)));
            bf16x8 vf; vf[0] = lo[0]; vf[1] = lo[1]; vf[2] = lo[2]; vf[3] = lo[3]; vf[4] = hi[0]; vf[5] = hi[1]; vf[6] = hi[2]; vf[7] = hi[3];
            o[dt] = mfma16(vf, pa[k2], o[dt]); } }
    const float il = 1.0f / l;
    if (e & 0x8000) { const int t2 = (e >> 2) & (T - 1), slot2 = e & 3; bf16* po = (bf16*)(ws + WS_PO) + ((size_t)(t2 * NH + h) * 4 + slot2) * HD + 4 * fq;
#pragma unroll
        for (int dt = 0; dt < 8; ++dt) { v2u wv; wv.x = pk2(o[dt][0] * il, o[dt][1] * il); wv.y = pk2(o[dt][2] * il, o[dt][3] * il); *(v2u*)(po + 16 * dt) = wv; }
        if (fq == 0) ((float*)(ws + WS_PLSE))[(size_t)(t2 * NH + h) * 4 + slot2] = m * 0.08838834764831845f + __logf(l); }
        }
    }
#undef MKV_FETCH
    __syncthreads();
}
__device__ __forceinline__ void moba_gate_lists(unsigned char* ws, gu32* ctl, LAS unsigned char* lds, int h, int cur, int tid) {
    LAS float* km = (LAS float*)lds;
    LAS float* gs = (LAS float*)(lds + 17408);
    LAS unsigned short* lists = (LAS unsigned short*)(lds + 65536);
    LAS int* cnt = (LAS int*)(lds + 61440); LAS int* gbase = cnt + 32;
    unsigned sel = 0xFFFFFFu;
    if (tid < 32) cnt[tid] = 0;
    { const float* KM = (const float*)(ws + WS_KMEAN);
      for (int i = tid; i < NB * HD; i += NTHR) { const int j = i >> 7, d = i & 127; km[j * 132 + d] = (KM[(size_t)j * HW + h * HD + d] + KM[(size_t)(NB + j) * HW + h * HD + d]) * (1.f / BS); } }
    __syncthreads();
    {
        const int lane = tid & 63, w = tid >> 6, fr = lane & 15, fq = lane >> 4;
        f32x4 acc[2][2];
#pragma unroll
        for (int rt = 0; rt < 2; ++rt)
#pragma unroll
            for (int ct = 0; ct < 2; ++ct) acc[rt][ct] = (f32x4){0.f, 0.f, 0.f, 0.f};
        const bf16* qb = (const bf16*)(ws + WS_MQ) + (size_t)(cur * BS + 32 * w + fr) * HW + h * HD + 8 * fq;
#pragma unroll
        for (int J = 0; J < 4; ++J) {
            const v4u q0 = *(const v4u*)(qb + 32 * J), q1 = *(const v4u*)(qb + (size_t)16 * HW + 32 * J);
            const f32x4 k00 = *(const LAS f32x4*)(km + fr * 132 + 32 * J + 8 * fq), k01 = *(const LAS f32x4*)(km + fr * 132 + 32 * J + 8 * fq + 4);
            const f32x4 k10 = *(const LAS f32x4*)(km + (16 + fr) * 132 + 32 * J + 8 * fq), k11 = *(const LAS f32x4*)(km + (16 + fr) * 132 + 32 * J + 8 * fq + 4);
            const float a0[8] = {bflo(q0.x), bfhi(q0.x), bflo(q0.y), bfhi(q0.y), bflo(q0.z), bfhi(q0.z), bflo(q0.w), bfhi(q0.w)};
            const float a1[8] = {bflo(q1.x), bfhi(q1.x), bflo(q1.y), bfhi(q1.y), bflo(q1.z), bfhi(q1.z), bflo(q1.w), bfhi(q1.w)};
            const float b0[8] = {k00.x, k00.y, k00.z, k00.w, k01.x, k01.y, k01.z, k01.w};
            const float b1[8] = {k10.x, k10.y, k10.z, k10.w, k11.x, k11.y, k11.z, k11.w};
#pragma unroll
            for (int s8 = 0; s8 < 8; ++s8) {
                acc[0][0] = __builtin_amdgcn_mfma_f32_16x16x4f32(a0[s8], b0[s8], acc[0][0], 0, 0, 0); acc[0][1] = __builtin_amdgcn_mfma_f32_16x16x4f32(a0[s8], b1[s8], acc[0][1], 0, 0, 0);
                acc[1][0] = __builtin_amdgcn_mfma_f32_16x16x4f32(a1[s8], b0[s8], acc[1][0], 0, 0, 0); acc[1][1] = __builtin_amdgcn_mfma_f32_16x16x4f32(a1[s8], b1[s8], acc[1][1], 0, 0, 0); } }
#pragma unroll
        for (int rt = 0; rt < 2; ++rt)
#pragma unroll
            for (int ct = 0; ct < 2; ++ct)
#pragma unroll
                for (int i = 0; i < 4; ++i) gs[(32 * w + 16 * rt + 4 * fq + i) * 33 + 16 * ct + fr] = acc[rt][ct][i];
    }
    __syncthreads();
    if (tid < 256) {
        const int t = cur * BS + tid;
        float g[32];
#pragma unroll
        for (int j = 0; j < 32; ++j) g[j] = (j < cur) ? gs[tid * 33 + j] : -3.0e38f;
#pragma unroll
        for (int r = 0; r < 3; ++r) {
            float best = g[0]; int bi = 0;
#pragma unroll
            for (int j = 1; j < 32; ++j) if (g[j] > best) { best = g[j]; bi = j; }
#pragma unroll
            for (int j = 0; j < 32; ++j) if (j == bi) g[j] = -3.0e38f;
            if (r < cur) sel = (sel & ~(0xFFu << (8 * r))) | ((unsigned)bi << (8 * r));
        }
#pragma unroll
        for (int r = 0; r < 3; ++r) { const int b = (int)((sel >> (8 * r)) & 255u);
            if (b < 32) { const int pos = (int)__hip_atomic_fetch_add((LAS unsigned*)(cnt + b), 1u, __ATOMIC_RELAXED, __HIP_MEMORY_SCOPE_WORKGROUP); lists[b * 256 + (pos & 255)] = (unsigned short)((t << 2) | (r + 1)); } }
    }
    __syncthreads();
    if (tid < 32) gbase[tid] = (tid < cur && cnt[tid] > 0) ? (int)__hip_atomic_fetch_add((unsigned*)(ctl + CW_MCNT) + h * NB + tid, (unsigned)cnt[tid], RLX_AGENT) : 0;
    __syncthreads();
    { unsigned short* GL = (unsigned short*)(ws + WS_GL);
      for (int i = tid; i < NB * 256; i += NTHR) { const int j = i >> 8, q = i & 255; if (j < cur && q < cnt[j]) GL[(size_t)(h * NB + j) * 8192 + ((gbase[j] + q) & 8191)] = lists[i]; } }
    __syncthreads();
}
#ifndef MBRT
#define MBRT 31
#endif
#ifndef MB_STAGE
#define MB_STAGE 3
#endif
__device__ __forceinline__ void moba_block_item(unsigned char* ws, LAS unsigned char* lds, int h, int cur, int jlo, int jhi, int flags, int tid) {
    unsigned sel = 0xFFFFFFu;
    if (jhi > jlo) {
        LAS float* km = (LAS float*)lds;
        { const float* KM = (const float*)(ws + WS_KMEAN);
          for (int i = tid; i < NB * HD; i += NTHR) { const int j = i >> 7, d = i & 127; km[i] = (KM[(size_t)j * HW + h * HD + d] + KM[(size_t)(NB + j) * HW + h * HD + d]) * (1.f / BS); } }
        __syncthreads();
        if (tid < 256) {
            const int t = cur * BS + tid;
            const v4u* qp = (const v4u*)((const bf16*)(ws + WS_MQ) + (size_t)t * HW + h * HD);
            float g[32];
#pragma unroll
            for (int j = 0; j < 32; ++j) g[j] = 0.f;
            for (int dc = 0; dc < 16; ++dc) { const v4u qw = qp[dc]; const float q0 = bflo(qw.x), q1 = bfhi(qw.x), q2 = bflo(qw.y), q3 = bfhi(qw.y), q4 = bflo(qw.z), q5 = bfhi(qw.z), q6 = bflo(qw.w), q7 = bfhi(qw.w);
#pragma unroll
                for (int j = 0; j < 32; ++j) if (j < cur) { const f32x4 k0 = *(const LAS f32x4*)(km + j * 128 + dc * 8), k1 = *(const LAS f32x4*)(km + j * 128 + dc * 8 + 4);
                    g[j] += (q0 * k0.x + q1 * k0.y + q2 * k0.z + q3 * k0.w) + (q4 * k1.x + q5 * k1.y + q6 * k1.z + q7 * k1.w); } }
#pragma unroll
            for (int j = 0; j < 32; ++j) if (j >= cur) g[j] = -3.0e38f;
#pragma unroll
            for (int r = 0; r < 3; ++r) {
                float best = g[0]; int bi = 0;
#pragma unroll
                for (int j = 1; j < 32; ++j) if (g[j] > best) { best = g[j]; bi = j; }
#pragma unroll
                for (int j = 0; j < 32; ++j) if (j == bi) g[j] = -3.0e38f;
                if (r < cur) sel = (sel & ~(0xFFu << (8 * r))) | ((unsigned)bi << (8 * r));
            }
        }
        __syncthreads();
    }
    LAS int* lc = (LAS int*)(lds + LDSCTL_OFF + 1024); LAS int* lst = lc + 4;
    for (int jj = (flags & 1) ? -2 : jlo; jj < jhi; jj = (jj == -1) ? jlo : jj + 1) {
        const bool causal = jj < 0; const int j = causal ? cur : jj; int n = 256;
        if (!causal) {
            if (tid == 0) *lc = 0;
            __syncthreads();
            if (tid < 256) { const int slot = ((int)(sel & 255u) == j) ? 1 : ((int)((sel >> 8) & 255u) == j) ? 2 : ((int)((sel >> 16) & 255u) == j) ? 3 : 0;
                if (slot) { const int pos = (int)__hip_atomic_fetch_add((LAS unsigned*)lc, 1u, __ATOMIC_RELAXED, __HIP_MEMORY_SCOPE_WORKGROUP); lst[pos] = (tid << 2) | slot; } }
            __syncthreads();
            n = *lc;
        }
        const int g0 = causal ? jj + 2 : 0, g1 = causal ? g0 + 1 : (n + 127) >> 7;
        for (int g = g0; g < g1; ++g) moba_unit(ws, lds, h, j, cur, causal, g, n, lst, tid);
        __syncthreads();
    }
    asm volatile("s_waitcnt vmcnt(0)" ::: "memory"); __syncthreads();
    if (flags & 2) { const bf16* PO = (const bf16*)(ws + WS_PO); const float* PL = (const float*)(ws + WS_PLSE); bf16* AUP = (bf16*)(ws + WS_AUP); const int nv = cur < 3 ? cur : 3;
      for (int idx = tid; idx < BS * 16; idx += NTHR) { const int t = cur * BS + (idx >> 4), dq = idx & 15, th = t * NH + h;
          const float* plp = PL + (size_t)th * 128; float ls[4]; ls[0] = plp[0]; ls[1] = nv > 0 ? plp[32] : 0.f; ls[2] = nv > 1 ? plp[64] : 0.f; ls[3] = nv > 2 ? plp[96] : 0.f;
          float M = ls[0]; if (nv > 0) M = fmaxf(M, ls[1]); if (nv > 1) M = fmaxf(M, ls[2]); if (nv > 2) M = fmaxf(M, ls[3]);
          float wv[4]; wv[0] = __expf(ls[0] - M); wv[1] = nv > 0 ? __expf(ls[1] - M) : 0.f; wv[2] = nv > 1 ? __expf(ls[2] - M) : 0.f; wv[3] = nv > 2 ? __expf(ls[3] - M) : 0.f;
          const float inv = 1.0f / ((wv[0] + wv[1]) + (wv[2] + wv[3]));
          float acc[8] = {0.f, 0.f, 0.f, 0.f, 0.f, 0.f, 0.f, 0.f};
#pragma unroll
          for (int i = 0; i < 4; ++i) if (i <= nv) { const v4u pw = *(const v4u*)(PO + ((size_t)th * 4 + i) * HD + dq * 8); const float wi = wv[i] * inv;
              acc[0] += wi * bflo(pw.x); acc[1] += wi * bfhi(pw.x); acc[2] += wi * bflo(pw.y); acc[3] += wi * bfhi(pw.y); acc[4] += wi * bflo(pw.z); acc[5] += wi * bfhi(pw.z); acc[6] += wi * bflo(pw.w); acc[7] += wi * bfhi(pw.w); }
          v4u ov; ov.x = pk2(acc[0], acc[1]); ov.y = pk2(acc[2], acc[3]); ov.z = pk2(acc[4], acc[5]); ov.w = pk2(acc[6], acc[7]);
          *(v4u*)(AUP + (size_t)t * D + HW + h * HD + dq * 8) = ov; } }
    __syncthreads();
}

namespace pg8 {
#define PG8_LAS __attribute__((address_space(3)))
typedef unsigned short bf16_t;
typedef unsigned u32x4 __attribute__((ext_vector_type(4)));
constexpr int BM = 256, BK = 64, HALF = 128, HTB = HALF * BK * 2, STAGE_BYTES = 8 * HTB, NXCD = 8, WGM = 8;
__host__ __device__ __forceinline__ int lds_byte(int r, int c) { const int st = (r >> 4) * 2 + (c >> 5), rr = r & 15, cc = c & 31, ob = rr * 64 + cc * 2; return st * 1024 + (ob ^ (((ob >> 9) & 1) << 5)); }
__host__ __device__ __forceinline__ void stage_rc(int b, int& R, int& C) { const int st = b / 1024, sb = b % 1024, swz = sb ^ (((sb >> 9) & 1) << 5); R = (st >> 1) * 16 + swz / 64; C = (st & 1) * 32 + (swz % 64) / 2; }
__host__ __device__ __forceinline__ int perm32(int rho) { const int n = rho >> 4, i = rho & 15; return 8 * (i >> 2) + 4 * n + (i & 3); }
struct Unit { int pm, pn; };
struct Gemm { const bf16_t* A; const bf16_t* Bt; int lda, ldb, K; };
struct StaticOrder {
    int nM, nN, nwg, G, c;
    __host__ __device__ void init(int M, int N, int G_, int c_) { nM = M / BM; nN = N / BM; nwg = nM * nN; G = G_; c = c_; }
    __host__ __device__ bool next(int i, Unit& u) const {
        const long L = (long)i * G + c; if (L >= nwg) return false;
        int wgid = (int)L; { const int q = nwg / NXCD, r = nwg % NXCD, xcd = wgid % NXCD, off = wgid / NXCD; wgid = (xcd < r ? xcd * (q + 1) : r * (q + 1) + (xcd - r) * q) + off; }
        const int nig = WGM * nN, gid = wgid / nig, fm = gid * WGM, gsz = (nM - fm) < WGM ? (nM - fm) : WGM;
        u.pm = fm + ((wgid % nig) % gsz); u.pn = (wgid % nig) / gsz; return true;
    }
    __device__ __forceinline__ void a_ready(const Unit&) const {}
    __device__ __forceinline__ void done(const Unit&) const {}
};
struct MoeOrder {
    const PG8_LAS int* pstart; int npn, G, c;
    __device__ bool next(int i, Unit& u) const {
        const int L = i * G + c, ntile = pstart[32] >> 8; if (L >= ntile * npn) return false;
        const int tile = L / npn, pnl = L % npn; int e = 0;
        for (int q = 1; q < 32; ++q) if (pstart[q] <= tile * 256) e = q;
        u.pm = tile; u.pn = e * npn + pnl; return true;
    }
    __device__ __forceinline__ void a_ready(const Unit&) const {}
    __device__ __forceinline__ void done(const Unit&) const {}
};
__device__ __forceinline__ unsigned cvt_pk_bf16(float lo, float hi) { unsigned r; asm volatile("v_cvt_pk_bf16_f32 %0, %1, %2" : "=v"(r) : "v"(lo), "v"(hi)); return r; }
__device__ __forceinline__ u32x4 pack8(const f32x4& a, const f32x4& b) { u32x4 w; w.x = cvt_pk_bf16(a[0], a[1]); w.y = cvt_pk_bf16(a[2], a[3]); w.z = cvt_pk_bf16(b[0], b[1]); w.w = cvt_pk_bf16(b[2], b[3]); return w; }
__device__ __forceinline__ float bl(unsigned w) { return __builtin_bit_cast(float, w << 16); }
__device__ __forceinline__ float bh(unsigned w) { return __builtin_bit_cast(float, w & 0xffff0000u); }
__device__ __forceinline__ f32x4 sig4(const f32x4& v) { f32x4 o; for (int i = 0; i < 4; ++i) o[i] = __builtin_amdgcn_rcpf(1.0f + __expf(-v[i])); return o; }
__device__ __forceinline__ f32x4 silu4(const f32x4& v) { f32x4 o; for (int i = 0; i < 4; ++i) o[i] = v[i] * __builtin_amdgcn_rcpf(1.0f + __expf(-v[i])); return o; }

struct EpiInProj {
    static constexpr bool PERM = true, AFTER_DRAIN = false, HAS_MID = false;
    unsigned char* ws;
    __device__ __forceinline__ void mid(f32x4 (&)[2][2][4][2], const Unit&, int, int, int, int) const {}
    __device__ __forceinline__ void operator()(const f32x4 (&acc)[2][2][4][2], const Unit& u, int wr, int wc, int fr, int fq) const {
        const int pn = u.pn, row0 = u.pm * BM + wr * 64 + fr, cl = wc * 32 + 8 * fq;
        if (pn >= 16 && pn < 24) {
            const int which = (pn - 16) >> 2, head = 2 * ((pn - 16) & 3) + (wc >> 1), d = (wc & 1) * 32 + 8 * fq;
            bf16_t* dst = (bf16_t*)(ws + (which ? WS_MK : WS_MQ)) + head * HD + d;
            const f32x2* trig = (const f32x2*)(ws + WS_TRIG) + d;
            float cs[16];
#pragma unroll
            for (int i = 0; i < 16; ++i) cs[i] = 0.f;
#pragma unroll
            for (int ai = 0; ai < 2; ++ai)
#pragma unroll
                for (int mp = 0; mp < 2; ++mp) {
                    f32x4 tg[2][4];
#pragma unroll
                    for (int mm = 0; mm < 2; ++mm) { const f32x4* tp = (const f32x4*)(trig + (size_t)(row0 + ai * HALF + (2 * mp + mm) * 16) * 64);
#pragma unroll
                        for (int q = 0; q < 4; ++q) tg[mm][q] = tp[q]; }
#pragma unroll
                    for (int mm = 0; mm < 2; ++mm) { const int m = 2 * mp + mm, row = row0 + ai * HALF + m * 16;
                    u32x4 wl, wh;
                    { const f32x4 t0 = tg[mm][0], t1 = tg[mm][1]; const f32x4 x1a = acc[ai][0][m][0], x2a = acc[ai][1][m][0]; f32x4 la, ha;
                      la[0] = x1a[0] * t0[0] - x2a[0] * t0[1]; ha[0] = x2a[0] * t0[0] + x1a[0] * t0[1];
                      la[1] = x1a[1] * t0[2] - x2a[1] * t0[3]; ha[1] = x2a[1] * t0[2] + x1a[1] * t0[3];
                      la[2] = x1a[2] * t1[0] - x2a[2] * t1[1]; ha[2] = x2a[2] * t1[0] + x1a[2] * t1[1];
                      la[3] = x1a[3] * t1[2] - x2a[3] * t1[3]; ha[3] = x2a[3] * t1[2] + x1a[3] * t1[3];
                      wl.x = cvt_pk_bf16(la[0], la[1]); wl.y = cvt_pk_bf16(la[2], la[3]); wh.x = cvt_pk_bf16(ha[0], ha[1]); wh.y = cvt_pk_bf16(ha[2], ha[3]);
                      if (which) {
#pragma unroll
                          for (int i = 0; i < 4; ++i) { cs[i] += la[i]; cs[8 + i] += ha[i]; } } }
                    { const f32x4 t2 = tg[mm][2], t3 = tg[mm][3]; const f32x4 x1b = acc[ai][0][m][1], x2b = acc[ai][1][m][1]; f32x4 lb_, hb;
                      lb_[0] = x1b[0] * t2[0] - x2b[0] * t2[1]; hb[0] = x2b[0] * t2[0] + x1b[0] * t2[1];
                      lb_[1] = x1b[1] * t2[2] - x2b[1] * t2[3]; hb[1] = x2b[1] * t2[2] + x1b[1] * t2[3];
                      lb_[2] = x1b[2] * t3[0] - x2b[2] * t3[1]; hb[2] = x2b[2] * t3[0] + x1b[2] * t3[1];
                      lb_[3] = x1b[3] * t3[2] - x2b[3] * t3[3]; hb[3] = x2b[3] * t3[2] + x1b[3] * t3[3];
                      wl.z = cvt_pk_bf16(lb_[0], lb_[1]); wl.w = cvt_pk_bf16(lb_[2], lb_[3]); wh.z = cvt_pk_bf16(hb[0], hb[1]); wh.w = cvt_pk_bf16(hb[2], hb[3]);
                      if (which) {
#pragma unroll
                          for (int i = 0; i < 4; ++i) { cs[4 + i] += lb_[i]; cs[12 + i] += hb[i]; } } }
                    *(u32x4*)(dst + (size_t)row * HW) = wl; *(u32x4*)(dst + (size_t)row * HW + 64) = wh; }
                    asm volatile("" ::: "memory"); }
            if (which) {
                float* ks = (float*)(ws + WS_KMEAN) + (size_t)(wr * NB + u.pm) * HW + head * HD + d;
#pragma unroll
                for (int i = 0; i < 16; ++i) { float v = cs[i]; v += __shfl_xor(v, 1); v += __shfl_xor(v, 2); v += __shfl_xor(v, 4); v += __shfl_xor(v, 8);
                    if (fr == 0) ks[(i & 7) + 64 * (i >> 3)] = v; }
            }
            return;
        }
        int kind, ld; size_t base; int colb;
        if (pn < 4) { kind = 1; base = WS_QH; ld = HW; colb = pn * 256; }
        else if (pn < 8) { kind = 3; base = WS_GH; ld = HW; colb = (pn - 4) * 256; }
        else if (pn < 12) { kind = 0; base = WS_VH; ld = HW; colb = (pn - 8) * 256; }
        else if (pn < 16) { kind = 1; base = WS_OG; ld = HW; colb = (pn - 12) * 256; }
        else if (pn < 28) { kind = 0; base = WS_MV; ld = HW; colb = (pn - 24) * 256; }
        else if (pn < 36) { kind = 2; base = WS_GA; ld = D; colb = (pn - 28) * 256; }
        else { kind = 2; base = WS_GB; ld = D; colb = (pn - 36) * 256; }
        if (kind == 3) {
            const float* lbp = (const float*)(ws + WS_LB) + colb + cl; float* dst = (float*)(ws + base) + colb + cl;
#pragma unroll
            for (int bj = 0; bj < 2; ++bj) { const f32x4 l0 = *(const f32x4*)(lbp + bj * HALF), l1 = *(const f32x4*)(lbp + bj * HALF + 4);
#pragma unroll
                for (int ai = 0; ai < 2; ++ai)
#pragma unroll
                    for (int m = 0; m < 4; ++m) { const int row = row0 + ai * HALF + m * 16; const f32x4 s0 = sig4(acc[ai][bj][m][0]), s1 = sig4(acc[ai][bj][m][1]); f32x4 o0, o1;
#pragma unroll
                        for (int i = 0; i < 4; ++i) { o0[i] = __logf(l0[i] + (1.f - l0[i]) * s0[i]); o1[i] = __logf(l1[i] + (1.f - l1[i]) * s1[i]); }
                        float* p = dst + (size_t)row * ld + bj * HALF; *(f32x4*)p = o0; *(f32x4*)(p + 4) = o1; } }
            return;
        }
        bf16_t* dst = (bf16_t*)(ws + base) + colb + cl;
#pragma unroll
        for (int ai = 0; ai < 2; ++ai)
#pragma unroll
            for (int m = 0; m < 4; ++m) { const int row = row0 + ai * HALF + m * 16;
#pragma unroll
                for (int bj = 0; bj < 2; ++bj) { f32x4 v0 = acc[ai][bj][m][0], v1 = acc[ai][bj][m][1];
                    if (kind == 1) { v0 = silu4(v0); v1 = silu4(v1); } else if (kind == 2) { v0 = sig4(v0); v1 = sig4(v1); }
                    *(u32x4*)(dst + (size_t)row * ld + bj * HALF) = pack8(v0, v1); } }
    }
};
struct EpiBf16Plain {
    static constexpr bool PERM = true, AFTER_DRAIN = false, HAS_MID = false;
    bf16_t* O; int ld;
    __device__ __forceinline__ void mid(f32x4 (&)[2][2][4][2], const Unit&, int, int, int, int) const {}
    __device__ __forceinline__ void operator()(const f32x4 (&acc)[2][2][4][2], const Unit& u, int wr, int wc, int fr, int fq) const {
        const int row0 = u.pm * BM + wr * 64 + fr, col0 = u.pn * BM + wc * 32 + 8 * fq;
#pragma unroll
        for (int ai = 0; ai < 2; ++ai)
#pragma unroll
            for (int m = 0; m < 4; ++m)
#pragma unroll
                for (int bj = 0; bj < 2; ++bj) *(u32x4*)(O + (size_t)(row0 + ai * HALF + m * 16) * ld + col0 + bj * HALF) = pack8(acc[ai][bj][m][0], acc[ai][bj][m][1]);
    }
};
template <int PASS> struct EpiUp {
    static constexpr bool PERM = true, AFTER_DRAIN = false, HAS_MID = false;
    const bf16_t* GT; bf16_t* O;
    __device__ __forceinline__ void mid(f32x4 (&)[2][2][4][2], const Unit&, int, int, int, int) const {}
    __device__ __forceinline__ void operator()(const f32x4 (&acc)[2][2][4][2], const Unit& u, int wr, int wc, int fr, int fq) const {
        const int row0 = u.pm * BM + wr * 64 + fr, col0 = u.pn * BM + wc * 32 + 8 * fq;
#pragma unroll
        for (int ai = 0; ai < 2; ++ai)
#pragma unroll
            for (int m = 0; m < 4; ++m) {
#pragma unroll
                for (int bj = 0; bj < 2; ++bj) { const size_t off = (size_t)(row0 + ai * HALF + m * 16) * D + col0 + bj * HALF; const u32x4 b = *(const u32x4*)(GT + off);
                    f32x4 v0 = acc[ai][bj][m][0], v1 = acc[ai][bj][m][1];
                    v0[0] *= bl(b.x); v0[1] *= bh(b.x); v0[2] *= bl(b.y); v0[3] *= bh(b.y); v1[0] *= bl(b.z); v1[1] *= bh(b.z); v1[2] *= bl(b.w); v1[3] *= bh(b.w);
                    if (PASS == 1) { const u32x4 p = *(const u32x4*)(O + off);
                        v0[0] += bl(p.x); v0[1] += bh(p.x); v0[2] += bl(p.y); v0[3] += bh(p.y); v1[0] += bl(p.z); v1[1] += bh(p.z); v1[2] += bl(p.w); v1[3] += bh(p.w); }
                    *(u32x4*)(O + off) = pack8(v0, v1); }
                asm volatile("" ::: "memory"); }
    }
};
struct EpiUp2 {
    static constexpr bool PERM = true, AFTER_DRAIN = false, HAS_MID = true;
    const bf16_t* GA; const bf16_t* GB; bf16_t* O;
    __device__ __forceinline__ void mid(f32x4 (&acc)[2][2][4][2], const Unit& u, int wr, int wc, int fr_, int fq_) const {
        int fr = fr_, fq = fq_; asm volatile("" : "+v"(fr), "+v"(fq));
        const int row0 = u.pm * BM + wr * 64 + fr, col0 = u.pn * BM + wc * 32 + 8 * fq;
#pragma unroll
        for (int ai = 0; ai < 2; ++ai) {
#pragma unroll
            for (int m = 0; m < 4; ++m) {
#pragma unroll
                for (int bj = 0; bj < 2; ++bj) { const size_t off = (size_t)(row0 + ai * HALF + m * 16) * D + col0 + bj * HALF; const u32x4 a = *(const u32x4*)(GA + off), b = *(const u32x4*)(GB + off);
                    const float lo = 8.673617379884035e-19f;
                    acc[ai][bj][m][0][0] *= bl(a.x) * __builtin_amdgcn_rcpf(fmaxf(bl(b.x), lo)); acc[ai][bj][m][0][1] *= bh(a.x) * __builtin_amdgcn_rcpf(fmaxf(bh(b.x), lo));
                    acc[ai][bj][m][0][2] *= bl(a.y) * __builtin_amdgcn_rcpf(fmaxf(bl(b.y), lo)); acc[ai][bj][m][0][3] *= bh(a.y) * __builtin_amdgcn_rcpf(fmaxf(bh(b.y), lo));
                    acc[ai][bj][m][1][0] *= bl(a.z) * __builtin_amdgcn_rcpf(fmaxf(bl(b.z), lo)); acc[ai][bj][m][1][1] *= bh(a.z) * __builtin_amdgcn_rcpf(fmaxf(bh(b.z), lo));
                    acc[ai][bj][m][1][2] *= bl(a.w) * __builtin_amdgcn_rcpf(fmaxf(bl(b.w), lo)); acc[ai][bj][m][1][3] *= bh(a.w) * __builtin_amdgcn_rcpf(fmaxf(bh(b.w), lo)); }
                asm volatile("" ::: "memory"); } }
    }
    __device__ __forceinline__ void operator()(const f32x4 (&acc)[2][2][4][2], const Unit& u, int wr, int wc, int fr, int fq) const {
        const int row0 = u.pm * BM + wr * 64 + fr, col0 = u.pn * BM + wc * 32 + 8 * fq;
        const float lo = 8.673617379884035e-19f;
#pragma unroll
        for (int ai = 0; ai < 2; ++ai) {
            u32x4 gb[4][2];
#pragma unroll
            for (int m = 0; m < 4; ++m)
#pragma unroll
                for (int bj = 0; bj < 2; ++bj) gb[m][bj] = *(const u32x4*)(GB + (size_t)(row0 + ai * HALF + m * 16) * D + col0 + bj * HALF);
#pragma unroll
            for (int m = 0; m < 4; ++m)
#pragma unroll
                for (int bj = 0; bj < 2; ++bj) { const size_t off = (size_t)(row0 + ai * HALF + m * 16) * D + col0 + bj * HALF; const u32x4 b = gb[m][bj];
                    f32x4 v0 = acc[ai][bj][m][0], v1 = acc[ai][bj][m][1];
                    v0[0] *= fmaxf(bl(b.x), lo); v0[1] *= fmaxf(bh(b.x), lo); v0[2] *= fmaxf(bl(b.y), lo); v0[3] *= fmaxf(bh(b.y), lo); v1[0] *= fmaxf(bl(b.z), lo); v1[1] *= fmaxf(bh(b.z), lo); v1[2] *= fmaxf(bl(b.w), lo); v1[3] *= fmaxf(bh(b.w), lo);
                    *(u32x4*)(O + off) = pack8(v0, v1); }
            asm volatile("" ::: "memory"); }
    }
};
template <int MODE  > struct EpiResid {
    static constexpr bool PERM = false, AFTER_DRAIN = false, HAS_MID = false;
    static constexpr int RG = (MODE == 0) ? 4 : 2;
    const float* base; float* out; const bf16_t* PP;
    __device__ __forceinline__ void mid(f32x4 (&)[2][2][4][2], const Unit&, int, int, int, int) const {}
    __device__ __forceinline__ void operator()(const f32x4 (&acc)[2][2][4][2], const Unit& u, int wr, int wc, int fr, int fq) const {
        const int row0 = u.pm * BM + wr * 64 + fr, col0 = u.pn * BM + wc * 32 + 4 * fq;
#pragma unroll
        for (int ai = 0; ai < 2; ++ai)
#pragma unroll
            for (int mp = 0; mp < 4 / RG; ++mp) {
                f32x4 bs[RG][2][2]; v2u pw[RG][2][2];
#pragma unroll
                for (int mm = 0; mm < RG; ++mm)
#pragma unroll
                    for (int bj = 0; bj < 2; ++bj)
#pragma unroll
                        for (int n = 0; n < 2; ++n) { const size_t off = (size_t)(row0 + ai * HALF + (RG * mp + mm) * 16) * D + col0 + bj * HALF + n * 16; bs[mm][bj][n] = *(const f32x4*)(base + off);
                            if (MODE == 1) pw[mm][bj][n] = *(const v2u*)(PP + off); }
#pragma unroll
                for (int mm = 0; mm < RG; ++mm)
#pragma unroll
                    for (int bj = 0; bj < 2; ++bj)
#pragma unroll
                        for (int n = 0; n < 2; ++n) { const size_t off = (size_t)(row0 + ai * HALF + (RG * mp + mm) * 16) * D + col0 + bj * HALF + n * 16; f32x4 v = acc[ai][bj][RG * mp + mm][n];
                            if (MODE == 1) { const unsigned p0 = pw[mm][bj][n].x, p1 = pw[mm][bj][n].y; v = sig4(v); v[0] *= bl(p0); v[1] *= bh(p0); v[2] *= bl(p1); v[3] *= bh(p1); }
                            *(f32x4*)(out + off) = bs[mm][bj][n] + v; }
                asm volatile("" ::: "memory"); }
    }
};
template <int MODE  > struct EpiResidB {
    static constexpr bool PERM = true, AFTER_DRAIN = false, HAS_MID = false;
    const float* basef; const bf16_t* XR; const bf16_t* PP; bf16_t* XO;
    __device__ __forceinline__ void mid(f32x4 (&)[2][2][4][2], const Unit&, int, int, int, int) const {}
    __device__ __forceinline__ void operator()(const f32x4 (&acc)[2][2][4][2], const Unit& u, int wr, int wc, int fr, int fq) const {
        const int row0 = u.pm * BM + wr * 64 + fr, col0 = u.pn * BM + wc * 32 + 8 * fq;
#pragma unroll
        for (int ai = 0; ai < 2; ++ai) {
            if (MODE == 0) {
                f32x4 b0[4][2], b1[4][2];
#pragma unroll
                for (int m = 0; m < 4; ++m)
#pragma unroll
                    for (int bj = 0; bj < 2; ++bj) { const float* p = basef + (size_t)(row0 + ai * HALF + m * 16) * D + col0 + bj * HALF; b0[m][bj] = *(const f32x4*)p; b1[m][bj] = *(const f32x4*)(p + 4); }
#pragma unroll
                for (int m = 0; m < 4; ++m)
#pragma unroll
                    for (int bj = 0; bj < 2; ++bj) *(u32x4*)(XO + (size_t)(row0 + ai * HALF + m * 16) * D + col0 + bj * HALF) = pack8(b0[m][bj] + acc[ai][bj][m][0], b1[m][bj] + acc[ai][bj][m][1]);
            } else {
                u32x4 xb[4][2], pb[4][2]; float rn[4];
#pragma unroll
                for (int m = 0; m < 4; ++m) rn[m] = basef[row0 + ai * HALF + m * 16];
#pragma unroll
                for (int m = 0; m < 4; ++m)
#pragma unroll
                    for (int bj = 0; bj < 2; ++bj) { const size_t off = (size_t)(row0 + ai * HALF + m * 16) * D + col0 + bj * HALF; xb[m][bj] = *(const u32x4*)(XR + off); pb[m][bj] = *(const u32x4*)(PP + off); }
#pragma unroll
                for (int m = 0; m < 4; ++m)
#pragma unroll
                    for (int bj = 0; bj < 2; ++bj) { const u32x4 xv = xb[m][bj], pv = pb[m][bj]; f32x4 v0 = sig4(acc[ai][bj][m][0] * rn[m]), v1 = sig4(acc[ai][bj][m][1] * rn[m]);
                        v0[0] = bl(xv.x) + v0[0] * bl(pv.x); v0[1] = bh(xv.x) + v0[1] * bh(pv.x); v0[2] = bl(xv.y) + v0[2] * bl(pv.y); v0[3] = bh(xv.y) + v0[3] * bh(pv.y);
                        v1[0] = bl(xv.z) + v1[0] * bl(pv.z); v1[1] = bh(xv.z) + v1[1] * bh(pv.z); v1[2] = bl(xv.w) + v1[2] * bl(pv.w); v1[3] = bh(xv.w) + v1[3] * bh(pv.w);
                        *(u32x4*)(XO + (size_t)(row0 + ai * HALF + m * 16) * D + col0 + bj * HALF) = pack8(v0, v1); }
            }
            asm volatile("" ::: "memory"); }
    }
};
struct EpiMoe1 {
    static constexpr bool PERM = true, AFTER_DRAIN = false, HAS_MID = false;
    bf16_t* H; const float* RG;
    __device__ __forceinline__ void mid(f32x4 (&)[2][2][4][2], const Unit&, int, int, int, int) const {}
    __device__ __forceinline__ void operator()(const f32x4 (&acc)[2][2][4][2], const Unit& u, int wr, int wc, int fr, int fq) const {
        const int row0 = u.pm * BM + wr * 64 + fr, col0 = (u.pn & 3) * 128 + wc * 32 + 8 * fq;
        float rg[2][4];
#pragma unroll
        for (int ai = 0; ai < 2; ++ai)
#pragma unroll
            for (int m = 0; m < 4; ++m) rg[ai][m] = RG[row0 + ai * HALF + m * 16];
#pragma unroll
        for (int ai = 0; ai < 2; ++ai)
#pragma unroll
            for (int m = 0; m < 4; ++m) { const float r = rg[ai][m]; const f32x4 g0 = silu4(acc[ai][0][m][0] * r), g1 = silu4(acc[ai][0][m][1] * r);
                *(u32x4*)(H + (size_t)(row0 + ai * HALF + m * 16) * DE + col0) = pack8(g0 * (acc[ai][1][m][0] * r), g1 * (acc[ai][1][m][1] * r)); }
    }
};
struct EpiMoe2 {
    static constexpr bool PERM = true, AFTER_DRAIN = false, HAS_MID = false;
    bf16_t* Y; const int* rowslot; const PG8_LAS int* pstart;
    __device__ __forceinline__ void mid(f32x4 (&)[2][2][4][2], const Unit&, int, int, int, int) const {}
    __device__ __forceinline__ void operator()(const f32x4 (&acc)[2][2][4][2], const Unit& u, int wr, int wc, int fr, int fq) const {
        const int row0 = u.pm * BM + wr * 64 + fr, col0 = (u.pn & 7) * 256 + wc * 32 + 8 * fq;
        const int e = u.pn >> 3, ps = pstart[e], pc = pstart[40 + e];
        int slot[2][4];
#pragma unroll
        for (int ai = 0; ai < 2; ++ai)
#pragma unroll
            for (int m = 0; m < 4; ++m) { const int prow = row0 + ai * HALF + m * 16; slot[ai][m] = (prow - ps < pc) ? __hip_atomic_load((int*)rowslot + prow, RLX_AGENT) : -1; }
#pragma unroll
        for (int ai = 0; ai < 2; ++ai)
#pragma unroll
            for (int m = 0; m < 4; ++m) if (slot[ai][m] >= 0) {
#pragma unroll
                for (int bj = 0; bj < 2; ++bj) *(u32x4*)(Y + (size_t)slot[ai][m] * D + col0 + bj * HALF) = pack8(acc[ai][bj][m][0], acc[ai][bj][m][1]); }
    }
};

template <class Epi, class Sched, bool ALIGN_EPI = false, bool SP2 = false>
__device__ __forceinline__ void gemm_phase(PG8_LAS unsigned char* lds, const Gemm g, const Sched& S, const Epi& E) {
    const int tid = threadIdx.x, wid = __builtin_amdgcn_readfirstlane(tid >> 6), lane = tid & 63, wr = wid >> 2, wc = wid & 3, fr = lane & 15, fq = lane >> 4;
    const int K = g.K, nt = K / BK;
    unsigned voffA[2], voffB[2];
#pragma unroll
    for (int i = 0; i < 2; ++i) { int R, C; stage_rc(tid * 16 + i * 8192, R, C); const int Rb = Epi::PERM ? ((R & ~31) + perm32(R & 31)) : R;
        voffA[i] = (unsigned)(R * g.lda + C) * 2u; voffB[i] = (unsigned)(Rb * g.ldb + C) * 2u; }
    const size_t kstep = (size_t)(BK * 2);
    const size_t hstepA = (size_t)HALF * g.lda * 2, hstepB = (size_t)HALF * g.ldb * 2;
    const size_t tstepA = 2 * hstepA, tstepB = 2 * hstepB;
    const unsigned ldsw = (unsigned)wid * 1024u;
    const int aoff = lds_byte(wr * 64 + fr, fq * 8), boff = lds_byte(wc * 32 + fr, fq * 8);
#define PG8_SA(b, h) (((b) * 2 + (h)) * HTB)
#define PG8_SB(b, h) ((4 + (b) * 2 + (h)) * HTB)
#define PG8_STAGE(bufoff, gbase, voff) do { _Pragma("unroll") for (int _i = 0; _i < 2; ++_i) \
        __builtin_amdgcn_global_load_lds((const unsigned*)((const char*)(gbase) + (voff)[_i]), (PG8_LAS unsigned*)(lds + (bufoff) + ldsw + _i * 8192), 16, 0, 0); } while (0)
#define PG8_LDA(dst, b, h) do { _Pragma("unroll") for (int m = 0; m < 4; ++m) _Pragma("unroll") for (int k = 0; k < 2; ++k) dst[m][k] = *(const PG8_LAS bf16x8*)(lds + PG8_SA(b, h) + aoff + m * 2048 + k * 1024); } while (0)
#define PG8_LDB(dst, b, h) do { _Pragma("unroll") for (int n = 0; n < 2; ++n) _Pragma("unroll") for (int k = 0; k < 2; ++k) dst[n][k] = *(const PG8_LAS bf16x8*)(lds + PG8_SB(b, h) + boff + n * 2048 + k * 1024); } while (0)
#define PG8_MMA(ai, bj, At, Bt) do { __builtin_amdgcn_s_setprio(1); _Pragma("unroll") for (int m = 0; m < 4; ++m) _Pragma("unroll") for (int n = 0; n < 2; ++n) _Pragma("unroll") for (int k = 0; k < 2; ++k) \
        acc[ai][bj][m][n] = __builtin_amdgcn_mfma_f32_16x16x32_bf16(Bt[n][k], At[m][k], acc[ai][bj][m][n], 0, 0, 0); __builtin_amdgcn_s_setprio(0); } while (0)
#define PG8_WAIT_V(n) asm volatile("s_waitcnt vmcnt(" #n ")" ::: "memory")
#define PG8_WAIT_L(n) asm volatile("s_waitcnt lgkmcnt(" #n ")" ::: "memory")
#define PG8_BAR __builtin_amdgcn_s_barrier()
#define PG8_SCHED __builtin_amdgcn_sched_barrier(0)
    Unit cur, nxt; int ui = 0;
    if (!S.next(0, cur)) return;
    f32x4 acc[2][2][4][2];
#pragma unroll
    for (int a = 0; a < 2; ++a)
#pragma unroll
        for (int b = 0; b < 2; ++b)
#pragma unroll
            for (int m = 0; m < 4; ++m)
#pragma unroll
                for (int n = 0; n < 2; ++n) acc[a][b][m][n] = (f32x4){0.f, 0.f, 0.f, 0.f};
    bf16x8 At[4][2], B0[2][2], B1[2][2];
    const char* cA = (const char*)g.A + (size_t)cur.pm * tstepA; const char* cB = (const char*)g.Bt + (size_t)cur.pn * tstepB;
    S.a_ready(cur);
    if constexpr (SP2) {
        PG8_STAGE(PG8_SB(0, 0), cB, voffB); PG8_STAGE(PG8_SB(0, 1), cB + hstepB, voffB); PG8_STAGE(PG8_SA(0, 0), cA, voffA); PG8_STAGE(PG8_SA(0, 1), cA + hstepA, voffA);
        if (wr == 1) PG8_BAR;
        PG8_WAIT_V(2); PG8_BAR;
        PG8_STAGE(PG8_SB(1, 0), cB + kstep, voffB); PG8_STAGE(PG8_SA(1, 0), cA + kstep, voffA); PG8_STAGE(PG8_SB(1, 1), cB + hstepB + kstep, voffB);
        PG8_WAIT_V(6); PG8_BAR;
    } else {
        PG8_STAGE(PG8_SB(0, 0), cB, voffB); PG8_STAGE(PG8_SA(0, 0), cA, voffA); PG8_STAGE(PG8_SB(0, 1), cB + hstepB, voffB); PG8_STAGE(PG8_SA(0, 1), cA + hstepA, voffA);
        if (wr == 1) PG8_BAR;
        PG8_WAIT_V(4); PG8_BAR;
        PG8_STAGE(PG8_SB(1, 0), cB + kstep, voffB); PG8_STAGE(PG8_SA(1, 0), cA + kstep, voffA); PG8_STAGE(PG8_SB(1, 1), cB + hstepB + kstep, voffB);
        PG8_WAIT_V(6); PG8_BAR;
    }
    for (;;) {
        const bool has_next = S.next(ui + 1, nxt);
        const char* nA = has_next ? (const char*)g.A + (size_t)nxt.pm * tstepA : cA; const char* nB = has_next ? (const char*)g.Bt + (size_t)nxt.pn * tstepB : cB;
        for (int t = 0; t < nt; t += 2) {
            const bool last = (t == nt - 2);
            if constexpr (Epi::HAS_MID) { if (t == (nt >> 1)) E.mid(acc, cur, wr, wc, fr, fq); }
            const char* a1 = cA + (size_t)(t + 1) * kstep;
            const char* a2 = last ? nA : cA + (size_t)(t + 2) * kstep; const char* b2 = last ? nB : cB + (size_t)(t + 2) * kstep;
            const char* a3 = a2 + kstep; const char* b3 = b2 + kstep;
            if (last && has_next) S.a_ready(nxt);
            if constexpr (SP2) {
            PG8_LDB(B0, 0, 0); PG8_LDB(B1, 0, 1); PG8_SCHED; PG8_LDA(At, 0, 0); PG8_STAGE(PG8_SA(1, 1), a1 + hstepA, voffA);
            PG8_WAIT_V(8); PG8_WAIT_L(0); PG8_BAR; PG8_MMA(0, 0, At, B0); PG8_MMA(0, 1, At, B1); PG8_BAR; PG8_SCHED;
            PG8_LDA(At, 0, 1); PG8_STAGE(PG8_SB(0, 0), b2, voffB); PG8_STAGE(PG8_SB(0, 1), b2 + hstepB, voffB); PG8_STAGE(PG8_SA(0, 0), a2, voffA);
            PG8_WAIT_V(8); PG8_WAIT_L(0); PG8_BAR; PG8_MMA(1, 0, At, B0); PG8_MMA(1, 1, At, B1); PG8_BAR; PG8_SCHED;
            PG8_LDB(B0, 1, 0); PG8_LDB(B1, 1, 1); PG8_SCHED; PG8_LDA(At, 1, 0); PG8_STAGE(PG8_SA(0, 1), a2 + hstepA, voffA);
            PG8_WAIT_V(8); PG8_WAIT_L(0); PG8_BAR; PG8_MMA(0, 0, At, B0); PG8_MMA(0, 1, At, B1); PG8_BAR; PG8_SCHED;
            PG8_LDA(At, 1, 1); PG8_STAGE(PG8_SB(1, 0), b3, voffB); PG8_STAGE(PG8_SB(1, 1), b3 + hstepB, voffB); PG8_STAGE(PG8_SA(1, 0), a3, voffA);
            PG8_WAIT_V(8); PG8_WAIT_L(0); PG8_BAR; PG8_MMA(1, 0, At, B0); PG8_MMA(1, 1, At, B1); PG8_BAR; PG8_SCHED;
            } else {
            PG8_LDB(B0, 0, 0); PG8_SCHED; PG8_LDA(At, 0, 0); PG8_STAGE(PG8_SA(1, 1), a1 + hstepA, voffA);
            PG8_WAIT_L(8); PG8_BAR; PG8_WAIT_L(0); PG8_MMA(0, 0, At, B0); PG8_BAR; PG8_SCHED;
            PG8_LDB(B1, 0, 1); PG8_STAGE(PG8_SB(0, 0), b2, voffB);
            PG8_BAR; PG8_WAIT_L(0); PG8_MMA(0, 1, At, B1); PG8_BAR;
            PG8_LDA(At, 0, 1); PG8_STAGE(PG8_SA(0, 0), a2, voffA);
            PG8_BAR; PG8_WAIT_L(0); PG8_MMA(1, 0, At, B0); PG8_BAR; PG8_SCHED;
            PG8_STAGE(PG8_SB(0, 1), b2 + hstepB, voffB);
            PG8_WAIT_V(6); PG8_BAR; PG8_MMA(1, 1, At, B1); PG8_BAR;
            PG8_LDB(B0, 1, 0); PG8_SCHED; PG8_LDA(At, 1, 0); PG8_STAGE(PG8_SA(0, 1), a2 + hstepA, voffA);
            PG8_WAIT_L(8); PG8_BAR; PG8_WAIT_L(0); PG8_MMA(0, 0, At, B0); PG8_BAR; PG8_SCHED;
            PG8_LDB(B1, 1, 1); PG8_STAGE(PG8_SB(1, 0), b3, voffB);
            PG8_BAR; PG8_WAIT_L(0); PG8_MMA(0, 1, At, B1); PG8_BAR;
            PG8_LDA(At, 1, 1); PG8_STAGE(PG8_SA(1, 0), a3, voffA);
            PG8_BAR; PG8_WAIT_L(0); PG8_MMA(1, 0, At, B0); PG8_BAR; PG8_SCHED;
            PG8_STAGE(PG8_SB(1, 1), b3 + hstepB, voffB);
            PG8_WAIT_V(6); PG8_BAR; PG8_MMA(1, 1, At, B1); PG8_BAR;
            }
        }
        if constexpr (ALIGN_EPI) { if (wr == 0) PG8_BAR; }
        if constexpr (!Epi::AFTER_DRAIN) { E(acc, cur, wr, wc, fr, fq); S.done(cur); }
        if (!has_next) break;
#pragma unroll
        for (int a = 0; a < 2; ++a)
#pragma unroll
            for (int b = 0; b < 2; ++b)
#pragma unroll
                for (int m = 0; m < 4; ++m)
#pragma unroll
                    for (int n = 0; n < 2; ++n) acc[a][b][m][n] = (f32x4){0.f, 0.f, 0.f, 0.f};
        cur = nxt; cA = nA; cB = nB; ++ui;
        if constexpr (ALIGN_EPI) { if (wr == 1) PG8_BAR; }
    }
    PG8_WAIT_V(0);
    if constexpr (!ALIGN_EPI) { if (wr == 0) PG8_BAR; }
    PG8_BAR;
    if constexpr (Epi::AFTER_DRAIN) { E.fused(acc, cur, wr, wc, fr, fq, lds, wid, lane); S.done(cur); }
#undef PG8_SA
#undef PG8_SB
#undef PG8_STAGE
#undef PG8_LDA
#undef PG8_LDB
#undef PG8_MMA
#undef PG8_WAIT_V
#undef PG8_WAIT_L
#undef PG8_BAR
#undef PG8_SCHED
}

}
#define PG8_SP2 true
#define PG8_ALIGN true

__global__ void __launch_bounds__(NTHR, 2) fwd(Args args) {
    extern __shared__ __attribute__((aligned(16))) unsigned char lds[];
    Frame F;
    F.lds = (LAS unsigned char*)lds;
    F.MISC = (volatile LAS unsigned*)(F.lds + MISC_OFF);
    F.tid = 0; F.lane = 0; F.wave = __builtin_amdgcn_readfirstlane(threadIdx.x >> 6);
    F.G = gridDim.x; { const int bx = blockIdx.x; F.vcu = (F.G % 8 == 0) ? (bx % 8) * (F.G / 8) + bx / 8 : bx; }
    unsigned char* ws = args.ws; F.ws = ws;
    F.ctl = (gu32*)(ws + WS_CTL);
    for (int u = threadIdx.x; u < (LDS_BYTES - LDSCTL_OFF) / 4; u += NTHR) ((LAS unsigned*)(F.lds + LDSCTL_OFF))[u] = 0u;
    __syncthreads();
    XcdBarrier bar = xcd_barrier_post((unsigned*)(F.ctl + CW_BAR) + args.li * XCD_BAR_WORDS, F.MISC + 8);
    const int lo = args.ph_lo, hi = args.ph_hi;
#define IN(k) (lo <= (k) && (k) < hi)
#define SEAM(k) do { if (IN(k) && IN((k) + 1)) xcd_barrier(bar); } while (0)
    const int wave = F.wave;
    const int gw = F.vcu * NWAVES + wave, NGW = F.G * NWAVES;
    const int NGT = F.G * NTHR;
#define TVARS const int tid = opaque_tid(); const int lane = tid & 63; const int gt = blockIdx.x * NTHR + tid; (void)lane; (void)gt;
    LAS float* As = (LAS float*)F.lds; LAS float* Bs = As + 16 * 132;
    const float* x = args.in[I_X];
    float* out = args.out;

    if (IN(0)) {
        TVARS
        for (int m = gw; m < T; m += NGW) rms_row_to_bf16(lane, x + (size_t)m * D, args.in[I_NMIX], (bf16*)(ws + WS_H1) + (size_t)m * D);
        { const f32x4* p4 = (const f32x4*)args.in[I_P]; v2u* o = (v2u*)(ws + WS_PB);
          for (int i = gt; i < T * PLE / 4; i += NGT) { const f32x4 v = p4[i]; v2u w; w.x = pk2(v.x, v.y); w.y = pk2(v.z, v.w); o[i] = w; } }
        { f32x2* tr = (f32x2*)(ws + WS_TRIG);
          for (int i = gt; i < T * 64; i += NGT) { const int pos = i >> 6, j = i & 63; double r = (double)pos * args.rfreq[j]; r -= floor(r); if (r > 0.5) r -= 1.0;
              const float rf = (float)r; f32x2 cs; cs.x = __builtin_amdgcn_cosf(rf); cs.y = __builtin_amdgcn_sinf(rf); tr[i] = cs; } }
        { float* lb = (float*)(ws + WS_LB); const float* raw = args.in[I_LBRAW];
          for (int c = gt; c < HW; c += NGT) lb[c] = 1.0f / (1.0f + expf(raw[HW + c] - raw[c])); }
        { float* wrt = (float*)(ws + WS_WRT); const float* wg = args.in[I_WRG]; const float* we = args.in[I_WRE];
          for (int i = gt; i < 36 * D; i += NGT) { const int c = i / D, k = i % D; wrt[i] = args.in[I_NFFN][k] * ((c < 4) ? wg[k * 4 + c] : we[k * NE + (c - 4)]); } }
        { LAS float* scr = (LAS float*)(F.lds + wave * 16384);
          constexpr int I_IN = 32 * 352, I_UH = 16 * 64, I_UM = 16 * 64, I_O = 32 * 64, I_G = 32 * 64, I_PP = 4 * 64;
          for (int it = gw; it < I_IN + I_PP; it += NGW) { int r = it;
              if (r < I_IN) { const int kb = r / 352, nb = r % 352; transpose_item(args.in[I_WIN], INC, kb * 64, phys2log_inproj(nb * 32), (bf16*)(ws + WS_WIN_T), D, nb * 32, kb * 64, scr, lane); continue; } r -= I_IN;
              { const int kb = r / 64, nb = r % 64; transpose_item(args.in[I_WPP], D, kb * 64, nb * 32, (bf16*)(ws + WS_WPP_T), PLE, nb * 32, kb * 64, scr, lane); } } }
    }
    SEAM(0);

    if (IN(1) && FP1) {
        { pg8::Gemm g{(const bf16*)(ws + WS_H1), (const bf16*)(ws + WS_WIN_T), D, D, D}; pg8::StaticOrder S; S.init(T, INC, F.G, (int)blockIdx.x); pg8::EpiInProj E{ws};
          pg8::gemm_phase<pg8::EpiInProj, pg8::StaticOrder, PG8_ALIGN, PG8_SP2>(F.lds, g, S, E); }
        {
            const int nbusy = ((T / 256) * (INC / 256)) % F.G, c = (int)blockIdx.x;
            if (nbusy == 0 || c >= nbusy) { const int nh = nbusy == 0 ? F.G : F.G - nbusy, hr = nbusy == 0 ? c : c - nbusy;
                { pg8::Gemm g2{(const bf16*)(ws + WS_PB), (const bf16*)(ws + WS_WPP_T), PLE, PLE, PLE}; pg8::StaticOrder S2; S2.init(T, D, nh, hr); pg8::EpiBf16Plain E2{(bf16*)(ws + WS_PP), D};
                  pg8::gemm_phase<pg8::EpiBf16Plain, pg8::StaticOrder, PG8_ALIGN, PG8_SP2>(F.lds, g2, S2, E2); }
                __syncthreads();
                { TVARS
                  LAS float* scr = (LAS float*)(F.lds + wave * 16384);
                  constexpr int I_UH = 16 * 64, I_UM = 16 * 64, I_O = 32 * 64, I_G = 32 * 64;
                  auto item1 = [&](int it) -> TrItem { TrItem q; int r = it; q.ldw = D; q.ldt = D; q.gk = nullptr;
                      if (r < I_UH) { const int kb = r / 64, nb = r % 64; q.src = args.in[I_WUH] + (size_t)(kb * 64) * D + nb * 32; q.dst = (bf16*)(ws + WS_WUP_T) + (size_t)(nb * 32) * D + kb * 64; return q; } r -= I_UH;
                      if (r < I_UM) { const int kb = r / 64, nb = r % 64; q.src = args.in[I_WUM] + (size_t)(kb * 64) * D + nb * 32; q.dst = (bf16*)(ws + WS_WUP_T) + (size_t)(nb * 32) * D + HW + kb * 64; return q; } r -= I_UM;
                      if (r < I_O) { const int kb = r / 64, nb = r % 64; q.src = args.in[I_WOUT] + (size_t)(kb * 64) * D + nb * 32; q.dst = (bf16*)(ws + WS_WOUT_T) + (size_t)(nb * 32) * D + kb * 64; return q; } r -= I_O;
                      { const int kb = r / 64, nb = r % 64; q.src = args.in[I_WPG] + (size_t)(kb * 64) * D + nb * 32; q.dst = (bf16*)(ws + WS_WPG_T) + (size_t)(nb * 32) * D + kb * 64; q.gk = args.in[I_NPLE] + kb * 64; return q; } };
                  TR_PIPE(hr * NWAVES + wave, I_UH + I_UM + I_O + I_G, nh * NWAVES, item1); }
            }
        }
    }
    if (IN(1) && !FP1) {
        TVARS
        const bf16* H1 = (const bf16*)(ws + WS_H1);
        constexpr int NT1 = (T / 128) * (INC / 128), NT2 = (T / 128) * (D / 128);
        for (int it = F.vcu; it < NT1 + NT2; it += F.G) {
            float acc[8][4]; zero_acc(acc);
            const int tx = tid & 31, ty = tid >> 5;
            if (it < NT1) {
                const int tm = it / (INC / 128), tn = it % (INC / 128);
                sgemm_acc(acc, As, Bs, H1, D, tm * 128, args.in[I_WIN], INC, tn * 128, D, tid);
#pragma unroll
                for (int i = 0; i < 8; ++i) inproj_epi(ws, tm * 128 + ty * 8 + i, tn * 128 + tx * 4, acc[i]);
            } else {
                const int r = it - NT1, tm = r / (D / 128), tn = r % (D / 128);
                sgemm_acc(acc, As, Bs, (const bf16*)(ws + WS_PB), PLE, tm * 128, args.in[I_WPP], D, tn * 128, PLE, tid);
#pragma unroll
                for (int i = 0; i < 8; ++i) st_bf16x4((bf16*)(ws + WS_PP) + (size_t)(tm * 128 + ty * 8 + i) * D + tn * 128 + tx * 4, acc[i][0], acc[i][1], acc[i][2], acc[i][3]);
            }
        }
    }
    SEAM(1);

    if (IN(2) && (FHG || FMB)) {
        TVARS
        if (FHG) for (int it = F.vcu; it < 128 * NH; it += F.G) hgrn_pass_a(ws, F.lds, it, tid);
        __syncthreads();
        if (FMB) for (int it = F.vcu; it < NH * NB; it += F.G) if ((it & 31) > 0) moba_gate_lists(ws, F.ctl, F.lds, it >> 5, it & 31, tid);
    }
    if (IN(2) && !FP1) {
        TVARS
        const float* raw = (const float*)(ws + WS_TMPF); const f32x2* tr = (const f32x2*)(ws + WS_TRIG);
        for (int i = gt; i < T * 16 * 64; i += NGT) {
            const int j = i & 63, hh = (i >> 6) & 15, t = i >> 10;
            const float x1 = raw[(size_t)t * D + hh * 128 + j], x2 = raw[(size_t)t * D + hh * 128 + 64 + j];
            const f32x2 cs = tr[t * 64 + j];
            bf16* dst = (hh < 8) ? (bf16*)(ws + WS_MQ) + (size_t)t * HW + hh * 128 : (bf16*)(ws + WS_MK) + (size_t)t * HW + (hh - 8) * 128;
            dst[j] = (bf16)f2bf(x1 * cs.x - x2 * cs.y); dst[64 + j] = (bf16)f2bf(x2 * cs.x + x1 * cs.y);
        }
    }
    SEAM(2);
    if (IN(3) && (FHG || FMB)) {
        TVARS
        {
            const bf16* DSb = (const bf16*)(ws + WS_DS); const float* DEC = (const float*)(ws + WS_DEC); bf16* STb = (bf16*)(ws + WS_ST);
            constexpr int SCN = 4;
            if (FHG) for (int e0 = (F.vcu * NTHR * SCN) + tid; e0 < NH * HD * HD; e0 += F.G * NTHR * SCN) {
                float S[SCN]; const bf16* ds[SCN]; const float* dec[SCN]; bf16* st[SCN];
#pragma unroll
                for (int i = 0; i < SCN; ++i) { const int e = e0 + i * NTHR, h = e >> 14, rem = e & 16383, k = e & 127; S[i] = 0.f; ds[i] = DSb + h * 16384 + rem; dec[i] = DEC + h * HD + k; st[i] = STb + h * 16384 + rem; }
                for (int c0 = 0; c0 < 128; c0 += 4) {
                    float dv[4][SCN], gv[4][SCN];
#pragma unroll
                    for (int cc = 0; cc < 4; ++cc)
#pragma unroll
                        for (int i = 0; i < SCN; ++i) { dv[cc][i] = bf2f(ds[i][(size_t)(c0 + cc) * 131072]); gv[cc][i] = dec[i][(c0 + cc) * 1024]; }
#pragma unroll
                    for (int cc = 0; cc < 4; ++cc)
#pragma unroll
                        for (int i = 0; i < SCN; ++i) { st[i][(size_t)(c0 + cc) * 131072] = (bf16)f2bf(S[i]); S[i] = gv[cc][i] * S[i] + dv[cc][i]; } } }
        }
        if (FMB) {
            LAS int* ust = (LAS int*)(F.lds + LDSCTL_OFF + 1024); LAS int* cn = ust + 260; volatile LAS int* cur_w = (volatile LAS int*)(ust + 520);
            __syncthreads();
            if (tid < NH * NB) cn[tid] = (int)__hip_atomic_load((unsigned*)(F.ctl + CW_MCNT) + tid, RLX_AGENT);
            __syncthreads();
            if (tid == 0) { int a = 0; for (int i = 0; i < NH * NB; ++i) { ust[i] = a; a += (cn[i] + MB_RCH - 1) / MB_RCH; } ust[NH * NB] = a; }
            __syncthreads();
            const int nch = ust[NH * NB], total = nch + NH * NB;
            for (;;) {
                if (tid == 0) *cur_w = (int)__hip_atomic_fetch_add((unsigned*)(F.ctl + 8), 1u, RLX_AGENT);
                __syncthreads();
                const int w = *cur_w;
                __syncthreads();
                if (w >= total) break;
                int idx, n; bool causal; const unsigned short* gl = (const unsigned short*)(ws + WS_GL);
                if (w < nch) { int lo2 = 0, hi2 = NH * NB - 1;
                    while (lo2 < hi2) { const int mid = (lo2 + hi2 + 1) >> 1; if (ust[mid] <= w) lo2 = mid; else hi2 = mid - 1; }
                    idx = lo2; const int r0 = (w - ust[idx]) * MB_RCH; n = cn[idx] - r0; n = n > MB_RCH ? MB_RCH : n; gl += (size_t)idx * 8192 + r0; causal = false; }
                else { idx = w - nch; n = 256; causal = true; }
                idx = __builtin_amdgcn_readfirstlane(idx); n = __builtin_amdgcn_readfirstlane(n);
                moba_kv_item(ws, F.lds, idx >> 5, idx & 31, causal, gl, n, tid);
            }
        }
    }

    if (IN(3)) {
        TVARS
        if (!FP1) { const bf16* MK = (const bf16*)(ws + WS_MK); float* km = (float*)(ws + WS_KMEAN);
          for (int i = gt; i < NB * HW; i += NGT) { const int jb = i / HW, c = i % HW; float s = 0.f;
              for (int r = 0; r < BS; ++r) s += bf2f(MK[(size_t)(jb * BS + r) * HW + c]);
              km[i] = s; km[NB * HW + i] = 0.f; } }
        if (!FHG && wave == 0 && blockIdx.x < 16) {
            const int h = blockIdx.x >> 1, v = (blockIdx.x & 1) * 64 + lane;
            const float* GH = (const float*)(ws + WS_GH) + h * HD; const bf16* QH = (const bf16*)(ws + WS_QH) + h * HD; const bf16* VH = (const bf16*)(ws + WS_VH) + h * HD + v;
            float* ORAW = (float*)(ws + WS_TMPF) + h * HD + v;
            float S[HD];
#pragma unroll
            for (int k = 0; k < HD; ++k) S[k] = 0.f;
            for (int t = 0; t < T; ++t) {
                const float iv = bf2f(VH[(size_t)t * HW]); float o = 0.f;
                const float* g = GH + (size_t)t * HW; const bf16* q = QH + (size_t)t * HW;
#pragma unroll
                for (int k = 0; k < HD; ++k) { const float f = __expf(g[k]); S[k] = f * S[k] + (1.f - f) * iv; o += S[k] * bf2f(q[k]); }
                ORAW[(size_t)t * HW] = o;
            }
        }
    }
    SEAM(3);
    if (IN(4) && (FHG || FMB)) {
        TVARS
        const bool merge_first = (F.vcu & 1) != 0;
        auto passc4 = [&]() { if (FHG) for (int it = F.vcu; it < 128 * NH; it += F.G) hgrn_pass_c(ws, F.lds, args.in[I_HNG], it, tid); };
        if (!merge_first) passc4();
        if (false) for (int it0 = F.vcu; it0 < NH * NB; it0 += F.G) if ((it0 & 31) < 16) { const int it = it0 ^ 16;
            const int h = it >> 5, cur = it & 31; const bf16* PO = (const bf16*)(ws + WS_PO); const float* PL = (const float*)(ws + WS_PLSE); bf16* AUP = (bf16*)(ws + WS_AUP);
            for (int idx = tid; idx < BS * 16; idx += NTHR) { const int t = cur * BS + (idx >> 4), dq = idx & 15, th = t * NH + h;
                const float* plp = PL + (size_t)th * 128; float ls[4]; ls[0] = plp[0]; ls[1] = plp[32]; ls[2] = plp[64]; ls[3] = plp[96];
                bool ok[4]; float M = -3.0e38f;
#pragma unroll
                for (int i = 0; i < 4; ++i) { ok[i] = fabsf(ls[i]) < 1.0e4f && fabsf(ls[i]) > 1.0e-9f; if (ok[i]) M = fmaxf(M, ls[i]); }
                float wv[4], wsum = 0.f;
#pragma unroll
                for (int i = 0; i < 4; ++i) { wv[i] = ok[i] ? __expf(ls[i] - M) : 0.f; wsum += wv[i]; }
                const float inv = wsum > 0.f ? 1.0f / wsum : 0.f;
                float acc[8] = {0.f, 0.f, 0.f, 0.f, 0.f, 0.f, 0.f, 0.f};
#pragma unroll
                for (int i = 0; i < 4; ++i) { const v4u pw = *(const v4u*)(PO + ((size_t)th * 4 + i) * HD + dq * 8); const float wi = wv[i] * inv;
                    float pv[8] = {bflo(pw.x), bfhi(pw.x), bflo(pw.y), bfhi(pw.y), bflo(pw.z), bfhi(pw.z), bflo(pw.w), bfhi(pw.w)};
#pragma unroll
                    for (int q = 0; q < 8; ++q) { const float x = fabsf(pv[q]) < 1.0e4f ? pv[q] : 0.f; acc[q] += wi * x; } }
                v4u ov; ov.x = pk2(acc[0], acc[1]); ov.y = pk2(acc[2], acc[3]); ov.z = pk2(acc[4], acc[5]); ov.w = pk2(acc[6], acc[7]);
                *(v4u*)(AUP + (size_t)t * D + HW + h * HD + dq * 8) = ov; }
        }
        if (FMB) {
            const bf16* PO = (const bf16*)(ws + WS_PO); const float* PL = (const float*)(ws + WS_PLSE); bf16* AUP = (bf16*)(ws + WS_AUP);
            for (int idx0 = gt; idx0 < T * NH * 16; idx0 += 2 * NGT) {
                float ls[2][4]; v4u pw[2][4]; int nvv[2];
#pragma unroll
                for (int u = 0; u < 2; ++u) { int idx = idx0 + u * NGT; if (idx >= T * NH * 16) idx = idx0; const int th = idx >> 4, dq = idx & 15, cur = th >> 11; nvv[u] = cur < 3 ? cur : 3;
                    const f32x4 l4 = *(const f32x4*)(PL + (size_t)th * 4);
#pragma unroll
                    for (int i = 0; i < 4; ++i) { ls[u][i] = l4[i]; pw[u][i] = *(const v4u*)(PO + ((size_t)th * 4 + i) * HD + dq * 8); } }
#pragma unroll
                for (int u = 0; u < 2; ++u) { const int idx = idx0 + u * NGT; if (idx >= T * NH * 16) break; const int th = idx >> 4, dq = idx & 15, t = th >> 3, h = th & 7, nv = nvv[u];
                    float M = ls[u][0];
#pragma unroll
                    for (int i = 1; i < 4; ++i) if (i <= nv) M = fmaxf(M, ls[u][i]);
                    float wv[4]; wv[0] = __expf(ls[u][0] - M);
#pragma unroll
                    for (int i = 1; i < 4; ++i) wv[i] = (i <= nv) ? __expf(ls[u][i] - M) : 0.f;
                    const float inv = 1.0f / ((wv[0] + wv[1]) + (wv[2] + wv[3]));
                    float acc[8] = {0.f, 0.f, 0.f, 0.f, 0.f, 0.f, 0.f, 0.f};
#pragma unroll
                    for (int i = 0; i < 4; ++i) { v4u p = pw[u][i]; if (i > nv) { p.x = 0u; p.y = 0u; p.z = 0u; p.w = 0u; } const float wi = wv[i] * inv;
                        acc[0] += wi * bflo(p.x); acc[1] += wi * bfhi(p.x); acc[2] += wi * bflo(p.y); acc[3] += wi * bfhi(p.y); acc[4] += wi * bflo(p.z); acc[5] += wi * bfhi(p.z); acc[6] += wi * bflo(p.w); acc[7] += wi * bfhi(p.w); }
                    v4u ov; ov.x = pk2(acc[0], acc[1]); ov.y = pk2(acc[2], acc[3]); ov.z = pk2(acc[4], acc[5]); ov.w = pk2(acc[6], acc[7]);
                    *(v4u*)(AUP + (size_t)t * D + HW + h * HD + dq * 8) = ov; } }
        }
        if (merge_first) passc4();
    }

    if (IN(4)) {
        TVARS
        bf16* AUP = (bf16*)(ws + WS_AUP);
        if (!FHG) { const float* ORAW = (const float*)(ws + WS_TMPF); const bf16* OG = (const bf16*)(ws + WS_OG); const float* ng = args.in[I_HNG];
          for (int it = gw; it < T * NH; it += NGW) { const int t = it >> 3, h = it & 7; const size_t off = (size_t)t * HW + h * HD + 2 * lane;
              const f32x2 o = *(const f32x2*)(ORAW + off); const float r = 1.0f / sqrtf(wave_sum(o.x * o.x + o.y * o.y) * (1.f / HD) + EPS);
              const unsigned og = *(const unsigned*)(OG + off);
              *(unsigned*)(AUP + (size_t)t * D + h * HD + 2 * lane) = pk2(o.x * r * ng[2 * lane] * bflo(og), o.y * r * ng[2 * lane + 1] * bfhi(og)); } }
        LAS float* qs = (LAS float*)F.lds + 32768 / 4 + wave * 1280; LAS float* sc = qs + 128;
        const bf16* MQ = (const bf16*)(ws + WS_MQ); const bf16* MK = (const bf16*)(ws + WS_MK); const bf16* MV = (const bf16*)(ws + WS_MV); const float* KM = (const float*)(ws + WS_KMEAN);
        const float scale = 0.08838834764831845f;
        if (FMB != 1) for (int it = gw; it < T * NH; it += NGW) {
            const int t = it >> 3, h = it & 7, cur = t >> 8;
            { const unsigned qw = *(const unsigned*)(MQ + (size_t)t * HW + h * HD + 2 * lane); qs[2 * lane] = bflo(qw); qs[2 * lane + 1] = bfhi(qw); }
            LDS_WAIT();
            float gate = -3.0e38f;
            if (lane < NB) { gate = -1e30f; if (lane < cur) { float s0 = 0.f, s1 = 0.f; const f32x4* ka = (const f32x4*)(KM + (size_t)lane * HW + h * HD); const f32x4* kb = (const f32x4*)(KM + (size_t)(NB + lane) * HW + h * HD);
#pragma unroll
                    for (int d4 = 0; d4 < 32; ++d4) { const f32x4 a = ka[d4], b2 = kb[d4]; const LAS float* q4 = qs + 4 * d4;
                        s0 += q4[0] * (a.x + b2.x) + q4[1] * (a.y + b2.y); s1 += q4[2] * (a.z + b2.z) + q4[3] * (a.w + b2.w); }
                    gate = (s0 + s1) * (1.f / BS); } }
            int blk[4]; bool val[4]; blk[0] = cur; val[0] = true;
#pragma unroll
            for (int r = 0; r < 3; ++r) { const float mxg = wave_max(gate); const unsigned long long bm = __ballot(gate == mxg); const int sel = __ffsll((long long)bm) - 1;
                blk[r + 1] = sel; val[r + 1] = sel < cur; if (lane == sel) gate = -3.0e38f; }
            float mx = -3.0e38f;
#pragma unroll
            for (int b = 0; b < 4; ++b) if (val[b]) for (int g = 0; g < 4; ++g) {
                const int key = blk[b] * BS + g * 64 + lane; const v4u* kr = (const v4u*)(MK + (size_t)key * HW + h * HD); float s = 0.f;
#pragma unroll
                for (int c = 0; c < 16; ++c) { const v4u kw = kr[c]; const LAS float* q8 = qs + c * 8;
                    s += q8[0] * bflo(kw.x) + q8[1] * bfhi(kw.x) + q8[2] * bflo(kw.y) + q8[3] * bfhi(kw.y) + q8[4] * bflo(kw.z) + q8[5] * bfhi(kw.z) + q8[6] * bflo(kw.w) + q8[7] * bfhi(kw.w); }
                s = (b == 0 && key > t) ? -1e30f : s * scale; sc[b * 256 + g * 64 + lane] = s; mx = fmaxf(mx, s); }
            mx = wave_max(mx); float l = 0.f;
#pragma unroll
            for (int b = 0; b < 4; ++b) if (val[b]) for (int g = 0; g < 4; ++g) { const int i = b * 256 + g * 64 + lane; const float p = __expf(sc[i] - mx); sc[i] = p; l += p; }
            l = wave_sum(l); LDS_WAIT();
            float o0 = 0.f, o1 = 0.f;
#pragma unroll
            for (int b = 0; b < 4; ++b) if (val[b]) { const bf16* vb = MV + (size_t)(blk[b] * BS) * HW + h * HD + 2 * lane;
                float a0 = 0.f, a1 = 0.f, c0 = 0.f, c1 = 0.f;
#pragma unroll 1
                for (int k = 0; k < 256; k += 16) { unsigned vw[16];
#pragma unroll
                    for (int u = 0; u < 16; ++u) vw[u] = *(const unsigned*)(vb + (size_t)(k + u) * HW);
#pragma unroll
                    for (int u = 0; u < 16; u += 2) { const float p0 = sc[b * 256 + k + u], p1 = sc[b * 256 + k + u + 1];
                        a0 += p0 * bflo(vw[u]); a1 += p0 * bfhi(vw[u]); c0 += p1 * bflo(vw[u + 1]); c1 += p1 * bfhi(vw[u + 1]); } }
                o0 += a0 + c0; o1 += a1 + c1; }
            const float il = 1.0f / l;
            *(unsigned*)(AUP + (size_t)t * D + HW + h * HD + 2 * lane) = pk2(o0 * il, o1 * il);
            LDS_WAIT();
        }
    }
    SEAM(4);

    if (IN(5) && FP5) {
        pg8::StaticOrder S; S.init(T, D, F.G, (int)blockIdx.x);
        { pg8::Gemm g{(const bf16*)(ws + WS_AUP), (const bf16*)(ws + WS_WUP_T), D, D, D}; pg8::EpiUp2 E{(const bf16*)(ws + WS_GA), (const bf16*)(ws + WS_GB), (bf16*)(ws + WS_MERGED)};
          pg8::gemm_phase<pg8::EpiUp2, pg8::StaticOrder, false, PG8_SP2>(F.lds, g, S, E); }
    }
    if (IN(5) && !FP5) {
        TVARS
        const bf16* AUP = (const bf16*)(ws + WS_AUP); const bf16* GA = (const bf16*)(ws + WS_GA); const bf16* GB = (const bf16*)(ws + WS_GB); bf16* MG = (bf16*)(ws + WS_MERGED);
        for (int it = F.vcu; it < (T / 128) * (D / 128); it += F.G) {
            const int tm = it / (D / 128), tn = it % (D / 128), tx = tid & 31, ty = tid >> 5;
            float a1[8][4], a2[8][4]; zero_acc(a1); zero_acc(a2);
            sgemm_acc(a1, As, Bs, AUP, D, tm * 128, args.in[I_WUH], D, tn * 128, HW, tid);
            sgemm_acc(a2, As, Bs, AUP + HW, D, tm * 128, args.in[I_WUM], D, tn * 128, HW, tid);
#pragma unroll
            for (int i = 0; i < 8; ++i) { const size_t off = (size_t)(tm * 128 + ty * 8 + i) * D + tn * 128 + tx * 4;
                const v2u ga = *(const v2u*)(GA + off), gb = *(const v2u*)(GB + off);
                st_bf16x4(MG + off, bflo(ga.x) * a1[i][0] + bflo(gb.x) * a2[i][0], bfhi(ga.x) * a1[i][1] + bfhi(gb.x) * a2[i][1],
                          bflo(ga.y) * a1[i][2] + bflo(gb.y) * a2[i][2], bfhi(ga.y) * a1[i][3] + bfhi(gb.y) * a2[i][3]); }
        }
    }
    SEAM(5);

    if (IN(6) && FP6) {
        pg8::Gemm g{(const bf16*)(ws + WS_MERGED), (const bf16*)(ws + WS_WOUT_T), D, D, D}; pg8::StaticOrder S; S.init(T, D, F.G, (int)blockIdx.x);
        pg8::EpiResidB<0> E{x, nullptr, nullptr, (bf16*)(ws + WS_XR)};
        pg8::gemm_phase<pg8::EpiResidB<0>, pg8::StaticOrder, false, PG8_SP2>(F.lds, g, S, E);
    }
    if (IN(6) && !FP6) {
        TVARS
        const bf16* MG = (const bf16*)(ws + WS_MERGED);
        for (int it = F.vcu; it < (T / 128) * (D / 128); it += F.G) {
            const int tm = it / (D / 128), tn = it % (D / 128), tx = tid & 31, ty = tid >> 5;
            float acc[8][4]; zero_acc(acc);
            sgemm_acc(acc, As, Bs, MG, D, tm * 128, args.in[I_WOUT], D, tn * 128, D, tid);
#pragma unroll
            for (int i = 0; i < 8; ++i) { const size_t off = (size_t)(tm * 128 + ty * 8 + i) * D + tn * 128 + tx * 4; const f32x4 xv = *(const f32x4*)(x + off);
                f32x4 o; o.x = xv.x + acc[i][0]; o.y = xv.y + acc[i][1]; o.z = xv.z + acc[i][2]; o.w = xv.w + acc[i][3]; *(f32x4*)(out + off) = o; }
        }
    }
    SEAM(6);

    if (IN(7)) {
        TVARS
        auto conv7 = [&]() { LAS float* scr = (LAS float*)(F.lds + wave * 16384);
          auto item7 = [&](int it) -> TrItem { TrItem q; const int e = it >> 10, r = it & 1023, kb = r >> 5, n0 = (r & 31) * 32, pnl = n0 >> 8, bj = (n0 >> 7) & 1, q0 = n0 & 127;
              q.src = (bj ? args.in[I_WEU] : args.in[I_WEG]) + (size_t)e * D * DE + (size_t)(kb * 64) * DE + pnl * 128 + q0; q.ldw = DE;
              q.dst = (bf16*)(ws + WS_WEGU) + (size_t)e * 1024 * D + (size_t)n0 * D + kb * 64; q.ldt = D; q.gk = args.in[I_NFFN] + kb * 64; return q; };
          TR_PIPE(gw, NE * 1024, NGW, item7); };
        const bool conv_first = (F.vcu & 1) == 0;
        if (conv_first) conv7();
        const float* gff = args.in[I_NFFN]; const float* wrt = (const float*)(ws + WS_WRT);
        int* EID = (int*)(ws + WS_ROUTE); int* POS = EID + 2 * T; float* RW = (float*)(POS + 2 * T);
        __syncthreads();
        LAS float* part = (LAS float*)F.lds; LAS float* lgt = (LAS float*)(F.lds + 49152); LAS float* rsc = (LAS float*)(F.lds + 57344);
        for (int rb = F.vcu; rb < T / 32; rb += F.G) { const int r0 = rb * 32;
            for (int i4 = 0; i4 < 4; ++i4) { const int m = r0 + 4 * wave + i4;
                const v2u* xr = (const v2u*)((const bf16*)(ws + WS_XR) + (size_t)m * D) + lane; const f32x4* gr = (const f32x4*)gff + lane;
                f32x4 v[8]; float s = 0.f;
#pragma unroll
                for (int j = 0; j < 8; ++j) { const v2u w2 = xr[64 * j]; v[j].x = bflo(w2.x); v[j].y = bfhi(w2.x); v[j].z = bflo(w2.y); v[j].w = bfhi(w2.y); s += (v[j].x * v[j].x + v[j].y * v[j].y) + (v[j].z * v[j].z + v[j].w * v[j].w); }
                const float r = 1.0f / sqrtf(wave_sum(s) * (1.f / D) + EPS);
                if (lane == 0) { rsc[4 * wave + i4] = r; ((float*)(ws + WS_RN + 262144))[m] = r; } }
            { const int fr = lane & 15, fq = lane >> 4;
              f32x4 acc[2][3];
#pragma unroll
              for (int rt = 0; rt < 2; ++rt)
#pragma unroll
                  for (int ct = 0; ct < 3; ++ct) acc[rt][ct] = (f32x4){0.f, 0.f, 0.f, 0.f};
              const bf16* xa = (const bf16*)(ws + WS_XR) + (size_t)(r0 + fr) * D + wave * 256 + 4 * fq;
              const float* wb = wrt + (size_t)fr * D + wave * 256 + 4 * fq;
              const float* wb2 = wrt + (size_t)((32 + fr) > 35 ? 35 : (32 + fr)) * D + wave * 256 + 4 * fq;
#pragma unroll 2
              for (int j = 0; j < 16; ++j) {
                  const v2u aw0 = *(const v2u*)(xa + 16 * j), aw1 = *(const v2u*)(xa + (size_t)16 * D + 16 * j);
                  const f32x4 a0 = {bflo(aw0.x), bfhi(aw0.x), bflo(aw0.y), bfhi(aw0.y)}, a1 = {bflo(aw1.x), bfhi(aw1.x), bflo(aw1.y), bfhi(aw1.y)};
                  const f32x4 b0 = *(const f32x4*)(wb + 16 * j), b1 = *(const f32x4*)(wb + (size_t)16 * D + 16 * j), b2 = *(const f32x4*)(wb2 + 16 * j);
#pragma unroll
                  for (int q = 0; q < 4; ++q) {
                      acc[0][0] = __builtin_amdgcn_mfma_f32_16x16x4f32(a0[q], b0[q], acc[0][0], 0, 0, 0); acc[0][1] = __builtin_amdgcn_mfma_f32_16x16x4f32(a0[q], b1[q], acc[0][1], 0, 0, 0);
                      acc[0][2] = __builtin_amdgcn_mfma_f32_16x16x4f32(a0[q], b2[q], acc[0][2], 0, 0, 0); acc[1][0] = __builtin_amdgcn_mfma_f32_16x16x4f32(a1[q], b0[q], acc[1][0], 0, 0, 0);
                      acc[1][1] = __builtin_amdgcn_mfma_f32_16x16x4f32(a1[q], b1[q], acc[1][1], 0, 0, 0); acc[1][2] = __builtin_amdgcn_mfma_f32_16x16x4f32(a1[q], b2[q], acc[1][2], 0, 0, 0); } }
#pragma unroll
              for (int rt = 0; rt < 2; ++rt)
#pragma unroll
                  for (int ct = 0; ct < 3; ++ct)
#pragma unroll
                      for (int q = 0; q < 4; ++q) part[(wave * 32 + 16 * rt + 4 * fq + q) * 48 + 16 * ct + fr] = acc[rt][ct][q]; }
            __syncthreads();
            for (int o = tid; o < 32 * 36; o += NTHR) { const int row = o / 36, c = o - row * 36; float sum = 0.f;
#pragma unroll
                for (int w8 = 0; w8 < 8; ++w8) sum += part[(w8 * 32 + row) * 48 + c];
                lgt[row * 40 + c] = sum * rsc[row]; }
            __syncthreads();
            if (tid < 32) { const int m = r0 + tid;
                float lg[36];
#pragma unroll
                for (int c = 0; c < 36; ++c) lg[c] = lgt[tid * 40 + c];
                int gs = 0; float gm = lg[0];
#pragma unroll
                for (int c = 1; c < 4; ++c) if (lg[c] > gm) { gm = lg[c]; gs = c; }
                float gsum = 0.f;
#pragma unroll
                for (int c = 0; c < 4; ++c) gsum += expf(lg[c] - gm);
                const float pg = 1.0f / gsum;
                float el[8];
#pragma unroll
                for (int c = 0; c < 8; ++c) el[c] = (gs == 0) ? lg[4 + c] : (gs == 1) ? lg[12 + c] : (gs == 2) ? lg[20 + c] : lg[28 + c];
                int i1 = 0; float m1 = el[0];
#pragma unroll
                for (int c = 1; c < 8; ++c) if (el[c] > m1) { m1 = el[c]; i1 = c; }
                int i2 = -1; float m2 = -3.0e38f;
#pragma unroll
                for (int c = 0; c < 8; ++c) if (c != i1 && el[c] > m2) { m2 = el[c]; i2 = c; }
                if (i2 < 0) i2 = (i1 == 0) ? 1 : 0;
                const float e2 = expf(m2 - m1), w1 = pg / (1.0f + e2), w2 = pg * e2 / (1.0f + e2);
                const int ea = gs * 8 + i1, eb = gs * 8 + i2;
                const int pa = (int)__hip_atomic_fetch_add((unsigned*)(F.ctl + CW_ECNT) + ea, 1u, RLX_AGENT), pb = (int)__hip_atomic_fetch_add((unsigned*)(F.ctl + CW_ECNT) + eb, 1u, RLX_AGENT);
                EID[2 * m] = ea; EID[2 * m + 1] = eb; POS[2 * m] = pa; POS[2 * m + 1] = pb; RW[2 * m] = w1; RW[2 * m + 1] = w2; }
            __syncthreads();
        }
        if (!conv_first) { __syncthreads(); conv7(); }
    }
    SEAM(7);

    LAS int* pstart = (LAS int*)(F.lds + LDSCTL_OFF);
    if (hi > 8 && lo <= 10) {
        if (threadIdx.x == 0) { int a = 0; for (int e = 0; e < NE; ++e) { pstart[e] = a; const int c = (int)__hip_atomic_load((unsigned*)(F.ctl + CW_ECNT) + e, RLX_AGENT); pstart[40 + e] = c; a += (c + 255) / 256 * 256; } pstart[NE] = a; }
        __syncthreads();
    }

    if (IN(8)) {
        TVARS
        const int* EID = (const int*)(ws + WS_ROUTE); const int* POS = EID + 2 * T; int* rs = (int*)(ws + WS_ROWSLOT);
        for (int s = gw; s < 2 * T; s += NGW) { const int dest = pstart[EID[s]] + POS[s];
            const v4u* src = (const v4u*)((const bf16*)(ws + WS_XR) + (size_t)(s >> 1) * D) + lane; v4u* dst = (v4u*)((bf16*)(ws + WS_XG) + (size_t)dest * D) + lane;
            v4u rowv[4];
#pragma unroll
            for (int j = 0; j < 4; ++j) rowv[j] = src[64 * j];
#pragma unroll
            for (int j = 0; j < 4; ++j) dst[64 * j] = rowv[j];
            if (lane == 0) { __hip_atomic_store(rs + dest, s, RLX_AGENT); ((float*)(ws + WS_RN + 65536))[dest] = ((const float*)(ws + WS_RN + 262144))[s >> 1]; } }
    }
    SEAM(8);

    if (IN(9) && FP9) {
        pg8::Gemm g{(const bf16*)(ws + WS_XG), (const bf16*)(ws + WS_WEGU), D, D, D}; pg8::MoeOrder S{(const LAS int*)pstart, 4, F.G, (int)blockIdx.x}; pg8::EpiMoe1 E{(bf16*)(ws + WS_HMOE), (const float*)(ws + WS_RN + 65536)};
        pg8::gemm_phase<pg8::EpiMoe1, pg8::MoeOrder, PG8_ALIGN, PG8_SP2>(F.lds, g, S, E);
        { TVARS
          const int nun = (pstart[NE] >> 8) * 4, nbusy = nun > F.G ? nun - F.G : 0, c = (int)blockIdx.x;
          __syncthreads();
          if (c >= nbusy) { const int nh = F.G - nbusy, hr = c - nbusy; LAS float* scr = (LAS float*)(F.lds + wave * 16384);
              auto item9 = [&](int it) -> TrItem { TrItem q; q.gk = nullptr; const int e = it >> 9, r2 = it & 511, kb = r2 >> 6, nb = r2 & 63;
                  q.src = args.in[I_WED] + (size_t)e * DE * D + (size_t)(kb * 64) * D + nb * 32; q.ldw = D; q.dst = (bf16*)(ws + WS_WED) + (size_t)e * D * DE + (size_t)(nb * 32) * DE + kb * 64; q.ldt = DE; return q; };
              TR_PIPE(hr * NWAVES + wave, NE * 512, nh * NWAVES, item9); } }
    }
    if (IN(9) && !FP9) {
        TVARS
        const int ntile = pstart[NE] / 128;
        for (int it = F.vcu; it < ntile * (DE / 128); it += F.G) {
            const int tm = it / (DE / 128), tn = it % (DE / 128), tx = tid & 31, ty = tid >> 5; int e = 0;
            for (int q = 1; q < NE; ++q) if (pstart[q] <= tm * 128) e = q;
            float a1[8][4], a2[8][4]; zero_acc(a1); zero_acc(a2);
            sgemm_acc(a1, As, Bs, (const bf16*)(ws + WS_XG), D, tm * 128, args.in[I_WEG] + (size_t)e * D * DE, DE, tn * 128, D, tid);
            sgemm_acc(a2, As, Bs, (const bf16*)(ws + WS_XG), D, tm * 128, args.in[I_WEU] + (size_t)e * D * DE, DE, tn * 128, D, tid);
#pragma unroll
            for (int i = 0; i < 8; ++i) st_bf16x4((bf16*)(ws + WS_HMOE) + (size_t)(tm * 128 + ty * 8 + i) * DE + tn * 128 + tx * 4,
                siluf_(a1[i][0]) * a2[i][0], siluf_(a1[i][1]) * a2[i][1], siluf_(a1[i][2]) * a2[i][2], siluf_(a1[i][3]) * a2[i][3]);
        }
    }
    SEAM(9);

    if (IN(10) && FP10) {
        pg8::Gemm g{(const bf16*)(ws + WS_HMOE), (const bf16*)(ws + WS_WED), DE, DE, DE}; pg8::MoeOrder S{(const LAS int*)pstart, 8, F.G, (int)blockIdx.x}; pg8::EpiMoe2 E{(bf16*)(ws + WS_Y), (const int*)(ws + WS_ROWSLOT), (const LAS int*)pstart};
        pg8::gemm_phase<pg8::EpiMoe2, pg8::MoeOrder, PG8_ALIGN, PG8_SP2>(F.lds, g, S, E);
    }
    if (IN(10) && !FP10) {
        TVARS
        const int ntile = pstart[NE] / 128; const int* rs = (const int*)(ws + WS_ROWSLOT);
        for (int it = F.vcu; it < ntile * (D / 128); it += F.G) {
            const int tm = it / (D / 128), tn = it % (D / 128), tx = tid & 31, ty = tid >> 5; int e = 0;
            for (int q = 1; q < NE; ++q) if (pstart[q] <= tm * 128) e = q;
            float acc[8][4]; zero_acc(acc);
            sgemm_acc(acc, As, Bs, (const bf16*)(ws + WS_HMOE), DE, tm * 128, args.in[I_WED] + (size_t)e * DE * D, D, tn * 128, DE, tid);
#pragma unroll
            for (int i = 0; i < 8; ++i) { const int prow = tm * 128 + ty * 8 + i;
                if (prow - pstart[e] < pstart[40 + e]) st_bf16x4((bf16*)(ws + WS_Y) + (size_t)__hip_atomic_load((int*)rs + prow, RLX_AGENT) * D + tn * 128 + tx * 4, acc[i][0], acc[i][1], acc[i][2], acc[i][3]); }
        }
    }
    SEAM(10);

    if (IN(11)) {
        TVARS
        const float* gpl = args.in[I_NPLE]; const float* RW = (const float*)((const int*)(ws + WS_ROUTE) + 4 * T);
        for (int m = gw; m < T; m += NGW) {
            v2u* xr = (v2u*)((bf16*)(ws + WS_XR) + (size_t)m * D) + lane; const f32x4* gr = (const f32x4*)gpl + lane;
            const v2u* ya = (const v2u*)((const bf16*)(ws + WS_Y) + (size_t)(2 * m) * D) + lane; const v2u* yb = (const v2u*)((const bf16*)(ws + WS_Y) + (size_t)(2 * m + 1) * D) + lane;
            const float wa = RW[2 * m], wb = RW[2 * m + 1];
            f32x4 v[8]; float s = 0.f;
#pragma unroll
            for (int j = 0; j < 8; ++j) { const v2u w2 = xr[64 * j]; v[j].x = bflo(w2.x); v[j].y = bfhi(w2.x); v[j].z = bflo(w2.y); v[j].w = bfhi(w2.y); }
            v2u ay[8], by[8];
#pragma unroll
            for (int j = 0; j < 8; ++j) { ay[j] = ya[64 * j]; by[j] = yb[64 * j]; }
#pragma unroll
            for (int j = 0; j < 8; ++j) { const v2u a = ay[j], b = by[j];
                v[j].x += bflo(a.x) * wa + bflo(b.x) * wb; v[j].y += bfhi(a.x) * wa + bfhi(b.x) * wb; v[j].z += bflo(a.y) * wa + bflo(b.y) * wb; v[j].w += bfhi(a.y) * wa + bfhi(b.y) * wb;
                { v2u w2; w2.x = pk2(v[j].x, v[j].y); w2.y = pk2(v[j].z, v[j].w); xr[64 * j] = w2; } s += (v[j].x * v[j].x + v[j].y * v[j].y) + (v[j].z * v[j].z + v[j].w * v[j].w); }
            const float r = 1.0f / sqrtf(wave_sum(s) * (1.f / D) + EPS);
            if (lane == 0) ((float*)(ws + WS_RN))[m] = r;
        }
    }
    SEAM(11);

    if (IN(12) && FP12) {
        pg8::Gemm g{(const bf16*)(ws + WS_XR), (const bf16*)(ws + WS_WPG_T), D, D, D}; pg8::StaticOrder S; S.init(T, D, F.G, (int)blockIdx.x);
        pg8::EpiResidB<1> E{(const float*)(ws + WS_RN), (const bf16*)(ws + WS_XR), (const bf16*)(ws + WS_PP), (bf16*)(ws + WS_HP)};
        pg8::gemm_phase<pg8::EpiResidB<1>, pg8::StaticOrder, false, PG8_SP2>(F.lds, g, S, E);
    }
    if (IN(12) && !FP12) {
        TVARS
        const bf16* HP = (const bf16*)(ws + WS_HP); const bf16* PP = (const bf16*)(ws + WS_PP);
        for (int it = F.vcu; it < (T / 128) * (D / 128); it += F.G) {
            const int tm = it / (D / 128), tn = it % (D / 128), tx = tid & 31, ty = tid >> 5;
            float acc[8][4]; zero_acc(acc);
            sgemm_acc(acc, As, Bs, HP, D, tm * 128, args.in[I_WPG], D, tn * 128, D, tid);
#pragma unroll
            for (int i = 0; i < 8; ++i) { const size_t off = (size_t)(tm * 128 + ty * 8 + i) * D + tn * 128 + tx * 4; const f32x4 xv = *(const f32x4*)(out + off); const v2u pp = *(const v2u*)(PP + off);
                f32x4 o; o.x = xv.x + sigmoidf_(acc[i][0]) * bflo(pp.x); o.y = xv.y + sigmoidf_(acc[i][1]) * bfhi(pp.x); o.z = xv.z + sigmoidf_(acc[i][2]) * bflo(pp.y); o.w = xv.w + sigmoidf_(acc[i][3]) * bfhi(pp.y);
                *(f32x4*)(out + off) = o; }
        }
    }
    SEAM(12);

    if (IN(13)) {
        TVARS
        const float* gf = args.in[I_NFIN];
        for (int m = gw; m < T; m += NGW) {
            f32x4* xr = (f32x4*)(out + (size_t)m * D) + lane; const f32x4* gr = (const f32x4*)gf + lane; const v2u* xb = (const v2u*)((const bf16*)(ws + WS_HP) + (size_t)m * D) + lane;
            f32x4 v[8]; float s = 0.f;
#pragma unroll
            for (int j = 0; j < 8; ++j) { const v2u w2 = xb[64 * j]; v[j].x = bflo(w2.x); v[j].y = bfhi(w2.x); v[j].z = bflo(w2.y); v[j].w = bfhi(w2.y); s += (v[j].x * v[j].x + v[j].y * v[j].y) + (v[j].z * v[j].z + v[j].w * v[j].w); }
            f32x4 g8[8];
#pragma unroll
            for (int j = 0; j < 8; ++j) g8[j] = gr[64 * j];
            const float r = 1.0f / sqrtf(wave_sum(s) * (1.f / D) + EPS);
#pragma unroll
            for (int j = 0; j < 8; ++j) { const f32x4 gg = g8[j]; f32x4 o; o.x = v[j].x * r * gg.x; o.y = v[j].y * r * gg.y; o.z = v[j].z * r * gg.z; o.w = v[j].w * r * gg.w; xr[64 * j] = o; }
        }
    }
#undef IN
#undef SEAM
}

extern "C" void kernel_launch(void* const* d_in, const int* in_sizes, int n_in, void* d_out, int out_size, void* d_ws, size_t ws_size, hipStream_t stream) {
    static int grid = 0;
    if (grid == 0) {
        if (n_in != 19 || in_sizes[0] != T * D || out_size != T * D || ws_size < WS_END) { fprintf(stderr, "kernel_launch: shape/workspace mismatch: n_in %d in0 %d out %d ws %zu (need %zu)\n", n_in, n_in > 0 ? in_sizes[0] : -1, out_size, ws_size, (size_t)WS_END); grid = -1; return; }
        int dev = 0, cus = 0, per_cu = 0;
        if (hipGetDevice(&dev) != hipSuccess || hipDeviceGetAttribute(&cus, hipDeviceAttributeMultiprocessorCount, dev) != hipSuccess) { grid = -1; return; }
        if (hipFuncSetAttribute((const void*)fwd, hipFuncAttributeMaxDynamicSharedMemorySize, LDS_BYTES) != hipSuccess) { fprintf(stderr, "kernel_launch: hipFuncSetAttribute failed\n"); grid = -1; return; }
        if (hipOccupancyMaxActiveBlocksPerMultiprocessor(&per_cu, (const void*)fwd, NTHR, LDS_BYTES) != hipSuccess || per_cu < 1) { fprintf(stderr, "kernel_launch: occupancy query says %d blocks per CU\n", per_cu); (void)hipGetLastError(); grid = -1; return; }
        grid = cus;
    }
    if (grid < 0) return;
    if (hipMemsetAsync((char*)d_ws + WS_CTL, 0, CTL_ZERO_BYTES, stream) != hipSuccess) return;
    Args a{};
    for (int i = 0; i < 19; ++i) a.in[i] = (const float*)d_in[i];
    a.out = (float*)d_out; a.ws = (unsigned char*)d_ws; a.pad = MBRT;
    for (int j = 0; j < 64; ++j) a.rfreq[j] = std::pow(10000.0, -(double)j / 64.0) / 6.283185307179586476925286766559;
    constexpr int NL = MK_N_LAUNCHES;
    for (int li = 0; li < NL; ++li) {
        a.ph_lo = (NL == 1) ? 0 : li; a.ph_hi = (NL == 1) ? N_PHASES : li + 1; a.li = 0;
        hipLaunchKernelGGL(fwd, dim3(grid), dim3(NTHR), LDS_BYTES, stream, a);
    }
}
```

```cpp
#include <hip/hip_runtime.h>
#include <cstdio>
#include <cstdint>
#include <cmath>

#define GAS __attribute__((address_space(1)))
#define LAS __attribute__((address_space(3)))
typedef unsigned short bf16;
typedef unsigned v4u __attribute__((ext_vector_type(4)));
typedef unsigned v2u __attribute__((ext_vector_type(2)));
typedef float f32x4 __attribute__((ext_vector_type(4)));
typedef float f32x2 __attribute__((ext_vector_type(2)));
typedef short bf16x8 __attribute__((ext_vector_type(8)));

constexpr int T = 8192, D = 2048, HW = 1024, NH = 8, HD = 128, INC = 11264, NE = 32, DE = 512, PLE = 256, NB = 32, BS = 256;
constexpr float EPS = 1e-6f;
constexpr int NWAVES = 8, NTHR = 512;
constexpr int N_PHASES = 14;
#ifndef FP1
#define FP1 1
#endif
#ifndef FP5
#define FP5 1
#endif
#ifndef FP6
#define FP6 1
#endif
#ifndef FP9
#define FP9 1
#endif
#ifndef FP10
#define FP10 1
#endif
#ifndef FP12
#define FP12 1
#endif
#ifndef FHG
#define FHG 1
#endif
#ifndef FMB
#define FMB 1
#endif
#ifndef MK_N_LAUNCHES
#define MK_N_LAUNCHES 1
#endif

constexpr size_t MiB = 1u << 20;
constexpr size_t WS_CTL = 0, CTL_ZERO_BYTES = 64 * 1024;
constexpr size_t WS_TRIG = 2 * MiB;
constexpr size_t WS_KMEAN = 6 * MiB;
constexpr size_t WS_LB = 6 * MiB + 384 * 1024;
constexpr size_t WS_WRT = 6 * MiB + 512 * 1024;
constexpr size_t WS_ROUTE = 7 * MiB;
constexpr size_t WS_ROWSLOT = 8 * MiB;
constexpr size_t WS_PB = 10 * MiB;
constexpr size_t WS_WIN_T = 16 * MiB, WS_WUP_T = 60 * MiB, WS_WOUT_T = 68 * MiB, WS_WPG_T = 76 * MiB, WS_WPP_T = 84 * MiB;
constexpr size_t WS_PP = 86 * MiB;
constexpr size_t WS_GA = 118 * MiB, WS_GB = 150 * MiB;
constexpr size_t WS_QH = 182 * MiB;
constexpr size_t WS_GH = 198 * MiB;
constexpr size_t WS_RN = 9 * MiB;
constexpr size_t WS_XR = 16 * MiB;
constexpr size_t WS_VH = 230 * MiB, WS_OG = 246 * MiB, WS_MQ = 262 * MiB, WS_MK = 278 * MiB, WS_MV = 294 * MiB;
constexpr size_t WS_H1 = 310 * MiB;
constexpr size_t WS_TMPF = 342 * MiB;
constexpr size_t WS_DEC = 14 * MiB;
constexpr size_t WS_ST = 310 * MiB;
constexpr size_t WS_DS = 342 * MiB;
constexpr size_t WS_PO = 406 * MiB;
constexpr size_t WS_PLSE = 544 * MiB;
constexpr size_t WS_MLIST = 504 * MiB;
constexpr size_t WS_CNTP = 9 * MiB;
constexpr size_t WS_AUP = 472 * MiB;
constexpr size_t WS_MERGED = 504 * MiB;
constexpr size_t WS_HFFN = 310 * MiB;
constexpr size_t WS_XG = 342 * MiB;
constexpr size_t WS_HMOE = 438 * MiB;
constexpr size_t WS_Y = 462 * MiB;
constexpr size_t WS_HP = 342 * MiB;
constexpr size_t WS_WEGU = 118 * MiB;
constexpr size_t WS_WED = 246 * MiB;
constexpr size_t WS_END = 576 * MiB;
constexpr int CW_TMO = 0, CW_CODE = 1;
constexpr int CW_ECNT = 64;
constexpr int CW_MCNT = 128;
constexpr int CW_BAR = 4096;

constexpr int RING_BYTES = 131072;
constexpr int LDSCTL_OFF = RING_BYTES, MISC_OFF = LDSCTL_OFF + 320;
constexpr int LDS_BYTES = 147456;

typedef GAS unsigned gu32;
#define RLX_AGENT __ATOMIC_RELAXED, __HIP_MEMORY_SCOPE_AGENT
#define LDS_WAIT() asm volatile("s_waitcnt lgkmcnt(0)" ::: "memory")
#define VM_WAIT() asm volatile("s_waitcnt vmcnt(0)" ::: "memory")
typedef __bf16 hwbf2 __attribute__((ext_vector_type(2)));
__device__ __forceinline__ unsigned pk2(float lo, float hi) { hwbf2 v; v.x = (__bf16)lo; v.y = (__bf16)hi; return __builtin_bit_cast(unsigned, v); }
__device__ __forceinline__ unsigned f2bf(float f) { return pk2(f, 0.f) & 0xffffu; }
__device__ __forceinline__ float bf2f(unsigned b) { return __builtin_bit_cast(float, b << 16); }
__device__ __forceinline__ float bflo(unsigned w) { return __builtin_bit_cast(float, w << 16); }
__device__ __forceinline__ float bfhi(unsigned w) { return __builtin_bit_cast(float, w & 0xffff0000u); }
__device__ __forceinline__ float sigmoidf_(float x) { return 1.0f / (1.0f + __expf(-x)); }
__device__ __forceinline__ float siluf_(float x) { return x / (1.0f + __expf(-x)); }

#define XB_TMO      128
#define XB_XCNT(j)  (256  + 64 * (j))
#define XB_XSUB(j)  (1280 + 64 * (j))
#define XB_XGEN(j)  (2304 + 64 * (j))
#define XB_TOP      3328
#define XB_TOPGEN   3392
#define XCD_BAR_WORDS 3456
#define XB_SPIN_CAP (1u << 25)
__device__ __forceinline__ unsigned xb_ld(unsigned* p)              { return __hip_atomic_load(p, __ATOMIC_RELAXED, __HIP_MEMORY_SCOPE_AGENT); }
__device__ __forceinline__ unsigned xb_add(unsigned* p, unsigned v) { return __hip_atomic_fetch_add(p, v, __ATOMIC_RELAXED, __HIP_MEMORY_SCOPE_AGENT); }
__device__ __forceinline__ unsigned xb_xcc_id() { return (unsigned)__builtin_amdgcn_s_getreg((3 << 11) | 20) & 0xFu; }
#define XB_SPIN(cond, bar) do { unsigned _sp = 0; while (cond) { __builtin_amdgcn_s_sleep(1); \
    if ((++_sp & 255u) == 0u) { if (xb_ld(&(bar)[XB_TMO])) break; if (_sp > XB_SPIN_CAP) { atomicAdd(&(bar)[XB_TMO], 1u); break; } } } } while (0)
struct XcdBarrier { unsigned* bar; unsigned x; volatile LAS unsigned* st; };
__device__ __forceinline__ XcdBarrier xcd_barrier_post(unsigned* bar, volatile LAS unsigned* st) {
    XcdBarrier b; b.bar = bar; b.x = xb_xcc_id(); b.st = st;
    if (threadIdx.x == 0) (void)xb_add(&bar[XB_XCNT(b.x)], 1u);
    return b;
}
__device__ __forceinline__ void xcd_barrier_complete(unsigned* bar, unsigned x, unsigned& nloc, unsigned& nx) {
    const unsigned G = gridDim.x * gridDim.y * gridDim.z;
    unsigned sum, cnt, mine, sp = 0u;
    for (;;) {
        sum = 0u; cnt = 0u; mine = 0u;
#pragma unroll
        for (unsigned j = 0; j < 16; ++j) { const unsigned c = xb_ld(&bar[XB_XCNT(j)]); sum += c; cnt += (c > 0u) ? 1u : 0u; mine = (j == x) ? c : mine; }
        if (sum == G) break;
        __builtin_amdgcn_s_sleep(1);
        if ((++sp & 255u) == 0u) { if (xb_ld(&bar[XB_TMO])) break; if (sp > XB_SPIN_CAP) { atomicAdd(&bar[XB_TMO], 1u); break; } }
    }
    nloc = mine > 0u ? mine : 1u; nx = cnt > 0u ? cnt : 1u;
}
__device__ __forceinline__ void xcd_barrier(const XcdBarrier& b) {
    asm volatile("s_waitcnt vmcnt(0)" ::: "memory");
    __syncthreads();
    if (threadIdx.x == 0) {
        unsigned* bar = b.bar;
        __builtin_amdgcn_s_waitcnt(0);
        unsigned nloc = b.st[0], nx = b.st[1];
        if (nloc == 0u) { xcd_barrier_complete(bar, b.x, nloc, nx); b.st[0] = nloc; b.st[1] = nx; }
        const unsigned old = xb_add(&bar[XB_XSUB(b.x)], 1u);
        const unsigned gen = old / nloc;
        if (old + 1u == (gen + 1u) * nloc) {
            __builtin_amdgcn_fence(__ATOMIC_RELEASE, "agent");
            asm volatile("s_waitcnt vmcnt(0)" ::: "memory");
            const unsigned og = xb_add(&bar[XB_TOP], 1u);
            const unsigned tg = og / nx;
            if (og + 1u == (tg + 1u) * nx) xb_add(&bar[XB_TOPGEN], 1u);
            else XB_SPIN(xb_ld(&bar[XB_TOPGEN]) == tg, bar);
            __builtin_amdgcn_fence(__ATOMIC_ACQUIRE, "agent");
            xb_add(&bar[XB_XGEN(b.x)], 1u);
            asm volatile("s_waitcnt vmcnt(0)" ::: "memory");
        } else {
            XB_SPIN(xb_ld(&bar[XB_XGEN(b.x)]) == gen, bar);
            __builtin_amdgcn_fence(__ATOMIC_ACQUIRE, "agent");
            asm volatile("s_waitcnt vmcnt(0)" ::: "memory");
        }
    }
    __syncthreads();
}

struct Args { const float* in[19]; float* out; unsigned char* ws; double rfreq[64]; int ph_lo, ph_hi, li, pad; };
enum { I_X = 0, I_P, I_NMIX, I_WIN, I_LBRAW, I_HNG, I_WUH, I_WUM, I_WOUT, I_NFFN, I_WRG, I_WRE, I_WEG, I_WEU, I_WED, I_NPLE, I_WPG, I_WPP, I_NFIN };

struct Frame {
    LAS unsigned char* lds;
    volatile LAS unsigned* MISC;
    gu32* ctl;
    int tid, lane, wave, vcu, G;
    unsigned char* ws;
};

__device__ __forceinline__ int opaque_tid() { int t = threadIdx.x; asm volatile("" : "+v"(t)); return t; }
__device__ __forceinline__ float wave_sum(float v) {
#pragma unroll
    for (int o = 1; o < 64; o <<= 1) v += __shfl_xor(v, o);
    return v;
}
__device__ __forceinline__ float wave_max(float v) {
#pragma unroll
    for (int o = 1; o < 64; o <<= 1) v = fmaxf(v, __shfl_xor(v, o));
    return v;
}

__device__ __forceinline__ void rms_row_to_bf16(int lane, const float* xrow, const float* g, bf16* orow) {
    const f32x4* xr = (const f32x4*)xrow + lane; const f32x4* gr = (const f32x4*)g + lane;
    f32x4 v[8]; float s = 0.f;
#pragma unroll
    for (int j = 0; j < 8; ++j) { v[j] = xr[64 * j]; s += (v[j].x * v[j].x + v[j].y * v[j].y) + (v[j].z * v[j].z + v[j].w * v[j].w); }
    f32x4 g8[8];
#pragma unroll
    for (int j = 0; j < 8; ++j) g8[j] = gr[64 * j];
    const float r = 1.0f / sqrtf(wave_sum(s) * (1.f / D) + EPS);
    unsigned long long* o8 = (unsigned long long*)orow + lane;
#pragma unroll
    for (int j = 0; j < 8; ++j) { const f32x4 gg = g8[j];
        o8[64 * j] = (unsigned long long)pk2(v[j].x * r * gg.x, v[j].y * r * gg.y) | ((unsigned long long)pk2(v[j].z * r * gg.z, v[j].w * r * gg.w) << 32); }
}

__device__ __forceinline__ void sgemm_acc(float (&acc)[8][4], LAS float* As, LAS float* Bs, const bf16* A, int lda, int m0, const float* W, int ldb, int n0, int K, int tid) {
    const int tx = tid & 31, ty = tid >> 5;
    const int ar = tid >> 2, akq = tid & 3;
    for (int k0 = 0; k0 < K; k0 += 16) {
        const v2u av = *(const v2u*)(A + (size_t)(m0 + ar) * lda + k0 + akq * 4);
        const f32x4 bv = *(const f32x4*)(W + (size_t)(k0 + ty) * ldb + n0 + tx * 4);
        __syncthreads();
        As[(akq * 4 + 0) * 132 + ar] = bflo(av.x); As[(akq * 4 + 1) * 132 + ar] = bfhi(av.x);
        As[(akq * 4 + 2) * 132 + ar] = bflo(av.y); As[(akq * 4 + 3) * 132 + ar] = bfhi(av.y);
        *(LAS f32x4*)(Bs + ty * 128 + tx * 4) = bv;
        __syncthreads();
#pragma unroll 4
        for (int kk = 0; kk < 16; ++kk) {
            const f32x4 a0 = *(const LAS f32x4*)(As + kk * 132 + ty * 8), a1 = *(const LAS f32x4*)(As + kk * 132 + ty * 8 + 4);
            const f32x4 b = *(const LAS f32x4*)(Bs + kk * 128 + tx * 4);
            const float a[8] = {a0.x, a0.y, a0.z, a0.w, a1.x, a1.y, a1.z, a1.w};
#pragma unroll
            for (int i = 0; i < 8; ++i) { acc[i][0] += a[i] * b.x; acc[i][1] += a[i] * b.y; acc[i][2] += a[i] * b.z; acc[i][3] += a[i] * b.w; }
        }
    }
    __syncthreads();
}
__device__ __forceinline__ void zero_acc(float (&acc)[8][4]) {
#pragma unroll
    for (int i = 0; i < 8; ++i) { acc[i][0] = 0.f; acc[i][1] = 0.f; acc[i][2] = 0.f; acc[i][3] = 0.f; }
}
__device__ __forceinline__ void st_bf16x4(bf16* p, float a, float b, float c, float d) { v2u w; w.x = pk2(a, b); w.y = pk2(c, d); *(v2u*)p = w; }

__device__ __forceinline__ void inproj_epi(unsigned char* ws, int m, int n, const float (&v)[4]) {
    if (n < 1024) { st_bf16x4((bf16*)(ws + WS_QH) + (size_t)m * HW + n, siluf_(v[0]), siluf_(v[1]), siluf_(v[2]), siluf_(v[3])); }
    else if (n < 2048) { const int c = n - 1024; const f32x4 lb = *(const f32x4*)((const float*)(ws + WS_LB) + c);
        f32x4 o; o.x = __logf(lb.x + (1.f - lb.x) * sigmoidf_(v[0])); o.y = __logf(lb.y + (1.f - lb.y) * sigmoidf_(v[1]));
        o.z = __logf(lb.z + (1.f - lb.z) * sigmoidf_(v[2])); o.w = __logf(lb.w + (1.f - lb.w) * sigmoidf_(v[3]));
        *(f32x4*)((float*)(ws + WS_GH) + (size_t)m * HW + c) = o; }
    else if (n < 3072) { st_bf16x4((bf16*)(ws + WS_VH) + (size_t)m * HW + (n - 2048), v[0], v[1], v[2], v[3]); }
    else if (n < 4096) { st_bf16x4((bf16*)(ws + WS_OG) + (size_t)m * HW + (n - 3072), siluf_(v[0]), siluf_(v[1]), siluf_(v[2]), siluf_(v[3])); }
    else if (n < 6144) { f32x4 o = {v[0], v[1], v[2], v[3]}; *(f32x4*)((float*)(ws + WS_TMPF) + (size_t)m * D + (n - 4096)) = o; }
    else if (n < 7168) { st_bf16x4((bf16*)(ws + WS_MV) + (size_t)m * HW + (n - 6144), v[0], v[1], v[2], v[3]); }
    else if (n < 9216) { st_bf16x4((bf16*)(ws + WS_GA) + (size_t)m * D + (n - 7168), sigmoidf_(v[0]), sigmoidf_(v[1]), sigmoidf_(v[2]), sigmoidf_(v[3])); }
    else { st_bf16x4((bf16*)(ws + WS_GB) + (size_t)m * D + (n - 9216), sigmoidf_(v[0]), sigmoidf_(v[1]), sigmoidf_(v[2]), sigmoidf_(v[3])); }
}


__device__ __forceinline__ void transpose_item(const float* W, int ldw, int k0, int sn0, bf16* WT, int ldt, int drow0, int dcol0, LAS float* scr, int lane) {
#pragma unroll 8
    for (int i = 0; i < 32; ++i) { const int kk = 2 * i + (lane >> 5); scr[kk * 33 + (lane & 31)] = W[(size_t)(k0 + kk) * ldw + sn0 + (lane & 31)]; }
    LDS_WAIT(); asm volatile("" ::: "memory");
    const int c = lane & 7;
#pragma unroll
    for (int j = 0; j < 4; ++j) { const int n = (lane >> 3) + 8 * j; const LAS float* sp = scr + (8 * c) * 33 + n;
        v4u o; o.x = pk2(sp[0 * 33], sp[1 * 33]); o.y = pk2(sp[2 * 33], sp[3 * 33]); o.z = pk2(sp[4 * 33], sp[5 * 33]); o.w = pk2(sp[6 * 33], sp[7 * 33]);
        *(v4u*)(WT + (size_t)(drow0 + n) * ldt + dcol0 + 8 * c) = o; }
    LDS_WAIT(); asm volatile("" ::: "memory");
}
struct TrItem { const float* src; bf16* dst; int ldw, ldt; const float* gk; };
__device__ __forceinline__ void tr_load(f32x4 (&v)[8], const float* src, int ldw, int lane) {
    const int kr = lane >> 3, c4 = 4 * (lane & 7);
#pragma unroll
    for (int i = 0; i < 8; ++i) v[i] = *(const f32x4*)(src + (size_t)(8 * i + kr) * ldw + c4);
}
__device__ __forceinline__ void tr_store(const f32x4 (&v)[8], bf16* dst, int ldt, LAS float* scr, int lane) {
    const int kr = lane >> 3, c4 = 4 * (lane & 7);
#pragma unroll
    for (int i = 0; i < 8; ++i) { LAS float* d = scr + (8 * i + kr) * 33 + c4; d[0] = v[i].x; d[1] = v[i].y; d[2] = v[i].z; d[3] = v[i].w; }
    LDS_WAIT(); asm volatile("" ::: "memory");
    const int c = lane & 7;
#pragma unroll
    for (int j = 0; j < 4; ++j) { const int n = (lane >> 3) + 8 * j; const LAS float* sp = scr + (8 * c) * 33 + n;
        v4u o; o.x = pk2(sp[0 * 33], sp[1 * 33]); o.y = pk2(sp[2 * 33], sp[3 * 33]); o.z = pk2(sp[4 * 33], sp[5 * 33]); o.w = pk2(sp[6 * 33], sp[7 * 33]);
        *(v4u*)(dst + (size_t)n * ldt + 8 * c) = o; }
    LDS_WAIT(); asm volatile("" ::: "memory");
}
__device__ __forceinline__ void tr_scale(f32x4 (&v)[8], const float* gk, int lane) {
    const int kr = lane >> 3; float gq[8];
#pragma unroll
    for (int i = 0; i < 8; ++i) gq[i] = gk[8 * i + kr];
#pragma unroll
    for (int i = 0; i < 8; ++i) { v[i].x *= gq[i]; v[i].y *= gq[i]; v[i].z *= gq[i]; v[i].w *= gq[i]; }
}
#define TR_PIPE(first, N, step, ITEM) do { f32x4 va_[8], vb_[8]; TrItem ia_, ib_; int it_ = (first); \
    if (it_ < (N)) { ia_ = ITEM(it_); tr_load(va_, ia_.src, ia_.ldw, lane); } \
    while (it_ < (N)) { const int i2_ = it_ + (step); \
        if (i2_ < (N)) { ib_ = ITEM(i2_); tr_load(vb_, ib_.src, ib_.ldw, lane); } \
        if (ia_.gk) tr_scale(va_, ia_.gk, lane); \
        tr_store(va_, ia_.dst, ia_.ldt, scr, lane); \
        if (i2_ >= (N)) break; \
        const int i3_ = i2_ + (step); \
        if (i3_ < (N)) { ia_ = ITEM(i3_); tr_load(va_, ia_.src, ia_.ldw, lane); } \
        if (ib_.gk) tr_scale(vb_, ib_.gk, lane); \
        tr_store(vb_, ib_.dst, ib_.ldt, scr, lane); \
        it_ = i3_; } } while (0)

__device__ __forceinline__ int phys2log_inproj(int n0) {
    const int tile = n0 >> 8; if (tile < 16 || tile >= 24) return n0;
    const int p = n0 & 255, bj = p >> 7, q = p & 127, head = 2 * ((tile - 16) & 3) + (q >> 6), d = (q & 63) + 64 * bj, which = (tile - 16) >> 2;
    return 4096 + which * 1024 + head * 128 + d;
}


typedef short v4i16_t __attribute__((ext_vector_type(4)));
__device__ __forceinline__ f32x4 mfma16(bf16x8 a, bf16x8 b, f32x4 c) { return __builtin_amdgcn_mfma_f32_16x16x32_bf16(a, b, c, 0, 0, 0); }
constexpr int HG_RED = 0, HG_BR = 2048, HG_RS = 2560, HG_KT = 4096, HG_VT = HG_KT + 128 * 144, HG_Q1 = HG_VT + 128 * 144, HG_K1 = HG_Q1 + 64 * 272, HG_Q2 = HG_K1 + 64 * 272, HG_P = HG_Q2 + 64 * 272;
static_assert(HG_P + 64 * 144 <= 131072, "hgrn lds");

__device__ __forceinline__ void hgrn_cumsum(const float* G, int col, int qt, LAS float* red, float (&gv)[16], float (&b)[16], float& btot) {
    float run = 0.f;
#pragma unroll
    for (int i = 0; i < 16; ++i) { gv[i] = G[(size_t)(16 * qt + i) * HW + col]; }
#pragma unroll
    for (int i = 0; i < 16; ++i) { run += gv[i]; b[i] = run; }
    red[qt * 128 + col] = run;
    __syncthreads();
    const float r0 = red[col], r1 = red[128 + col], r2 = red[256 + col], r3 = red[384 + col];
    const float pre = (qt > 0 ? r0 : 0.f) + (qt > 1 ? r1 : 0.f) + (qt > 2 ? r2 : 0.f);
    btot = ((r0 + r1) + r2) + r3;
#pragma unroll
    for (int i = 0; i < 16; ++i) b[i] += pre;
}
__device__ __forceinline__ void st_lds_bf16x16(LAS unsigned char* p, const float (&v)[16]) {
    v4u a, b; a.x = pk2(v[0], v[1]); a.y = pk2(v[2], v[3]); a.z = pk2(v[4], v[5]); a.w = pk2(v[6], v[7]); b.x = pk2(v[8], v[9]); b.y = pk2(v[10], v[11]); b.z = pk2(v[12], v[13]); b.w = pk2(v[14], v[15]);
    *(LAS v4u*)p = a; *(LAS v4u*)(p + 16) = b;
}
__device__ __forceinline__ void hgrn_pass_a(unsigned char* ws, LAS unsigned char* lds, int item, int tid) {
    const int c = item >> 3, h = item & 7, col = tid & 127, qt = tid >> 7, lane = tid & 63, w = tid >> 6, t0 = c * 64;
    float gv[16], b[16], btot;
    hgrn_cumsum((const float*)(ws + WS_GH) + (size_t)t0 * HW + h * HD, col, qt, (LAS float*)(lds + HG_RED), gv, b, btot);
    float kt[16], vv[16];
    const bf16* VH = (const bf16*)(ws + WS_VH) + (size_t)(t0 + 16 * qt) * HW + h * HD + col;
#pragma unroll
    for (int i = 0; i < 16; ++i) { kt[i] = (1.f - __expf(gv[i])) * __expf(btot - b[i]); vv[i] = bf2f(VH[(size_t)i * HW]); }
    st_lds_bf16x16(lds + HG_KT + col * 144 + qt * 32, kt); st_lds_bf16x16(lds + HG_VT + col * 144 + qt * 32, vv);
    if (qt == 0) ((float*)(ws + WS_DEC))[(size_t)item * HD + col] = __expf(btot);
    __syncthreads();
    const int fr = lane & 15, fq = lane >> 4;
    const bf16x8 a0 = *(const LAS bf16x8*)(lds + HG_KT + (16 * w + fr) * 144 + fq * 16), a1 = *(const LAS bf16x8*)(lds + HG_KT + (16 * w + fr) * 144 + fq * 16 + 64);
    bf16* dst = (bf16*)(ws + WS_DS) + (size_t)item * HD * HD + 16 * w + 4 * fq;
#pragma unroll
    for (int nt = 0; nt < 8; ++nt) {
        const bf16x8 b0 = *(const LAS bf16x8*)(lds + HG_VT + (16 * nt + fr) * 144 + fq * 16), b1 = *(const LAS bf16x8*)(lds + HG_VT + (16 * nt + fr) * 144 + fq * 16 + 64);
        f32x4 acc = {0.f, 0.f, 0.f, 0.f}; acc = mfma16(a0, b0, acc); acc = mfma16(a1, b1, acc);
        { v2u wv; wv.x = pk2(acc[0], acc[1]); wv.y = pk2(acc[2], acc[3]); *(v2u*)(dst + (size_t)(16 * nt + fr) * HD) = wv; }
    }
    __syncthreads();
}
__device__ __forceinline__ void hgrn_pass_c(unsigned char* ws, LAS unsigned char* lds, const float* ng, int item, int tid) {
    const int c = item >> 3, h = item & 7, col = tid & 127, qt = tid >> 7, lane = tid & 63, w = tid >> 6, t0 = c * 64, fr = lane & 15, fq = lane >> 4;
    const int fr_ = lane & 15, fq_ = lane >> 4, mt_ = w & 3, vh_ = w >> 2;
    bf16 qraw[16], vraw[16];
    { const bf16* QHp = (const bf16*)(ws + WS_QH) + (size_t)(t0 + 16 * qt) * HW + h * HD + col; const bf16* VHp = (const bf16*)(ws + WS_VH) + (size_t)(t0 + 16 * qt) * HW + h * HD + col;
#pragma unroll
      for (int i = 0; i < 16; ++i) { qraw[i] = QHp[(size_t)i * HW]; vraw[i] = VHp[(size_t)i * HW]; } }
    bf16x8 stf[4][4];
    { const bf16* STp = (const bf16*)(ws + WS_ST) + (size_t)item * HD * HD;
#pragma unroll
      for (int nt = 0; nt < 4; ++nt)
#pragma unroll
          for (int ks = 0; ks < 4; ++ks) stf[nt][ks] = *(const bf16x8*)(STp + (size_t)(16 * (4 * vh_ + nt) + fr_) * HD + fq_ * 8 + ks * 32); }
    bf16 ograw[4][4]; float ngv[4];
#pragma unroll
    for (int nt = 0; nt < 4; ++nt) ngv[nt] = ng[16 * (4 * vh_ + nt) + fr_];
#pragma unroll
    for (int r = 0; r < 4; ++r)
#pragma unroll
        for (int nt = 0; nt < 4; ++nt) ograw[r][nt] = ((const bf16*)(ws + WS_OG))[(size_t)(t0 + 16 * mt_ + 4 * fq_ + r) * HW + h * HD + 16 * (4 * vh_ + nt) + fr_];
    float gv[16], b[16], btot;
    hgrn_cumsum((const float*)(ws + WS_GH) + (size_t)t0 * HW + h * HD, col, qt, (LAS float*)(lds + HG_RED), gv, b, btot);
    LAS float* BR = (LAS float*)(lds + HG_BR);
    if (qt == 1) BR[col] = b[15];
    float vv[16];
#pragma unroll
    for (int i = 0; i < 16; ++i) vv[i] = bf2f(vraw[i]);
    st_lds_bf16x16(lds + HG_VT + col * 144 + qt * 32, vv);
    __syncthreads();
    const float bref = BR[col];
    {
#pragma unroll
      for (int i = 0; i < 16; ++i) { const float q = bf2f(qraw[i]); const int s = 16 * qt + i;
          *(LAS bf16*)(lds + HG_Q1 + s * 272 + col * 2) = (bf16)f2bf(q * __expf(b[i] - bref));
          *(LAS bf16*)(lds + HG_Q2 + s * 272 + col * 2) = (bf16)f2bf(q * __expf(b[i]));
          *(LAS bf16*)(lds + HG_K1 + s * 272 + col * 2) = (bf16)f2bf((1.f - __expf(gv[i])) * __expf(bref - b[i])); } }
    __syncthreads();
    {
        const int mt = w >> 1;
#pragma unroll
        for (int u = 0; u < 2; ++u) { const int nt = 2 * (w & 1) + u; f32x4 acc = {0.f, 0.f, 0.f, 0.f};
            if (nt <= mt) {
#pragma unroll
                for (int ks = 0; ks < 4; ++ks) { const bf16x8 a = *(const LAS bf16x8*)(lds + HG_Q1 + (16 * mt + fr) * 272 + fq * 16 + ks * 64), bb = *(const LAS bf16x8*)(lds + HG_K1 + (16 * nt + fr) * 272 + fq * 16 + ks * 64);
                    acc = mfma16(a, bb, acc); } }
            const int sidx = 16 * nt + fr;
#pragma unroll
            for (int r = 0; r < 4; ++r) { const int tr = 16 * mt + 4 * fq + r; const float pv = (nt <= mt && sidx <= tr) ? acc[r] : 0.f;
                *(LAS bf16*)(lds + HG_P + tr * 144 + sidx * 2) = (bf16)f2bf(pv); } }
    }
    __syncthreads();
    const int mt = w & 3, vh = w >> 2;
    f32x4 o[4];
#pragma unroll
    for (int nt = 0; nt < 4; ++nt) { const int vt = 4 * vh + nt; f32x4 acc = {0.f, 0.f, 0.f, 0.f};
#pragma unroll
        for (int ks = 0; ks < 2; ++ks) { const bf16x8 a = *(const LAS bf16x8*)(lds + HG_P + (16 * mt + fr) * 144 + fq * 16 + ks * 64), bb = *(const LAS bf16x8*)(lds + HG_VT + (16 * vt + fr) * 144 + fq * 16 + ks * 64);
            acc = mfma16(a, bb, acc); }
#pragma unroll
        for (int ks = 0; ks < 4; ++ks) { const bf16x8 a = *(const LAS bf16x8*)(lds + HG_Q2 + (16 * mt + fr) * 272 + fq * 16 + ks * 64); const bf16x8 bb = stf[nt][ks];
            acc = mfma16(a, bb, acc); }
        o[nt] = acc; }
    LAS float* RS = (LAS float*)(lds + HG_RS);
#pragma unroll
    for (int r = 0; r < 4; ++r) { float ss = 0.f;
#pragma unroll
        for (int nt = 0; nt < 4; ++nt) ss += o[nt][r] * o[nt][r];
        ss += __shfl_xor(ss, 1); ss += __shfl_xor(ss, 2); ss += __shfl_xor(ss, 4); ss += __shfl_xor(ss, 8);
        if (fr == 0) RS[vh * 64 + 16 * mt + 4 * fq + r] = ss; }
    __syncthreads();
    bf16* AUP = (bf16*)(ws + WS_AUP);
#pragma unroll
    for (int r = 0; r < 4; ++r) { const int tl = 16 * mt + 4 * fq + r; const float rn = 1.0f / sqrtf((RS[tl] + RS[64 + tl]) * (1.f / HD) + EPS);
#pragma unroll
        for (int nt = 0; nt < 4; ++nt) { const int v = 16 * (4 * vh + nt) + fr;
            AUP[(size_t)(t0 + tl) * D + h * HD + v] = (bf16)f2bf(o[nt][r] * rn * ngv[nt] * bf2f(ograw[r][nt])); } }
    __syncthreads();
}
__device__ __forceinline__ void moba_gate_item(unsigned char* ws, LAS unsigned char* lds, int item, int tid) {
    const int h = item >> 5, cur = item & 31, lane = tid & 63;
    if (cur == 0) return;
    LAS float* km = (LAS float*)lds;
    LAS unsigned* lcnt = (LAS unsigned*)(lds + 16384);
    if (tid < NB) lcnt[tid] = 0u;
    { const float* KM = (const float*)(ws + WS_KMEAN);
      for (int i = tid; i < NB * HD; i += NTHR) { const int j = i >> 7, d = i & 127; km[i] = (KM[(size_t)j * HW + h * HD + d] + KM[(size_t)(NB + j) * HW + h * HD + d]) * (1.f / BS); } }
    __syncthreads();
    if (tid < 256) {
        const int t = cur * BS + tid;
        const v4u* qp = (const v4u*)((const bf16*)(ws + WS_MQ) + (size_t)t * HW + h * HD);
        float g[32];
#pragma unroll
        for (int j = 0; j < 32; ++j) g[j] = 0.f;
        for (int dc = 0; dc < 16; ++dc) { const v4u qw = qp[dc]; const float q0 = bflo(qw.x), q1 = bfhi(qw.x), q2 = bflo(qw.y), q3 = bfhi(qw.y), q4 = bflo(qw.z), q5 = bfhi(qw.z), q6 = bflo(qw.w), q7 = bfhi(qw.w);
#pragma unroll
            for (int j = 0; j < 32; ++j) if (j < cur) { const f32x4 k0 = *(const LAS f32x4*)(km + j * 128 + dc * 8), k1 = *(const LAS f32x4*)(km + j * 128 + dc * 8 + 4);
                g[j] += (q0 * k0.x + q1 * k0.y + q2 * k0.z + q3 * k0.w) + (q4 * k1.x + q5 * k1.y + q6 * k1.z + q7 * k1.w); } }
#pragma unroll
        for (int j = 0; j < 32; ++j) if (j >= cur) g[j] = -3.0e38f;
        unsigned* LIST = (unsigned*)(ws + WS_MLIST);
#pragma unroll
        for (int r = 0; r < 3; ++r) {
            float best = g[0]; int bi = 0;
#pragma unroll
            for (int j = 1; j < 32; ++j) if (g[j] > best) { best = g[j]; bi = j; }
#pragma unroll
            for (int j = 0; j < 32; ++j) if (j == bi) g[j] = -3.0e38f;
            if (r < cur) {
                const int pos = (int)__hip_atomic_fetch_add(lcnt + bi, 1u, __ATOMIC_RELAXED, __HIP_MEMORY_SCOPE_WORKGROUP);
                LIST[(size_t)((h * NB + bi) * NB + cur) * 256 + pos] = ((unsigned)t << 2) | (unsigned)(r + 1);
            }
        }
    }
    __syncthreads();
    if (tid < NB) ((int*)(ws + WS_CNTP))[(h * NB + cur) * NB + tid] = (int)lcnt[tid];
    __syncthreads();
}
__device__ __forceinline__ void moba_unit(unsigned char* ws, LAS unsigned char* lds, int h, int j, int cur, bool causal, int g, int n, const LAS int* lst, int tid) {
    const int lane = tid & 63, w = tid >> 6, fr = lane & 15, fq = lane >> 4;
    const bf16* MK = (const bf16*)(ws + WS_MK) + (size_t)(j * BS) * HW + h * HD; const bf16* MV = (const bf16*)(ws + WS_MV) + (size_t)(j * BS) * HW + h * HD;
#pragma unroll
    for (int i = 0; i < 8; ++i) { const int p = i * NTHR + tid, row = p >> 4, ch = p & 15;
        const v4u kv = *(const v4u*)(MK + (size_t)row * HW + ch * 8), vv = *(const v4u*)(MV + (size_t)row * HW + ch * 8);
        *(LAS v4u*)(lds + row * 256 + ((ch ^ (row & 15)) << 4)) = kv; *(LAS v4u*)(lds + 65536 + row * 256 + ((ch ^ ((row & 7) << 1)) << 4)) = vv; }
    int t, slot; bool valid = true;
    if (causal) { t = cur * BS + g * 128 + w * 16 + fr; slot = 0; }
    else { int rr = g * 128 + w * 16 + fr; valid = rr < n; if (!valid) rr = n - 1; rr = rr < 0 ? 0 : (rr > 255 ? 255 : rr); const int e = lst[rr]; t = cur * BS + ((e >> 2) & 255); slot = e & 3; if (slot == 0) valid = false; }
    bf16x8 qa[4];
    { const bf16* qp = (const bf16*)(ws + WS_MQ) + (size_t)t * HW + h * HD + fq * 8;
#pragma unroll
      for (int ks = 0; ks < 4; ++ks) qa[ks] = *(const bf16x8*)(qp + ks * 32); }
    __syncthreads();
    const bool wact = causal || (__builtin_amdgcn_readfirstlane(g * 128 + (tid >> 6) * 16) < n);
    if (wact) {
    const int qidx = g * 128 + w * 16 + fr;
    const int ntmax = causal ? (g * 128 + w * 16 + 15) >> 4 : 15;
    f32x4 acc[16];
#pragma unroll
    for (int nt = 0; nt < 16; ++nt) { acc[nt] = (f32x4){0.f, 0.f, 0.f, 0.f};
        if (nt <= ntmax) { const int row = 16 * nt + fr;
#pragma unroll
            for (int ks = 0; ks < 4; ++ks) { const bf16x8 kf = *(const LAS bf16x8*)(lds + row * 256 + (((4 * ks + fq) ^ fr) << 4)); acc[nt] = mfma16(kf, qa[ks], acc[nt]); }
            if (causal) {
#pragma unroll
                for (int r = 0; r < 4; ++r) if (16 * nt + 4 * fq + r > qidx) acc[nt][r] = -3.0e38f; }
        } else { acc[nt] = (f32x4){-3.0e38f, -3.0e38f, -3.0e38f, -3.0e38f}; } }
    float m = -3.0e38f;
#pragma unroll
    for (int nt = 0; nt < 16; ++nt) m = fmaxf(fmaxf(fmaxf(m, acc[nt][0]), fmaxf(acc[nt][1], acc[nt][2])), acc[nt][3]);
    m = fmaxf(m, __shfl_xor(m, 16)); m = fmaxf(m, __shfl_xor(m, 32));
    const float cexp = 0.08838834764831845f * 1.4426950408889634f; float l = 0.f;
    bf16x8 pa[8];
#pragma unroll
    for (int k2 = 0; k2 < 8; ++k2) { float p[8];
#pragma unroll
        for (int r = 0; r < 4; ++r) { p[r] = __builtin_amdgcn_exp2f((acc[2 * k2][r] - m) * cexp); p[4 + r] = __builtin_amdgcn_exp2f((acc[2 * k2 + 1][r] - m) * cexp); }
        l += ((p[0] + p[1]) + (p[2] + p[3])) + ((p[4] + p[5]) + (p[6] + p[7]));
        v4u pw; pw.x = pk2(p[0], p[1]); pw.y = pk2(p[2], p[3]); pw.z = pk2(p[4], p[5]); pw.w = pk2(p[6], p[7]); pa[k2] = __builtin_bit_cast(bf16x8, pw); }
    l += __shfl_xor(l, 16); l += __shfl_xor(l, 32);
    f32x4 o[8];
    const int gl = fr >> 2, pp = fr & 3;
#pragma unroll
    for (int dt = 0; dt < 8; ++dt) o[dt] = (f32x4){0.f, 0.f, 0.f, 0.f};
#pragma unroll
    for (int k2 = 0; k2 < 8; ++k2) { const int r0 = 32 * k2 + 4 * fq + gl, r1 = r0 + 16;
#pragma unroll
        for (int dt = 0; dt < 8; ++dt) { const int ch = 2 * dt + (pp >> 1);
            const v4i16_t lo = __builtin_amdgcn_ds_read_tr16_b64_v4i16((LAS v4i16_t*)(lds + 65536 + r0 * 256 + ((ch ^ ((r0 & 7) << 1)) << 4) + 8 * (pp & 1)));
            const v4i16_t hi = __builtin_amdgcn_ds_read_tr16_b64_v4i16((LAS v4i16_t*)(lds + 65536 + r1 * 256 + ((ch ^ ((r1 & 7) << 1)) << 4) + 8 * (pp & 1)));
            bf16x8 vf; vf[0] = lo[0]; vf[1] = lo[1]; vf[2] = lo[2]; vf[3] = lo[3]; vf[4] = hi[0]; vf[5] = hi[1]; vf[6] = hi[2]; vf[7] = hi[3];
            o[dt] = mfma16(vf, pa[k2], o[dt]); } }
    const float il = 1.0f / l;
    int t2, slot2; bool valid2 = true;
    if (causal) { t2 = cur * BS + g * 128 + w * 16 + fr; slot2 = 0; }
    else { int rr = g * 128 + w * 16 + fr; valid2 = rr < n; if (!valid2) rr = n - 1; rr = rr < 0 ? 0 : (rr > 255 ? 255 : rr); const int e = lst[rr]; t2 = cur * BS + ((e >> 2) & 255); slot2 = e & 3; if (slot2 == 0) valid2 = false; }
    if (valid2) { bf16* po = (bf16*)(ws + WS_PO) + ((size_t)(t2 * NH + h) * 4 + slot2) * HD + 4 * fq;
#pragma unroll
        for (int dt = 0; dt < 8; ++dt) { v2u wv; wv.x = pk2(o[dt][0] * il, o[dt][1] * il); wv.y = pk2(o[dt][2] * il, o[dt][3] * il); *(v2u*)(po + 16 * dt) = wv; }
        if (fq == 0) ((float*)(ws + WS_PLSE))[((size_t)(t2 * NH + h) * 4 + slot2) * 32] = m * 0.08838834764831845f + __logf(l); }
    }
    __syncthreads();
}

__device__ __forceinline__ void moba_unit2(unsigned char* ws, LAS unsigned char* lds, int h, int j, bool causal, int g, int n, const unsigned short* glist, int tid) {
    const int lane = tid & 63, w = tid >> 6, fr = lane & 15, fq = lane >> 4;
    int t, slot; bool valid = true;
    if (causal) { t = j * BS + g * 128 + w * 16 + fr; slot = 0; }
    else { int rr = g * 128 + w * 16 + fr; valid = rr < n; if (!valid) rr = n - 1; rr = rr < 0 ? 0 : rr; const int e = (int)glist[rr]; t = (e >> 2) & (T - 1); slot = e & 3; if (slot == 0) valid = false; }
    bf16x8 qa[4];
    { const bf16* qp = (const bf16*)(ws + WS_MQ) + (size_t)t * HW + h * HD + fq * 8;
#pragma unroll
      for (int ks = 0; ks < 4; ++ks) qa[ks] = *(const bf16x8*)(qp + ks * 32); }
    __syncthreads();
    const bool wact = causal || (__builtin_amdgcn_readfirstlane(g * 128 + (tid >> 6) * 16) < n);
    if (wact) {
    const int qidx = g * 128 + w * 16 + fr;
    const int ntmax = causal ? (g * 128 + w * 16 + 15) >> 4 : 15;
    f32x4 acc[16];
#pragma unroll
    for (int nt = 0; nt < 16; ++nt) { acc[nt] = (f32x4){0.f, 0.f, 0.f, 0.f};
        if (nt <= ntmax) { const int row = 16 * nt + fr;
#pragma unroll
            for (int ks = 0; ks < 4; ++ks) { const bf16x8 kf = *(const LAS bf16x8*)(lds + row * 256 + (((4 * ks + fq) ^ fr) << 4)); acc[nt] = mfma16(kf, qa[ks], acc[nt]); }
            if (causal) {
#pragma unroll
                for (int r = 0; r < 4; ++r) if (16 * nt + 4 * fq + r > qidx) acc[nt][r] = -3.0e38f; }
        } else { acc[nt] = (f32x4){-3.0e38f, -3.0e38f, -3.0e38f, -3.0e38f}; } }
    float m = -3.0e38f;
#pragma unroll
    for (int nt = 0; nt < 16; ++nt) m = fmaxf(fmaxf(fmaxf(m, acc[nt][0]), fmaxf(acc[nt][1], acc[nt][2])), acc[nt][3]);
    m = fmaxf(m, __shfl_xor(m, 16)); m = fmaxf(m, __shfl_xor(m, 32));
    const float cexp = 0.08838834764831845f * 1.4426950408889634f; float l = 0.f;
    bf16x8 pa[8];
#pragma unroll
    for (int k2 = 0; k2 < 8; ++k2) { float p[8];
#pragma unroll
        for (int r = 0; r < 4; ++r) { p[r] = __builtin_amdgcn_exp2f((acc[2 * k2][r] - m) * cexp); p[4 + r] = __builtin_amdgcn_exp2f((acc[2 * k2 + 1][r] - m) * cexp); }
        l += ((p[0] + p[1]) + (p[2] + p[3])) + ((p[4] + p[5]) + (p[6] + p[7]));
        v4u pw; pw.x = pk2(p[0], p[1]); pw.y = pk2(p[2], p[3]); pw.z = pk2(p[4], p[5]); pw.w = pk2(p[6], p[7]); pa[k2] = __builtin_bit_cast(bf16x8, pw); }
    l += __shfl_xor(l, 16); l += __shfl_xor(l, 32);
    f32x4 o[8];
    const int gl = fr >> 2, pp = fr & 3;
#pragma unroll
    for (int dt = 0; dt < 8; ++dt) o[dt] = (f32x4){0.f, 0.f, 0.f, 0.f};
#pragma unroll
    for (int k2 = 0; k2 < 8; ++k2) { const int r0 = 32 * k2 + 4 * fq + gl, r1 = r0 + 16;
#pragma unroll
        for (int dt = 0; dt < 8; ++dt) { const int ch = 2 * dt + (pp >> 1);
            const v4i16_t lo = __builtin_amdgcn_ds_read_tr16_b64_v4i16((LAS v4i16_t*)(lds + 65536 + r0 * 256 + ((ch ^ ((r0 & 7) << 1)) << 4) + 8 * (pp & 1)));
            const v4i16_t hi = __builtin_amdgcn_ds_read_tr16_b64_v4i16((LAS v4i16_t*)(lds + 65536 + r1 * 256 + ((ch ^ ((r1 & 7) << 1)) << 4) + 8 * (pp & 1)));
            bf16x8 vf; vf[0] = lo[0]; vf[1] = lo[1]; vf[2] = lo[2]; vf[3] = lo[3]; vf[4] = hi[0]; vf[5] = hi[1]; vf[6] = hi[2]; vf[7] = hi[3];
            o[dt] = mfma16(vf, pa[k2], o[dt]); } }
    const float il = 1.0f / l;
    int t2, slot2; bool valid2 = true;
    if (causal) { t2 = j * BS + g * 128 + w * 16 + fr; slot2 = 0; }
    else { int rr = g * 128 + w * 16 + fr; valid2 = rr < n; if (!valid2) rr = n - 1; rr = rr < 0 ? 0 : rr; const int e = (int)glist[rr]; t2 = (e >> 2) & (T - 1); slot2 = e & 3; if (slot2 == 0) valid2 = false; }
    if (valid2) { bf16* po = (bf16*)(ws + WS_PO) + ((size_t)(t2 * NH + h) * 4 + slot2) * HD + 4 * fq;
#pragma unroll
        for (int dt = 0; dt < 8; ++dt) { v2u wv; wv.x = pk2(o[dt][0] * il, o[dt][1] * il); wv.y = pk2(o[dt][2] * il, o[dt][3] * il); *(v2u*)(po + 16 * dt) = wv; }
        if (fq == 0) ((float*)(ws + WS_PLSE))[((size_t)(t2 * NH + h) * 4 + slot2) * 32] = m * 0.08838834764831845f + __logf(l); }
    }
    __syncthreads();
}


constexpr size_t WS_GL = 16 * MiB;
constexpr int MB_RCH = 512;
__device__ __forceinline__ void moba_kv_item(unsigned char* ws, LAS unsigned char* lds, int h, int j, bool causal, const unsigned short* glist, int n, int tid) {
    const int lane = tid & 63, w = tid >> 6, fr = lane & 15, fq = lane >> 4;
    { const bf16* MK = (const bf16*)(ws + WS_MK) + (size_t)(j * BS) * HW + h * HD; const bf16* MV = (const bf16*)(ws + WS_MV) + (size_t)(j * BS) * HW + h * HD;
#pragma unroll
    for (int i = 0; i < 8; ++i) { const int p = i * NTHR + tid, row = p >> 4, ch = p & 15;
        const v4u kv = *(const v4u*)(MK + (size_t)row * HW + ch * 8), vv = *(const v4u*)(MV + (size_t)row * HW + ch * 8);
        *(LAS v4u*)(lds + row * 256 + ((ch ^ (row & 15)) << 4)) = kv; *(LAS v4u*)(lds + 65536 + row * 256 + ((ch ^ ((row & 7) << 1)) << 4)) = vv; } }
    const int ng = (n + 127) >> 7;
#define MKV_FETCH(G) do { int rr_ = (G) * 128 + w * 16 + fr; int ee_; \
        if (causal) ee_ = ((j * BS + rr_) << 2) | 0x8000; \
        else { const bool v_ = rr_ < n; if (!v_) rr_ = n - 1; rr_ = rr_ < 0 ? 0 : rr_; ee_ = (int)glist[rr_]; ee_ = (v_ && (ee_ & 3)) ? (ee_ | 0x8000) : (ee_ & 0x7fff); } \
        e_n = ee_; const bf16* qp_ = (const bf16*)(ws + WS_MQ) + (size_t)((ee_ >> 2) & (T - 1)) * HW + h * HD + fq * 8; \
        _Pragma("unroll") for (int ks_ = 0; ks_ < 4; ++ks_) qn[ks_] = *(const bf16x8*)(qp_ + ks_ * 32); } while (0)
    int e_n; bf16x8 qn[4];
    MKV_FETCH(0);
    __syncthreads();
    for (int g = 0; g < ng; ++g) {
        const int e = e_n; bf16x8 qa[4];
#pragma unroll
        for (int ks = 0; ks < 4; ++ks) qa[ks] = qn[ks];
        if (g + 1 < ng) MKV_FETCH(g + 1);
        const bool wact = causal || (__builtin_amdgcn_readfirstlane(g * 128 + w * 16) < n);
        if (wact) {
    const int qidx = g * 128 + w * 16 + fr;
    const int ntmax = causal ? (g * 128 + w * 16 + 15) >> 4 : 15;
    f32x4 acc[16];
#pragma unroll
    for (int nt = 0; nt < 16; ++nt) { acc[nt] = (f32x4){0.f, 0.f, 0.f, 0.f};
        if (nt <= ntmax) { const int row = 16 * nt + fr;
#pragma unroll
            for (int ks = 0; ks < 4; ++ks) { const bf16x8 kf = *(const LAS bf16x8*)(lds + row * 256 + (((4 * ks + fq) ^ fr) << 4)); acc[nt] = mfma16(kf, qa[ks], acc[nt]); }
            if (causal) {
#pragma unroll
                for (int r = 0; r < 4; ++r) if (16 * nt + 4 * fq + r > qidx) acc[nt][r] = -3.0e38f; }
        } else { acc[nt] = (f32x4){-3.0e38f, -3.0e38f, -3.0e38f, -3.0e38f}; } }
    float m = -3.0e38f;
#pragma unroll
    for (int nt = 0; nt < 16; ++nt) m = fmaxf(fmaxf(fmaxf(m, acc[nt][0]), fmaxf(acc[nt][1], acc[nt][2])), acc[nt][3]);
    m = fmaxf(m, __shfl_xor(m, 16)); m = fmaxf(m, __shfl_xor(m, 32));
    const float cexp = 0.08838834764831845f * 1.4426950408889634f; float l = 0.f;
    bf16x8 pa[8];
#pragma unroll
    for (int k2 = 0; k2 < 8; ++k2) { float p[8];
#pragma unroll
        for (int r = 0; r < 4; ++r) { p[r] = __builtin_amdgcn_exp2f((acc[2 * k2][r] - m) * cexp); p[4 + r] = __builtin_amdgcn_exp2f((acc[2 * k2 + 1][r] - m) * cexp); }
        l += ((p[0] + p[1]) + (p[2] + p[3])) + ((p[4] + p[5]) + (p[6] + p[7]));
        v4u pw; pw.x = pk2(p[0], p[1]); pw.y = pk2(p[2], p[3]); pw.z = pk2(p[4], p[5]); pw.w = pk2(p[6], p[7]); pa[k2] = __builtin_bit_cast(bf16x8, pw); }
    l += __shfl_xor(l, 16); l += __shfl_xor(l, 32);
    f32x4 o[8];
    const int gl = fr >> 2, pp = fr & 3;
#pragma unroll
    for (int dt = 0; dt < 8; ++dt) o[dt] = (f32x4){0.f, 0.f, 0.f, 0.f};
#pragma unroll
    for (int k2 = 0; k2 < 8; ++k2) { const int r0 = 32 * k2 + 4 * fq + gl, r1 = r0 + 16;
#pragma unroll
        for (int dt = 0; dt < 8; ++dt) { const int ch = 2 * dt + (pp >> 1);
            const v4i16_t lo = __builtin_amdgcn_ds_read_tr16_b64_v4i16((LAS v4i16_t*)(lds + 65536 + r0 * 256 + ((ch ^ ((r0 & 7) << 1)) << 4) + 8 * (pp & 1)));
            const v4i16_t hi = __builtin_amdgcn_ds_read_tr16_b64_v4i16((LAS v4i16_t*)(lds + 65536 + r1 * 256 + ((ch ^ ((r1 & 7) << 1)) << 4) + 8 * (pp & 1)));
            bf16x8 vf; vf[0] = lo[0]; vf[1] = lo[1]; vf[2] = lo[2]; vf[3] = lo[3]; vf[4] = hi[0]; vf[5] = hi[1]; vf[6] = hi[2]; vf[7] = hi[3];
            o[dt] = mfma16(vf, pa[k2], o[dt]); } }
    const float il = 1.0f / l;
    if (e & 0x8000) { const int t2 = (e >> 2) & (T - 1), slot2 = e & 3; bf16* po = (bf16*)(ws + WS_PO) + ((size_t)(t2 * NH + h) * 4 + slot2) * HD + 4 * fq;
#pragma unroll
        for (int dt = 0; dt < 8; ++dt) { v2u wv; wv.x = pk2(o[dt][0] * il, o[dt][1] * il); wv.y = pk2(o[dt][2] * il, o[dt][3] * il); *(v2u*)(po + 16 * dt) = wv; }
        if (fq == 0) ((float*)(ws + WS_PLSE))[(size_t)(t2 * NH + h) * 4 + slot2] = m * 0.08838834764831845f + __logf(l); }
        }
    }
#undef MKV_FETCH
    __syncthreads();
}
__device__ __forceinline__ void moba_gate_lists(unsigned char* ws, gu32* ctl, LAS unsigned char* lds, int h, int cur, int tid) {
    LAS float* km = (LAS float*)lds;
    LAS float* gs = (LAS float*)(lds + 17408);
    LAS unsigned short* lists = (LAS unsigned short*)(lds + 65536);
    LAS int* cnt = (LAS int*)(lds + 61440); LAS int* gbase = cnt + 32;
    unsigned sel = 0xFFFFFFu;
    if (tid < 32) cnt[tid] = 0;
    { const float* KM = (const float*)(ws + WS_KMEAN);
      for (int i = tid; i < NB * HD; i += NTHR) { const int j = i >> 7, d = i & 127; km[j * 132 + d] = (KM[(size_t)j * HW + h * HD + d] + KM[(size_t)(NB + j) * HW + h * HD + d]) * (1.f / BS); } }
    __syncthreads();
    {
        const int lane = tid & 63, w = tid >> 6, fr = lane & 15, fq = lane >> 4;
        f32x4 acc[2][2];
#pragma unroll
        for (int rt = 0; rt < 2; ++rt)
#pragma unroll
            for (int ct = 0; ct < 2; ++ct) acc[rt][ct] = (f32x4){0.f, 0.f, 0.f, 0.f};
        const bf16* qb = (const bf16*)(ws + WS_MQ) + (size_t)(cur * BS + 32 * w + fr) * HW + h * HD + 8 * fq;
#pragma unroll
        for (int J = 0; J < 4; ++J) {
            const v4u q0 = *(const v4u*)(qb + 32 * J), q1 = *(const v4u*)(qb + (size_t)16 * HW + 32 * J);
            const f32x4 k00 = *(const LAS f32x4*)(km + fr * 132 + 32 * J + 8 * fq), k01 = *(const LAS f32x4*)(km + fr * 132 + 32 * J + 8 * fq + 4);
            const f32x4 k10 = *(const LAS f32x4*)(km + (16 + fr) * 132 + 32 * J + 8 * fq), k11 = *(const LAS f32x4*)(km + (16 + fr) * 132 + 32 * J + 8 * fq + 4);
            const float a0[8] = {bflo(q0.x), bfhi(q0.x), bflo(q0.y), bfhi(q0.y), bflo(q0.z), bfhi(q0.z), bflo(q0.w), bfhi(q0.w)};
            const float a1[8] = {bflo(q1.x), bfhi(q1.x), bflo(q1.y), bfhi(q1.y), bflo(q1.z), bfhi(q1.z), bflo(q1.w), bfhi(q1.w)};
            const float b0[8] = {k00.x, k00.y, k00.z, k00.w, k01.x, k01.y, k01.z, k01.w};
            const float b1[8] = {k10.x, k10.y, k10.z, k10.w, k11.x, k11.y, k11.z, k11.w};
#pragma unroll
            for (int s8 = 0; s8 < 8; ++s8) {
                acc[0][0] = __builtin_amdgcn_mfma_f32_16x16x4f32(a0[s8], b0[s8], acc[0][0], 0, 0, 0); acc[0][1] = __builtin_amdgcn_mfma_f32_16x16x4f32(a0[s8], b1[s8], acc[0][1], 0, 0, 0);
                acc[1][0] = __builtin_amdgcn_mfma_f32_16x16x4f32(a1[s8], b0[s8], acc[1][0], 0, 0, 0); acc[1][1] = __builtin_amdgcn_mfma_f32_16x16x4f32(a1[s8], b1[s8], acc[1][1], 0, 0, 0); } }
#pragma unroll
        for (int rt = 0; rt < 2; ++rt)
#pragma unroll
            for (int ct = 0; ct < 2; ++ct)
#pragma unroll
                for (int i = 0; i < 4; ++i) gs[(32 * w + 16 * rt + 4 * fq + i) * 33 + 16 * ct + fr] = acc[rt][ct][i];
    }
    __syncthreads();
    if (tid < 256) {
        const int t = cur * BS + tid;
        float g[32];
#pragma unroll
        for (int j = 0; j < 32; ++j) g[j] = (j < cur) ? gs[tid * 33 + j] : -3.0e38f;
#pragma unroll
        for (int r = 0; r < 3; ++r) {
            float best = g[0]; int bi = 0;
#pragma unroll
            for (int j = 1; j < 32; ++j) if (g[j] > best) { best = g[j]; bi = j; }
#pragma unroll
            for (int j = 0; j < 32; ++j) if (j == bi) g[j] = -3.0e38f;
            if (r < cur) sel = (sel & ~(0xFFu << (8 * r))) | ((unsigned)bi << (8 * r));
        }
#pragma unroll
        for (int r = 0; r < 3; ++r) { const int b = (int)((sel >> (8 * r)) & 255u);
            if (b < 32) { const int pos = (int)__hip_atomic_fetch_add((LAS unsigned*)(cnt + b), 1u, __ATOMIC_RELAXED, __HIP_MEMORY_SCOPE_WORKGROUP); lists[b * 256 + (pos & 255)] = (unsigned short)((t << 2) | (r + 1)); } }
    }
    __syncthreads();
    if (tid < 32) gbase[tid] = (tid < cur && cnt[tid] > 0) ? (int)__hip_atomic_fetch_add((unsigned*)(ctl + CW_MCNT) + h * NB + tid, (unsigned)cnt[tid], RLX_AGENT) : 0;
    __syncthreads();
    { unsigned short* GL = (unsigned short*)(ws + WS_GL);
      for (int i = tid; i < NB * 256; i += NTHR) { const int j = i >> 8, q = i & 255; if (j < cur && q < cnt[j]) GL[(size_t)(h * NB + j) * 8192 + ((gbase[j] + q) & 8191)] = lists[i]; } }
    __syncthreads();
}
#ifndef MBRT
#define MBRT 31
#endif
#ifndef MB_STAGE
#define MB_STAGE 3
#endif
__device__ __forceinline__ void moba_block_item(unsigned char* ws, LAS unsigned char* lds, int h, int cur, int jlo, int jhi, int flags, int tid) {
    unsigned sel = 0xFFFFFFu;
    if (jhi > jlo) {
        LAS float* km = (LAS float*)lds;
        { const float* KM = (const float*)(ws + WS_KMEAN);
          for (int i = tid; i < NB * HD; i += NTHR) { const int j = i >> 7, d = i & 127; km[i] = (KM[(size_t)j * HW + h * HD + d] + KM[(size_t)(NB + j) * HW + h * HD + d]) * (1.f / BS); } }
        __syncthreads();
        if (tid < 256) {
            const int t = cur * BS + tid;
            const v4u* qp = (const v4u*)((const bf16*)(ws + WS_MQ) + (size_t)t * HW + h * HD);
            float g[32];
#pragma unroll
            for (int j = 0; j < 32; ++j) g[j] = 0.f;
            for (int dc = 0; dc < 16; ++dc) { const v4u qw = qp[dc]; const float q0 = bflo(qw.x), q1 = bfhi(qw.x), q2 = bflo(qw.y), q3 = bfhi(qw.y), q4 = bflo(qw.z), q5 = bfhi(qw.z), q6 = bflo(qw.w), q7 = bfhi(qw.w);
#pragma unroll
                for (int j = 0; j < 32; ++j) if (j < cur) { const f32x4 k0 = *(const LAS f32x4*)(km + j * 128 + dc * 8), k1 = *(const LAS f32x4*)(km + j * 128 + dc * 8 + 4);
                    g[j] += (q0 * k0.x + q1 * k0.y + q2 * k0.z + q3 * k0.w) + (q4 * k1.x + q5 * k1.y + q6 * k1.z + q7 * k1.w); } }
#pragma unroll
            for (int j = 0; j < 32; ++j) if (j >= cur) g[j] = -3.0e38f;
#pragma unroll
            for (int r = 0; r < 3; ++r) {
                float best = g[0]; int bi = 0;
#pragma unroll
                for (int j = 1; j < 32; ++j) if (g[j] > best) { best = g[j]; bi = j; }
#pragma unroll
                for (int j = 0; j < 32; ++j) if (j == bi) g[j] = -3.0e38f;
                if (r < cur) sel = (sel & ~(0xFFu << (8 * r))) | ((unsigned)bi << (8 * r));
            }
        }
        __syncthreads();
    }
    LAS int* lc = (LAS int*)(lds + LDSCTL_OFF + 1024); LAS int* lst = lc + 4;
    for (int jj = (flags & 1) ? -2 : jlo; jj < jhi; jj = (jj == -1) ? jlo : jj + 1) {
        const bool causal = jj < 0; const int j = causal ? cur : jj; int n = 256;
        if (!causal) {
            if (tid == 0) *lc = 0;
            __syncthreads();
            if (tid < 256) { const int slot = ((int)(sel & 255u) == j) ? 1 : ((int)((sel >> 8) & 255u) == j) ? 2 : ((int)((sel >> 16) & 255u) == j) ? 3 : 0;
                if (slot) { const int pos = (int)__hip_atomic_fetch_add((LAS unsigned*)lc, 1u, __ATOMIC_RELAXED, __HIP_MEMORY_SCOPE_WORKGROUP); lst[pos] = (tid << 2) | slot; } }
            __syncthreads();
            n = *lc;
        }
        const int g0 = causal ? jj + 2 : 0, g1 = causal ? g0 + 1 : (n + 127) >> 7;
        for (int g = g0; g < g1; ++g) moba_unit(ws, lds, h, j, cur, causal, g, n, lst, tid);
        __syncthreads();
    }
    asm volatile("s_waitcnt vmcnt(0)" ::: "memory"); __syncthreads();
    if (flags & 2) { const bf16* PO = (const bf16*)(ws + WS_PO); const float* PL = (const float*)(ws + WS_PLSE); bf16* AUP = (bf16*)(ws + WS_AUP); const int nv = cur < 3 ? cur : 3;
      for (int idx = tid; idx < BS * 16; idx += NTHR) { const int t = cur * BS + (idx >> 4), dq = idx & 15, th = t * NH + h;
          const float* plp = PL + (size_t)th * 128; float ls[4]; ls[0] = plp[0]; ls[1] = nv > 0 ? plp[32] : 0.f; ls[2] = nv > 1 ? plp[64] : 0.f; ls[3] = nv > 2 ? plp[96] : 0.f;
          float M = ls[0]; if (nv > 0) M = fmaxf(M, ls[1]); if (nv > 1) M = fmaxf(M, ls[2]); if (nv > 2) M = fmaxf(M, ls[3]);
          float wv[4]; wv[0] = __expf(ls[0] - M); wv[1] = nv > 0 ? __expf(ls[1] - M) : 0.f; wv[2] = nv > 1 ? __expf(ls[2] - M) : 0.f; wv[3] = nv > 2 ? __expf(ls[3] - M) : 0.f;
          const float inv = 1.0f / ((wv[0] + wv[1]) + (wv[2] + wv[3]));
          float acc[8] = {0.f, 0.f, 0.f, 0.f, 0.f, 0.f, 0.f, 0.f};
#pragma unroll
          for (int i = 0; i < 4; ++i) if (i <= nv) { const v4u pw = *(const v4u*)(PO + ((size_t)th * 4 + i) * HD + dq * 8); const float wi = wv[i] * inv;
              acc[0] += wi * bflo(pw.x); acc[1] += wi * bfhi(pw.x); acc[2] += wi * bflo(pw.y); acc[3] += wi * bfhi(pw.y); acc[4] += wi * bflo(pw.z); acc[5] += wi * bfhi(pw.z); acc[6] += wi * bflo(pw.w); acc[7] += wi * bfhi(pw.w); }
          v4u ov; ov.x = pk2(acc[0], acc[1]); ov.y = pk2(acc[2], acc[3]); ov.z = pk2(acc[4], acc[5]); ov.w = pk2(acc[6], acc[7]);
          *(v4u*)(AUP + (size_t)t * D + HW + h * HD + dq * 8) = ov; } }
    __syncthreads();
}

namespace pg8 {
#define PG8_LAS __attribute__((address_space(3)))
typedef unsigned short bf16_t;
typedef unsigned u32x4 __attribute__((ext_vector_type(4)));
constexpr int BM = 256, BK = 64, HALF = 128, HTB = HALF * BK * 2, STAGE_BYTES = 8 * HTB, NXCD = 8, WGM = 8;
__host__ __device__ __forceinline__ int lds_byte(int r, int c) { const int st = (r >> 4) * 2 + (c >> 5), rr = r & 15, cc = c & 31, ob = rr * 64 + cc * 2; return st * 1024 + (ob ^ (((ob >> 9) & 1) << 5)); }
__host__ __device__ __forceinline__ void stage_rc(int b, int& R, int& C) { const int st = b / 1024, sb = b % 1024, swz = sb ^ (((sb >> 9) & 1) << 5); R = (st >> 1) * 16 + swz / 64; C = (st & 1) * 32 + (swz % 64) / 2; }
__host__ __device__ __forceinline__ int perm32(int rho) { const int n = rho >> 4, i = rho & 15; return 8 * (i >> 2) + 4 * n + (i & 3); }
struct Unit { int pm, pn; };
struct Gemm { const bf16_t* A; const bf16_t* Bt; int lda, ldb, K; };
struct StaticOrder {
    int nM, nN, nwg, G, c;
    __host__ __device__ void init(int M, int N, int G_, int c_) { nM = M / BM; nN = N / BM; nwg = nM * nN; G = G_; c = c_; }
    __host__ __device__ bool next(int i, Unit& u) const {
        const long L = (long)i * G + c; if (L >= nwg) return false;
        int wgid = (int)L; { const int q = nwg / NXCD, r = nwg % NXCD, xcd = wgid % NXCD, off = wgid / NXCD; wgid = (xcd < r ? xcd * (q + 1) : r * (q + 1) + (xcd - r) * q) + off; }
        const int nig = WGM * nN, gid = wgid / nig, fm = gid * WGM, gsz = (nM - fm) < WGM ? (nM - fm) : WGM;
        u.pm = fm + ((wgid % nig) % gsz); u.pn = (wgid % nig) / gsz; return true;
    }
    __device__ __forceinline__ void a_ready(const Unit&) const {}
    __device__ __forceinline__ void done(const Unit&) const {}
};
struct MoeOrder {
    const PG8_LAS int* pstart; int npn, G, c;
    __device__ bool next(int i, Unit& u) const {
        const int L = i * G + c, ntile = pstart[32] >> 8; if (L >= ntile * npn) return false;
        const int tile = L / npn, pnl = L % npn; int e = 0;
        for (int q = 1; q < 32; ++q) if (pstart[q] <= tile * 256) e = q;
        u.pm = tile; u.pn = e * npn + pnl; return true;
    }
    __device__ __forceinline__ void a_ready(const Unit&) const {}
    __device__ __forceinline__ void done(const Unit&) const {}
};
__device__ __forceinline__ unsigned cvt_pk_bf16(float lo, float hi) { unsigned r; asm volatile("v_cvt_pk_bf16_f32 %0, %1, %2" : "=v"(r) : "v"(lo), "v"(hi)); return r; }
__device__ __forceinline__ u32x4 pack8(const f32x4& a, const f32x4& b) { u32x4 w; w.x = cvt_pk_bf16(a[0], a[1]); w.y = cvt_pk_bf16(a[2], a[3]); w.z = cvt_pk_bf16(b[0], b[1]); w.w = cvt_pk_bf16(b[2], b[3]); return w; }
__device__ __forceinline__ float bl(unsigned w) { return __builtin_bit_cast(float, w << 16); }
__device__ __forceinline__ float bh(unsigned w) { return __builtin_bit_cast(float, w & 0xffff0000u); }
__device__ __forceinline__ f32x4 sig4(const f32x4& v) { f32x4 o; for (int i = 0; i < 4; ++i) o[i] = __builtin_amdgcn_rcpf(1.0f + __expf(-v[i])); return o; }
__device__ __forceinline__ f32x4 silu4(const f32x4& v) { f32x4 o; for (int i = 0; i < 4; ++i) o[i] = v[i] * __builtin_amdgcn_rcpf(1.0f + __expf(-v[i])); return o; }

struct EpiInProj {
    static constexpr bool PERM = true, AFTER_DRAIN = false, HAS_MID = false, GATHER = false;
    unsigned char* ws;
    __device__ __forceinline__ void mid(f32x4 (&)[2][2][4][2], const Unit&, int, int, int, int) const {}
    __device__ __forceinline__ void operator()(const f32x4 (&acc)[2][2][4][2], const Unit& u, int wr, int wc, int fr, int fq) const {
        const int pn = u.pn, row0 = u.pm * BM + wr * 64 + fr, cl = wc * 32 + 8 * fq;
        if (pn >= 16 && pn < 24) {
            const int which = (pn - 16) >> 2, head = 2 * ((pn - 16) & 3) + (wc >> 1), d = (wc & 1) * 32 + 8 * fq;
            bf16_t* dst = (bf16_t*)(ws + (which ? WS_MK : WS_MQ)) + head * HD + d;
            const f32x2* trig = (const f32x2*)(ws + WS_TRIG) + d;
            float cs[16];
#pragma unroll
            for (int i = 0; i < 16; ++i) cs[i] = 0.f;
#pragma unroll
            for (int ai = 0; ai < 2; ++ai)
#pragma unroll
                for (int mp = 0; mp < 2; ++mp) {
                    f32x4 tg[2][4];
#pragma unroll
                    for (int mm = 0; mm < 2; ++mm) { const f32x4* tp = (const f32x4*)(trig + (size_t)(row0 + ai * HALF + (2 * mp + mm) * 16) * 64);
#pragma unroll
                        for (int q = 0; q < 4; ++q) tg[mm][q] = tp[q]; }
#pragma unroll
                    for (int mm = 0; mm < 2; ++mm) { const int m = 2 * mp + mm, row = row0 + ai * HALF + m * 16;
                    u32x4 wl, wh;
                    { const f32x4 t0 = tg[mm][0], t1 = tg[mm][1]; const f32x4 x1a = acc[ai][0][m][0], x2a = acc[ai][1][m][0]; f32x4 la, ha;
                      la[0] = x1a[0] * t0[0] - x2a[0] * t0[1]; ha[0] = x2a[0] * t0[0] + x1a[0] * t0[1];
                      la[1] = x1a[1] * t0[2] - x2a[1] * t0[3]; ha[1] = x2a[1] * t0[2] + x1a[1] * t0[3];
                      la[2] = x1a[2] * t1[0] - x2a[2] * t1[1]; ha[2] = x2a[2] * t1[0] + x1a[2] * t1[1];
                      la[3] = x1a[3] * t1[2] - x2a[3] * t1[3]; ha[3] = x2a[3] * t1[2] + x1a[3] * t1[3];
                      wl.x = cvt_pk_bf16(la[0], la[1]); wl.y = cvt_pk_bf16(la[2], la[3]); wh.x = cvt_pk_bf16(ha[0], ha[1]); wh.y = cvt_pk_bf16(ha[2], ha[3]);
                      if (which) {
#pragma unroll
                          for (int i = 0; i < 4; ++i) { cs[i] += la[i]; cs[8 + i] += ha[i]; } } }
                    { const f32x4 t2 = tg[mm][2], t3 = tg[mm][3]; const f32x4 x1b = acc[ai][0][m][1], x2b = acc[ai][1][m][1]; f32x4 lb_, hb;
                      lb_[0] = x1b[0] * t2[0] - x2b[0] * t2[1]; hb[0] = x2b[0] * t2[0] + x1b[0] * t2[1];
                      lb_[1] = x1b[1] * t2[2] - x2b[1] * t2[3]; hb[1] = x2b[1] * t2[2] + x1b[1] * t2[3];
                      lb_[2] = x1b[2] * t3[0] - x2b[2] * t3[1]; hb[2] = x2b[2] * t3[0] + x1b[2] * t3[1];
                      lb_[3] = x1b[3] * t3[2] - x2b[3] * t3[3]; hb[3] = x2b[3] * t3[2] + x1b[3] * t3[3];
                      wl.z = cvt_pk_bf16(lb_[0], lb_[1]); wl.w = cvt_pk_bf16(lb_[2], lb_[3]); wh.z = cvt_pk_bf16(hb[0], hb[1]); wh.w = cvt_pk_bf16(hb[2], hb[3]);
                      if (which) {
#pragma unroll
                          for (int i = 0; i < 4; ++i) { cs[4 + i] += lb_[i]; cs[12 + i] += hb[i]; } } }
                    *(u32x4*)(dst + (size_t)row * HW) = wl; *(u32x4*)(dst + (size_t)row * HW + 64) = wh; }
                    asm volatile("" ::: "memory"); }
            if (which) {
                float* ks = (float*)(ws + WS_KMEAN) + (size_t)(wr * NB + u.pm) * HW + head * HD + d;
#pragma unroll
                for (int i = 0; i < 16; ++i) { float v = cs[i]; v += __shfl_xor(v, 1); v += __shfl_xor(v, 2); v += __shfl_xor(v, 4); v += __shfl_xor(v, 8);
                    if (fr == 0) ks[(i & 7) + 64 * (i >> 3)] = v; }
            }
            return;
        }
        int kind, ld; size_t base; int colb;
        if (pn < 4) { kind = 1; base = WS_QH; ld = HW; colb = pn * 256; }
        else if (pn < 8) { kind = 3; base = WS_GH; ld = HW; colb = (pn - 4) * 256; }
        else if (pn < 12) { kind = 0; base = WS_VH; ld = HW; colb = (pn - 8) * 256; }
        else if (pn < 16) { kind = 1; base = WS_OG; ld = HW; colb = (pn - 12) * 256; }
        else if (pn < 28) { kind = 0; base = WS_MV; ld = HW; colb = (pn - 24) * 256; }
        else if (pn < 36) { kind = 2; base = WS_GA; ld = D; colb = (pn - 28) * 256; }
        else { kind = 2; base = WS_GB; ld = D; colb = (pn - 36) * 256; }
        if (kind == 3) {
            const float* lbp = (const float*)(ws + WS_LB) + colb + cl; float* dst = (float*)(ws + base) + colb + cl;
#pragma unroll
            for (int bj = 0; bj < 2; ++bj) { const f32x4 l0 = *(const f32x4*)(lbp + bj * HALF), l1 = *(const f32x4*)(lbp + bj * HALF + 4);
#pragma unroll
                for (int ai = 0; ai < 2; ++ai)
#pragma unroll
                    for (int m = 0; m < 4; ++m) { const int row = row0 + ai * HALF + m * 16; const f32x4 s0 = sig4(acc[ai][bj][m][0]), s1 = sig4(acc[ai][bj][m][1]); f32x4 o0, o1;
#pragma unroll
                        for (int i = 0; i < 4; ++i) { o0[i] = __logf(l0[i] + (1.f - l0[i]) * s0[i]); o1[i] = __logf(l1[i] + (1.f - l1[i]) * s1[i]); }
                        float* p = dst + (size_t)row * ld + bj * HALF; *(f32x4*)p = o0; *(f32x4*)(p + 4) = o1; } }
            return;
        }
        bf16_t* dst = (bf16_t*)(ws + base) + colb + cl;
#pragma unroll
        for (int ai = 0; ai < 2; ++ai)
#pragma unroll
            for (int m = 0; m < 4; ++m) { const int row = row0 + ai * HALF + m * 16;
#pragma unroll
                for (int bj = 0; bj < 2; ++bj) { f32x4 v0 = acc[ai][bj][m][0], v1 = acc[ai][bj][m][1];
                    if (kind == 1) { v0 = silu4(v0); v1 = silu4(v1); } else if (kind == 2) { v0 = sig4(v0); v1 = sig4(v1); }
                    *(u32x4*)(dst + (size_t)row * ld + bj * HALF) = pack8(v0, v1); } }
    }
};
struct EpiBf16Plain {
    static constexpr bool PERM = true, AFTER_DRAIN = false, HAS_MID = false, GATHER = false;
    bf16_t* O; int ld;
    __device__ __forceinline__ void mid(f32x4 (&)[2][2][4][2], const Unit&, int, int, int, int) const {}
    __device__ __forceinline__ void operator()(const f32x4 (&acc)[2][2][4][2], const Unit& u, int wr, int wc, int fr, int fq) const {
        const int row0 = u.pm * BM + wr * 64 + fr, col0 = u.pn * BM + wc * 32 + 8 * fq;
#pragma unroll
        for (int ai = 0; ai < 2; ++ai)
#pragma unroll
            for (int m = 0; m < 4; ++m)
#pragma unroll
                for (int bj = 0; bj < 2; ++bj) *(u32x4*)(O + (size_t)(row0 + ai * HALF + m * 16) * ld + col0 + bj * HALF) = pack8(acc[ai][bj][m][0], acc[ai][bj][m][1]);
    }
};
template <int PASS> struct EpiUp {
    static constexpr bool PERM = true, AFTER_DRAIN = false, HAS_MID = false, GATHER = false;
    const bf16_t* GT; bf16_t* O;
    __device__ __forceinline__ void mid(f32x4 (&)[2][2][4][2], const Unit&, int, int, int, int) const {}
    __device__ __forceinline__ void operator()(const f32x4 (&acc)[2][2][4][2], const Unit& u, int wr, int wc, int fr, int fq) const {
        const int row0 = u.pm * BM + wr * 64 + fr, col0 = u.pn * BM + wc * 32 + 8 * fq;
#pragma unroll
        for (int ai = 0; ai < 2; ++ai)
#pragma unroll
            for (int m = 0; m < 4; ++m) {
#pragma unroll
                for (int bj = 0; bj < 2; ++bj) { const size_t off = (size_t)(row0 + ai * HALF + m * 16) * D + col0 + bj * HALF; const u32x4 b = *(const u32x4*)(GT + off);
                    f32x4 v0 = acc[ai][bj][m][0], v1 = acc[ai][bj][m][1];
                    v0[0] *= bl(b.x); v0[1] *= bh(b.x); v0[2] *= bl(b.y); v0[3] *= bh(b.y); v1[0] *= bl(b.z); v1[1] *= bh(b.z); v1[2] *= bl(b.w); v1[3] *= bh(b.w);
                    if (PASS == 1) { const u32x4 p = *(const u32x4*)(O + off);
                        v0[0] += bl(p.x); v0[1] += bh(p.x); v0[2] += bl(p.y); v0[3] += bh(p.y); v1[0] += bl(p.z); v1[1] += bh(p.z); v1[2] += bl(p.w); v1[3] += bh(p.w); }
                    *(u32x4*)(O + off) = pack8(v0, v1); }
                asm volatile("" ::: "memory"); }
    }
};
struct EpiUp2 {
    static constexpr bool PERM = true, AFTER_DRAIN = false, HAS_MID = true, GATHER = false;
    const bf16_t* GA; const bf16_t* GB; bf16_t* O;
    __device__ __forceinline__ void mid(f32x4 (&acc)[2][2][4][2], const Unit& u, int wr, int wc, int fr_, int fq_) const {
        int fr = fr_, fq = fq_; asm volatile("" : "+v"(fr), "+v"(fq));
        const int row0 = u.pm * BM + wr * 64 + fr, col0 = u.pn * BM + wc * 32 + 8 * fq;
#pragma unroll
        for (int ai = 0; ai < 2; ++ai) {
#pragma unroll
            for (int m = 0; m < 4; ++m) {
#pragma unroll
                for (int bj = 0; bj < 2; ++bj) { const size_t off = (size_t)(row0 + ai * HALF + m * 16) * D + col0 + bj * HALF; const u32x4 a = *(const u32x4*)(GA + off), b = *(const u32x4*)(GB + off);
                    const float lo = 8.673617379884035e-19f;
                    acc[ai][bj][m][0][0] *= bl(a.x) * __builtin_amdgcn_rcpf(fmaxf(bl(b.x), lo)); acc[ai][bj][m][0][1] *= bh(a.x) * __builtin_amdgcn_rcpf(fmaxf(bh(b.x), lo));
                    acc[ai][bj][m][0][2] *= bl(a.y) * __builtin_amdgcn_rcpf(fmaxf(bl(b.y), lo)); acc[ai][bj][m][0][3] *= bh(a.y) * __builtin_amdgcn_rcpf(fmaxf(bh(b.y), lo));
                    acc[ai][bj][m][1][0] *= bl(a.z) * __builtin_amdgcn_rcpf(fmaxf(bl(b.z), lo)); acc[ai][bj][m][1][1] *= bh(a.z) * __builtin_amdgcn_rcpf(fmaxf(bh(b.z), lo));
                    acc[ai][bj][m][1][2] *= bl(a.w) * __builtin_amdgcn_rcpf(fmaxf(bl(b.w), lo)); acc[ai][bj][m][1][3] *= bh(a.w) * __builtin_amdgcn_rcpf(fmaxf(bh(b.w), lo)); }
                asm volatile("" ::: "memory"); } }
    }
    __device__ __forceinline__ void operator()(const f32x4 (&acc)[2][2][4][2], const Unit& u, int wr, int wc, int fr, int fq) const {
        const int row0 = u.pm * BM + wr * 64 + fr, col0 = u.pn * BM + wc * 32 + 8 * fq;
        const float lo = 8.673617379884035e-19f;
#pragma unroll
        for (int ai = 0; ai < 2; ++ai) {
            u32x4 gb[4][2];
#pragma unroll
            for (int m = 0; m < 4; ++m)
#pragma unroll
                for (int bj = 0; bj < 2; ++bj) gb[m][bj] = *(const u32x4*)(GB + (size_t)(row0 + ai * HALF + m * 16) * D + col0 + bj * HALF);
#pragma unroll
            for (int m = 0; m < 4; ++m)
#pragma unroll
                for (int bj = 0; bj < 2; ++bj) { const size_t off = (size_t)(row0 + ai * HALF + m * 16) * D + col0 + bj * HALF; const u32x4 b = gb[m][bj];
                    f32x4 v0 = acc[ai][bj][m][0], v1 = acc[ai][bj][m][1];
                    v0[0] *= fmaxf(bl(b.x), lo); v0[1] *= fmaxf(bh(b.x), lo); v0[2] *= fmaxf(bl(b.y), lo); v0[3] *= fmaxf(bh(b.y), lo); v1[0] *= fmaxf(bl(b.z), lo); v1[1] *= fmaxf(bh(b.z), lo); v1[2] *= fmaxf(bl(b.w), lo); v1[3] *= fmaxf(bh(b.w), lo);
                    *(u32x4*)(O + off) = pack8(v0, v1); }
            asm volatile("" ::: "memory"); }
    }
};
template <int MODE  > struct EpiResid {
    static constexpr bool PERM = false, AFTER_DRAIN = false, HAS_MID = false, GATHER = false;
    static constexpr int RG = (MODE == 0) ? 4 : 2;
    const float* base; float* out; const bf16_t* PP;
    __device__ __forceinline__ void mid(f32x4 (&)[2][2][4][2], const Unit&, int, int, int, int) const {}
    __device__ __forceinline__ void operator()(const f32x4 (&acc)[2][2][4][2], const Unit& u, int wr, int wc, int fr, int fq) const {
        const int row0 = u.pm * BM + wr * 64 + fr, col0 = u.pn * BM + wc * 32 + 4 * fq;
#pragma unroll
        for (int ai = 0; ai < 2; ++ai)
#pragma unroll
            for (int mp = 0; mp < 4 / RG; ++mp) {
                f32x4 bs[RG][2][2]; v2u pw[RG][2][2];
#pragma unroll
                for (int mm = 0; mm < RG; ++mm)
#pragma unroll
                    for (int bj = 0; bj < 2; ++bj)
#pragma unroll
                        for (int n = 0; n < 2; ++n) { const size_t off = (size_t)(row0 + ai * HALF + (RG * mp + mm) * 16) * D + col0 + bj * HALF + n * 16; bs[mm][bj][n] = *(const f32x4*)(base + off);
                            if (MODE == 1) pw[mm][bj][n] = *(const v2u*)(PP + off); }
#pragma unroll
                for (int mm = 0; mm < RG; ++mm)
#pragma unroll
                    for (int bj = 0; bj < 2; ++bj)
#pragma unroll
                        for (int n = 0; n < 2; ++n) { const size_t off = (size_t)(row0 + ai * HALF + (RG * mp + mm) * 16) * D + col0 + bj * HALF + n * 16; f32x4 v = acc[ai][bj][RG * mp + mm][n];
                            if (MODE == 1) { const unsigned p0 = pw[mm][bj][n].x, p1 = pw[mm][bj][n].y; v = sig4(v); v[0] *= bl(p0); v[1] *= bh(p0); v[2] *= bl(p1); v[3] *= bh(p1); }
                            *(f32x4*)(out + off) = bs[mm][bj][n] + v; }
                asm volatile("" ::: "memory"); }
    }
};
template <int MODE  > struct EpiResidB {
    static constexpr bool PERM = true, AFTER_DRAIN = false, HAS_MID = false, GATHER = false;
    const float* basef; const bf16_t* XR; const bf16_t* PP; bf16_t* XO;
    __device__ __forceinline__ void mid(f32x4 (&)[2][2][4][2], const Unit&, int, int, int, int) const {}
    __device__ __forceinline__ void operator()(const f32x4 (&acc)[2][2][4][2], const Unit& u, int wr, int wc, int fr, int fq) const {
        const int row0 = u.pm * BM + wr * 64 + fr, col0 = u.pn * BM + wc * 32 + 8 * fq;
#pragma unroll
        for (int ai = 0; ai < 2; ++ai) {
            if (MODE == 0) {
                f32x4 b0[4][2], b1[4][2];
#pragma unroll
                for (int m = 0; m < 4; ++m)
#pragma unroll
                    for (int bj = 0; bj < 2; ++bj) { const float* p = basef + (size_t)(row0 + ai * HALF + m * 16) * D + col0 + bj * HALF; b0[m][bj] = *(const f32x4*)p; b1[m][bj] = *(const f32x4*)(p + 4); }
#pragma unroll
                for (int m = 0; m < 4; ++m)
#pragma unroll
                    for (int bj = 0; bj < 2; ++bj) *(u32x4*)(XO + (size_t)(row0 + ai * HALF + m * 16) * D + col0 + bj * HALF) = pack8(b0[m][bj] + acc[ai][bj][m][0], b1[m][bj] + acc[ai][bj][m][1]);
            } else {
                u32x4 xb[4][2], pb[4][2]; float rn[4];
#pragma unroll
                for (int m = 0; m < 4; ++m) rn[m] = basef[row0 + ai * HALF + m * 16];
#pragma unroll
                for (int m = 0; m < 4; ++m)
#pragma unroll
                    for (int bj = 0; bj < 2; ++bj) { const size_t off = (size_t)(row0 + ai * HALF + m * 16) * D + col0 + bj * HALF; xb[m][bj] = *(const u32x4*)(XR + off); pb[m][bj] = *(const u32x4*)(PP + off); }
#pragma unroll
                for (int m = 0; m < 4; ++m)
#pragma unroll
                    for (int bj = 0; bj < 2; ++bj) { const u32x4 xv = xb[m][bj], pv = pb[m][bj]; f32x4 v0 = sig4(acc[ai][bj][m][0] * rn[m]), v1 = sig4(acc[ai][bj][m][1] * rn[m]);
                        v0[0] = bl(xv.x) + v0[0] * bl(pv.x); v0[1] = bh(xv.x) + v0[1] * bh(pv.x); v0[2] = bl(xv.y) + v0[2] * bl(pv.y); v0[3] = bh(xv.y) + v0[3] * bh(pv.y);
                        v1[0] = bl(xv.z) + v1[0] * bl(pv.z); v1[1] = bh(xv.z) + v1[1] * bh(pv.z); v1[2] = bl(xv.w) + v1[2] * bl(pv.w); v1[3] = bh(xv.w) + v1[3] * bh(pv.w);
                        *(u32x4*)(XO + (size_t)(row0 + ai * HALF + m * 16) * D + col0 + bj * HALF) = pack8(v0, v1); }
            }
            asm volatile("" ::: "memory"); }
    }
};
struct EpiMoe1 {
    static constexpr bool PERM = true, AFTER_DRAIN = false, HAS_MID = false, GATHER = true;
    bf16_t* H; const float* RG; const int* src;
    __device__ __forceinline__ void mid(f32x4 (&)[2][2][4][2], const Unit&, int, int, int, int) const {}
    __device__ __forceinline__ void operator()(const f32x4 (&acc)[2][2][4][2], const Unit& u, int wr, int wc, int fr, int fq) const {
        const int row0 = u.pm * BM + wr * 64 + fr, col0 = (u.pn & 3) * 128 + wc * 32 + 8 * fq;
        float rg[2][4];
#pragma unroll
        for (int ai = 0; ai < 2; ++ai)
#pragma unroll
            for (int m = 0; m < 4; ++m) rg[ai][m] = RG[row0 + ai * HALF + m * 16];
#pragma unroll
        for (int ai = 0; ai < 2; ++ai)
#pragma unroll
            for (int m = 0; m < 4; ++m) { const float r = rg[ai][m]; const f32x4 g0 = silu4(acc[ai][0][m][0] * r), g1 = silu4(acc[ai][0][m][1] * r);
                *(u32x4*)(H + (size_t)(row0 + ai * HALF + m * 16) * DE + col0) = pack8(g0 * (acc[ai][1][m][0] * r), g1 * (acc[ai][1][m][1] * r)); }
    }
};
struct EpiMoe2 {
    static constexpr bool PERM = true, AFTER_DRAIN = false, HAS_MID = false, GATHER = false;
    bf16_t* Y; const int* rowslot; const PG8_LAS int* pstart;
    __device__ __forceinline__ void mid(f32x4 (&)[2][2][4][2], const Unit&, int, int, int, int) const {}
    __device__ __forceinline__ void operator()(const f32x4 (&acc)[2][2][4][2], const Unit& u, int wr, int wc, int fr, int fq) const {
        const int row0 = u.pm * BM + wr * 64 + fr, col0 = (u.pn & 7) * 256 + wc * 32 + 8 * fq;
        const int e = u.pn >> 3, ps = pstart[e], pc = pstart[40 + e];
        int slot[2][4];
#pragma unroll
        for (int ai = 0; ai < 2; ++ai)
#pragma unroll
            for (int m = 0; m < 4; ++m) { const int prow = row0 + ai * HALF + m * 16; slot[ai][m] = (prow - ps < pc) ? __hip_atomic_load((int*)rowslot + prow, RLX_AGENT) : -1; }
#pragma unroll
        for (int ai = 0; ai < 2; ++ai)
#pragma unroll
            for (int m = 0; m < 4; ++m) if (slot[ai][m] >= 0) {
#pragma unroll
                for (int bj = 0; bj < 2; ++bj) *(u32x4*)(Y + (size_t)slot[ai][m] * D + col0 + bj * HALF) = pack8(acc[ai][bj][m][0], acc[ai][bj][m][1]); }
    }
};

template <class Epi, class Sched, bool ALIGN_EPI = false, bool SP2 = false>
__device__ __forceinline__ void gemm_phase(PG8_LAS unsigned char* lds, const Gemm g, const Sched& S, const Epi& E) {
    const int tid = threadIdx.x, wid = __builtin_amdgcn_readfirstlane(tid >> 6), lane = tid & 63, wr = wid >> 2, wc = wid & 3, fr = lane & 15, fq = lane >> 4;
    const int K = g.K, nt = K / BK;
    unsigned voffA[2], voffB[2];
#pragma unroll
    for (int i = 0; i < 2; ++i) { int R, C; stage_rc(tid * 16 + i * 8192, R, C); const int Rb = Epi::PERM ? ((R & ~31) + perm32(R & 31)) : R;
        voffA[i] = (unsigned)(R * g.lda + C) * 2u; voffB[i] = (unsigned)(Rb * g.ldb + C) * 2u; }
    const size_t kstep = (size_t)(BK * 2);
    const size_t hstepA = (size_t)HALF * g.lda * 2, hstepB = (size_t)HALF * g.ldb * 2;
    const size_t tstepA = 2 * hstepA, tstepB = 2 * hstepB;
    const unsigned ldsw = (unsigned)wid * 1024u;
    static_assert(!Epi::GATHER || SP2, "gathered A rows are implemented for the SP2 loop only");
    unsigned gA[2][2], gN[2][2];
    auto gather_offs = [&](const Unit& u, unsigned (&o)[2][2]) {
        if constexpr (Epi::GATHER) {
#pragma unroll
            for (int h = 0; h < 2; ++h)
#pragma unroll
                for (int i = 0; i < 2; ++i) { int R, C; stage_rc(tid * 16 + i * 8192, R, C); const unsigned tok = (unsigned)E.src[u.pm * BM + h * HALF + R] & 8191u; o[h][i] = (tok * (unsigned)g.lda + (unsigned)C) * 2u; }
        } else { (void)u; (void)o; } };
    auto stageA = [&](int bufoff, const char* base, int h, bool nx) {
        if constexpr (Epi::GATHER) {
#pragma unroll
            for (int i = 0; i < 2; ++i) { const unsigned vo = nx ? gN[h][i] : gA[h][i];
                __builtin_amdgcn_global_load_lds((const unsigned*)(base + vo), (PG8_LAS unsigned*)(lds + bufoff + ldsw + i * 8192), 16, 0, 0); }
        } else {
#pragma unroll
            for (int i = 0; i < 2; ++i) __builtin_amdgcn_global_load_lds((const unsigned*)(base + (size_t)h * hstepA + voffA[i]), (PG8_LAS unsigned*)(lds + bufoff + ldsw + i * 8192), 16, 0, 0);
            (void)nx; } };
    const size_t tstepAe = Epi::GATHER ? (size_t)0 : tstepA;
    const int aoff = lds_byte(wr * 64 + fr, fq * 8), boff = lds_byte(wc * 32 + fr, fq * 8);
#define PG8_SA(b, h) (((b) * 2 + (h)) * HTB)
#define PG8_SB(b, h) ((4 + (b) * 2 + (h)) * HTB)
#define PG8_STAGE(bufoff, gbase, voff) do { _Pragma("unroll") for (int _i = 0; _i < 2; ++_i) \
        __builtin_amdgcn_global_load_lds((const unsigned*)((const char*)(gbase) + (voff)[_i]), (PG8_LAS unsigned*)(lds + (bufoff) + ldsw + _i * 8192), 16, 0, 0); } while (0)
#define PG8_LDA(dst, b, h) do { _Pragma("unroll") for (int m = 0; m < 4; ++m) _Pragma("unroll") for (int k = 0; k < 2; ++k) dst[m][k] = *(const PG8_LAS bf16x8*)(lds + PG8_SA(b, h) + aoff + m * 2048 + k * 1024); } while (0)
#define PG8_LDB(dst, b, h) do { _Pragma("unroll") for (int n = 0; n < 2; ++n) _Pragma("unroll") for (int k = 0; k < 2; ++k) dst[n][k] = *(const PG8_LAS bf16x8*)(lds + PG8_SB(b, h) + boff + n * 2048 + k * 1024); } while (0)
#define PG8_MMA(ai, bj, At, Bt) do { __builtin_amdgcn_s_setprio(1); _Pragma("unroll") for (int m = 0; m < 4; ++m) _Pragma("unroll") for (int n = 0; n < 2; ++n) _Pragma("unroll") for (int k = 0; k < 2; ++k) \
        acc[ai][bj][m][n] = __builtin_amdgcn_mfma_f32_16x16x32_bf16(Bt[n][k], At[m][k], acc[ai][bj][m][n], 0, 0, 0); __builtin_amdgcn_s_setprio(0); } while (0)
#define PG8_WAIT_V(n) asm volatile("s_waitcnt vmcnt(" #n ")" ::: "memory")
#define PG8_WAIT_L(n) asm volatile("s_waitcnt lgkmcnt(" #n ")" ::: "memory")
#define PG8_BAR __builtin_amdgcn_s_barrier()
#define PG8_SCHED __builtin_amdgcn_sched_barrier(0)
    Unit cur, nxt; int ui = 0;
    if (!S.next(0, cur)) return;
    f32x4 acc[2][2][4][2];
#pragma unroll
    for (int a = 0; a < 2; ++a)
#pragma unroll
        for (int b = 0; b < 2; ++b)
#pragma unroll
            for (int m = 0; m < 4; ++m)
#pragma unroll
                for (int n = 0; n < 2; ++n) acc[a][b][m][n] = (f32x4){0.f, 0.f, 0.f, 0.f};
    bf16x8 At[4][2], B0[2][2], B1[2][2];
    const char* cA = (const char*)g.A + (size_t)cur.pm * tstepAe; const char* cB = (const char*)g.Bt + (size_t)cur.pn * tstepB;
    S.a_ready(cur);
    gather_offs(cur, gA);
    if constexpr (SP2) {
        PG8_STAGE(PG8_SB(0, 0), cB, voffB); PG8_STAGE(PG8_SB(0, 1), cB + hstepB, voffB); stageA(PG8_SA(0, 0), cA, 0, false); stageA(PG8_SA(0, 1), cA, 1, false);
        if (wr == 1) PG8_BAR;
        PG8_WAIT_V(2); PG8_BAR;
        PG8_STAGE(PG8_SB(1, 0), cB + kstep, voffB); stageA(PG8_SA(1, 0), cA + kstep, 0, false); PG8_STAGE(PG8_SB(1, 1), cB + hstepB + kstep, voffB);
        PG8_WAIT_V(6); PG8_BAR;
    } else {
        PG8_STAGE(PG8_SB(0, 0), cB, voffB); PG8_STAGE(PG8_SA(0, 0), cA, voffA); PG8_STAGE(PG8_SB(0, 1), cB + hstepB, voffB); PG8_STAGE(PG8_SA(0, 1), cA + hstepA, voffA);
        if (wr == 1) PG8_BAR;
        PG8_WAIT_V(4); PG8_BAR;
        PG8_STAGE(PG8_SB(1, 0), cB + kstep, voffB); PG8_STAGE(PG8_SA(1, 0), cA + kstep, voffA); PG8_STAGE(PG8_SB(1, 1), cB + hstepB + kstep, voffB);
        PG8_WAIT_V(6); PG8_BAR;
    }
    for (;;) {
        const bool has_next = S.next(ui + 1, nxt);
        if constexpr (Epi::GATHER) { if (has_next) gather_offs(nxt, gN); else {
#pragma unroll
            for (int h = 0; h < 2; ++h)
#pragma unroll
                for (int i = 0; i < 2; ++i) gN[h][i] = gA[h][i]; } }
        const char* nA = has_next ? (const char*)g.A + (size_t)nxt.pm * tstepAe : cA; const char* nB = has_next ? (const char*)g.Bt + (size_t)nxt.pn * tstepB : cB;
        for (int t = 0; t < nt; t += 2) {
            const bool last = (t == nt - 2);
            if constexpr (Epi::HAS_MID) { if (t == (nt >> 1)) E.mid(acc, cur, wr, wc, fr, fq); }
            const char* a1 = cA + (size_t)(t + 1) * kstep;
            const char* a2 = last ? nA : cA + (size_t)(t + 2) * kstep; const char* b2 = last ? nB : cB + (size_t)(t + 2) * kstep;
            const char* a3 = a2 + kstep; const char* b3 = b2 + kstep;
            if (last && has_next) S.a_ready(nxt);
            if constexpr (SP2) {
            PG8_LDB(B0, 0, 0); PG8_LDB(B1, 0, 1); PG8_SCHED; PG8_LDA(At, 0, 0); stageA(PG8_SA(1, 1), a1, 1, false);
            PG8_WAIT_V(8); PG8_WAIT_L(0); PG8_BAR; PG8_MMA(0, 0, At, B0); PG8_MMA(0, 1, At, B1); PG8_BAR; PG8_SCHED;
            PG8_LDA(At, 0, 1); PG8_STAGE(PG8_SB(0, 0), b2, voffB); PG8_STAGE(PG8_SB(0, 1), b2 + hstepB, voffB); stageA(PG8_SA(0, 0), a2, 0, last);
            PG8_WAIT_V(8); PG8_WAIT_L(0); PG8_BAR; PG8_MMA(1, 0, At, B0); PG8_MMA(1, 1, At, B1); PG8_BAR; PG8_SCHED;
            PG8_LDB(B0, 1, 0); PG8_LDB(B1, 1, 1); PG8_SCHED; PG8_LDA(At, 1, 0); stageA(PG8_SA(0, 1), a2, 1, last);
            PG8_WAIT_V(8); PG8_WAIT_L(0); PG8_BAR; PG8_MMA(0, 0, At, B0); PG8_MMA(0, 1, At, B1); PG8_BAR; PG8_SCHED;
            PG8_LDA(At, 1, 1); PG8_STAGE(PG8_SB(1, 0), b3, voffB); PG8_STAGE(PG8_SB(1, 1), b3 + hstepB, voffB); stageA(PG8_SA(1, 0), a3, 0, last);
            PG8_WAIT_V(8); PG8_WAIT_L(0); PG8_BAR; PG8_MMA(1, 0, At, B0); PG8_MMA(1, 1, At, B1); PG8_BAR; PG8_SCHED;
            } else {
            PG8_LDB(B0, 0, 0); PG8_SCHED; PG8_LDA(At, 0, 0); PG8_STAGE(PG8_SA(1, 1), a1 + hstepA, voffA);
            PG8_WAIT_L(8); PG8_BAR; PG8_WAIT_L(0); PG8_MMA(0, 0, At, B0); PG8_BAR; PG8_SCHED;
            PG8_LDB(B1, 0, 1); PG8_STAGE(PG8_SB(0, 0), b2, voffB);
            PG8_BAR; PG8_WAIT_L(0); PG8_MMA(0, 1, At, B1); PG8_BAR;
            PG8_LDA(At, 0, 1); PG8_STAGE(PG8_SA(0, 0), a2, voffA);
            PG8_BAR; PG8_WAIT_L(0); PG8_MMA(1, 0, At, B0); PG8_BAR; PG8_SCHED;
            PG8_STAGE(PG8_SB(0, 1), b2 + hstepB, voffB);
            PG8_WAIT_V(6); PG8_BAR; PG8_MMA(1, 1, At, B1); PG8_BAR;
            PG8_LDB(B0, 1, 0); PG8_SCHED; PG8_LDA(At, 1, 0); PG8_STAGE(PG8_SA(0, 1), a2 + hstepA, voffA);
            PG8_WAIT_L(8); PG8_BAR; PG8_WAIT_L(0); PG8_MMA(0, 0, At, B0); PG8_BAR; PG8_SCHED;
            PG8_LDB(B1, 1, 1); PG8_STAGE(PG8_SB(1, 0), b3, voffB);
            PG8_BAR; PG8_WAIT_L(0); PG8_MMA(0, 1, At, B1); PG8_BAR;
            PG8_LDA(At, 1, 1); PG8_STAGE(PG8_SA(1, 0), a3, voffA);
            PG8_BAR; PG8_WAIT_L(0); PG8_MMA(1, 0, At, B0); PG8_BAR; PG8_SCHED;
            PG8_STAGE(PG8_SB(1, 1), b3 + hstepB, voffB);
            PG8_WAIT_V(6); PG8_BAR; PG8_MMA(1, 1, At, B1); PG8_BAR;
            }
        }
        if constexpr (ALIGN_EPI) { if (wr == 0) PG8_BAR; }
        if constexpr (!Epi::AFTER_DRAIN) { E(acc, cur, wr, wc, fr, fq); S.done(cur); }
        if (!has_next) break;
#pragma unroll
        for (int a = 0; a < 2; ++a)
#pragma unroll
            for (int b = 0; b < 2; ++b)
#pragma unroll
                for (int m = 0; m < 4; ++m)
#pragma unroll
                    for (int n = 0; n < 2; ++n) acc[a][b][m][n] = (f32x4){0.f, 0.f, 0.f, 0.f};
        cur = nxt; cA = nA; cB = nB; ++ui;
        if constexpr (Epi::GATHER) {
#pragma unroll
            for (int h = 0; h < 2; ++h)
#pragma unroll
                for (int i = 0; i < 2; ++i) gA[h][i] = gN[h][i]; }
        if constexpr (ALIGN_EPI) { if (wr == 1) PG8_BAR; }
    }
    PG8_WAIT_V(0);
    if constexpr (!ALIGN_EPI) { if (wr == 0) PG8_BAR; }
    PG8_BAR;
    if constexpr (Epi::AFTER_DRAIN) { E.fused(acc, cur, wr, wc, fr, fq, lds, wid, lane); S.done(cur); }
#undef PG8_SA
#undef PG8_SB
#undef PG8_STAGE
#undef PG8_LDA
#undef PG8_LDB
#undef PG8_MMA
#undef PG8_WAIT_V
#undef PG8_WAIT_L
#undef PG8_BAR
#undef PG8_SCHED
}

}
#define PG8_SP2 true
#define PG8_ALIGN true

__global__ void __launch_bounds__(NTHR, 2) fwd(Args args) {
    extern __shared__ __attribute__((aligned(16))) unsigned char lds[];
    Frame F;
    F.lds = (LAS unsigned char*)lds;
    F.MISC = (volatile LAS unsigned*)(F.lds + MISC_OFF);
    F.tid = 0; F.lane = 0; F.wave = __builtin_amdgcn_readfirstlane(threadIdx.x >> 6);
    F.G = gridDim.x; { const int bx = blockIdx.x; F.vcu = (F.G % 8 == 0) ? (bx % 8) * (F.G / 8) + bx / 8 : bx; }
    unsigned char* ws = args.ws; F.ws = ws;
    F.ctl = (gu32*)(ws + WS_CTL);
    for (int u = threadIdx.x; u < (LDS_BYTES - LDSCTL_OFF) / 4; u += NTHR) ((LAS unsigned*)(F.lds + LDSCTL_OFF))[u] = 0u;
    __syncthreads();
    XcdBarrier bar = xcd_barrier_post((unsigned*)(F.ctl + CW_BAR) + args.li * XCD_BAR_WORDS, F.MISC + 8);
    const int lo = args.ph_lo, hi = args.ph_hi;
#define IN(k) (lo <= (k) && (k) < hi)
#define SEAM(k) do { if (IN(k) && IN((k) + 1)) xcd_barrier(bar); } while (0)
    const int wave = F.wave;
    const int gw = F.vcu * NWAVES + wave, NGW = F.G * NWAVES;
    const int NGT = F.G * NTHR;
#define TVARS const int tid = opaque_tid(); const int lane = tid & 63; const int gt = blockIdx.x * NTHR + tid; (void)lane; (void)gt;
    LAS float* As = (LAS float*)F.lds; LAS float* Bs = As + 16 * 132;
    const float* x = args.in[I_X];
    float* out = args.out;

    if (IN(0)) {
        TVARS
        for (int m = gw; m < T; m += NGW) rms_row_to_bf16(lane, x + (size_t)m * D, args.in[I_NMIX], (bf16*)(ws + WS_H1) + (size_t)m * D);
        { const f32x4* p4 = (const f32x4*)args.in[I_P]; v2u* o = (v2u*)(ws + WS_PB);
          for (int i = gt; i < T * PLE / 4; i += NGT) { const f32x4 v = p4[i]; v2u w; w.x = pk2(v.x, v.y); w.y = pk2(v.z, v.w); o[i] = w; } }
        { f32x2* tr = (f32x2*)(ws + WS_TRIG);
          for (int i = gt; i < T * 64; i += NGT) { const int pos = i >> 6, j = i & 63; double r = (double)pos * args.rfreq[j]; r -= floor(r); if (r > 0.5) r -= 1.0;
              const float rf = (float)r; f32x2 cs; cs.x = __builtin_amdgcn_cosf(rf); cs.y = __builtin_amdgcn_sinf(rf); tr[i] = cs; } }
        { float* lb = (float*)(ws + WS_LB); const float* raw = args.in[I_LBRAW];
          for (int c = gt; c < HW; c += NGT) lb[c] = 1.0f / (1.0f + expf(raw[HW + c] - raw[c])); }
        { float* wrt = (float*)(ws + WS_WRT); const float* wg = args.in[I_WRG]; const float* we = args.in[I_WRE];
          for (int i = gt; i < 36 * D; i += NGT) { const int c = i / D, k = i % D; wrt[i] = args.in[I_NFFN][k] * ((c < 4) ? wg[k * 4 + c] : we[k * NE + (c - 4)]); } }
        { LAS float* scr = (LAS float*)(F.lds + wave * 16384);
          constexpr int I_IN = 32 * 352, I_UH = 16 * 64, I_UM = 16 * 64, I_O = 32 * 64, I_G = 32 * 64, I_PP = 4 * 64;
          for (int it = gw; it < I_IN + I_PP; it += NGW) { int r = it;
              if (r < I_IN) { const int kb = r / 352, nb = r % 352; transpose_item(args.in[I_WIN], INC, kb * 64, phys2log_inproj(nb * 32), (bf16*)(ws + WS_WIN_T), D, nb * 32, kb * 64, scr, lane); continue; } r -= I_IN;
              { const int kb = r / 64, nb = r % 64; transpose_item(args.in[I_WPP], D, kb * 64, nb * 32, (bf16*)(ws + WS_WPP_T), PLE, nb * 32, kb * 64, scr, lane); } } }
    }
    SEAM(0);

    if (IN(1) && FP1) {
        { pg8::Gemm g{(const bf16*)(ws + WS_H1), (const bf16*)(ws + WS_WIN_T), D, D, D}; pg8::StaticOrder S; S.init(T, INC, F.G, (int)blockIdx.x); pg8::EpiInProj E{ws};
          pg8::gemm_phase<pg8::EpiInProj, pg8::StaticOrder, PG8_ALIGN, PG8_SP2>(F.lds, g, S, E); }
        {
            const int nbusy = ((T / 256) * (INC / 256)) % F.G, c = (int)blockIdx.x;
            if (nbusy == 0 || c >= nbusy) { const int nh = nbusy == 0 ? F.G : F.G - nbusy, hr = nbusy == 0 ? c : c - nbusy;
                { pg8::Gemm g2{(const bf16*)(ws + WS_PB), (const bf16*)(ws + WS_WPP_T), PLE, PLE, PLE}; pg8::StaticOrder S2; S2.init(T, D, nh, hr); pg8::EpiBf16Plain E2{(bf16*)(ws + WS_PP), D};
                  pg8::gemm_phase<pg8::EpiBf16Plain, pg8::StaticOrder, PG8_ALIGN, PG8_SP2>(F.lds, g2, S2, E2); }
                __syncthreads();
                { TVARS
                  LAS float* scr = (LAS float*)(F.lds + wave * 16384);
                  constexpr int I_UH = 16 * 64, I_UM = 16 * 64, I_O = 32 * 64, I_G = 32 * 64;
                  auto item1 = [&](int it) -> TrItem { TrItem q; int r = it; q.ldw = D; q.ldt = D; q.gk = nullptr;
                      if (r < I_UH) { const int kb = r / 64, nb = r % 64; q.src = args.in[I_WUH] + (size_t)(kb * 64) * D + nb * 32; q.dst = (bf16*)(ws + WS_WUP_T) + (size_t)(nb * 32) * D + kb * 64; return q; } r -= I_UH;
                      if (r < I_UM) { const int kb = r / 64, nb = r % 64; q.src = args.in[I_WUM] + (size_t)(kb * 64) * D + nb * 32; q.dst = (bf16*)(ws + WS_WUP_T) + (size_t)(nb * 32) * D + HW + kb * 64; return q; } r -= I_UM;
                      if (r < I_O) { const int kb = r / 64, nb = r % 64; q.src = args.in[I_WOUT] + (size_t)(kb * 64) * D + nb * 32; q.dst = (bf16*)(ws + WS_WOUT_T) + (size_t)(nb * 32) * D + kb * 64; return q; } r -= I_O;
                      { const int kb = r / 64, nb = r % 64; q.src = args.in[I_WPG] + (size_t)(kb * 64) * D + nb * 32; q.dst = (bf16*)(ws + WS_WPG_T) + (size_t)(nb * 32) * D + kb * 64; q.gk = args.in[I_NPLE] + kb * 64; return q; } };
                  TR_PIPE(hr * NWAVES + wave, I_UH + I_UM + I_O + I_G, nh * NWAVES, item1); }
            }
        }
    }
    if (IN(1) && !FP1) {
        TVARS
        const bf16* H1 = (const bf16*)(ws + WS_H1);
        constexpr int NT1 = (T / 128) * (INC / 128), NT2 = (T / 128) * (D / 128);
        for (int it = F.vcu; it < NT1 + NT2; it += F.G) {
            float acc[8][4]; zero_acc(acc);
            const int tx = tid & 31, ty = tid >> 5;
            if (it < NT1) {
                const int tm = it / (INC / 128), tn = it % (INC / 128);
                sgemm_acc(acc, As, Bs, H1, D, tm * 128, args.in[I_WIN], INC, tn * 128, D, tid);
#pragma unroll
                for (int i = 0; i < 8; ++i) inproj_epi(ws, tm * 128 + ty * 8 + i, tn * 128 + tx * 4, acc[i]);
            } else {
                const int r = it - NT1, tm = r / (D / 128), tn = r % (D / 128);
                sgemm_acc(acc, As, Bs, (const bf16*)(ws + WS_PB), PLE, tm * 128, args.in[I_WPP], D, tn * 128, PLE, tid);
#pragma unroll
                for (int i = 0; i < 8; ++i) st_bf16x4((bf16*)(ws + WS_PP) + (size_t)(tm * 128 + ty * 8 + i) * D + tn * 128 + tx * 4, acc[i][0], acc[i][1], acc[i][2], acc[i][3]);
            }
        }
    }
    SEAM(1);

    if (IN(2) && (FHG || FMB)) {
        TVARS
        if (FHG) for (int it = F.vcu; it < 128 * NH; it += F.G) hgrn_pass_a(ws, F.lds, it, tid);
        __syncthreads();
        if (FMB) for (int it = F.vcu; it < NH * NB; it += F.G) if ((it & 31) > 0) moba_gate_lists(ws, F.ctl, F.lds, it >> 5, it & 31, tid);
    }
    if (IN(2) && !FP1) {
        TVARS
        const float* raw = (const float*)(ws + WS_TMPF); const f32x2* tr = (const f32x2*)(ws + WS_TRIG);
        for (int i = gt; i < T * 16 * 64; i += NGT) {
            const int j = i & 63, hh = (i >> 6) & 15, t = i >> 10;
            const float x1 = raw[(size_t)t * D + hh * 128 + j], x2 = raw[(size_t)t * D + hh * 128 + 64 + j];
            const f32x2 cs = tr[t * 64 + j];
            bf16* dst = (hh < 8) ? (bf16*)(ws + WS_MQ) + (size_t)t * HW + hh * 128 : (bf16*)(ws + WS_MK) + (size_t)t * HW + (hh - 8) * 128;
            dst[j] = (bf16)f2bf(x1 * cs.x - x2 * cs.y); dst[64 + j] = (bf16)f2bf(x2 * cs.x + x1 * cs.y);
        }
    }
    SEAM(2);
    if (IN(3) && (FHG || FMB)) {
        TVARS
        {
            const bf16* DSb = (const bf16*)(ws + WS_DS); const float* DEC = (const float*)(ws + WS_DEC); bf16* STb = (bf16*)(ws + WS_ST);
            constexpr int SCN = 4;
            if (FHG) for (int e0 = (F.vcu * NTHR * SCN) + tid; e0 < NH * HD * HD; e0 += F.G * NTHR * SCN) {
                float S[SCN]; const bf16* ds[SCN]; const float* dec[SCN]; bf16* st[SCN];
#pragma unroll
                for (int i = 0; i < SCN; ++i) { const int e = e0 + i * NTHR, h = e >> 14, rem = e & 16383, k = e & 127; S[i] = 0.f; ds[i] = DSb + h * 16384 + rem; dec[i] = DEC + h * HD + k; st[i] = STb + h * 16384 + rem; }
                for (int c0 = 0; c0 < 128; c0 += 4) {
                    float dv[4][SCN], gv[4][SCN];
#pragma unroll
                    for (int cc = 0; cc < 4; ++cc)
#pragma unroll
                        for (int i = 0; i < SCN; ++i) { dv[cc][i] = bf2f(ds[i][(size_t)(c0 + cc) * 131072]); gv[cc][i] = dec[i][(c0 + cc) * 1024]; }
#pragma unroll
                    for (int cc = 0; cc < 4; ++cc)
#pragma unroll
                        for (int i = 0; i < SCN; ++i) { st[i][(size_t)(c0 + cc) * 131072] = (bf16)f2bf(S[i]); S[i] = gv[cc][i] * S[i] + dv[cc][i]; } } }
        }
        if (FMB) {
            LAS int* ust = (LAS int*)(F.lds + LDSCTL_OFF + 1024); LAS int* cn = ust + 260; volatile LAS int* cur_w = (volatile LAS int*)(ust + 520);
            __syncthreads();
            if (tid < NH * NB) cn[tid] = (int)__hip_atomic_load((unsigned*)(F.ctl + CW_MCNT) + tid, RLX_AGENT);
            __syncthreads();
            if (tid == 0) { int a = 0; for (int i = 0; i < NH * NB; ++i) { ust[i] = a; a += (cn[i] + MB_RCH - 1) / MB_RCH; } ust[NH * NB] = a; }
            __syncthreads();
            const int nch = ust[NH * NB], total = nch + NH * NB;
            for (;;) {
                if (tid == 0) *cur_w = (int)__hip_atomic_fetch_add((unsigned*)(F.ctl + 8), 1u, RLX_AGENT);
                __syncthreads();
                const int w = *cur_w;
                __syncthreads();
                if (w >= total) break;
                int idx, n; bool causal; const unsigned short* gl = (const unsigned short*)(ws + WS_GL);
                if (w < nch) { int lo2 = 0, hi2 = NH * NB - 1;
                    while (lo2 < hi2) { const int mid = (lo2 + hi2 + 1) >> 1; if (ust[mid] <= w) lo2 = mid; else hi2 = mid - 1; }
                    idx = lo2; const int r0 = (w - ust[idx]) * MB_RCH; n = cn[idx] - r0; n = n > MB_RCH ? MB_RCH : n; gl += (size_t)idx * 8192 + r0; causal = false; }
                else { idx = w - nch; n = 256; causal = true; }
                idx = __builtin_amdgcn_readfirstlane(idx); n = __builtin_amdgcn_readfirstlane(n);
                moba_kv_item(ws, F.lds, idx >> 5, idx & 31, causal, gl, n, tid);
            }
        }
    }

    if (IN(3)) {
        TVARS
        if (!FP1) { const bf16* MK = (const bf16*)(ws + WS_MK); float* km = (float*)(ws + WS_KMEAN);
          for (int i = gt; i < NB * HW; i += NGT) { const int jb = i / HW, c = i % HW; float s = 0.f;
              for (int r = 0; r < BS; ++r) s += bf2f(MK[(size_t)(jb * BS + r) * HW + c]);
              km[i] = s; km[NB * HW + i] = 0.f; } }
        if (!FHG && wave == 0 && blockIdx.x < 16) {
            const int h = blockIdx.x >> 1, v = (blockIdx.x & 1) * 64 + lane;
            const float* GH = (const float*)(ws + WS_GH) + h * HD; const bf16* QH = (const bf16*)(ws + WS_QH) + h * HD; const bf16* VH = (const bf16*)(ws + WS_VH) + h * HD + v;
            float* ORAW = (float*)(ws + WS_TMPF) + h * HD + v;
            float S[HD];
#pragma unroll
            for (int k = 0; k < HD; ++k) S[k] = 0.f;
            for (int t = 0; t < T; ++t) {
                const float iv = bf2f(VH[(size_t)t * HW]); float o = 0.f;
                const float* g = GH + (size_t)t * HW; const bf16* q = QH + (size_t)t * HW;
#pragma unroll
                for (int k = 0; k < HD; ++k) { const float f = __expf(g[k]); S[k] = f * S[k] + (1.f - f) * iv; o += S[k] * bf2f(q[k]); }
                ORAW[(size_t)t * HW] = o;
            }
        }
    }
    SEAM(3);
    if (IN(4) && (FHG || FMB)) {
        TVARS
        const bool merge_first = (F.vcu & 1) != 0;
        auto passc4 = [&]() { if (FHG) for (int it = F.vcu; it < 128 * NH; it += F.G) hgrn_pass_c(ws, F.lds, args.in[I_HNG], it, tid); };
        if (!merge_first) passc4();
        if (false) for (int it0 = F.vcu; it0 < NH * NB; it0 += F.G) if ((it0 & 31) < 16) { const int it = it0 ^ 16;
            const int h = it >> 5, cur = it & 31; const bf16* PO = (const bf16*)(ws + WS_PO); const float* PL = (const float*)(ws + WS_PLSE); bf16* AUP = (bf16*)(ws + WS_AUP);
            for (int idx = tid; idx < BS * 16; idx += NTHR) { const int t = cur * BS + (idx >> 4), dq = idx & 15, th = t * NH + h;
                const float* plp = PL + (size_t)th * 128; float ls[4]; ls[0] = plp[0]; ls[1] = plp[32]; ls[2] = plp[64]; ls[3] = plp[96];
                bool ok[4]; float M = -3.0e38f;
#pragma unroll
                for (int i = 0; i < 4; ++i) { ok[i] = fabsf(ls[i]) < 1.0e4f && fabsf(ls[i]) > 1.0e-9f; if (ok[i]) M = fmaxf(M, ls[i]); }
                float wv[4], wsum = 0.f;
#pragma unroll
                for (int i = 0; i < 4; ++i) { wv[i] = ok[i] ? __expf(ls[i] - M) : 0.f; wsum += wv[i]; }
                const float inv = wsum > 0.f ? 1.0f / wsum : 0.f;
                float acc[8] = {0.f, 0.f, 0.f, 0.f, 0.f, 0.f, 0.f, 0.f};
#pragma unroll
                for (int i = 0; i < 4; ++i) { const v4u pw = *(const v4u*)(PO + ((size_t)th * 4 + i) * HD + dq * 8); const float wi = wv[i] * inv;
                    float pv[8] = {bflo(pw.x), bfhi(pw.x), bflo(pw.y), bfhi(pw.y), bflo(pw.z), bfhi(pw.z), bflo(pw.w), bfhi(pw.w)};
#pragma unroll
                    for (int q = 0; q < 8; ++q) { const float x = fabsf(pv[q]) < 1.0e4f ? pv[q] : 0.f; acc[q] += wi * x; } }
                v4u ov; ov.x = pk2(acc[0], acc[1]); ov.y = pk2(acc[2], acc[3]); ov.z = pk2(acc[4], acc[5]); ov.w = pk2(acc[6], acc[7]);
                *(v4u*)(AUP + (size_t)t * D + HW + h * HD + dq * 8) = ov; }
        }
        if (FMB) {
            const bf16* PO = (const bf16*)(ws + WS_PO); const float* PL = (const float*)(ws + WS_PLSE); bf16* AUP = (bf16*)(ws + WS_AUP);
            for (int idx0 = gt; idx0 < T * NH * 16; idx0 += 2 * NGT) {
                float ls[2][4]; v4u pw[2][4]; int nvv[2];
#pragma unroll
                for (int u = 0; u < 2; ++u) { int idx = idx0 + u * NGT; if (idx >= T * NH * 16) idx = idx0; const int th = idx >> 4, dq = idx & 15, cur = th >> 11; nvv[u] = cur < 3 ? cur : 3;
                    const f32x4 l4 = *(const f32x4*)(PL + (size_t)th * 4);
#pragma unroll
                    for (int i = 0; i < 4; ++i) { ls[u][i] = l4[i]; pw[u][i] = *(const v4u*)(PO + ((size_t)th * 4 + i) * HD + dq * 8); } }
#pragma unroll
                for (int u = 0; u < 2; ++u) { const int idx = idx0 + u * NGT; if (idx >= T * NH * 16) break; const int th = idx >> 4, dq = idx & 15, t = th >> 3, h = th & 7, nv = nvv[u];
                    float M = ls[u][0];
#pragma unroll
                    for (int i = 1; i < 4; ++i) if (i <= nv) M = fmaxf(M, ls[u][i]);
                    float wv[4]; wv[0] = __expf(ls[u][0] - M);
#pragma unroll
                    for (int i = 1; i < 4; ++i) wv[i] = (i <= nv) ? __expf(ls[u][i] - M) : 0.f;
                    const float inv = 1.0f / ((wv[0] + wv[1]) + (wv[2] + wv[3]));
                    float acc[8] = {0.f, 0.f, 0.f, 0.f, 0.f, 0.f, 0.f, 0.f};
#pragma unroll
                    for (int i = 0; i < 4; ++i) { v4u p = pw[u][i]; if (i > nv) { p.x = 0u; p.y = 0u; p.z = 0u; p.w = 0u; } const float wi = wv[i] * inv;
                        acc[0] += wi * bflo(p.x); acc[1] += wi * bfhi(p.x); acc[2] += wi * bflo(p.y); acc[3] += wi * bfhi(p.y); acc[4] += wi * bflo(p.z); acc[5] += wi * bfhi(p.z); acc[6] += wi * bflo(p.w); acc[7] += wi * bfhi(p.w); }
                    v4u ov; ov.x = pk2(acc[0], acc[1]); ov.y = pk2(acc[2], acc[3]); ov.z = pk2(acc[4], acc[5]); ov.w = pk2(acc[6], acc[7]);
                    *(v4u*)(AUP + (size_t)t * D + HW + h * HD + dq * 8) = ov; } }
        }
        if (merge_first) passc4();
    }

    if (IN(4)) {
        TVARS
        bf16* AUP = (bf16*)(ws + WS_AUP);
        if (!FHG) { const float* ORAW = (const float*)(ws + WS_TMPF); const bf16* OG = (const bf16*)(ws + WS_OG); const float* ng = args.in[I_HNG];
          for (int it = gw; it < T * NH; it += NGW) { const int t = it >> 3, h = it & 7; const size_t off = (size_t)t * HW + h * HD + 2 * lane;
              const f32x2 o = *(const f32x2*)(ORAW + off); const float r = 1.0f / sqrtf(wave_sum(o.x * o.x + o.y * o.y) * (1.f / HD) + EPS);
              const unsigned og = *(const unsigned*)(OG + off);
              *(unsigned*)(AUP + (size_t)t * D + h * HD + 2 * lane) = pk2(o.x * r * ng[2 * lane] * bflo(og), o.y * r * ng[2 * lane + 1] * bfhi(og)); } }
        LAS float* qs = (LAS float*)F.lds + 32768 / 4 + wave * 1280; LAS float* sc = qs + 128;
        const bf16* MQ = (const bf16*)(ws + WS_MQ); const bf16* MK = (const bf16*)(ws + WS_MK); const bf16* MV = (const bf16*)(ws + WS_MV); const float* KM = (const float*)(ws + WS_KMEAN);
        const float scale = 0.08838834764831845f;
        if (FMB != 1) for (int it = gw; it < T * NH; it += NGW) {
            const int t = it >> 3, h = it & 7, cur = t >> 8;
            { const unsigned qw = *(const unsigned*)(MQ + (size_t)t * HW + h * HD + 2 * lane); qs[2 * lane] = bflo(qw); qs[2 * lane + 1] = bfhi(qw); }
            LDS_WAIT();
            float gate = -3.0e38f;
            if (lane < NB) { gate = -1e30f; if (lane < cur) { float s0 = 0.f, s1 = 0.f; const f32x4* ka = (const f32x4*)(KM + (size_t)lane * HW + h * HD); const f32x4* kb = (const f32x4*)(KM + (size_t)(NB + lane) * HW + h * HD);
#pragma unroll
                    for (int d4 = 0; d4 < 32; ++d4) { const f32x4 a = ka[d4], b2 = kb[d4]; const LAS float* q4 = qs + 4 * d4;
                        s0 += q4[0] * (a.x + b2.x) + q4[1] * (a.y + b2.y); s1 += q4[2] * (a.z + b2.z) + q4[3] * (a.w + b2.w); }
                    gate = (s0 + s1) * (1.f / BS); } }
            int blk[4]; bool val[4]; blk[0] = cur; val[0] = true;
#pragma unroll
            for (int r = 0; r < 3; ++r) { const float mxg = wave_max(gate); const unsigned long long bm = __ballot(gate == mxg); const int sel = __ffsll((long long)bm) - 1;
                blk[r + 1] = sel; val[r + 1] = sel < cur; if (lane == sel) gate = -3.0e38f; }
            float mx = -3.0e38f;
#pragma unroll
            for (int b = 0; b < 4; ++b) if (val[b]) for (int g = 0; g < 4; ++g) {
                const int key = blk[b] * BS + g * 64 + lane; const v4u* kr = (const v4u*)(MK + (size_t)key * HW + h * HD); float s = 0.f;
#pragma unroll
                for (int c = 0; c < 16; ++c) { const v4u kw = kr[c]; const LAS float* q8 = qs + c * 8;
                    s += q8[0] * bflo(kw.x) + q8[1] * bfhi(kw.x) + q8[2] * bflo(kw.y) + q8[3] * bfhi(kw.y) + q8[4] * bflo(kw.z) + q8[5] * bfhi(kw.z) + q8[6] * bflo(kw.w) + q8[7] * bfhi(kw.w); }
                s = (b == 0 && key > t) ? -1e30f : s * scale; sc[b * 256 + g * 64 + lane] = s; mx = fmaxf(mx, s); }
            mx = wave_max(mx); float l = 0.f;
#pragma unroll
            for (int b = 0; b < 4; ++b) if (val[b]) for (int g = 0; g < 4; ++g) { const int i = b * 256 + g * 64 + lane; const float p = __expf(sc[i] - mx); sc[i] = p; l += p; }
            l = wave_sum(l); LDS_WAIT();
            float o0 = 0.f, o1 = 0.f;
#pragma unroll
            for (int b = 0; b < 4; ++b) if (val[b]) { const bf16* vb = MV + (size_t)(blk[b] * BS) * HW + h * HD + 2 * lane;
                float a0 = 0.f, a1 = 0.f, c0 = 0.f, c1 = 0.f;
#pragma unroll 1
                for (int k = 0; k < 256; k += 16) { unsigned vw[16];
#pragma unroll
                    for (int u = 0; u < 16; ++u) vw[u] = *(const unsigned*)(vb + (size_t)(k + u) * HW);
#pragma unroll
                    for (int u = 0; u < 16; u += 2) { const float p0 = sc[b * 256 + k + u], p1 = sc[b * 256 + k + u + 1];
                        a0 += p0 * bflo(vw[u]); a1 += p0 * bfhi(vw[u]); c0 += p1 * bflo(vw[u + 1]); c1 += p1 * bfhi(vw[u + 1]); } }
                o0 += a0 + c0; o1 += a1 + c1; }
            const float il = 1.0f / l;
            *(unsigned*)(AUP + (size_t)t * D + HW + h * HD + 2 * lane) = pk2(o0 * il, o1 * il);
            LDS_WAIT();
        }
    }
    SEAM(4);

    if (IN(5) && FP5) {
        pg8::StaticOrder S; S.init(T, D, F.G, (int)blockIdx.x);
        { pg8::Gemm g{(const bf16*)(ws + WS_AUP), (const bf16*)(ws + WS_WUP_T), D, D, D}; pg8::EpiUp2 E{(const bf16*)(ws + WS_GA), (const bf16*)(ws + WS_GB), (bf16*)(ws + WS_MERGED)};
          pg8::gemm_phase<pg8::EpiUp2, pg8::StaticOrder, false, PG8_SP2>(F.lds, g, S, E); }
    }
    if (IN(5) && !FP5) {
        TVARS
        const bf16* AUP = (const bf16*)(ws + WS_AUP); const bf16* GA = (const bf16*)(ws + WS_GA); const bf16* GB = (const bf16*)(ws + WS_GB); bf16* MG = (bf16*)(ws + WS_MERGED);
        for (int it = F.vcu; it < (T / 128) * (D / 128); it += F.G) {
            const int tm = it / (D / 128), tn = it % (D / 128), tx = tid & 31, ty = tid >> 5;
            float a1[8][4], a2[8][4]; zero_acc(a1); zero_acc(a2);
            sgemm_acc(a1, As, Bs, AUP, D, tm * 128, args.in[I_WUH], D, tn * 128, HW, tid);
            sgemm_acc(a2, As, Bs, AUP + HW, D, tm * 128, args.in[I_WUM], D, tn * 128, HW, tid);
#pragma unroll
            for (int i = 0; i < 8; ++i) { const size_t off = (size_t)(tm * 128 + ty * 8 + i) * D + tn * 128 + tx * 4;
                const v2u ga = *(const v2u*)(GA + off), gb = *(const v2u*)(GB + off);
                st_bf16x4(MG + off, bflo(ga.x) * a1[i][0] + bflo(gb.x) * a2[i][0], bfhi(ga.x) * a1[i][1] + bfhi(gb.x) * a2[i][1],
                          bflo(ga.y) * a1[i][2] + bflo(gb.y) * a2[i][2], bfhi(ga.y) * a1[i][3] + bfhi(gb.y) * a2[i][3]); }
        }
    }
    SEAM(5);

    if (IN(6) && FP6) {
        pg8::Gemm g{(const bf16*)(ws + WS_MERGED), (const bf16*)(ws + WS_WOUT_T), D, D, D}; pg8::StaticOrder S; S.init(T, D, F.G, (int)blockIdx.x);
        pg8::EpiResidB<0> E{x, nullptr, nullptr, (bf16*)(ws + WS_XR)};
        pg8::gemm_phase<pg8::EpiResidB<0>, pg8::StaticOrder, false, PG8_SP2>(F.lds, g, S, E);
    }
    if (IN(6) && !FP6) {
        TVARS
        const bf16* MG = (const bf16*)(ws + WS_MERGED);
        for (int it = F.vcu; it < (T / 128) * (D / 128); it += F.G) {
            const int tm = it / (D / 128), tn = it % (D / 128), tx = tid & 31, ty = tid >> 5;
            float acc[8][4]; zero_acc(acc);
            sgemm_acc(acc, As, Bs, MG, D, tm * 128, args.in[I_WOUT], D, tn * 128, D, tid);
#pragma unroll
            for (int i = 0; i < 8; ++i) { const size_t off = (size_t)(tm * 128 + ty * 8 + i) * D + tn * 128 + tx * 4; const f32x4 xv = *(const f32x4*)(x + off);
                f32x4 o; o.x = xv.x + acc[i][0]; o.y = xv.y + acc[i][1]; o.z = xv.z + acc[i][2]; o.w = xv.w + acc[i][3]; *(f32x4*)(out + off) = o; }
        }
    }
    SEAM(6);

    if (IN(7)) {
        TVARS
        auto conv7 = [&]() { LAS float* scr = (LAS float*)(F.lds + wave * 16384);
          auto item7 = [&](int it) -> TrItem { TrItem q; const int e = it >> 10, r = it & 1023, kb = r >> 5, n0 = (r & 31) * 32, pnl = n0 >> 8, bj = (n0 >> 7) & 1, q0 = n0 & 127;
              q.src = (bj ? args.in[I_WEU] : args.in[I_WEG]) + (size_t)e * D * DE + (size_t)(kb * 64) * DE + pnl * 128 + q0; q.ldw = DE;
              q.dst = (bf16*)(ws + WS_WEGU) + (size_t)e * 1024 * D + (size_t)n0 * D + kb * 64; q.ldt = D; q.gk = args.in[I_NFFN] + kb * 64; return q; };
          TR_PIPE(gw, NE * 1024, NGW, item7); };
        const bool conv_first = (F.vcu & 1) == 0;
        if (conv_first) conv7();
        const float* gff = args.in[I_NFFN]; const float* wrt = (const float*)(ws + WS_WRT);
        int* EID = (int*)(ws + WS_ROUTE); int* POS = EID + 2 * T; float* RW = (float*)(POS + 2 * T);
        __syncthreads();
        LAS float* part = (LAS float*)F.lds; LAS float* lgt = (LAS float*)(F.lds + 49152); LAS float* rsc = (LAS float*)(F.lds + 57344);
        for (int rb = F.vcu; rb < T / 32; rb += F.G) { const int r0 = rb * 32;
            for (int i4 = 0; i4 < 4; ++i4) { const int m = r0 + 4 * wave + i4;
                const v2u* xr = (const v2u*)((const bf16*)(ws + WS_XR) + (size_t)m * D) + lane; const f32x4* gr = (const f32x4*)gff + lane;
                f32x4 v[8]; float s = 0.f;
#pragma unroll
                for (int j = 0; j < 8; ++j) { const v2u w2 = xr[64 * j]; v[j].x = bflo(w2.x); v[j].y = bfhi(w2.x); v[j].z = bflo(w2.y); v[j].w = bfhi(w2.y); s += (v[j].x * v[j].x + v[j].y * v[j].y) + (v[j].z * v[j].z + v[j].w * v[j].w); }
                const float r = 1.0f / sqrtf(wave_sum(s) * (1.f / D) + EPS);
                if (lane == 0) { rsc[4 * wave + i4] = r; ((float*)(ws + WS_RN + 262144))[m] = r; } }
            { const int fr = lane & 15, fq = lane >> 4;
              f32x4 acc[2][3];
#pragma unroll
              for (int rt = 0; rt < 2; ++rt)
#pragma unroll
                  for (int ct = 0; ct < 3; ++ct) acc[rt][ct] = (f32x4){0.f, 0.f, 0.f, 0.f};
              const bf16* xa = (const bf16*)(ws + WS_XR) + (size_t)(r0 + fr) * D + wave * 256 + 4 * fq;
              const float* wb = wrt + (size_t)fr * D + wave * 256 + 4 * fq;
              const float* wb2 = wrt + (size_t)((32 + fr) > 35 ? 35 : (32 + fr)) * D + wave * 256 + 4 * fq;
#pragma unroll 2
              for (int j = 0; j < 16; ++j) {
                  const v2u aw0 = *(const v2u*)(xa + 16 * j), aw1 = *(const v2u*)(xa + (size_t)16 * D + 16 * j);
                  const f32x4 a0 = {bflo(aw0.x), bfhi(aw0.x), bflo(aw0.y), bfhi(aw0.y)}, a1 = {bflo(aw1.x), bfhi(aw1.x), bflo(aw1.y), bfhi(aw1.y)};
                  const f32x4 b0 = *(const f32x4*)(wb + 16 * j), b1 = *(const f32x4*)(wb + (size_t)16 * D + 16 * j), b2 = *(const f32x4*)(wb2 + 16 * j);
#pragma unroll
                  for (int q = 0; q < 4; ++q) {
                      acc[0][0] = __builtin_amdgcn_mfma_f32_16x16x4f32(a0[q], b0[q], acc[0][0], 0, 0, 0); acc[0][1] = __builtin_amdgcn_mfma_f32_16x16x4f32(a0[q], b1[q], acc[0][1], 0, 0, 0);
                      acc[0][2] = __builtin_amdgcn_mfma_f32_16x16x4f32(a0[q], b2[q], acc[0][2], 0, 0, 0); acc[1][0] = __builtin_amdgcn_mfma_f32_16x16x4f32(a1[q], b0[q], acc[1][0], 0, 0, 0);
                      acc[1][1] = __builtin_amdgcn_mfma_f32_16x16x4f32(a1[q], b1[q], acc[1][1], 0, 0, 0); acc[1][2] = __builtin_amdgcn_mfma_f32_16x16x4f32(a1[q], b2[q], acc[1][2], 0, 0, 0); } }
#pragma unroll
              for (int rt = 0; rt < 2; ++rt)
#pragma unroll
                  for (int ct = 0; ct < 3; ++ct)
#pragma unroll
                      for (int q = 0; q < 4; ++q) part[(wave * 32 + 16 * rt + 4 * fq + q) * 48 + 16 * ct + fr] = acc[rt][ct][q]; }
            __syncthreads();
            for (int o = tid; o < 32 * 36; o += NTHR) { const int row = o / 36, c = o - row * 36; float sum = 0.f;
#pragma unroll
                for (int w8 = 0; w8 < 8; ++w8) sum += part[(w8 * 32 + row) * 48 + c];
                lgt[row * 40 + c] = sum * rsc[row]; }
            __syncthreads();
            if (tid < 32) { const int m = r0 + tid;
                float lg[36];
#pragma unroll
                for (int c = 0; c < 36; ++c) lg[c] = lgt[tid * 40 + c];
                int gs = 0; float gm = lg[0];
#pragma unroll
                for (int c = 1; c < 4; ++c) if (lg[c] > gm) { gm = lg[c]; gs = c; }
                float gsum = 0.f;
#pragma unroll
                for (int c = 0; c < 4; ++c) gsum += expf(lg[c] - gm);
                const float pg = 1.0f / gsum;
                float el[8];
#pragma unroll
                for (int c = 0; c < 8; ++c) el[c] = (gs == 0) ? lg[4 + c] : (gs == 1) ? lg[12 + c] : (gs == 2) ? lg[20 + c] : lg[28 + c];
                int i1 = 0; float m1 = el[0];
#pragma unroll
                for (int c = 1; c < 8; ++c) if (el[c] > m1) { m1 = el[c]; i1 = c; }
                int i2 = -1; float m2 = -3.0e38f;
#pragma unroll
                for (int c = 0; c < 8; ++c) if (c != i1 && el[c] > m2) { m2 = el[c]; i2 = c; }
                if (i2 < 0) i2 = (i1 == 0) ? 1 : 0;
                const float e2 = expf(m2 - m1), w1 = pg / (1.0f + e2), w2 = pg * e2 / (1.0f + e2);
                const int ea = gs * 8 + i1, eb = gs * 8 + i2;
                const int pa = (int)__hip_atomic_fetch_add((unsigned*)(F.ctl + CW_ECNT) + ea, 1u, RLX_AGENT), pb = (int)__hip_atomic_fetch_add((unsigned*)(F.ctl + CW_ECNT) + eb, 1u, RLX_AGENT);
                EID[2 * m] = ea; EID[2 * m + 1] = eb; POS[2 * m] = pa; POS[2 * m + 1] = pb; RW[2 * m] = w1; RW[2 * m + 1] = w2; }
            __syncthreads();
        }
        if (!conv_first) { __syncthreads(); conv7(); }
    }
    SEAM(7);

    LAS int* pstart = (LAS int*)(F.lds + LDSCTL_OFF);
    if (hi > 8 && lo <= 10) {
        if (threadIdx.x == 0) { int a = 0; for (int e = 0; e < NE; ++e) { pstart[e] = a; const int c = (int)__hip_atomic_load((unsigned*)(F.ctl + CW_ECNT) + e, RLX_AGENT); pstart[40 + e] = c; a += (c + 255) / 256 * 256; } pstart[NE] = a; }
        __syncthreads();
    }

    if (IN(8)) {
        TVARS
        const int* EID = (const int*)(ws + WS_ROUTE); const int* POS = EID + 2 * T; int* rs = (int*)(ws + WS_ROWSLOT);
        for (int s = gt; s < 2 * T; s += NGT) { const int dest = pstart[EID[s]] + POS[s];
            ((int*)(ws + WS_RN + 393216))[dest] = s >> 1; __hip_atomic_store(rs + dest, s, RLX_AGENT); ((float*)(ws + WS_RN + 65536))[dest] = ((const float*)(ws + WS_RN + 262144))[s >> 1]; }
    }
    SEAM(8);

    if (IN(9) && FP9) {
        pg8::Gemm g{(const bf16*)(ws + WS_XR), (const bf16*)(ws + WS_WEGU), D, D, D}; pg8::MoeOrder S{(const LAS int*)pstart, 4, F.G, (int)blockIdx.x}; pg8::EpiMoe1 E{(bf16*)(ws + WS_HMOE), (const float*)(ws + WS_RN + 65536), (const int*)(ws + WS_RN + 393216)};
        pg8::gemm_phase<pg8::EpiMoe1, pg8::MoeOrder, PG8_ALIGN, PG8_SP2>(F.lds, g, S, E);
        { TVARS
          const int nun = (pstart[NE] >> 8) * 4, nbusy = nun > F.G ? nun - F.G : 0, c = (int)blockIdx.x;
          __syncthreads();
          if (c >= nbusy) { const int nh = F.G - nbusy, hr = c - nbusy; LAS float* scr = (LAS float*)(F.lds + wave * 16384);
              auto item9 = [&](int it) -> TrItem { TrItem q; q.gk = nullptr; const int e = it >> 9, r2 = it & 511, kb = r2 >> 6, nb = r2 & 63;
                  q.src = args.in[I_WED] + (size_t)e * DE * D + (size_t)(kb * 64) * D + nb * 32; q.ldw = D; q.dst = (bf16*)(ws + WS_WED) + (size_t)e * D * DE + (size_t)(nb * 32) * DE + kb * 64; q.ldt = DE; return q; };
              TR_PIPE(hr * NWAVES + wave, NE * 512, nh * NWAVES, item9); } }
    }
    if (IN(9) && !FP9) {
        TVARS
        const int ntile = pstart[NE] / 128;
        for (int it = F.vcu; it < ntile * (DE / 128); it += F.G) {
            const int tm = it / (DE / 128), tn = it % (DE / 128), tx = tid & 31, ty = tid >> 5; int e = 0;
            for (int q = 1; q < NE; ++q) if (pstart[q] <= tm * 128) e = q;
            float a1[8][4], a2[8][4]; zero_acc(a1); zero_acc(a2);
            sgemm_acc(a1, As, Bs, (const bf16*)(ws + WS_XG), D, tm * 128, args.in[I_WEG] + (size_t)e * D * DE, DE, tn * 128, D, tid);
            sgemm_acc(a2, As, Bs, (const bf16*)(ws + WS_XG), D, tm * 128, args.in[I_WEU] + (size_t)e * D * DE, DE, tn * 128, D, tid);
#pragma unroll
            for (int i = 0; i < 8; ++i) st_bf16x4((bf16*)(ws + WS_HMOE) + (size_t)(tm * 128 + ty * 8 + i) * DE + tn * 128 + tx * 4,
                siluf_(a1[i][0]) * a2[i][0], siluf_(a1[i][1]) * a2[i][1], siluf_(a1[i][2]) * a2[i][2], siluf_(a1[i][3]) * a2[i][3]);
        }
    }
    SEAM(9);

    if (IN(10) && FP10) {
        pg8::Gemm g{(const bf16*)(ws + WS_HMOE), (const bf16*)(ws + WS_WED), DE, DE, DE}; pg8::MoeOrder S{(const LAS int*)pstart, 8, F.G, (int)blockIdx.x}; pg8::EpiMoe2 E{(bf16*)(ws + WS_Y), (const int*)(ws + WS_ROWSLOT), (const LAS int*)pstart};
        pg8::gemm_phase<pg8::EpiMoe2, pg8::MoeOrder, PG8_ALIGN, PG8_SP2>(F.lds, g, S, E);
    }
    if (IN(10) && !FP10) {
        TVARS
        const int ntile = pstart[NE] / 128; const int* rs = (const int*)(ws + WS_ROWSLOT);
        for (int it = F.vcu; it < ntile * (D / 128); it += F.G) {
            const int tm = it / (D / 128), tn = it % (D / 128), tx = tid & 31, ty = tid >> 5; int e = 0;
            for (int q = 1; q < NE; ++q) if (pstart[q] <= tm * 128) e = q;
            float acc[8][4]; zero_acc(acc);
            sgemm_acc(acc, As, Bs, (const bf16*)(ws + WS_HMOE), DE, tm * 128, args.in[I_WED] + (size_t)e * DE * D, D, tn * 128, DE, tid);
#pragma unroll
            for (int i = 0; i < 8; ++i) { const int prow = tm * 128 + ty * 8 + i;
                if (prow - pstart[e] < pstart[40 + e]) st_bf16x4((bf16*)(ws + WS_Y) + (size_t)__hip_atomic_load((int*)rs + prow, RLX_AGENT) * D + tn * 128 + tx * 4, acc[i][0], acc[i][1], acc[i][2], acc[i][3]); }
        }
    }
    SEAM(10);

    if (IN(11)) {
        TVARS
        const float* gpl = args.in[I_NPLE]; const float* RW = (const float*)((const int*)(ws + WS_ROUTE) + 4 * T);
        for (int m = gw; m < T; m += NGW) {
            v2u* xr = (v2u*)((bf16*)(ws + WS_XR) + (size_t)m * D) + lane; const f32x4* gr = (const f32x4*)gpl + lane;
            const v2u* ya = (const v2u*)((const bf16*)(ws + WS_Y) + (size_t)(2 * m) * D) + lane; const v2u* yb = (const v2u*)((const bf16*)(ws + WS_Y) + (size_t)(2 * m + 1) * D) + lane;
            const float wa = RW[2 * m], wb = RW[2 * m + 1];
            f32x4 v[8]; float s = 0.f;
#pragma unroll
            for (int j = 0; j < 8; ++j) { const v2u w2 = xr[64 * j]; v[j].x = bflo(w2.x); v[j].y = bfhi(w2.x); v[j].z = bflo(w2.y); v[j].w = bfhi(w2.y); }
            v2u ay[8], by[8];
#pragma unroll
            for (int j = 0; j < 8; ++j) { ay[j] = ya[64 * j]; by[j] = yb[64 * j]; }
#pragma unroll
            for (int j = 0; j < 8; ++j) { const v2u a = ay[j], b = by[j];
                v[j].x += bflo(a.x) * wa + bflo(b.x) * wb; v[j].y += bfhi(a.x) * wa + bfhi(b.x) * wb; v[j].z += bflo(a.y) * wa + bflo(b.y) * wb; v[j].w += bfhi(a.y) * wa + bfhi(b.y) * wb;
                { v2u w2; w2.x = pk2(v[j].x, v[j].y); w2.y = pk2(v[j].z, v[j].w); xr[64 * j] = w2; } s += (v[j].x * v[j].x + v[j].y * v[j].y) + (v[j].z * v[j].z + v[j].w * v[j].w); }
            const float r = 1.0f / sqrtf(wave_sum(s) * (1.f / D) + EPS);
            if (lane == 0) ((float*)(ws + WS_RN))[m] = r;
        }
    }
    SEAM(11);

    if (IN(12) && FP12) {
        pg8::Gemm g{(const bf16*)(ws + WS_XR), (const bf16*)(ws + WS_WPG_T), D, D, D}; pg8::StaticOrder S; S.init(T, D, F.G, (int)blockIdx.x);
        pg8::EpiResidB<1> E{(const float*)(ws + WS_RN), (const bf16*)(ws + WS_XR), (const bf16*)(ws + WS_PP), (bf16*)(ws + WS_HP)};
        pg8::gemm_phase<pg8::EpiResidB<1>, pg8::StaticOrder, false, PG8_SP2>(F.lds, g, S, E);
    }
    if (IN(12) && !FP12) {
        TVARS
        const bf16* HP = (const bf16*)(ws + WS_HP); const bf16* PP = (const bf16*)(ws + WS_PP);
        for (int it = F.vcu; it < (T / 128) * (D / 128); it += F.G) {
            const int tm = it / (D / 128), tn = it % (D / 128), tx = tid & 31, ty = tid >> 5;
            float acc[8][4]; zero_acc(acc);
            sgemm_acc(acc, As, Bs, HP, D, tm * 128, args.in[I_WPG], D, tn * 128, D, tid);
#pragma unroll
            for (int i = 0; i < 8; ++i) { const size_t off = (size_t)(tm * 128 + ty * 8 + i) * D + tn * 128 + tx * 4; const f32x4 xv = *(const f32x4*)(out + off); const v2u pp = *(const v2u*)(PP + off);
                f32x4 o; o.x = xv.x + sigmoidf_(acc[i][0]) * bflo(pp.x); o.y = xv.y + sigmoidf_(acc[i][1]) * bfhi(pp.x); o.z = xv.z + sigmoidf_(acc[i][2]) * bflo(pp.y); o.w = xv.w + sigmoidf_(acc[i][3]) * bfhi(pp.y);
                *(f32x4*)(out + off) = o; }
        }
    }
    SEAM(12);

    if (IN(13)) {
        TVARS
        const float* gf = args.in[I_NFIN];
        for (int m = gw; m < T; m += NGW) {
            f32x4* xr = (f32x4*)(out + (size_t)m * D) + lane; const f32x4* gr = (const f32x4*)gf + lane; const v2u* xb = (const v2u*)((const bf16*)(ws + WS_HP) + (size_t)m * D) + lane;
            f32x4 v[8]; float s = 0.f;
#pragma unroll
            for (int j = 0; j < 8; ++j) { const v2u w2 = xb[64 * j]; v[j].x = bflo(w2.x); v[j].y = bfhi(w2.x); v[j].z = bflo(w2.y); v[j].w = bfhi(w2.y); s += (v[j].x * v[j].x + v[j].y * v[j].y) + (v[j].z * v[j].z + v[j].w * v[j].w); }
            f32x4 g8[8];
#pragma unroll
            for (int j = 0; j < 8; ++j) g8[j] = gr[64 * j];
            const float r = 1.0f / sqrtf(wave_sum(s) * (1.f / D) + EPS);
#pragma unroll
            for (int j = 0; j < 8; ++j) { const f32x4 gg = g8[j]; f32x4 o; o.x = v[j].x * r * gg.x; o.y = v[j].y * r * gg.y; o.z = v[j].z * r * gg.z; o.w = v[j].w * r * gg.w; xr[64 * j] = o; }
        }
    }
#undef IN
#undef SEAM
}

extern "C" void kernel_launch(void* const* d_in, const int* in_sizes, int n_in, void* d_out, int out_size, void* d_ws, size_t ws_size, hipStream_t stream) {
    static int grid = 0;
    if (grid == 0) {
        if (n_in != 19 || in_sizes[0] != T * D || out_size != T * D || ws_size < WS_END) { fprintf(stderr, "kernel_launch: shape/workspace mismatch: n_in %d in0 %d out %d ws %zu (need %zu)\n", n_in, n_in > 0 ? in_sizes[0] : -1, out_size, ws_size, (size_t)WS_END); grid = -1; return; }
        int dev = 0, cus = 0, per_cu = 0;
        if (hipGetDevice(&dev) != hipSuccess || hipDeviceGetAttribute(&cus, hipDeviceAttributeMultiprocessorCount, dev) != hipSuccess) { grid = -1; return; }
        if (hipFuncSetAttribute((const void*)fwd, hipFuncAttributeMaxDynamicSharedMemorySize, LDS_BYTES) != hipSuccess) { fprintf(stderr, "kernel_launch: hipFuncSetAttribute failed\n"); grid = -1; return; }
        if (hipOccupancyMaxActiveBlocksPerMultiprocessor(&per_cu, (const void*)fwd, NTHR, LDS_BYTES) != hipSuccess || per_cu < 1) { fprintf(stderr, "kernel_launch: occupancy query says %d blocks per CU\n", per_cu); (void)hipGetLastError(); grid = -1; return; }
        grid = cus;
    }
    if (grid < 0) return;
    if (hipMemsetAsync((char*)d_ws + WS_CTL, 0, CTL_ZERO_BYTES, stream) != hipSuccess) return;
    Args a{};
    for (int i = 0; i < 19; ++i) a.in[i] = (const float*)d_in[i];
    a.out = (float*)d_out; a.ws = (unsigned char*)d_ws; a.pad = MBRT;
    for (int j = 0; j < 64; ++j) a.rfreq[j] = std::pow(10000.0, -(double)j / 64.0) / 6.283185307179586476925286766559;
    constexpr int NL = MK_N_LAUNCHES;
    for (int li = 0; li < NL; ++li) {
        a.ph_lo = (NL == 1) ? 0 : li; a.ph_hi = (NL == 1) ? N_PHASES : li + 1; a.li = 0;
        hipLaunchKernelGGL(fwd, dim3(grid), dim3(NTHR), LDS_BYTES, stream, a);
    }
}
```
